# Optimizing an MI355X kernel written in HIP

```python
import math
import jax, jax.numpy as jnp
from jax import lax
import numpy as np

D_MODEL = 1024
BATCH = 4
SEQ = 4096
DEPTH = 1

SSM_HEAD_DIM = 64
D_SSM = D_MODEL
SSM_HEADS = D_SSM // SSM_HEAD_DIM
SSM_GROUPS = 4
D_STATE = 128
CONV_K = 4
CONV_CH = D_SSM + 2 * SSM_GROUPS * D_STATE
CHUNK = 128
ATT_HEAD_DIM = 64
D_ATT = D_MODEL
ATT_HEADS = D_ATT // ATT_HEAD_DIM
KV_HEADS = ATT_HEADS // 4
Q_PER_KV = ATT_HEADS // KV_HEADS
D_KV = KV_HEADS * ATT_HEAD_DIM
D_MIX = D_SSM + D_ATT
WINDOW = 128
ATT_BLOCK = 128
REL_BUCKETS = 32
REL_MAX_DIST = 128
IN_COLS = D_SSM + CONV_CH + SSM_HEADS + D_ATT + 2 * D_KV
N_EXPERTS = 64
TOP_K = 8
EXPERT_DIM = D_MODEL // 4
SHARED_DIM = D_MODEL // 4
ROUTE_GROUPS = 8
ROUTE_TOPK_GROUPS = 4
ROUTED_SCALE = 2.5
MOE_BLOCK = 128
EPS = 1e-6

kernel_name = 'hybrid_ssd_swa_sink_moe_block'


def rms_norm(x, g):
    xf = x.astype(jnp.float32)
    y = xf * lax.rsqrt(jnp.mean(xf * xf, axis=-1, keepdims=True) + EPS)
    return (y * g.astype(jnp.float32)).astype(x.dtype)


def causal_depthwise_conv(u, w, b):
    out = lax.conv_general_dilated(u, w[:, None, :].astype(u.dtype), window_strides=(1,),
                                   padding=[(CONV_K - 1, 0)], dimension_numbers=('NWC', 'WIO', 'NWC'),
                                   feature_group_count=u.shape[-1])
    return out + b.astype(u.dtype)


def ssd_scan(xs, Bm, Cm, dt_raw, dt_bias, a_log, d_skip):
    f32 = jnp.float32
    Bsz, L, _ = xs.shape
    nc = L // CHUNK
    R = SSM_HEADS // SSM_GROUPS
    dt = jax.nn.softplus(dt_raw.astype(f32) + dt_bias.astype(f32))
    A = -jnp.exp(a_log.astype(f32))
    x = xs.astype(f32).reshape(Bsz, L, SSM_HEADS, SSM_HEAD_DIM)
    Xd = x.reshape(Bsz, nc, CHUNK, SSM_GROUPS, R, SSM_HEAD_DIM) * dt.reshape(Bsz, nc, CHUNK, SSM_GROUPS, R)[..., None]
    a = jnp.moveaxis((dt * A).reshape(Bsz, nc, CHUNK, SSM_GROUPS, R), 2, -1)
    cs = jnp.cumsum(a, axis=-1)
    Bc = Bm.astype(f32).reshape(Bsz, nc, CHUNK, SSM_GROUPS, D_STATE)
    Cc = Cm.astype(f32).reshape(Bsz, nc, CHUNK, SSM_GROUPS, D_STATE)
    causal = jnp.tril(jnp.ones((CHUNK, CHUNK), dtype=bool))
    Lmat = jnp.exp(jnp.where(causal, cs[..., :, None] - cs[..., None, :], -jnp.inf))
    CB = jnp.einsum('bclgn,bcsgn->bcgls', Cc, Bc)
    y_diag = jnp.einsum('bcgls,bcgrls,bcsgrp->bclgrp', CB, Lmat, Xd)
    decay_states = jnp.exp(cs[..., -1:] - cs)
    chunk_states = jnp.einsum('bclgn,bcgrl,bclgrp->bcgrpn', Bc, decay_states, Xd)
    chunk_decay = jnp.exp(cs[..., -1])

    def step(state, inp):
        s_c, d_c = inp
        return state * d_c[..., None, None] + s_c, state

    init = jnp.zeros((Bsz, SSM_GROUPS, R, SSM_HEAD_DIM, D_STATE), f32)
    _, states_in = lax.scan(step, init, (jnp.moveaxis(chunk_states, 1, 0), jnp.moveaxis(chunk_decay, 1, 0)))
    states_in = jnp.moveaxis(states_in, 0, 1)
    y_off = jnp.einsum('bclgn,bcgrpn,bcgrl->bclgrp', Cc, states_in, jnp.exp(cs))
    y = (y_diag + y_off).reshape(Bsz, L, SSM_HEADS, SSM_HEAD_DIM) + x * d_skip.astype(f32)[:, None]
    return y.reshape(Bsz, L, D_SSM)


def t5_causal_bucket(dist):
    max_exact = REL_BUCKETS // 2
    d = jnp.maximum(dist, 1).astype(jnp.float32)
    large = max_exact + (jnp.log(d / max_exact) / math.log(REL_MAX_DIST / max_exact)
                         * (REL_BUCKETS - max_exact)).astype(jnp.int32)
    large = jnp.minimum(large, REL_BUCKETS - 1)
    return jnp.where(dist < max_exact, dist, large)


def sliding_window_attention(q, k, v, sinks, rel_bias):
    f32 = jnp.float32
    Bsz, L, _ = q.shape
    nb = L // ATT_BLOCK
    qb = q.reshape(Bsz, nb, ATT_BLOCK, KV_HEADS, Q_PER_KV, ATT_HEAD_DIM)

    def band(t):
        tp = jnp.pad(t.reshape(Bsz, L, KV_HEADS, ATT_HEAD_DIM), ((0, 0), (ATT_BLOCK, 0), (0, 0), (0, 0)))
        tp = tp.reshape(Bsz, nb + 1, ATT_BLOCK, KV_HEADS, ATT_HEAD_DIM)
        return jnp.concatenate([tp[:, :-1], tp[:, 1:]], axis=2)

    kb, vb = band(k), band(v)
    qi = jnp.arange(ATT_BLOCK)[:, None]
    sj = jnp.arange(2 * ATT_BLOCK)[None, :]
    dist = qi + ATT_BLOCK - sj
    in_win = (dist >= 0) & (dist < WINDOW)
    key_abs = jnp.arange(nb)[:, None, None] * ATT_BLOCK - ATT_BLOCK + sj[None]
    mask = in_win[None] & (key_abs >= 0)
    bias = rel_bias.astype(f32)[t5_causal_bucket(jnp.maximum(dist, 0))]
    bias = bias.transpose(2, 0, 1).reshape(KV_HEADS, Q_PER_KV, ATT_BLOCK, 2 * ATT_BLOCK)
    s = jnp.einsum('bnqkgd,bnskd->bnkgqs', qb, kb).astype(f32) * (ATT_HEAD_DIM ** -0.5) + bias
    s = jnp.where(mask[None, :, None, None], s, -jnp.inf)
    sink = sinks.astype(f32).reshape(KV_HEADS, Q_PER_KV)[None, None, :, :, None, None]
    m = jnp.maximum(jnp.max(s, axis=-1, keepdims=True), sink)
    p = jnp.exp(s - m)
    p = p / (jnp.sum(p, axis=-1, keepdims=True) + jnp.exp(sink - m))
    o = jnp.einsum('bnkgqs,bnskd->bnqkgd', p.astype(v.dtype), vb)
    return o.reshape(Bsz, L, D_ATT)


def hybrid_mixer(h, w_in, conv_w, conv_b, dt_bias, a_log, d_skip, ssm_norm_g, att_norm_g, sinks, rel_bias, w_out):
    Bsz, L, _ = h.shape
    proj = h @ w_in
    i1 = D_SSM
    i2 = i1 + CONV_CH
    i3 = i2 + SSM_HEADS
    i4 = i3 + D_ATT
    i5 = i4 + D_KV
    z, xbc, dt_raw, q, k, v = jnp.split(proj, [i1, i2, i3, i4, i5], axis=-1)
    xbc = jax.nn.silu(causal_depthwise_conv(xbc, conv_w, conv_b))
    xs, Bm, Cm = jnp.split(xbc, [D_SSM, D_SSM + SSM_GROUPS * D_STATE], axis=-1)
    y = ssd_scan(xs, Bm, Cm, dt_raw, dt_bias, a_log, d_skip)
    yz = (y * jax.nn.silu(z.astype(jnp.float32))).reshape(Bsz, L, SSM_GROUPS, D_SSM // SSM_GROUPS)
    yz = yz * lax.rsqrt(jnp.mean(yz * yz, axis=-1, keepdims=True) + EPS)
    y_ssm = (yz.reshape(Bsz, L, D_SSM) * ssm_norm_g.astype(jnp.float32)).astype(h.dtype)
    y_att = rms_norm(sliding_window_attention(q, k, v, sinks, rel_bias), att_norm_g)
    return jnp.concatenate([y_ssm, y_att], axis=-1) @ w_out


def moe_ffn(h, router_w, router_bias, exp_w_gate, exp_w_up, exp_w_down, sh_w_gate, sh_w_up, sh_w_down):
    f32 = jnp.float32
    N = h.shape[0]
    scores = jax.nn.sigmoid(h.astype(f32) @ router_w.astype(f32))
    sel = scores + router_bias.astype(f32)
    per_group = N_EXPERTS // ROUTE_GROUPS
    grp_score = lax.top_k(sel.reshape(N, ROUTE_GROUPS, per_group), 2)[0].sum(-1)
    _, gidx = lax.top_k(grp_score, ROUTE_TOPK_GROUPS)
    gmask = jax.nn.one_hot(gidx, ROUTE_GROUPS, dtype=f32).sum(1)
    allowed = jnp.repeat(gmask, per_group, axis=1) > 0
    _, idx = lax.top_k(jnp.where(allowed, sel, -jnp.inf), TOP_K)
    w = jnp.take_along_axis(scores, idx, axis=1)
    gates = w / jnp.sum(w, axis=-1, keepdims=True) * ROUTED_SCALE

    A = N * TOP_K
    NB = (A + N_EXPERTS * (MOE_BLOCK - 1) + MOE_BLOCK - 1) // MOE_BLOCK
    P = NB * MOE_BLOCK
    flat_e = idx.reshape(-1)
    flat_tok = jnp.arange(A, dtype=jnp.int32) // TOP_K
    order = jnp.argsort(flat_e)
    se, stok, sg = flat_e[order], flat_tok[order], gates.reshape(-1)[order]
    counts = jnp.bincount(flat_e, length=N_EXPERTS)
    padded = (counts + MOE_BLOCK - 1) // MOE_BLOCK * MOE_BLOCK
    pad_end = jnp.cumsum(padded)
    pad_start = pad_end - padded
    grp_start = jnp.cumsum(counts) - counts
    dest = pad_start[se] + (jnp.arange(A) - grp_start[se])
    row_tok = jnp.zeros((P,), jnp.int32).at[dest].set(stok)
    row_gate = jnp.zeros((P,), f32).at[dest].set(sg)
    block_expert = jnp.minimum(jnp.searchsorted(pad_end, jnp.arange(NB) * MOE_BLOCK, side='right'), N_EXPERTS - 1)

    def expert_block(args):
        toks, e, g = args
        xb = h[toks]
        u = jax.nn.silu(xb @ exp_w_gate[e]) * (xb @ exp_w_up[e])
        return (u @ exp_w_down[e]).astype(f32) * g[:, None]

    y_rows = lax.map(expert_block, (row_tok.reshape(NB, MOE_BLOCK), block_expert, row_gate.reshape(NB, MOE_BLOCK)))
    routed = jax.ops.segment_sum(y_rows.reshape(P, -1), row_tok, num_segments=N)
    shared = (jax.nn.silu(h @ sh_w_gate) * (h @ sh_w_up)) @ sh_w_down
    return (routed + shared.astype(f32)).astype(h.dtype)


def setup_inputs(seed: int = 0) -> dict:
    key = jax.random.key(seed)
    ks = jax.random.split(key, 26)
    f32 = jnp.float32

    def nrm(k, shape, scale):
        return jax.random.normal(k, shape, f32) * scale

    dt0 = jnp.exp(jax.random.uniform(ks[9], (DEPTH, SSM_HEADS), f32, math.log(1e-3), math.log(1e-1)))
    return {
        'x': nrm(ks[0], (BATCH, SEQ, D_MODEL), 1.0),
        'c': nrm(ks[1], (BATCH, D_MODEL), 1.0),
        'mod_w': nrm(ks[2], (DEPTH, D_MODEL, 6 * D_MODEL), 0.5 * D_MODEL ** -0.5),
        'mod_b': nrm(ks[3], (DEPTH, 6 * D_MODEL), 0.02),
        'norm1_g': 1.0 + nrm(ks[4], (DEPTH, D_MODEL), 0.02),
        'norm2_g': 1.0 + nrm(ks[5], (DEPTH, D_MODEL), 0.02),
        'w_in': nrm(ks[6], (DEPTH, D_MODEL, IN_COLS), D_MODEL ** -0.5),
        'conv_w': nrm(ks[7], (DEPTH, CONV_K, CONV_CH), CONV_K ** -0.5),
        'conv_b': nrm(ks[8], (DEPTH, CONV_CH), 0.02),
        'dt_bias': dt0 + jnp.log(-jnp.expm1(-dt0)),
        'a_log': jnp.log(jax.random.uniform(ks[10], (DEPTH, SSM_HEADS), f32, 1.0, 16.0)),
        'd_skip': 1.0 + nrm(ks[11], (DEPTH, SSM_HEADS), 0.1),
        'ssm_norm_g': 1.0 + nrm(ks[12], (DEPTH, D_SSM), 0.02),
        'att_norm_g': 1.0 + nrm(ks[13], (DEPTH, D_ATT), 0.02),
        'sinks': nrm(ks[14], (DEPTH, ATT_HEADS), 0.5),
        'rel_bias': nrm(ks[15], (REL_BUCKETS, ATT_HEADS), 0.5),
        'w_out': nrm(ks[16], (DEPTH, D_MIX, D_MODEL), D_MIX ** -0.5),
        'router_w': nrm(ks[17], (DEPTH, D_MODEL, N_EXPERTS), D_MODEL ** -0.5),
        'router_bias': nrm(ks[18], (DEPTH, N_EXPERTS), 0.01),
        'exp_w_gate': nrm(ks[19], (DEPTH, N_EXPERTS, D_MODEL, EXPERT_DIM), D_MODEL ** -0.5),
        'exp_w_up': nrm(ks[20], (DEPTH, N_EXPERTS, D_MODEL, EXPERT_DIM), D_MODEL ** -0.5),
        'exp_w_down': nrm(ks[21], (DEPTH, N_EXPERTS, EXPERT_DIM, D_MODEL), EXPERT_DIM ** -0.5),
        'sh_w_gate': nrm(ks[22], (DEPTH, D_MODEL, SHARED_DIM), D_MODEL ** -0.5),
        'sh_w_up': nrm(ks[23], (DEPTH, D_MODEL, SHARED_DIM), D_MODEL ** -0.5),
        'sh_w_down': nrm(ks[24], (DEPTH, SHARED_DIM, D_MODEL), SHARED_DIM ** -0.5),
        'final_g': 1.0 + nrm(ks[25], (D_MODEL,), 0.02),
    }


def reference(x, c, mod_w, mod_b, norm1_g, norm2_g, w_in, conv_w, conv_b, dt_bias, a_log, d_skip,
              ssm_norm_g, att_norm_g, sinks, rel_bias, w_out, router_w, router_bias, exp_w_gate, exp_w_up,
              exp_w_down, sh_w_gate, sh_w_up, sh_w_down, final_g):
    Bsz, L, D = x.shape
    for layer in range(DEPTH):
        mod = jax.nn.silu(c) @ mod_w[layer] + mod_b[layer]
        sh1, sc1, g1, sh2, sc2, g2 = [m[:, None, :] for m in jnp.split(mod, 6, axis=-1)]
        h = rms_norm(x, norm1_g[layer]) * (1.0 + sc1) + sh1
        x = x + g1 * hybrid_mixer(h, w_in[layer], conv_w[layer], conv_b[layer], dt_bias[layer], a_log[layer],
                                  d_skip[layer], ssm_norm_g[layer], att_norm_g[layer], sinks[layer], rel_bias,
                                  w_out[layer])
        h = rms_norm(x, norm2_g[layer]) * (1.0 + sc2) + sh2
        y = moe_ffn(h.reshape(Bsz * L, D), router_w[layer], router_bias[layer], exp_w_gate[layer], exp_w_up[layer],
                    exp_w_down[layer], sh_w_gate[layer], sh_w_up[layer], sh_w_down[layer])
        x = x + g2 * y.reshape(Bsz, L, D)
    return rms_norm(x, final_g)
```

```cpp
#include <hip/hip_runtime.h>
#include <stdint.h>
#include <stdio.h>

typedef unsigned short bf16_t;

constexpr int D = 1024, BATCH = 4, SEQ = 4096, M = BATCH * SEQ;
constexpr int D_SSM = 1024, SSM_HEADS = 16, SSM_GROUPS = 4, D_STATE = 128, CONV_K = 4, CONV_CH = 2048, CHUNK = 128, NCHUNK = SEQ / CHUNK;
constexpr int HD = 64, ATT_HEADS = 16, KV_HEADS = 4, D_KV = 256, WINDOW = 128;
constexpr int IN_COLS = 4624;
constexpr int C_Z = 0, C_XBC = 1024, C_DT = 3072, C_Q = 3088, C_K = 4112, C_V = 4368;
constexpr int NE = 64, TOPK = 8, ED = 256;
constexpr float EPS = 1e-6f;
constexpr int NSLOT = 9;

constexpr size_t MiB = 1u << 20;
constexpr size_t WS_CTL = 0;
constexpr size_t CTL_BYTES = 64 * 1024;
constexpr size_t WS_MOD = 1 * MiB;
constexpr size_t WS_EIDX = 2 * MiB;
constexpr size_t WS_EGATE = 3 * MiB;
constexpr size_t WS_LIST = 4 * MiB;
constexpr size_t WS_PLAN = 1 * MiB + 512 * 1024;
constexpr size_t WS_ZQ = 24 * MiB;
constexpr size_t WS_XBC = 88 * MiB;
constexpr size_t WS_K = 152 * MiB;
constexpr size_t WS_V = 160 * MiB;
constexpr size_t WS_DT = 168 * MiB;
constexpr size_t WS_CS = 169 * MiB;
constexpr size_t WS_HN = 170 * MiB;
constexpr size_t WS_S = 170 * MiB;
constexpr size_t WS_XC = 234 * MiB;
constexpr size_t WS_H2 = 24 * MiB;
constexpr size_t WS_YC = 24 * MiB;
constexpr size_t WS_U = 168 * MiB;
constexpr size_t WS_END = 300 * MiB;
constexpr int UROWS_MAX = 163840;

__device__ __forceinline__ float bf2f(bf16_t v) { return __uint_as_float(((unsigned)v) << 16); }
__device__ __forceinline__ bf16_t f2bf(float f) { unsigned u = __float_as_uint(f); return (bf16_t)((u + 0x7fffu + ((u >> 16) & 1u)) >> 16); }
__device__ __forceinline__ float silu_f(float x) { return x / (1.f + __expf(-x)); }
__device__ __forceinline__ float softplus_f(float x) { return x > 20.f ? x : log1pf(__expf(x)); }

__constant__ int c_bucket[128] = {0, 1, 2, 3, 4, 5, 6, 7, 8, 9, 10, 11, 12, 13, 14, 15, 16, 16, 16, 17, 17, 18, 18, 18, 19, 19, 19, 20, 20, 20, 20, 21, 21, 21, 21, 22, 22, 22, 22, 22, 23, 23, 23, 23, 23, 23, 24, 24, 24, 24, 24, 24, 25, 25, 25, 25, 25, 25, 25, 26, 26, 26, 26, 26, 26, 26, 26, 27, 27, 27, 27, 27, 27, 27, 27, 27, 27, 28, 28, 28, 28, 28, 28, 28, 28, 28, 28, 29, 29, 29, 29, 29, 29, 29, 29, 29, 29, 29, 29, 30, 30, 30, 30, 30, 30, 30, 30, 30, 30, 30, 30, 30, 30, 31, 31, 31, 31, 31, 31, 31, 31, 31, 31, 31, 31, 31, 31, 31};

struct P {
    const float *x, *c, *mod_w, *mod_b, *norm1_g, *norm2_g, *w_in, *conv_w, *conv_b, *dt_bias, *a_log, *d_skip, *ssm_norm_g, *att_norm_g, *sinks, *rel_bias,
        *w_out, *router_w, *router_bias, *exp_w_gate, *exp_w_up, *exp_w_down, *sh_w_gate, *sh_w_up, *sh_w_down, *final_g;
    float* out; unsigned char* ws;
};

__global__ void __launch_bounds__(256) k_mod(P p) {
    int i = blockIdx.x * blockDim.x + threadIdx.x; if (i >= BATCH * 6 * D) return;
    int b = i / (6 * D), j = i % (6 * D);
    float acc = p.mod_b[j];
    for (int k = 0; k < D; ++k) acc += silu_f(p.c[b * D + k]) * p.mod_w[(size_t)k * 6 * D + j];
    ((float*)(p.ws + WS_MOD))[i] = acc;
}

__device__ __forceinline__ float block_sum_256(float v, float* sh) {
    for (int o = 32; o > 0; o >>= 1) v += __shfl_xor(v, o);
    int w = threadIdx.x >> 6; __syncthreads(); if ((threadIdx.x & 63) == 0) sh[w] = v; __syncthreads();
    return sh[0] + sh[1] + sh[2] + sh[3];
}

__global__ void __launch_bounds__(256) k_norm1(P p) {
    __shared__ float sh[4];
    int row = blockIdx.x, b = row / SEQ; const float* xr = p.x + (size_t)row * D; const float* mod = (const float*)(p.ws + WS_MOD) + b * 6 * D;
    float v[4], ss = 0.f;
    for (int i = 0; i < 4; ++i) { v[i] = xr[threadIdx.x + 256 * i]; ss += v[i] * v[i]; }
    ss = block_sum_256(ss, sh); float rstd = rsqrtf(ss / D + EPS);
    bf16_t* hn = (bf16_t*)(p.ws + WS_HN) + (size_t)row * D;
    for (int i = 0; i < 4; ++i) { int d = threadIdx.x + 256 * i; float h = v[i] * rstd * p.norm1_g[d] * (1.f + mod[D + d]) + mod[d]; hn[d] = f2bf(h); }
}

template <bool DUAL, class AL, class BL, class BL2, class EP>
__device__ __forceinline__ void gemm_tile(int m0, int n0, int Mrows, int N, int K, const AL& al, const BL& bl, const BL2& bl2, const EP& ep) {
    __shared__ float As[16][65], Bs[16][65], Bs2[DUAL ? 16 : 1][65];
    int tx = threadIdx.x & 15, ty = threadIdx.x >> 4;
    float acc[4][4] = {}, acc2[4][4] = {};
    for (int k0 = 0; k0 < K; k0 += 16) {
        for (int i = threadIdx.x; i < 64 * 16; i += 256) { int r = i >> 4, k = i & 15; As[k][r] = (m0 + r < Mrows) ? al(m0 + r, k0 + k) : 0.f; }
        for (int i = threadIdx.x; i < 64 * 16; i += 256) { int k = i >> 6, c = i & 63; Bs[k][c] = (n0 + c < N) ? bl(k0 + k, n0 + c) : 0.f; if (DUAL) Bs2[k][c] = (n0 + c < N) ? bl2(k0 + k, n0 + c) : 0.f; }
        __syncthreads();
#pragma unroll
        for (int k = 0; k < 16; ++k) {
            float a[4], b[4], b2[4];
#pragma unroll
            for (int i = 0; i < 4; ++i) { a[i] = As[k][ty * 4 + i]; b[i] = Bs[k][tx * 4 + i]; if (DUAL) b2[i] = Bs2[k][tx * 4 + i]; }
#pragma unroll
            for (int i = 0; i < 4; ++i)
#pragma unroll
                for (int j = 0; j < 4; ++j) { acc[i][j] += a[i] * b[j]; if (DUAL) acc2[i][j] += a[i] * b2[j]; }
        }
        __syncthreads();
    }
    for (int i = 0; i < 4; ++i) for (int j = 0; j < 4; ++j) { int r = m0 + ty * 4 + i, c = n0 + tx * 4 + j; if (r < Mrows && c < N) ep(r, c, acc[i][j], acc2[i][j]); }
}

__global__ void __launch_bounds__(256) k_gemm_in(P p) {
    const bf16_t* hn = (const bf16_t*)(p.ws + WS_HN); const float* w = p.w_in;
    bf16_t* zq = (bf16_t*)(p.ws + WS_ZQ); bf16_t* xbc = (bf16_t*)(p.ws + WS_XBC); bf16_t* kk = (bf16_t*)(p.ws + WS_K); bf16_t* vv = (bf16_t*)(p.ws + WS_V); float* dt = (float*)(p.ws + WS_DT);
    auto al = [=](int r, int k) { return bf2f(hn[(size_t)r * D + k]); };
    auto bl = [=](int k, int c) { return w[(size_t)k * IN_COLS + c]; };
    auto ep = [=](int r, int c, float v, float) {
        if (c < C_XBC) zq[(size_t)r * 2048 + c] = f2bf(v);
        else if (c < C_DT) xbc[(size_t)r * 2048 + (c - C_XBC)] = f2bf(v);
        else if (c < C_Q) dt[r * 16 + (c - C_DT)] = v;
        else if (c < C_K) zq[(size_t)r * 2048 + 1024 + (c - C_Q)] = f2bf(v);
        else if (c < C_V) kk[(size_t)r * 256 + (c - C_K)] = f2bf(v);
        else vv[(size_t)r * 256 + (c - C_V)] = f2bf(v);
    };
    gemm_tile<false>(blockIdx.y * 64, blockIdx.x * 64, M, IN_COLS, D, al, bl, bl, ep);
}

__global__ void __launch_bounds__(256) k_conv(P p) {
    size_t i = (size_t)blockIdx.x * blockDim.x + threadIdx.x; if (i >= (size_t)M * CONV_CH) return;
    int row = (int)(i / CONV_CH), ch = (int)(i % CONV_CH), t = row % SEQ;
    const bf16_t* xbc = (const bf16_t*)(p.ws + WS_XBC);
    float acc = p.conv_b[ch];
    for (int j = 0; j < CONV_K; ++j) { int tt = t - (CONV_K - 1) + j; if (tt >= 0) acc += p.conv_w[j * CONV_CH + ch] * bf2f(xbc[(size_t)(row - (CONV_K - 1) + j) * CONV_CH + ch]); }
    ((bf16_t*)(p.ws + WS_XC))[i] = f2bf(silu_f(acc));
}

__global__ void __launch_bounds__(256) k_ssd_cs(P p) {
    int i = blockIdx.x * blockDim.x + threadIdx.x; if (i >= BATCH * NCHUNK * SSM_HEADS) return;
    int h = i % SSM_HEADS, bc = i / SSM_HEADS; float* dt = (float*)(p.ws + WS_DT); float* cs = (float*)(p.ws + WS_CS);
    float A = -__expf(p.a_log[h]), run = 0.f;
    for (int l = 0; l < CHUNK; ++l) { int row = bc * CHUNK + l; float d = softplus_f(dt[row * 16 + h] + p.dt_bias[h]); dt[row * 16 + h] = d; run += d * A; cs[row * 16 + h] = run; }
}

__global__ void __launch_bounds__(256) k_ssd_state(P p) {
    int bch = blockIdx.x, h = bch % SSM_HEADS, bc = bch / SSM_HEADS, g = h / 4;
    const bf16_t* xc = (const bf16_t*)(p.ws + WS_XC); const float* dt = (const float*)(p.ws + WS_DT); const float* cs = (const float*)(p.ws + WS_CS);
    __shared__ float xs[CHUNK][HD + 1]; __shared__ float wl[CHUNK];
    float cl = cs[(bc * CHUNK + CHUNK - 1) * 16 + h];
    for (int i = threadIdx.x; i < CHUNK; i += 256) { int row = bc * CHUNK + i; wl[i] = __expf(cl - cs[row * 16 + h]) * dt[row * 16 + h]; }
    for (int i = threadIdx.x; i < CHUNK * HD; i += 256) { int l = i / HD, pp = i % HD; xs[l][pp] = bf2f(xc[(size_t)(bc * CHUNK + l) * CONV_CH + h * HD + pp]); }
    __syncthreads();
    float* S = (float*)(p.ws + WS_S) + (size_t)bch * HD * D_STATE;
    int n = threadIdx.x & 127, ph = threadIdx.x >> 7;
    float acc[32] = {};
    for (int l = 0; l < CHUNK; ++l) { float bv = bf2f(xc[(size_t)(bc * CHUNK + l) * CONV_CH + D_SSM + g * D_STATE + n]) * wl[l];
#pragma unroll
        for (int j = 0; j < 32; ++j) acc[j] += bv * xs[l][ph * 32 + j]; }
#pragma unroll
    for (int j = 0; j < 32; ++j) S[(ph * 32 + j) * D_STATE + n] = acc[j];
}

__global__ void __launch_bounds__(256) k_ssd_scan(P p) {
    int i = blockIdx.x * blockDim.x + threadIdx.x; if (i >= BATCH * SSM_HEADS * HD * D_STATE) return;
    int pn = i % (HD * D_STATE), bh = i / (HD * D_STATE), h = bh % SSM_HEADS, b = bh / SSM_HEADS;
    float* S = (float*)(p.ws + WS_S); const float* cs = (const float*)(p.ws + WS_CS);
    float st = 0.f;
    for (int c = 0; c < NCHUNK; ++c) { size_t idx = ((size_t)((b * NCHUNK + c) * SSM_HEADS + h)) * HD * D_STATE + pn; float s = S[idx]; S[idx] = st;
        float dec = __expf(cs[((b * NCHUNK + c) * CHUNK + CHUNK - 1) * 16 + h]); st = st * dec + s; }
}

__global__ void __launch_bounds__(256) k_ssd_y(P p) {
    int lh = blockIdx.x & 1, bcg = blockIdx.x >> 1, g = bcg % SSM_GROUPS, bc = bcg / SSM_GROUPS;
    __shared__ float CB[64 * 129]; __shared__ float csl[128], dtl[128];
    const bf16_t* xc = (const bf16_t*)(p.ws + WS_XC); const float* dt = (const float*)(p.ws + WS_DT); const float* cs = (const float*)(p.ws + WS_CS);
    const bf16_t* Bm = xc + (size_t)bc * CHUNK * CONV_CH + D_SSM + g * D_STATE; const bf16_t* Cm = Bm + SSM_GROUPS * D_STATE;
    for (int i = threadIdx.x; i < 64 * CHUNK; i += 256) { int ll = i >> 7, l = lh * 64 + ll, s = i & 127; float a = 0.f;
        if (s <= l) for (int n = 0; n < D_STATE; ++n) a += bf2f(Cm[(size_t)l * CONV_CH + n]) * bf2f(Bm[(size_t)s * CONV_CH + n]);
        CB[ll * 129 + s] = a; }
    float* ytmp = (float*)(p.ws + WS_XBC);
    for (int r = 0; r < 4; ++r) { int h = g * 4 + r;
        __syncthreads();
        for (int i = threadIdx.x; i < CHUNK; i += 256) { csl[i] = cs[(bc * CHUNK + i) * 16 + h]; dtl[i] = dt[(bc * CHUNK + i) * 16 + h]; }
        __syncthreads();
        const float* St = (const float*)(p.ws + WS_S) + (size_t)(bc * SSM_HEADS + h) * HD * D_STATE;
        for (int i = threadIdx.x; i < 64 * HD; i += 256) { int ll = i / HD, l = lh * 64 + ll, pp = i % HD; float acc = 0.f;
            for (int s = 0; s <= l; ++s) acc += CB[ll * 129 + s] * __expf(csl[l] - csl[s]) * dtl[s] * bf2f(xc[(size_t)(bc * CHUNK + s) * CONV_CH + h * HD + pp]);
            float off = 0.f; for (int n = 0; n < D_STATE; ++n) off += bf2f(Cm[(size_t)l * CONV_CH + n]) * St[pp * D_STATE + n];
            acc += __expf(csl[l]) * off + p.d_skip[h] * bf2f(xc[(size_t)(bc * CHUNK + l) * CONV_CH + h * HD + pp]);
            ytmp[(size_t)(bc * CHUNK + l) * D_SSM + h * HD + pp] = acc; }
    }
}

__global__ void __launch_bounds__(256) k_ssd_gate(P p) {
    __shared__ float sh[4];
    int row = blockIdx.x; const float* y = (const float*)(p.ws + WS_XBC) + (size_t)row * D_SSM; bf16_t* zq = (bf16_t*)(p.ws + WS_ZQ) + (size_t)row * 2048;
    for (int g = 0; g < 4; ++g) { int d = g * 256 + threadIdx.x; float yz = y[d] * silu_f(bf2f(zq[d])); float ss = block_sum_256(yz * yz, sh);
        float r = rsqrtf(ss / 256.f + EPS); __syncthreads(); zq[d] = f2bf(yz * r * p.ssm_norm_g[d]); }
}

__global__ void __launch_bounds__(256) k_attn(P p) {
    int i = blockIdx.x * blockDim.x + threadIdx.x; if (i >= BATCH * ATT_HEADS * SEQ) return;
    int t = i % SEQ, bh = i / SEQ, h = bh % ATT_HEADS, b = bh / ATT_HEADS, kvh = h / 4, row = b * SEQ + t;
    const bf16_t* zq = (const bf16_t*)(p.ws + WS_ZQ); const bf16_t* kk = (const bf16_t*)(p.ws + WS_K); const bf16_t* vv = (const bf16_t*)(p.ws + WS_V);
    float q[HD], o[HD];
#pragma unroll
    for (int d = 0; d < HD; ++d) { q[d] = bf2f(zq[(size_t)row * 2048 + 1024 + h * HD + d]); o[d] = 0.f; }
    float sink = p.sinks[h], m = sink, l = 1.f;
    for (int dist = 0; dist < WINDOW; ++dist) { int s = t - dist; if (s < 0) break; int kr = b * SEQ + s;
        float sc = 0.f;
#pragma unroll
        for (int d = 0; d < HD; ++d) sc += q[d] * bf2f(kk[(size_t)kr * D_KV + kvh * HD + d]);
        sc = sc * 0.125f + p.rel_bias[c_bucket[dist] * ATT_HEADS + h];
        float mn = fmaxf(m, sc), f = __expf(m - mn), pe = __expf(sc - mn); l = l * f + pe; m = mn;
#pragma unroll
        for (int d = 0; d < HD; ++d) o[d] = o[d] * f + pe * bf2f(vv[(size_t)kr * D_KV + kvh * HD + d]); }
    float* ot = (float*)(p.ws + WS_XC) + (size_t)row * 1024 + h * HD; float inv = 1.f / l;
#pragma unroll
    for (int d = 0; d < HD; ++d) ot[d] = o[d] * inv;
}

__global__ void __launch_bounds__(256) k_attn_norm(P p) {
    __shared__ float sh[4];
    int row = blockIdx.x; const float* o = (const float*)(p.ws + WS_XC) + (size_t)row * 1024; bf16_t* zq = (bf16_t*)(p.ws + WS_ZQ) + (size_t)row * 2048 + 1024;
    float v[4], ss = 0.f; for (int i = 0; i < 4; ++i) { v[i] = o[threadIdx.x + 256 * i]; ss += v[i] * v[i]; }
    ss = block_sum_256(ss, sh); float r = rsqrtf(ss / 1024.f + EPS);
    for (int i = 0; i < 4; ++i) { int d = threadIdx.x + 256 * i; zq[d] = f2bf(v[i] * r * p.att_norm_g[d]); }
}

__global__ void __launch_bounds__(256) k_gemm_out(P p) {
    const bf16_t* zq = (const bf16_t*)(p.ws + WS_ZQ); const float* w = p.w_out; const float* x = p.x; float* x1 = p.out; const float* mod = (const float*)(p.ws + WS_MOD);
    auto al = [=](int r, int k) { return bf2f(zq[(size_t)r * 2048 + k]); };
    auto bl = [=](int k, int c) { return w[(size_t)k * D + c]; };
    auto ep = [=](int r, int c, float v, float) { int b = r / SEQ; x1[(size_t)r * D + c] = x[(size_t)r * D + c] + mod[b * 6 * D + 2 * D + c] * v; };
    gemm_tile<false>(blockIdx.y * 64, blockIdx.x * 64, M, D, 2048, al, bl, bl, ep);
}

__global__ void __launch_bounds__(256) k_norm2_route(P p) {
    __shared__ float sh[4]; __shared__ float hs[D]; __shared__ float sc[NE], sel[NE];
    int row = blockIdx.x, b = row / SEQ; const float* xr = p.out + (size_t)row * D; const float* mod = (const float*)(p.ws + WS_MOD) + b * 6 * D;
    float v[4], ss = 0.f; for (int i = 0; i < 4; ++i) { v[i] = xr[threadIdx.x + 256 * i]; ss += v[i] * v[i]; }
    ss = block_sum_256(ss, sh); float rstd = rsqrtf(ss / D + EPS);
    bf16_t* h2 = (bf16_t*)(p.ws + WS_H2) + (size_t)row * D;
    for (int i = 0; i < 4; ++i) { int d = threadIdx.x + 256 * i; float h = v[i] * rstd * p.norm2_g[d] * (1.f + mod[4 * D + d]) + mod[3 * D + d]; hs[d] = h; h2[d] = f2bf(h); }
    __syncthreads();
    {
        int e = threadIdx.x & 63, kq = threadIdx.x >> 6; float a = 0.f;
        for (int k = kq * 256; k < kq * 256 + 256; ++k) a += hs[k] * p.router_w[k * NE + e];
        __shared__ float part[4][NE]; part[kq][e] = a; __syncthreads();
        if (threadIdx.x < NE) { float lg = part[0][e] + part[1][e] + part[2][e] + part[3][e]; float s = 1.f / (1.f + __expf(-lg)); sc[e] = s; sel[e] = s + p.router_bias[e]; }
        __syncthreads();
    }
    __shared__ float gs[8]; __shared__ int idx[TOPK]; __shared__ float w[TOPK];
    if (threadIdx.x == 0) {
        for (int g = 0; g < 8; ++g) { float m1 = -INFINITY, m2 = -INFINITY; for (int j = 0; j < 8; ++j) { float s = sel[g * 8 + j]; if (s > m1) { m2 = m1; m1 = s; } else if (s > m2) m2 = s; } gs[g] = m1 + m2; }
        unsigned gok = 0; for (int it = 0; it < 4; ++it) { int best = 0; float bv = -INFINITY; for (int g = 0; g < 8; ++g) if (!((gok >> g) & 1u) && gs[g] > bv) { bv = gs[g]; best = g; } gok |= 1u << best; }
        float wsum = 0.f; unsigned long long used = 0ull;
        for (int it = 0; it < TOPK; ++it) { int best = 0; float bv = -INFINITY; for (int e = 0; e < NE; ++e) if (((gok >> (e >> 3)) & 1u) && !((used >> e) & 1ull) && sel[e] > bv) { bv = sel[e]; best = e; } used |= 1ull << best; idx[it] = best; w[it] = sc[best]; wsum += sc[best]; }
        int* eidx = (int*)(p.ws + WS_EIDX); float* eg = (float*)(p.ws + WS_EGATE); int* cnt = (int*)(p.ws + WS_CTL); int* list = (int*)(p.ws + WS_LIST);
        for (int it = 0; it < TOPK; ++it) { int a = row * 8 + it; eidx[a] = idx[it]; eg[a] = w[it] / wsum * 2.5f; int pos = atomicAdd(&cnt[idx[it]], 1); list[idx[it] * M + pos] = a; }
    }
}

__global__ void __launch_bounds__(256) k_plan(P p) {
    if (threadIdx.x == 0 && blockIdx.x == 0) { const int* cnt = (const int*)(p.ws + WS_CTL); int* plan = (int*)(p.ws + WS_PLAN); int off = 0;
        for (int e = 0; e <= NE; ++e) { int c = e < NE ? cnt[e] : M; plan[e] = off; plan[128 + e] = c; off += (c + 255) / 256 * 256; } }
}

__global__ void __launch_bounds__(256) k_moe_gu(P p) {
    int e = blockIdx.z; const int* plan = (const int*)(p.ws + WS_PLAN); int cnt = plan[128 + e], ub = plan[e]; int m0 = blockIdx.y * 64; if (m0 >= cnt) return;
    const int* list = (const int*)(p.ws + WS_LIST) + (size_t)e * M; const bf16_t* h2 = (const bf16_t*)(p.ws + WS_H2); bf16_t* u = (bf16_t*)(p.ws + WS_U) + (size_t)ub * ED;
    const float* wg = e < NE ? p.exp_w_gate + (size_t)e * D * ED : p.sh_w_gate; const float* wu = e < NE ? p.exp_w_up + (size_t)e * D * ED : p.sh_w_up;
    auto al = [=](int r, int k) { int tok = e < NE ? (list[r] >> 3) : r; return bf2f(h2[(size_t)tok * D + k]); };
    auto bl = [=](int k, int c) { return wg[(size_t)k * ED + c]; };
    auto bl2 = [=](int k, int c) { return wu[(size_t)k * ED + c]; };
    auto ep = [=](int r, int c, float g, float uu) { u[(size_t)r * ED + c] = f2bf(silu_f(g) * uu); };
    gemm_tile<true>(m0, blockIdx.x * 64, cnt, ED, D, al, bl, bl2, ep);
}

__global__ void __launch_bounds__(256) k_moe_down(P p, int half) {
    int e = blockIdx.z; const int* plan = (const int*)(p.ws + WS_PLAN); int cnt = plan[128 + e], ub = plan[e]; int m0 = blockIdx.y * 64; if (m0 >= cnt) return;
    const int* list = (const int*)(p.ws + WS_LIST) + (size_t)e * M; const bf16_t* u = (const bf16_t*)(p.ws + WS_U) + (size_t)ub * ED; const float* eg = (const float*)(p.ws + WS_EGATE);
    const float* wd = (e < NE ? p.exp_w_down + (size_t)e * ED * D : p.sh_w_down) + half * 512; bf16_t* yc = (bf16_t*)(p.ws + WS_YC);
    auto al = [=](int r, int k) { return bf2f(u[(size_t)r * ED + k]); };
    auto bl = [=](int k, int c) { return wd[(size_t)k * D + c]; };
    auto ep = [=](int r, int c, float v, float) { int tok, slot; float gt; if (e < NE) { int a = list[r]; tok = a >> 3; slot = a & 7; gt = eg[a]; } else { tok = r; slot = 8; gt = 1.f; }
        yc[((size_t)tok * NSLOT + slot) * 512 + c] = f2bf(v * gt); };
    gemm_tile<false>(m0, blockIdx.x * 64, cnt, 512, ED, al, bl, bl, ep);
}

__global__ void __launch_bounds__(256) k_combine(P p, int half) {
    size_t i = (size_t)blockIdx.x * blockDim.x + threadIdx.x; if (i >= (size_t)M * 512) return;
    int tok = (int)(i / 512), c = (int)(i % 512), b = tok / SEQ; const bf16_t* yc = (const bf16_t*)(p.ws + WS_YC) + (size_t)tok * NSLOT * 512 + c; const float* mod = (const float*)(p.ws + WS_MOD) + b * 6 * D;
    float s = 0.f; for (int k = 0; k < NSLOT; ++k) s += bf2f(yc[k * 512]);
    int col = half * 512 + c; p.out[(size_t)tok * D + col] += mod[5 * D + col] * s;
}

__global__ void __launch_bounds__(256) k_final(P p) {
    __shared__ float sh[4];
    int row = blockIdx.x; float* xr = p.out + (size_t)row * D;
    float v[4], ss = 0.f; for (int i = 0; i < 4; ++i) { v[i] = xr[threadIdx.x + 256 * i]; ss += v[i] * v[i]; }
    ss = block_sum_256(ss, sh); float rstd = rsqrtf(ss / D + EPS);
    for (int i = 0; i < 4; ++i) { int d = threadIdx.x + 256 * i; xr[d] = v[i] * rstd * p.final_g[d]; }
}

extern "C" void kernel_launch(void* const* d_in, const int* in_sizes, int n_in, void* d_out, int out_size, void* d_ws, size_t ws_size, hipStream_t stream) {
    P p{};
    const float** f = (const float**)&p;
    for (int i = 0; i < 26; ++i) f[i] = (const float*)d_in[i];
    p.out = (float*)d_out; p.ws = (unsigned char*)d_ws;
    if (ws_size < WS_END) { fprintf(stderr, "ws too small: %zu < %zu\n", ws_size, (size_t)WS_END); }
    (void)hipMemsetAsync(p.ws + WS_CTL, 0, CTL_BYTES, stream);
    k_mod<<<(BATCH * 6 * D + 255) / 256, 256, 0, stream>>>(p);
    k_norm1<<<M, 256, 0, stream>>>(p);
    k_gemm_in<<<dim3((IN_COLS + 63) / 64, M / 64), 256, 0, stream>>>(p);
    k_conv<<<(unsigned)(((size_t)M * CONV_CH + 255) / 256), 256, 0, stream>>>(p);
    k_ssd_cs<<<(BATCH * NCHUNK * SSM_HEADS + 255) / 256, 256, 0, stream>>>(p);
    k_ssd_state<<<BATCH * NCHUNK * SSM_HEADS, 256, 0, stream>>>(p);
    k_ssd_scan<<<BATCH * SSM_HEADS * HD * D_STATE / 256, 256, 0, stream>>>(p);
    k_ssd_y<<<BATCH * NCHUNK * SSM_GROUPS * 2, 256, 0, stream>>>(p);
    k_ssd_gate<<<M, 256, 0, stream>>>(p);
    k_attn<<<BATCH * ATT_HEADS * SEQ / 256, 256, 0, stream>>>(p);
    k_attn_norm<<<M, 256, 0, stream>>>(p);
    k_gemm_out<<<dim3(D / 64, M / 64), 256, 0, stream>>>(p);
    k_norm2_route<<<M, 256, 0, stream>>>(p);
    k_plan<<<1, 64, 0, stream>>>(p);
    k_moe_gu<<<dim3(ED / 64, M / 64, NE + 1), 256, 0, stream>>>(p);
    for (int half = 0; half < 2; ++half) {
        k_moe_down<<<dim3(512 / 64, M / 64, NE + 1), 256, 0, stream>>>(p, half);
        k_combine<<<(unsigned)(((size_t)M * 512 + 255) / 256), 256, 0, stream>>>(p, half);
    }
    k_final<<<M, 256, 0, stream>>>(p);
}
```

```cpp
#include <hip/hip_runtime.h>
#include <stdint.h>
#include <stdio.h>

typedef unsigned short bf16_t;

constexpr int D = 1024, BATCH = 4, SEQ = 4096, M = BATCH * SEQ;
constexpr int D_SSM = 1024, SSM_HEADS = 16, SSM_GROUPS = 4, D_STATE = 128, CONV_K = 4, CONV_CH = 2048, CHUNK = 128, NCHUNK = SEQ / CHUNK;
constexpr int HD = 64, ATT_HEADS = 16, KV_HEADS = 4, D_KV = 256, WINDOW = 128;
constexpr int IN_COLS = 4624;
constexpr int C_Z = 0, C_XBC = 1024, C_DT = 3072, C_Q = 3088, C_K = 4112, C_V = 4368;
constexpr int NE = 64, TOPK = 8, ED = 256;
constexpr float EPS = 1e-6f;
constexpr int NSLOT = 9;
constexpr int NWIN = 4864;

constexpr size_t MiB = 1u << 20;
constexpr size_t WS_CTL = 0;
constexpr size_t CTL_BYTES = 64 * 1024;
constexpr int CW_CNT = 0;
constexpr int CW_BAR = 4096;
constexpr size_t WS_MOD = 1 * MiB;
constexpr size_t WS_PLAN = 1 * MiB + 512 * 1024;
constexpr size_t WS_EIDX = 2 * MiB;
constexpr size_t WS_EGATE = 3 * MiB;
constexpr size_t WS_LIST = 4 * MiB;
constexpr size_t WS_WIN_T = 8 * MiB;
constexpr size_t WS_WOUT_T = 18 * MiB;
constexpr size_t WS_SSQ = 22 * MiB;
constexpr size_t WS_ZQ = 24 * MiB;
constexpr size_t WS_XBC = 88 * MiB;
constexpr size_t WS_K = 152 * MiB;
constexpr size_t WS_V = 160 * MiB;
constexpr size_t WS_DT = 168 * MiB;
constexpr size_t WS_CS = 169 * MiB;
constexpr size_t WS_HN = 170 * MiB;
constexpr size_t WS_S = 170 * MiB;
constexpr size_t WS_XC = 234 * MiB;
constexpr size_t WS_H2 = 24 * MiB;
constexpr size_t WS_WGU = 56 * MiB;
constexpr size_t WS_YC = 24 * MiB;
constexpr size_t WS_U = 168 * MiB;
constexpr size_t WS_WD = 248 * MiB;
constexpr size_t WS_END = 300 * MiB;
constexpr int UROWS_MAX = 163840;

__device__ __forceinline__ float bf2f(bf16_t v) { return __uint_as_float(((unsigned)v) << 16); }
__device__ __forceinline__ bf16_t f2bf(float f) { unsigned u = __float_as_uint(f); return (bf16_t)((u + 0x7fffu + ((u >> 16) & 1u)) >> 16); }
__device__ __forceinline__ unsigned pk2(float lo, float hi) { return (unsigned)f2bf(lo) | ((unsigned)f2bf(hi) << 16); }
__device__ __forceinline__ float silu_f(float x) { return x / (1.f + __expf(-x)); }
__device__ __forceinline__ float softplus_f(float x) { return x > 20.f ? x : log1pf(__expf(x)); }

__constant__ int c_bucket[128] = {0, 1, 2, 3, 4, 5, 6, 7, 8, 9, 10, 11, 12, 13, 14, 15, 16, 16, 16, 17, 17, 18, 18, 18, 19, 19, 19, 20, 20, 20, 20, 21, 21, 21, 21, 22, 22, 22, 22, 22, 23, 23, 23, 23, 23, 23, 24, 24, 24, 24, 24, 24, 25, 25, 25, 25, 25, 25, 25, 26, 26, 26, 26, 26, 26, 26, 26, 27, 27, 27, 27, 27, 27, 27, 27, 27, 27, 28, 28, 28, 28, 28, 28, 28, 28, 28, 28, 29, 29, 29, 29, 29, 29, 29, 29, 29, 29, 29, 29, 30, 30, 30, 30, 30, 30, 30, 30, 30, 30, 30, 30, 30, 30, 31, 31, 31, 31, 31, 31, 31, 31, 31, 31, 31, 31, 31, 31, 31};

struct P {
    const float *x, *c, *mod_w, *mod_b, *norm1_g, *norm2_g, *w_in, *conv_w, *conv_b, *dt_bias, *a_log, *d_skip, *ssm_norm_g, *att_norm_g, *sinks, *rel_bias,
        *w_out, *router_w, *router_bias, *exp_w_gate, *exp_w_up, *exp_w_down, *sh_w_gate, *sh_w_up, *sh_w_down, *final_g;
    float* out; unsigned char* ws;
    int ph_lo, ph_hi, li, pad;
};

namespace pg8 {
#define PG8_LAS __attribute__((address_space(3)))
typedef short bf16x8 __attribute__((ext_vector_type(8)));
typedef float f32x4 __attribute__((ext_vector_type(4)));
typedef unsigned u32x4 __attribute__((ext_vector_type(4)));
constexpr int BM = 256, BK = 64, HALF = 128, HTB = HALF * BK * 2  , STAGE_BYTES = 8 * HTB, NXCD = 8, WGM = 8;

__host__ __device__ __forceinline__ int lds_byte(int r, int c) { const int st = (r >> 4) * 2 + (c >> 5), rr = r & 15, cc = c & 31, ob = rr * 64 + cc * 2; return st * 1024 + (ob ^ (((ob >> 9) & 1) << 5)); }
__host__ __device__ __forceinline__ void stage_rc(int b, int& R, int& C) { const int st = b / 1024, sb = b % 1024, swz = sb ^ (((sb >> 9) & 1) << 5); R = (st >> 1) * 16 + swz / 64; C = (st & 1) * 32 + (swz % 64) / 2; }
__host__ __device__ __forceinline__ int perm32(int rho) { const int n = rho >> 4, i = rho & 15; return 8 * (i >> 2) + 4 * n + (i & 3); }

struct Unit { int pm, pn, e, nrows, lt; };

__device__ __forceinline__ unsigned cvt_pk_bf16(float lo, float hi) { unsigned r; asm volatile("v_cvt_pk_bf16_f32 %0, %1, %2" : "=v"(r) : "v"(lo), "v"(hi)); return r; }

struct DenseOrder {
    typedef pg8::Unit Unit;
    const char* A; const char* Bt; int K; int nM, nN, nwg, G, c;
    __device__ __forceinline__ void init(const void* A_, const void* Bt_, int M_, int N_, int K_, int G_, int c_) { A = (const char*)A_; Bt = (const char*)Bt_; K = K_; nM = M_ / BM; nN = N_ / BM; nwg = nM * nN; G = G_; c = c_; }
    __device__ __forceinline__ bool next(int i, Unit& u) const {
        const long L = (long)i * G + c; if (L >= nwg) return false;
        int wgid = (int)L; { const int q = nwg / NXCD, r = nwg % NXCD, xcd = wgid % NXCD, off = wgid / NXCD; wgid = (xcd < r ? xcd * (q + 1) : r * (q + 1) + (xcd - r) * q) + off; }
        const int nig = WGM * nN, gid = wgid / nig, fm = gid * WGM, gsz = (nM - fm) < WGM ? (nM - fm) : WGM;
        u.pm = fm + ((wgid % nig) % gsz); u.pn = (wgid % nig) / gsz; u.e = 0; u.nrows = 256; u.lt = 0; return true;
    }
    __device__ __forceinline__ const char* a_base(const Unit& u) const { return A + (size_t)u.pm * 512 * K; }
    __device__ __forceinline__ const char* b_base(const Unit& u) const { return Bt + (size_t)u.pn * 512 * K; }
    __device__ __forceinline__ void lane_off(const Unit&, const int (&R)[2], const int (&C)[2], unsigned (&o)[2][2]) const {
#pragma unroll
        for (int h = 0; h < 2; ++h)
#pragma unroll
            for (int i = 0; i < 2; ++i) o[h][i] = (unsigned)(((h * HALF + R[i]) * K + C[i]) * 2);
    }
    __device__ __forceinline__ void a_ready(const Unit&) const {}
    __device__ __forceinline__ void done(const Unit&) const {}
};

template <class Epi, class Sched, bool ALIGN_EPI = false, bool SP2 = false>
__device__ __forceinline__ void gemm_phase(PG8_LAS unsigned char* lds, const int K, const Sched& S, const Epi& E) {
    typedef typename Sched::Unit Unit;
    const int tid = threadIdx.x, wid = __builtin_amdgcn_readfirstlane(tid >> 6), lane = tid & 63, wr = wid >> 2, wc = wid & 3, fr = lane & 15, fq = lane >> 4;
    const int nt = K / BK;
    unsigned voffB[2]; int stR[2], stC[2];
#pragma unroll
    for (int i = 0; i < 2; ++i) { int R, C; stage_rc(tid * 16 + i * 8192, R, C); const int Rb = Epi::PERM ? ((R & ~31) + perm32(R & 31)) : R;
        stR[i] = R; stC[i] = C; voffB[i] = (unsigned)(Rb * K + C) * 2u; }
    const size_t kstep = (size_t)(BK * 2);
    const size_t hstep = (size_t)HALF * K * 2;
    const size_t tstep = 2 * hstep;
    const unsigned ldsw = (unsigned)wid * 1024u;
    const int aoff = lds_byte(wr * 64 + fr, fq * 8), boff = lds_byte(wc * 32 + fr, fq * 8);
#define PG8_SA(b, h) (((b) * 2 + (h)) * HTB)
#define PG8_SB(b, h) ((4 + (b) * 2 + (h)) * HTB)
#define PG8_STAGE(bufoff, gbase, voff) do { _Pragma("unroll") for (int _i = 0; _i < 2; ++_i) \
        __builtin_amdgcn_global_load_lds((const unsigned*)((const char*)(gbase) + (voff)[_i]), (PG8_LAS unsigned*)(lds + (bufoff) + ldsw + _i * 8192), 16, 0, 0); } while (0)
#define PG8_LDA(dst, b, h) do { _Pragma("unroll") for (int m = 0; m < 4; ++m) _Pragma("unroll") for (int k = 0; k < 2; ++k) dst[m][k] = *(const PG8_LAS bf16x8*)(lds + PG8_SA(b, h) + aoff + m * 2048 + k * 1024); } while (0)
#define PG8_LDB(dst, b, h) do { _Pragma("unroll") for (int n = 0; n < 2; ++n) _Pragma("unroll") for (int k = 0; k < 2; ++k) dst[n][k] = *(const PG8_LAS bf16x8*)(lds + PG8_SB(b, h) + boff + n * 2048 + k * 1024); } while (0)
#define PG8_MMA(ai, bj, At, Bt) do { __builtin_amdgcn_s_setprio(1); _Pragma("unroll") for (int m = 0; m < 4; ++m) _Pragma("unroll") for (int n = 0; n < 2; ++n) _Pragma("unroll") for (int k = 0; k < 2; ++k) \
        acc[ai][bj][m][n] = __builtin_amdgcn_mfma_f32_16x16x32_bf16(Bt[n][k], At[m][k], acc[ai][bj][m][n], 0, 0, 0); __builtin_amdgcn_s_setprio(0); } while (0)
#define PG8_WAIT_V(n) asm volatile("s_waitcnt vmcnt(" #n ")" ::: "memory")
#define PG8_WAIT_L(n) asm volatile("s_waitcnt lgkmcnt(" #n ")" ::: "memory")
#define PG8_BAR __builtin_amdgcn_s_barrier()
#define PG8_SCHED __builtin_amdgcn_sched_barrier(0)
    Unit cur, nxt; int ui = 0;
    if (!S.next(0, cur)) return;
    f32x4 acc[2][2][4][2];
#pragma unroll
    for (int a = 0; a < 2; ++a)
#pragma unroll
        for (int b = 0; b < 2; ++b)
#pragma unroll
            for (int m = 0; m < 4; ++m)
#pragma unroll
                for (int n = 0; n < 2; ++n) acc[a][b][m][n] = (f32x4){0.f, 0.f, 0.f, 0.f};
    bf16x8 At[4][2], B0[2][2], B1[2][2];
    const char* cA = S.a_base(cur); const char* cB = S.b_base(cur);
    unsigned oc[2][2], on[2][2];
    S.lane_off(cur, stR, stC, oc);
    S.a_ready(cur);
    if constexpr (SP2) {
        PG8_STAGE(PG8_SB(0, 0), cB, voffB); PG8_STAGE(PG8_SB(0, 1), cB + hstep, voffB); PG8_STAGE(PG8_SA(0, 0), cA, oc[0]); PG8_STAGE(PG8_SA(0, 1), cA, oc[1]);
        if (wr == 1) PG8_BAR;
        PG8_WAIT_V(2); PG8_BAR;
        PG8_STAGE(PG8_SB(1, 0), cB + kstep, voffB); PG8_STAGE(PG8_SA(1, 0), cA + kstep, oc[0]); PG8_STAGE(PG8_SB(1, 1), cB + hstep + kstep, voffB);
        PG8_WAIT_V(6); PG8_BAR;
    } else {
        PG8_STAGE(PG8_SB(0, 0), cB, voffB); PG8_STAGE(PG8_SA(0, 0), cA, oc[0]); PG8_STAGE(PG8_SB(0, 1), cB + hstep, voffB); PG8_STAGE(PG8_SA(0, 1), cA, oc[1]);
        if (wr == 1) PG8_BAR;
        PG8_WAIT_V(4); PG8_BAR;
        PG8_STAGE(PG8_SB(1, 0), cB + kstep, voffB); PG8_STAGE(PG8_SA(1, 0), cA + kstep, oc[0]); PG8_STAGE(PG8_SB(1, 1), cB + hstep + kstep, voffB);
        PG8_WAIT_V(6); PG8_BAR;
    }
    for (;;) {
        const bool has_next = S.next(ui + 1, nxt);
        const char* nA = has_next ? S.a_base(nxt) : cA; const char* nB = has_next ? S.b_base(nxt) : cB;
        if (has_next) S.lane_off(nxt, stR, stC, on); else {
#pragma unroll
            for (int h = 0; h < 2; ++h)
#pragma unroll
                for (int i = 0; i < 2; ++i) on[h][i] = oc[h][i]; }
#pragma unroll 1
        for (int t = 0; t < nt; t += 2) {
            const bool last = (t == nt - 2);
            const char* a1 = cA + (size_t)(t + 1) * kstep;
            const char* a2 = last ? nA : cA + (size_t)(t + 2) * kstep; const char* b2 = last ? nB : cB + (size_t)(t + 2) * kstep;
            const char* a3 = a2 + kstep; const char* b3 = b2 + kstep;
            unsigned o2[2][2];
#pragma unroll
            for (int h = 0; h < 2; ++h)
#pragma unroll
                for (int i = 0; i < 2; ++i) o2[h][i] = last ? on[h][i] : oc[h][i];
            if (last && has_next) S.a_ready(nxt);
            if constexpr (SP2) {
            PG8_LDB(B0, 0, 0); PG8_LDB(B1, 0, 1); PG8_SCHED; PG8_LDA(At, 0, 0); PG8_STAGE(PG8_SA(1, 1), a1, oc[1]);
            PG8_WAIT_V(8); PG8_WAIT_L(0); PG8_BAR; PG8_MMA(0, 0, At, B0); PG8_MMA(0, 1, At, B1); PG8_BAR; PG8_SCHED;
            PG8_LDA(At, 0, 1); PG8_STAGE(PG8_SB(0, 0), b2, voffB); PG8_STAGE(PG8_SB(0, 1), b2 + hstep, voffB); PG8_STAGE(PG8_SA(0, 0), a2, o2[0]);
            PG8_WAIT_V(8); PG8_WAIT_L(0); PG8_BAR; PG8_MMA(1, 0, At, B0); PG8_MMA(1, 1, At, B1); PG8_BAR; PG8_SCHED;
            PG8_LDB(B0, 1, 0); PG8_LDB(B1, 1, 1); PG8_SCHED; PG8_LDA(At, 1, 0); PG8_STAGE(PG8_SA(0, 1), a2, o2[1]);
            PG8_WAIT_V(8); PG8_WAIT_L(0); PG8_BAR; PG8_MMA(0, 0, At, B0); PG8_MMA(0, 1, At, B1); PG8_BAR; PG8_SCHED;
            PG8_LDA(At, 1, 1); PG8_STAGE(PG8_SB(1, 0), b3, voffB); PG8_STAGE(PG8_SB(1, 1), b3 + hstep, voffB); PG8_STAGE(PG8_SA(1, 0), a3, o2[0]);
            PG8_WAIT_V(8); PG8_WAIT_L(0); PG8_BAR; PG8_MMA(1, 0, At, B0); PG8_MMA(1, 1, At, B1); PG8_BAR; PG8_SCHED;
            } else {
            PG8_LDB(B0, 0, 0); PG8_SCHED; PG8_LDA(At, 0, 0); PG8_STAGE(PG8_SA(1, 1), a1, oc[1]);
            PG8_WAIT_L(8); PG8_BAR; PG8_WAIT_L(0); PG8_MMA(0, 0, At, B0); PG8_BAR; PG8_SCHED;
            PG8_LDB(B1, 0, 1); PG8_STAGE(PG8_SB(0, 0), b2, voffB);
            PG8_BAR; PG8_WAIT_L(0); PG8_MMA(0, 1, At, B1); PG8_BAR;
            PG8_LDA(At, 0, 1); PG8_STAGE(PG8_SA(0, 0), a2, o2[0]);
            PG8_BAR; PG8_WAIT_L(0); PG8_MMA(1, 0, At, B0); PG8_BAR; PG8_SCHED;
            PG8_STAGE(PG8_SB(0, 1), b2 + hstep, voffB);
            PG8_WAIT_V(6); PG8_BAR; PG8_MMA(1, 1, At, B1); PG8_BAR;
            PG8_LDB(B0, 1, 0); PG8_SCHED; PG8_LDA(At, 1, 0); PG8_STAGE(PG8_SA(0, 1), a2, o2[1]);
            PG8_WAIT_L(8); PG8_BAR; PG8_WAIT_L(0); PG8_MMA(0, 0, At, B0); PG8_BAR; PG8_SCHED;
            PG8_LDB(B1, 1, 1); PG8_STAGE(PG8_SB(1, 0), b3, voffB);
            PG8_BAR; PG8_WAIT_L(0); PG8_MMA(0, 1, At, B1); PG8_BAR;
            PG8_LDA(At, 1, 1); PG8_STAGE(PG8_SA(1, 0), a3, o2[0]);
            PG8_BAR; PG8_WAIT_L(0); PG8_MMA(1, 0, At, B0); PG8_BAR; PG8_SCHED;
            PG8_STAGE(PG8_SB(1, 1), b3 + hstep, voffB);
            PG8_WAIT_V(6); PG8_BAR; PG8_MMA(1, 1, At, B1); PG8_BAR;
            }
        }
        if constexpr (ALIGN_EPI) { if (wr == 0) PG8_BAR; }
        if constexpr (!Epi::AFTER_DRAIN) { E(acc, cur, wr, wc, fr, fq); S.done(cur); }
        if (!has_next) break;
#pragma unroll
        for (int a = 0; a < 2; ++a)
#pragma unroll
            for (int b = 0; b < 2; ++b)
#pragma unroll
                for (int m = 0; m < 4; ++m)
#pragma unroll
                    for (int n = 0; n < 2; ++n) acc[a][b][m][n] = (f32x4){0.f, 0.f, 0.f, 0.f};
        cur = nxt; cA = nA; cB = nB; ++ui;
#pragma unroll
        for (int h = 0; h < 2; ++h)
#pragma unroll
            for (int i = 0; i < 2; ++i) oc[h][i] = on[h][i];
        if constexpr (ALIGN_EPI) { if (wr == 1) PG8_BAR; }
    }
    PG8_WAIT_V(0);
    if constexpr (!ALIGN_EPI) { if (wr == 0) PG8_BAR; }
    PG8_BAR;
    if constexpr (Epi::AFTER_DRAIN) { E.fused(acc, cur, wr, wc, fr, fq, lds, wid, lane); S.done(cur); }
#undef PG8_SA
#undef PG8_SB
#undef PG8_STAGE
#undef PG8_LDA
#undef PG8_LDB
#undef PG8_MMA
#undef PG8_WAIT_V
#undef PG8_WAIT_L
#undef PG8_BAR
#undef PG8_SCHED
}
}

#define GAS __attribute__((address_space(1)))
#define LAS __attribute__((address_space(3)))
typedef unsigned v4u __attribute__((ext_vector_type(4)));
typedef float f32x4 __attribute__((ext_vector_type(4)));
typedef GAS unsigned gu32;
#define RLX_AGENT __ATOMIC_RELAXED, __HIP_MEMORY_SCOPE_AGENT
#define LDS_WAIT() asm volatile("s_waitcnt lgkmcnt(0)" ::: "memory")
#define VM_WAIT() asm volatile("s_waitcnt vmcnt(0)" ::: "memory")
constexpr int NWAVES = 8;
constexpr int RING_OFF = 0, RING_BYTES = 131072;
constexpr int LDSCTL_OFF = RING_BYTES, MISC_OFF = LDSCTL_OFF + 320;
constexpr int PLAN_OFF = LDSCTL_OFF + 1024;
constexpr int LDS_BYTES = 147456;

#define XB_TMO      128
#define XB_XCNT(j)  (256  + 64 * (j))
#define XB_XSUB(j)  (1280 + 64 * (j))
#define XB_XGEN(j)  (2304 + 64 * (j))
#define XB_TOP      3328
#define XB_TOPGEN   3392
#define XCD_BAR_WORDS 3456
#define XB_SPIN_CAP (1u << 18)

__device__ __forceinline__ unsigned xb_ld(unsigned* p)              { return __hip_atomic_load(p, __ATOMIC_RELAXED, __HIP_MEMORY_SCOPE_AGENT); }
__device__ __forceinline__ unsigned xb_add(unsigned* p, unsigned v) { return __hip_atomic_fetch_add(p, v, __ATOMIC_RELAXED, __HIP_MEMORY_SCOPE_AGENT); }
__device__ __forceinline__ unsigned xb_xcc_id() { return (unsigned)__builtin_amdgcn_s_getreg((3 << 11) | 20) & 0xFu; }
#define XB_SPIN(cond, bar) do { unsigned _sp = 0; while (cond) { __builtin_amdgcn_s_sleep(1); \
    if ((++_sp & 255u) == 0u) { if (xb_ld(&(bar)[XB_TMO])) break; if (_sp > XB_SPIN_CAP) { atomicAdd(&(bar)[XB_TMO], 1u); break; } } } } while (0)

struct XcdBarrier {
    unsigned* bar; unsigned x;
    volatile LAS unsigned* st;
};

__device__ __forceinline__ XcdBarrier xcd_barrier_post(unsigned* bar, volatile LAS unsigned* st) {
    XcdBarrier b; b.bar = bar; b.x = xb_xcc_id(); b.st = st;
    if (threadIdx.x == 0) (void)xb_add(&bar[XB_XCNT(b.x)], 1u);
    return b;
}
__device__ __forceinline__ void xcd_barrier_complete(unsigned* bar, unsigned x, unsigned& nloc, unsigned& nx) {
    const unsigned G = gridDim.x * gridDim.y * gridDim.z;
    unsigned sum, cnt, mine, sp = 0u;
    for (;;) {
        sum = 0u; cnt = 0u; mine = 0u;
#pragma unroll
        for (unsigned j = 0; j < 16; ++j) { const unsigned c = xb_ld(&bar[XB_XCNT(j)]); sum += c; cnt += (c > 0u) ? 1u : 0u; mine = (j == x) ? c : mine; }
        if (sum == G) break;
        __builtin_amdgcn_s_sleep(1);
        if ((++sp & 255u) == 0u) { if (xb_ld(&bar[XB_TMO])) break; if (sp > XB_SPIN_CAP) { atomicAdd(&bar[XB_TMO], 1u); break; } }
    }
    nloc = mine > 0u ? mine : 1u; nx = cnt > 0u ? cnt : 1u;
}

__device__ __forceinline__ void xcd_barrier(const XcdBarrier& b) {
    asm volatile("s_waitcnt vmcnt(0)" ::: "memory");
    __syncthreads();
    if (threadIdx.x == 0) {
        unsigned* bar = b.bar;
        __builtin_amdgcn_s_waitcnt(0);
        unsigned nloc = b.st[0], nx = b.st[1];
        if (nloc == 0u) { xcd_barrier_complete(bar, b.x, nloc, nx); b.st[0] = nloc; b.st[1] = nx; }
        const unsigned old = xb_add(&bar[XB_XSUB(b.x)], 1u);
        const unsigned gen = old / nloc;
        if (old + 1u == (gen + 1u) * nloc) {
            __builtin_amdgcn_fence(__ATOMIC_RELEASE, "agent");
            asm volatile("s_waitcnt vmcnt(0)" ::: "memory");
            const unsigned og = xb_add(&bar[XB_TOP], 1u);
            const unsigned tg = og / nx;
            if (og + 1u == (tg + 1u) * nx) xb_add(&bar[XB_TOPGEN], 1u);
            else XB_SPIN(xb_ld(&bar[XB_TOPGEN]) == tg, bar);
            __builtin_amdgcn_fence(__ATOMIC_ACQUIRE, "agent");
            xb_add(&bar[XB_XGEN(b.x)], 1u);
            asm volatile("s_waitcnt vmcnt(0)" ::: "memory");
        } else {
            XB_SPIN(xb_ld(&bar[XB_XGEN(b.x)]) == gen, bar);
            __builtin_amdgcn_fence(__ATOMIC_ACQUIRE, "agent");
            asm volatile("s_waitcnt vmcnt(0)" ::: "memory");
        }
    }
    __syncthreads();
}

__device__ __forceinline__ float wave_sum(float v) {
#pragma unroll
    for (int o = 1; o < 64; o <<= 1) v += __shfl_xor(v, o);
    return v;
}

struct EpiIn {
    static constexpr bool PERM = true, AFTER_DRAIN = false;
    bf16_t *zq, *xbc, *kk, *vv; float* dt;
    __device__ __forceinline__ void operator()(const pg8::f32x4 (&acc)[2][2][4][2], const pg8::Unit& u, int wr, int wc, int fr, int fq) const {
        const int row0 = u.pm * 256 + wr * 64 + fr, pn = u.pn;
        if (pn == 18) {
            if (wc == 0 && fq < 2) {
#pragma unroll
                for (int ai = 0; ai < 2; ++ai)
#pragma unroll
                    for (int m = 0; m < 4; ++m) { float* o = dt + (size_t)(row0 + ai * 128 + m * 16) * 16 + 8 * fq; *(pg8::f32x4*)o = acc[ai][0][m][0]; *(pg8::f32x4*)(o + 4) = acc[ai][0][m][1]; }
            }
            return;
        }
        bf16_t* base; int ldc, colt;
        if (pn < 4) { base = zq; ldc = 2048; colt = pn * 256; }
        else if (pn < 12) { base = xbc; ldc = 2048; colt = (pn - 4) * 256; }
        else if (pn < 16) { base = zq; ldc = 2048; colt = 1024 + (pn - 12) * 256; }
        else if (pn == 16) { base = kk; ldc = 256; colt = 0; }
        else { base = vv; ldc = 256; colt = 0; }
        const int col0 = colt + wc * 32 + 8 * fq;
#pragma unroll
        for (int ai = 0; ai < 2; ++ai)
#pragma unroll
            for (int m = 0; m < 4; ++m) { bf16_t* rowp = base + (size_t)(row0 + ai * 128 + m * 16) * ldc + col0;
#pragma unroll
                for (int bj = 0; bj < 2; ++bj) { const pg8::f32x4 v0 = acc[ai][bj][m][0], v1 = acc[ai][bj][m][1];
                    pg8::u32x4 w; w.x = pg8::cvt_pk_bf16(v0[0], v0[1]); w.y = pg8::cvt_pk_bf16(v0[2], v0[3]); w.z = pg8::cvt_pk_bf16(v1[0], v1[1]); w.w = pg8::cvt_pk_bf16(v1[2], v1[3]);
                    *(pg8::u32x4*)(rowp + bj * 128) = w; } }
    }
};

struct EpiOut {
    static constexpr bool PERM = true, AFTER_DRAIN = false;
    const float* x; float* x1; const float* mod;
    __device__ __forceinline__ void operator()(const pg8::f32x4 (&acc)[2][2][4][2], const pg8::Unit& u, int wr, int wc, int fr, int fq) const {
        const int row0 = u.pm * 256 + wr * 64 + fr, col0 = u.pn * 256 + wc * 32 + 8 * fq, b = (u.pm * 256) / SEQ;
        const float* g1 = mod + b * 6 * D + 2 * D + col0;
        pg8::f32x4 gv[2][2];
#pragma unroll
        for (int bj = 0; bj < 2; ++bj) { gv[bj][0] = *(const pg8::f32x4*)(g1 + bj * 128); gv[bj][1] = *(const pg8::f32x4*)(g1 + bj * 128 + 4); }
#pragma unroll
        for (int ai = 0; ai < 2; ++ai)
#pragma unroll
            for (int m = 0; m < 4; ++m) { const size_t off = (size_t)(row0 + ai * 128 + m * 16) * D + col0;
#pragma unroll
                for (int bj = 0; bj < 2; ++bj) { const float* xi = x + off + bj * 128; float* xo = x1 + off + bj * 128;
                    *(pg8::f32x4*)xo = *(const pg8::f32x4*)xi + gv[bj][0] * acc[ai][bj][m][0]; *(pg8::f32x4*)(xo + 4) = *(const pg8::f32x4*)(xi + 4) + gv[bj][1] * acc[ai][bj][m][1]; } }
    }
};
struct EpiGU {
    static constexpr bool PERM = true, AFTER_DRAIN = false;
    bf16_t* u;
    __device__ __forceinline__ void operator()(const pg8::f32x4 (&acc)[2][2][4][2], const pg8::Unit& un, int wr, int wc, int fr, int fq) const {
        const int row0 = un.pm * 256 + wr * 64 + fr, col0 = un.pn * 128 + wc * 32 + 8 * fq;
#pragma unroll
        for (int ai = 0; ai < 2; ++ai)
#pragma unroll
            for (int m = 0; m < 4; ++m) { bf16_t* rowp = u + (size_t)(row0 + ai * 128 + m * 16) * ED + col0;
                float o[8];
#pragma unroll
                for (int n = 0; n < 2; ++n)
#pragma unroll
                    for (int j = 0; j < 4; ++j) o[4 * n + j] = silu_f(acc[ai][0][m][n][j]) * acc[ai][1][m][n][j];
                pg8::u32x4 w; w.x = pg8::cvt_pk_bf16(o[0], o[1]); w.y = pg8::cvt_pk_bf16(o[2], o[3]); w.z = pg8::cvt_pk_bf16(o[4], o[5]); w.w = pg8::cvt_pk_bf16(o[6], o[7]);
                *(pg8::u32x4*)rowp = w; }
    }
};
struct EpiDown {
    static constexpr bool PERM = true, AFTER_DRAIN = false;
    bf16_t* yc; const int* list; const float* egate;
    __device__ __forceinline__ void operator()(const pg8::f32x4 (&acc)[2][2][4][2], const pg8::Unit& u, int wr, int wc, int fr, int fq) const {
        const unsigned col0 = (unsigned)(u.pn * 256 + wc * 32 + 8 * fq);
        const int* lp = list + (size_t)u.e * M + u.lt * 256;
#pragma unroll
        for (int ai = 0; ai < 2; ++ai)
#pragma unroll
            for (int m = 0; m < 4; ++m) { const int r = ai * 128 + wr * 64 + m * 16 + fr;
                if (r < u.nrows) { unsigned ts; float gt;
                    if (u.e < NE) { const int a = lp[r]; ts = (unsigned)((a >> 3) * NSLOT + (a & 7)); gt = egate[a]; } else { ts = (unsigned)((u.lt * 256 + r) * NSLOT + 8); gt = 1.f; }
                    bf16_t* rowp = yc + (ts * 512u + col0);
#pragma unroll
                    for (int bj = 0; bj < 2; ++bj) { const pg8::f32x4 v0 = acc[ai][bj][m][0] * gt, v1 = acc[ai][bj][m][1] * gt;
                        pg8::u32x4 w; w.x = pg8::cvt_pk_bf16(v0[0], v0[1]); w.y = pg8::cvt_pk_bf16(v0[2], v0[3]); w.z = pg8::cvt_pk_bf16(v1[0], v1[1]); w.w = pg8::cvt_pk_bf16(v1[2], v1[3]);
                        *(pg8::u32x4*)(rowp + bj * 128) = w; } }
                asm volatile("" ::: "memory"); }
    }
};
template <bool GATHER>
struct GroupedOrder {
    typedef pg8::Unit Unit;
    const char* A; const char* Bt; int K, nN, G, c, total; const LAS int* plan; const int* list; size_t bs_e, bs_pn; int pn0;
    __device__ __forceinline__ void init(const void* A_, const void* Bt_, int K_, int nN_, int G_, int c_, const LAS int* plan_, const int* list_, size_t bs_e_, size_t bs_pn_, int pn0_) {
        A = (const char*)A_; Bt = (const char*)Bt_; K = K_; nN = nN_; G = G_; c = c_; plan = plan_; list = list_; bs_e = bs_e_; bs_pn = bs_pn_; pn0 = pn0_; total = __builtin_amdgcn_readfirstlane(plan[NE + 1]) * nN; }
    __device__ __forceinline__ bool next(int i, Unit& u) const {
        const int L = i * G + c; if (L >= total) return false;
        int wgid = L; { const int q = total / 8, r = total % 8, xcd = wgid % 8, off = wgid / 8; wgid = (xcd < r ? xcd * (q + 1) : r * (q + 1) + (xcd - r) * q) + off; }
        const int tile = wgid / nN; u.pn = wgid % nN; u.pm = tile;
        int e = 0;
        for (int j = 1; j <= NE; ++j) e += (plan[j] <= tile) ? 1 : 0;
        e = __builtin_amdgcn_readfirstlane(e);
        u.e = e; u.lt = __builtin_amdgcn_readfirstlane(tile - plan[e]); const int rem = __builtin_amdgcn_readfirstlane(plan[80 + e]) - u.lt * 256; u.nrows = rem < 256 ? rem : 256; return true;
    }
    __device__ __forceinline__ const char* a_base(const Unit& u) const { return GATHER ? A : A + (size_t)u.pm * 512 * K; }
    __device__ __forceinline__ const char* b_base(const Unit& u) const { return Bt + (size_t)u.e * bs_e + (size_t)(pn0 + u.pn) * bs_pn; }
    __device__ __forceinline__ void lane_off(const Unit& u, const int (&R)[2], const int (&C)[2], unsigned (&o)[2][2]) const {
#pragma unroll
        for (int h = 0; h < 2; ++h)
#pragma unroll
            for (int i = 0; i < 2; ++i) { const int r = h * 128 + R[i];
                if (GATHER) { int tok = 0; if (r < u.nrows) { const int idx = u.lt * 256 + r; tok = u.e < NE ? (list[(size_t)u.e * M + idx] >> 3) : idx; }
                    o[h][i] = (unsigned)((tok * K + C[i]) * 2); }
                else o[h][i] = (unsigned)((r * K + C[i]) * 2); }
    }
    __device__ __forceinline__ void a_ready(const Unit&) const {}
    __device__ __forceinline__ void done(const Unit&) const {}
};

template <class CM>
__device__ __forceinline__ void transpose_item(const float* W, int ldw, bf16_t* WT, int ldt, int k0, int n0, LAS float* scr, int lane, const CM& colmap) {
    const int sc = colmap(n0 + (lane & 31));
#pragma unroll 8
    for (int i = 0; i < 32; ++i) { const int kk = 2 * i + (lane >> 5); scr[kk * 33 + (lane & 31)] = sc >= 0 ? W[(size_t)(k0 + kk) * ldw + sc] : 0.f; }
    LDS_WAIT(); asm volatile("" ::: "memory");
    const int c = lane & 7;
#pragma unroll
    for (int j = 0; j < 4; ++j) { const int n = (lane >> 3) + 8 * j; const LAS float* s = scr + (8 * c) * 33 + n;
        v4u o; o.x = pk2(s[0 * 33], s[1 * 33]); o.y = pk2(s[2 * 33], s[3 * 33]); o.z = pk2(s[4 * 33], s[5 * 33]); o.w = pk2(s[6 * 33], s[7 * 33]);
        *(GAS v4u*)(WT + (size_t)(n0 + n) * ldt + k0 + 8 * c) = o; }
    LDS_WAIT(); asm volatile("" ::: "memory");
}

constexpr int NPHASE = 14;
__global__ void __launch_bounds__(NWAVES * 64, 2) mega(P p) {
    extern __shared__ __attribute__((aligned(16))) unsigned char lds_raw[];
    LAS unsigned char* lds = (LAS unsigned char*)lds_raw;
    volatile LAS unsigned* MISC = (volatile LAS unsigned*)(lds + MISC_OFF);
    const int tid = threadIdx.x, lane = tid & 63, wave = __builtin_amdgcn_readfirstlane(tid >> 6);
    const int G = gridDim.x; const int bx = blockIdx.x; const int vcu = (G % 8 == 0) ? (bx % 8) * (G / 8) + bx / 8 : bx;
    unsigned char* ws = p.ws;
    gu32* ctl = (gu32*)(ws + WS_CTL);
    for (int u = tid; u < (LDS_BYTES - LDSCTL_OFF) / 4; u += NWAVES * 64) ((LAS unsigned*)(lds + LDSCTL_OFF))[u] = 0u;
    __syncthreads();
    XcdBarrier bar = xcd_barrier_post((unsigned*)(ctl + CW_BAR) + p.li * XCD_BAR_WORDS, MISC + 8);
    const int lo = p.ph_lo, hi = p.ph_hi;
#ifndef PHMASK
#define PHMASK 0xffffffffu
#endif
#define IN(k) (((PHMASK >> (k)) & 1u) && lo <= (k) && (k) < hi)
#define BOTH(k) (IN(k) && IN((k) + 1))
    const int gw = vcu * NWAVES + wave, NGW = G * NWAVES;
    float* modv = (float*)(ws + WS_MOD);

    if (IN(0)) {
        if (bx < 192) {
            LAS float* part = (LAS float*)(lds + RING_OFF);
            const int j0 = bx * 32, cc = lane & 31, ks = wave * 2 + (lane >> 5);
            float a0 = 0.f, a1 = 0.f, a2 = 0.f, a3 = 0.f;
#pragma unroll 8
            for (int k = ks * 64; k < ks * 64 + 64; ++k) { const float wv = p.mod_w[(size_t)k * 6 * D + j0 + cc];
                a0 += silu_f(p.c[k]) * wv; a1 += silu_f(p.c[D + k]) * wv; a2 += silu_f(p.c[2 * D + k]) * wv; a3 += silu_f(p.c[3 * D + k]) * wv; }
            part[(ks * 4 + 0) * 32 + cc] = a0; part[(ks * 4 + 1) * 32 + cc] = a1; part[(ks * 4 + 2) * 32 + cc] = a2; part[(ks * 4 + 3) * 32 + cc] = a3;
            __syncthreads();
            if (tid < 128) { const int b = tid >> 5, c2 = tid & 31; float s = p.mod_b[j0 + c2];
                for (int q = 0; q < 16; ++q) s += part[(q * 4 + b) * 32 + c2];
                modv[b * 6 * D + j0 + c2] = s; }
            __syncthreads();
        }
        LAS float* scr = (LAS float*)(lds + RING_OFF + wave * 16384);
        constexpr int I_IN = (D / 64) * (NWIN / 32), I_OUT = (2048 / 64) * (D / 32);
        bf16_t* WinT = (bf16_t*)(ws + WS_WIN_T); bf16_t* WoutT = (bf16_t*)(ws + WS_WOUT_T);
        for (int it = gw; it < I_IN + I_OUT; it += NGW) {
            if (it < I_IN) { const int nb = it % (NWIN / 32), kb = it / (NWIN / 32);
                transpose_item(p.w_in, IN_COLS, WinT, D, kb * 64, nb * 32, scr, lane, [](int n) { return n < 3072 ? n : (n < 4608 ? n + 16 : (n < 4624 ? n - 1536 : -1)); }); }
            else { const int r = it - I_IN, nb = r % (D / 32), kb = r / (D / 32);
                transpose_item(p.w_out, D, WoutT, 2048, kb * 64, nb * 32, scr, lane, [](int n) { return n; }); }
        }
        if (BOTH(0)) xcd_barrier(bar);
    }

    if (IN(1)) {
        bf16_t* hn = (bf16_t*)(ws + WS_HN);
        for (int m = gw; m < M; m += NGW) {
            const int b = m / SEQ; const GAS f32x4* xr = (const GAS f32x4*)(p.x + (size_t)m * D) + lane;
            f32x4 v[4]; float s = 0.f;
#pragma unroll
            for (int j = 0; j < 4; ++j) { v[j] = xr[64 * j]; s += (v[j].x * v[j].x + v[j].y * v[j].y) + (v[j].z * v[j].z + v[j].w * v[j].w); }
            const float rstd = rsqrtf(wave_sum(s) * (1.f / D) + EPS);
            GAS unsigned long long* o8 = (GAS unsigned long long*)(hn + (size_t)m * D) + lane;
#pragma unroll
            for (int j = 0; j < 4; ++j) { const int d = 4 * lane + 256 * j; const f32x4 g = *(const f32x4*)(p.norm1_g + d), sc = *(const f32x4*)(modv + b * 6 * D + D + d), sh = *(const f32x4*)(modv + b * 6 * D + d);
                const f32x4 h = v[j] * rstd * g * (sc + 1.f) + sh;
                o8[64 * j] = (unsigned long long)pk2(h.x, h.y) | ((unsigned long long)pk2(h.z, h.w) << 32); }
        }
        if (BOTH(1)) xcd_barrier(bar);
    }

    if (IN(2)) {
        pg8::DenseOrder S; S.init(ws + WS_HN, ws + WS_WIN_T, M, NWIN, D, G, bx);
        EpiIn E{(bf16_t*)(ws + WS_ZQ), (bf16_t*)(ws + WS_XBC), (bf16_t*)(ws + WS_K), (bf16_t*)(ws + WS_V), (float*)(ws + WS_DT)};
        pg8::gemm_phase<EpiIn, pg8::DenseOrder, true, true>(lds + RING_OFF, D, S, E);
        if (BOTH(2)) xcd_barrier(bar);
    }

    if (IN(3)) {
        const bf16_t* xbc = (const bf16_t*)(ws + WS_XBC); bf16_t* xc = (bf16_t*)(ws + WS_XC);
        for (int i = bx * 512 + tid; i < M * 256; i += G * 512) {
            const int row = i >> 8, cg = i & 255, t = row & (SEQ - 1), ch = cg * 8;
            float a[8];
#pragma unroll
            for (int j = 0; j < 8; ++j) a[j] = p.conv_b[ch + j];
#pragma unroll
            for (int k = 0; k < CONV_K; ++k) { const int tt = t - (CONV_K - 1) + k; if (tt >= 0) { const v4u raw = *(const v4u*)(xbc + (size_t)(row - (CONV_K - 1) + k) * CONV_CH + ch);
                const unsigned w4[4] = {raw.x, raw.y, raw.z, raw.w};
#pragma unroll
                for (int j = 0; j < 4; ++j) { a[2 * j] += p.conv_w[k * CONV_CH + ch + 2 * j] * __uint_as_float(w4[j] << 16); a[2 * j + 1] += p.conv_w[k * CONV_CH + ch + 2 * j + 1] * __uint_as_float(w4[j] & 0xffff0000u); } } }
            v4u o; o.x = pk2(silu_f(a[0]), silu_f(a[1])); o.y = pk2(silu_f(a[2]), silu_f(a[3])); o.z = pk2(silu_f(a[4]), silu_f(a[5])); o.w = pk2(silu_f(a[6]), silu_f(a[7]));
            *(v4u*)(xc + (size_t)row * CONV_CH + ch) = o;
        }
        {
            float* dt = (float*)(ws + WS_DT); float* cs = (float*)(ws + WS_CS);
            for (int it = gw; it < BATCH * NCHUNK * SSM_HEADS; it += NGW) { const int h = it % SSM_HEADS, bc = it / SSM_HEADS; const float A = -__expf(p.a_log[h]), bias = p.dt_bias[h];
                const int r0 = bc * CHUNK + lane, r1 = r0 + 64;
                const float d0 = softplus_f(dt[r0 * 16 + h] + bias), d1 = softplus_f(dt[r1 * 16 + h] + bias);
                float s0 = d0 * A, s1 = d1 * A;
#pragma unroll
                for (int o = 1; o < 64; o <<= 1) { const float u0 = __shfl_up(s0, o), u1 = __shfl_up(s1, o); if (lane >= o) { s0 += u0; s1 += u1; } }
                s1 += __shfl(s0, 63);
                dt[r0 * 16 + h] = d0; dt[r1 * 16 + h] = d1; cs[r0 * 16 + h] = s0; cs[r1 * 16 + h] = s1; }
        }
        {
            bf16_t* zq = (bf16_t*)(ws + WS_ZQ); const bf16_t* kk = (const bf16_t*)(ws + WS_K); const bf16_t* vv = (const bf16_t*)(ws + WS_V); float* ssq = (float*)(ws + WS_SSQ);
            for (int i = bx * 512 + tid; i < BATCH * ATT_HEADS * SEQ; i += G * 512) {
                const int t = i % SEQ, bh = i / SEQ, h = bh % ATT_HEADS, b = bh / ATT_HEADS, kvh = h / 4, row = b * SEQ + t;
                float q[HD], o[HD];
#pragma unroll
                for (int d = 0; d < HD; ++d) { q[d] = bf2f(zq[(size_t)row * 2048 + 1024 + h * HD + d]); o[d] = 0.f; }
                const float sink = p.sinks[h]; float m = sink, l = 1.f;
                for (int dist = 0; dist < WINDOW; ++dist) { const int s = t - dist; if (s < 0) break; const int kr = b * SEQ + s;
                    float sc = 0.f;
#pragma unroll
                    for (int d = 0; d < HD; ++d) sc += q[d] * bf2f(kk[(size_t)kr * D_KV + kvh * HD + d]);
                    sc = sc * 0.125f + p.rel_bias[c_bucket[dist] * ATT_HEADS + h];
                    const float mn = fmaxf(m, sc), f = __expf(m - mn), pe = __expf(sc - mn); l = l * f + pe; m = mn;
#pragma unroll
                    for (int d = 0; d < HD; ++d) o[d] = o[d] * f + pe * bf2f(vv[(size_t)kr * D_KV + kvh * HD + d]); }
                const float inv = 1.f / l; float ss = 0.f;
#pragma unroll
                for (int d = 0; d < HD; ++d) { const float ov = o[d] * inv; ss += ov * ov; zq[(size_t)row * 2048 + 1024 + h * HD + d] = f2bf(ov); }
                ssq[row * 16 + h] = ss;
            }
        }
        if (BOTH(3)) xcd_barrier(bar);
    }

    if (IN(4)) {
        const bf16_t* xc = (const bf16_t*)(ws + WS_XC); const float* dt = (const float*)(ws + WS_DT); const float* cs = (const float*)(ws + WS_CS);
        LAS float* xs = (LAS float*)(lds + RING_OFF);
        LAS float* wl = xs + CHUNK * 65;
        for (int bch = bx; bch < BATCH * NCHUNK * SSM_HEADS; bch += G) {
            const int h = bch % SSM_HEADS, bc = bch / SSM_HEADS, g = h / 4;
            const float cl = cs[(bc * CHUNK + CHUNK - 1) * 16 + h];
            __syncthreads();
            if (tid < CHUNK) { const int row = bc * CHUNK + tid; wl[tid] = __expf(cl - cs[row * 16 + h]) * dt[row * 16 + h]; }
            for (int i = tid; i < CHUNK * HD; i += 512) { const int l = i / HD, pp = i % HD; xs[l * 65 + pp] = bf2f(xc[(size_t)(bc * CHUNK + l) * CONV_CH + h * HD + pp]); }
            __syncthreads();
            float* S = (float*)(ws + WS_S) + (size_t)bch * HD * D_STATE;
            const int n = tid & 127, pq = tid >> 7;
            float acc[16];
#pragma unroll
            for (int j = 0; j < 16; ++j) acc[j] = 0.f;
            for (int l = 0; l < CHUNK; ++l) { const float bv = bf2f(xc[(size_t)(bc * CHUNK + l) * CONV_CH + D_SSM + g * D_STATE + n]) * wl[l];
#pragma unroll
                for (int j = 0; j < 16; ++j) acc[j] += bv * xs[l * 65 + pq * 16 + j]; }
#pragma unroll
            for (int j = 0; j < 16; ++j) S[(pq * 16 + j) * D_STATE + n] = acc[j];
        }
        if (BOTH(4)) xcd_barrier(bar);
    }

    if (IN(5)) {
        float* S = (float*)(ws + WS_S); const float* cs = (const float*)(ws + WS_CS);
        for (int i = bx * 512 + tid; i < BATCH * SSM_HEADS * HD * D_STATE; i += G * 512) {
            const int pn = i % (HD * D_STATE), bh = i / (HD * D_STATE), h = bh % SSM_HEADS, b = bh / SSM_HEADS;
            float st = 0.f;
            for (int c = 0; c < NCHUNK; ++c) { const size_t idx = ((size_t)((b * NCHUNK + c) * SSM_HEADS + h)) * HD * D_STATE + pn; const float s = S[idx]; S[idx] = st;
                const float dec = __expf(cs[((b * NCHUNK + c) * CHUNK + CHUNK - 1) * 16 + h]); st = st * dec + s; }
        }
        bf16_t* zq = (bf16_t*)(ws + WS_ZQ); const float* ssq = (const float*)(ws + WS_SSQ);
        for (int m = gw; m < M; m += NGW) {
            float s = lane < 16 ? ssq[m * 16 + lane] : 0.f; s = wave_sum(s); const float r = rsqrtf(s * (1.f / 1024.f) + EPS);
            bf16_t* o = zq + (size_t)m * 2048 + 1024 + lane * 16;
            v4u w0 = *(v4u*)o, w1 = *(v4u*)(o + 8); unsigned w[8] = {w0.x, w0.y, w0.z, w0.w, w1.x, w1.y, w1.z, w1.w};
#pragma unroll
            for (int j = 0; j < 8; ++j) { const int d = lane * 16 + 2 * j; w[j] = pk2(__uint_as_float(w[j] << 16) * r * p.att_norm_g[d], __uint_as_float(w[j] & 0xffff0000u) * r * p.att_norm_g[d + 1]); }
            *(v4u*)o = (v4u){w[0], w[1], w[2], w[3]}; *(v4u*)(o + 8) = (v4u){w[4], w[5], w[6], w[7]};
        }
        if (BOTH(5)) xcd_barrier(bar);
    }

    if (IN(6)) {
        const bf16_t* xc = (const bf16_t*)(ws + WS_XC); const float* dt = (const float*)(ws + WS_DT); const float* cs = (const float*)(ws + WS_CS); bf16_t* zq = (bf16_t*)(ws + WS_ZQ);
        LAS float* CB = (LAS float*)(lds + RING_OFF);
        LAS float* csl = CB + 64 * 129; LAS float* dtl = csl + 128;
        LAS float* yl = dtl + 128;
        for (int unit = bx; unit < BATCH * NCHUNK * SSM_GROUPS * 2; unit += G) {
            const int lh = unit & 1, bcg = unit >> 1, g = bcg % SSM_GROUPS, bc = bcg / SSM_GROUPS;
            const bf16_t* Bm = xc + (size_t)bc * CHUNK * CONV_CH + D_SSM + g * D_STATE; const bf16_t* Cm = Bm + SSM_GROUPS * D_STATE;
            __syncthreads();
            for (int i = tid; i < 64 * CHUNK; i += 512) { const int ll = i >> 7, l = lh * 64 + ll, s = i & 127; float a = 0.f;
                if (s <= l) for (int n = 0; n < D_STATE; ++n) a += bf2f(Cm[(size_t)l * CONV_CH + n]) * bf2f(Bm[(size_t)s * CONV_CH + n]);
                CB[ll * 129 + s] = a; }
            for (int r = 0; r < 4; ++r) { const int h = g * 4 + r;
                __syncthreads();
                if (tid < CHUNK) { csl[tid] = cs[(bc * CHUNK + tid) * 16 + h]; dtl[tid] = dt[(bc * CHUNK + tid) * 16 + h]; }
                __syncthreads();
                const float* St = (const float*)(ws + WS_S) + (size_t)(bc * SSM_HEADS + h) * HD * D_STATE;
                for (int i = tid; i < 64 * HD; i += 512) { const int ll = i / HD, l = lh * 64 + ll, pp = i % HD; float acc = 0.f;
                    for (int s = 0; s <= l; ++s) acc += CB[ll * 129 + s] * __expf(csl[l] - csl[s]) * dtl[s] * bf2f(xc[(size_t)(bc * CHUNK + s) * CONV_CH + h * HD + pp]);
                    float off = 0.f; for (int n = 0; n < D_STATE; ++n) off += bf2f(Cm[(size_t)l * CONV_CH + n]) * St[pp * D_STATE + n];
                    acc += __expf(csl[l]) * off + p.d_skip[h] * bf2f(xc[(size_t)(bc * CHUNK + l) * CONV_CH + h * HD + pp]);
                    yl[ll * 257 + r * HD + pp] = acc; }
            }
            __syncthreads();
            for (int ll = wave; ll < 64; ll += NWAVES) { const int row = bc * CHUNK + lh * 64 + ll; bf16_t* zr = zq + (size_t)row * 2048 + g * 256;
                float yz[4], ss = 0.f;
#pragma unroll
                for (int j = 0; j < 4; ++j) { const int c = lane + 64 * j; yz[j] = yl[ll * 257 + c] * silu_f(bf2f(zr[c])); ss += yz[j] * yz[j]; }
                const float rr = rsqrtf(wave_sum(ss) * (1.f / 256.f) + EPS);
#pragma unroll
                for (int j = 0; j < 4; ++j) { const int c = lane + 64 * j; zr[c] = f2bf(yz[j] * rr * p.ssm_norm_g[g * 256 + c]); } }
        }
        if (BOTH(6)) xcd_barrier(bar);
    }

    if (IN(7)) {
        pg8::DenseOrder S; S.init(ws + WS_ZQ, ws + WS_WOUT_T, M, D, 2048, G, bx);
        EpiOut E{p.x, p.out, modv};
        pg8::gemm_phase<EpiOut, pg8::DenseOrder, true, true>(lds + RING_OFF, 2048, S, E);
        if (BOTH(7)) xcd_barrier(bar);
    }

    if (IN(8)) {
        LAS float* hrow = (LAS float*)(lds + RING_OFF + wave * 16384);
        bf16_t* h2 = (bf16_t*)(ws + WS_H2); int* eidx = (int*)(ws + WS_EIDX); float* eg = (float*)(ws + WS_EGATE); int* cnt = (int*)(ws + WS_CTL) + CW_CNT; int* list = (int*)(ws + WS_LIST);
        const float rbias = p.router_bias[lane];
        for (int m0 = gw * 4; m0 < M; m0 += NGW * 4) {
#pragma unroll
            for (int r = 0; r < 4; ++r) { const int m = m0 + r, b = m / SEQ; const GAS f32x4* xr = (const GAS f32x4*)(p.out + (size_t)m * D) + lane;
                f32x4 v[4]; float s = 0.f;
#pragma unroll
                for (int j = 0; j < 4; ++j) { v[j] = xr[64 * j]; s += (v[j].x * v[j].x + v[j].y * v[j].y) + (v[j].z * v[j].z + v[j].w * v[j].w); }
                const float rstd = rsqrtf(wave_sum(s) * (1.f / D) + EPS);
                GAS unsigned long long* o8 = (GAS unsigned long long*)(h2 + (size_t)m * D) + lane;
#pragma unroll
                for (int j = 0; j < 4; ++j) { const int d = 4 * lane + 256 * j; const f32x4 g = *(const f32x4*)(p.norm2_g + d), sc = *(const f32x4*)(modv + b * 6 * D + 4 * D + d), sh = *(const f32x4*)(modv + b * 6 * D + 3 * D + d);
                    const f32x4 h = v[j] * rstd * g * (sc + 1.f) + sh;
                    *(LAS f32x4*)(hrow + r * 1024 + d) = h;
                    o8[64 * j] = (unsigned long long)pk2(h.x, h.y) | ((unsigned long long)pk2(h.z, h.w) << 32); } }
            LDS_WAIT();
            float lg0 = 0.f, lg1 = 0.f, lg2 = 0.f, lg3 = 0.f;
#pragma unroll 8
            for (int d = 0; d < D; ++d) { const float w = p.router_w[d * NE + lane]; lg0 += hrow[d] * w; lg1 += hrow[1024 + d] * w; lg2 += hrow[2048 + d] * w; lg3 += hrow[3072 + d] * w; }
            const float lgs[4] = {lg0, lg1, lg2, lg3};
#pragma unroll
            for (int r = 0; r < 4; ++r) { const int m = m0 + r;
                const float sc = 1.f / (1.f + __expf(-lgs[r])), sel = sc + rbias;
                float m1 = sel, m2 = -INFINITY;
#pragma unroll
                for (int o = 1; o < 8; o <<= 1) { const float p1 = __shfl_xor(m1, o), p2 = __shfl_xor(m2, o); const float n1 = fmaxf(m1, p1), n2 = fmaxf(fminf(m1, p1), fmaxf(m2, p2)); m1 = n1; m2 = n2; }
                const float gs = m1 + m2; const int myg = lane >> 3;
                int grank = 0;
#pragma unroll
                for (int g2 = 0; g2 < 8; ++g2) { const float og = __shfl(gs, g2 * 8); grank += (og > gs || (og == gs && g2 < myg)) ? 1 : 0; }
                const bool allowed = grank < 4; const float val = allowed ? sel : -INFINITY;
                int rank = 0;
#pragma unroll
                for (int e2 = 0; e2 < NE; ++e2) { const float ov = __shfl(val, e2); rank += (ov > val || (ov == val && e2 < lane)) ? 1 : 0; }
                const bool selb = allowed && rank < TOPK;
                const float wsum = wave_sum(selb ? sc : 0.f);
                if (selb) { const int a = m * 8 + rank; eidx[a] = lane; eg[a] = sc / wsum * 2.5f; const int pos = atomicAdd(&cnt[lane], 1); list[lane * M + pos] = a; }
            }
        }
        LAS float* scr = (LAS float*)(lds + RING_OFF + wave * 16384);
        constexpr int I_GU = 16 * 16, I_D = 4 * 32;
        bf16_t* WguT = (bf16_t*)(ws + WS_WGU); bf16_t* WdT = (bf16_t*)(ws + WS_WD);
        for (int it = gw; it < (NE + 1) * (I_GU + I_D); it += NGW) {
            const int e = it / (I_GU + I_D), r = it % (I_GU + I_D);
            if (r < I_GU) { const int nb = r & 15, kb = r >> 4, up = (nb >> 2) & 1;
                const float* W = e < NE ? (up ? p.exp_w_up : p.exp_w_gate) + (size_t)e * D * ED : (up ? p.sh_w_up : p.sh_w_gate);
                transpose_item(W, ED, WguT + (size_t)e * 512 * D, D, kb * 64, nb * 32, scr, lane, [](int n) { return (n >> 8) * 128 + (n & 127); }); }
            else { const int r2 = r - I_GU, nb = r2 & 31, kb = r2 >> 5;
                const float* W = e < NE ? p.exp_w_down + (size_t)e * ED * D : p.sh_w_down;
                transpose_item(W, D, WdT + (size_t)e * D * ED, ED, kb * 64, nb * 32, scr, lane, [](int n) { return n; }); }
        }
        if (BOTH(8)) xcd_barrier(bar);
    }

    LAS int* plan = (LAS int*)(lds + PLAN_OFF);
#define MAKE_PLAN() do { __syncthreads(); if (tid == 0) { const int* cnt = (const int*)(ws + WS_CTL) + CW_CNT; int off = 0; \
        for (int e = 0; e <= NE; ++e) { const int c = e < NE ? __hip_atomic_load(cnt + e, RLX_AGENT) : M; plan[e] = off; plan[80 + e] = c; off += (c + 255) >> 8; } plan[NE + 1] = off; } __syncthreads(); } while (0)
    if (IN(9)) {
        MAKE_PLAN();
        GroupedOrder<true> S; S.init(ws + WS_H2, ws + WS_WGU, D, 2, G, bx, plan, (const int*)(ws + WS_LIST), (size_t)512 * D * 2, (size_t)256 * D * 2, 0);
        EpiGU E{(bf16_t*)(ws + WS_U)};
        pg8::gemm_phase<EpiGU, GroupedOrder<true>, true, true>(lds + RING_OFF, D, S, E);
        if (BOTH(9)) xcd_barrier(bar);
    }
#define DOWN_PHASE(k, half) if (IN(k)) { MAKE_PLAN(); \
        GroupedOrder<false> S; S.init(ws + WS_U, ws + WS_WD, ED, 2, G, bx, plan, (const int*)(ws + WS_LIST), (size_t)D * ED * 2, (size_t)256 * ED * 2, 2 * (half)); \
        EpiDown E{(bf16_t*)(ws + WS_YC), (const int*)(ws + WS_LIST), (const float*)(ws + WS_EGATE)}; \
        pg8::gemm_phase<EpiDown, GroupedOrder<false>, true, true>(lds + RING_OFF, ED, S, E); \
        if (BOTH(k)) xcd_barrier(bar); }
    DOWN_PHASE(10, 0)
    if (IN(11)) {
        const bf16_t* yc = (const bf16_t*)(ws + WS_YC);
        for (int i = bx * 512 + tid; i < M * 64; i += G * 512) { const int tok = i >> 6, c8 = (i & 63) * 8, b = tok / SEQ;
            float s[8] = {0.f, 0.f, 0.f, 0.f, 0.f, 0.f, 0.f, 0.f};
#pragma unroll
            for (int k = 0; k < NSLOT; ++k) { const v4u raw = *(const v4u*)(yc + ((size_t)tok * NSLOT + k) * 512 + c8); const unsigned w4[4] = {raw.x, raw.y, raw.z, raw.w};
#pragma unroll
                for (int j = 0; j < 4; ++j) { s[2 * j] += __uint_as_float(w4[j] << 16); s[2 * j + 1] += __uint_as_float(w4[j] & 0xffff0000u); } }
            float* xo = p.out + (size_t)tok * D + c8; const float* g2 = modv + b * 6 * D + 5 * D + c8;
            f32x4 x0 = *(f32x4*)xo, x1v = *(f32x4*)(xo + 4);
            x0 = x0 + *(const f32x4*)g2 * (f32x4){s[0], s[1], s[2], s[3]}; x1v = x1v + *(const f32x4*)(g2 + 4) * (f32x4){s[4], s[5], s[6], s[7]};
            *(f32x4*)xo = x0; *(f32x4*)(xo + 4) = x1v; }
        if (BOTH(11)) xcd_barrier(bar);
    }
    DOWN_PHASE(12, 1)
    if (IN(13)) {
        const bf16_t* yc = (const bf16_t*)(ws + WS_YC);
        for (int m = gw; m < M; m += NGW) { const int b = m / SEQ, c8 = lane * 8;
            float s[8] = {0.f, 0.f, 0.f, 0.f, 0.f, 0.f, 0.f, 0.f};
#pragma unroll
            for (int k = 0; k < NSLOT; ++k) { const v4u raw = *(const v4u*)(yc + ((size_t)m * NSLOT + k) * 512 + c8); const unsigned w4[4] = {raw.x, raw.y, raw.z, raw.w};
#pragma unroll
                for (int j = 0; j < 4; ++j) { s[2 * j] += __uint_as_float(w4[j] << 16); s[2 * j + 1] += __uint_as_float(w4[j] & 0xffff0000u); } }
            float* xo = p.out + (size_t)m * D; const float* g2 = modv + b * 6 * D + 5 * D + 512 + c8;
            f32x4 a0 = *(f32x4*)(xo + c8), a1 = *(f32x4*)(xo + c8 + 4), b0 = *(f32x4*)(xo + 512 + c8), b1 = *(f32x4*)(xo + 512 + c8 + 4);
            b0 = b0 + *(const f32x4*)g2 * (f32x4){s[0], s[1], s[2], s[3]}; b1 = b1 + *(const f32x4*)(g2 + 4) * (f32x4){s[4], s[5], s[6], s[7]};
            float ss = (a0.x * a0.x + a0.y * a0.y) + (a0.z * a0.z + a0.w * a0.w) + (a1.x * a1.x + a1.y * a1.y) + (a1.z * a1.z + a1.w * a1.w)
                     + (b0.x * b0.x + b0.y * b0.y) + (b0.z * b0.z + b0.w * b0.w) + (b1.x * b1.x + b1.y * b1.y) + (b1.z * b1.z + b1.w * b1.w);
            const float rstd = rsqrtf(wave_sum(ss) * (1.f / D) + EPS);
            const float* fg = p.final_g;
            *(f32x4*)(xo + c8) = a0 * rstd * *(const f32x4*)(fg + c8); *(f32x4*)(xo + c8 + 4) = a1 * rstd * *(const f32x4*)(fg + c8 + 4);
            *(f32x4*)(xo + 512 + c8) = b0 * rstd * *(const f32x4*)(fg + 512 + c8); *(f32x4*)(xo + 512 + c8 + 4) = b1 * rstd * *(const f32x4*)(fg + 512 + c8 + 4); }
    }
#undef IN
#undef BOTH
}

extern "C" void kernel_launch(void* const* d_in, const int* in_sizes, int n_in, void* d_out, int out_size, void* d_ws, size_t ws_size, hipStream_t stream) {
    static int grid = 0;
    if (grid == 0) {
        int dev = 0, cus = 0;
        if (hipGetDevice(&dev) != hipSuccess || hipDeviceGetAttribute(&cus, hipDeviceAttributeMultiprocessorCount, dev) != hipSuccess) { fprintf(stderr, "device query failed\n"); grid = -1; return; }
        if (hipFuncSetAttribute((const void*)mega, hipFuncAttributeMaxDynamicSharedMemorySize, LDS_BYTES) != hipSuccess) { fprintf(stderr, "hipFuncSetAttribute failed\n"); grid = -1; return; }
        int per_cu = 0;
        if (hipOccupancyMaxActiveBlocksPerMultiprocessor(&per_cu, (const void*)mega, NWAVES * 64, LDS_BYTES) != hipSuccess || per_cu < 1) fprintf(stderr, "occupancy query: %d\n", per_cu);
        (void)hipGetLastError();
        grid = cus;
        if (ws_size < WS_END) fprintf(stderr, "ws too small: %zu < %zu\n", ws_size, (size_t)WS_END);
    }
    if (grid < 0) return;
    P p{};
    const float** f = (const float**)&p;
    for (int i = 0; i < 26; ++i) f[i] = (const float*)d_in[i];
    p.out = (float*)d_out; p.ws = (unsigned char*)d_ws;
    (void)hipMemsetAsync(p.ws + WS_CTL, 0, CTL_BYTES, stream);
    p.ph_lo = 0; p.ph_hi = NPHASE; p.li = 0;
    hipLaunchKernelGGL(mega, dim3(grid), dim3(NWAVES * 64), LDS_BYTES, stream, p);
}
```

```cpp
#include <hip/hip_runtime.h>
#include <stdint.h>
#include <stdio.h>

typedef unsigned short bf16_t;

constexpr int D = 1024, BATCH = 4, SEQ = 4096, M = BATCH * SEQ;
constexpr int D_SSM = 1024, SSM_HEADS = 16, SSM_GROUPS = 4, D_STATE = 128, CONV_K = 4, CONV_CH = 2048, CHUNK = 128, NCHUNK = SEQ / CHUNK;
constexpr int HD = 64, ATT_HEADS = 16, KV_HEADS = 4, D_KV = 256, WINDOW = 128;
constexpr int IN_COLS = 4624;
constexpr int C_Z = 0, C_XBC = 1024, C_DT = 3072, C_Q = 3088, C_K = 4112, C_V = 4368;
constexpr int NE = 64, TOPK = 8, ED = 256;
constexpr float EPS = 1e-6f;
constexpr int NSLOT = 9;
constexpr int NWIN = 4864;

constexpr size_t MiB = 1u << 20;
constexpr size_t WS_CTL = 0;
constexpr size_t CTL_BYTES = 64 * 1024;
constexpr int CW_CNT = 0;
constexpr int CW_BAR = 4096;
constexpr size_t WS_MOD = 1 * MiB;
constexpr size_t WS_PLAN = 1 * MiB + 512 * 1024;
constexpr size_t WS_EIDX = 2 * MiB;
constexpr size_t WS_EGATE = 3 * MiB;
constexpr size_t WS_LIST = 4 * MiB;
constexpr size_t WS_WIN_T = 8 * MiB;
constexpr size_t WS_WOUT_T = 18 * MiB;
constexpr size_t WS_SSQ = 22 * MiB;
constexpr size_t WS_ZQ = 24 * MiB;
constexpr size_t WS_XBC = 88 * MiB;
constexpr size_t WS_K = 152 * MiB;
constexpr size_t WS_V = 160 * MiB;
constexpr size_t WS_DT = 168 * MiB;
constexpr size_t WS_CS = 169 * MiB;
constexpr size_t WS_HN = 170 * MiB;
constexpr size_t WS_S = 170 * MiB;
constexpr size_t WS_ST = 234 * MiB;
constexpr size_t WS_H2 = 24 * MiB;
constexpr size_t WS_WGU = 56 * MiB;
constexpr size_t WS_YC = 24 * MiB;
constexpr size_t WS_U = 168 * MiB;
constexpr size_t WS_WD = 248 * MiB;
constexpr size_t WS_END = 300 * MiB;
constexpr int UROWS_MAX = 163840;

__device__ __forceinline__ float bf2f(bf16_t v) { return __uint_as_float(((unsigned)v) << 16); }
__device__ __forceinline__ bf16_t f2bf(float f) { unsigned u = __float_as_uint(f); return (bf16_t)((u + 0x7fffu + ((u >> 16) & 1u)) >> 16); }
__device__ __forceinline__ unsigned pk2(float lo, float hi) { return (unsigned)f2bf(lo) | ((unsigned)f2bf(hi) << 16); }
__device__ __forceinline__ float silu_f(float x) { return x / (1.f + __expf(-x)); }
__device__ __forceinline__ float softplus_f(float x) { return x > 20.f ? x : log1pf(__expf(x)); }

__constant__ int c_bucket[128] = {0, 1, 2, 3, 4, 5, 6, 7, 8, 9, 10, 11, 12, 13, 14, 15, 16, 16, 16, 17, 17, 18, 18, 18, 19, 19, 19, 20, 20, 20, 20, 21, 21, 21, 21, 22, 22, 22, 22, 22, 23, 23, 23, 23, 23, 23, 24, 24, 24, 24, 24, 24, 25, 25, 25, 25, 25, 25, 25, 26, 26, 26, 26, 26, 26, 26, 26, 27, 27, 27, 27, 27, 27, 27, 27, 27, 27, 28, 28, 28, 28, 28, 28, 28, 28, 28, 28, 29, 29, 29, 29, 29, 29, 29, 29, 29, 29, 29, 29, 30, 30, 30, 30, 30, 30, 30, 30, 30, 30, 30, 30, 30, 30, 31, 31, 31, 31, 31, 31, 31, 31, 31, 31, 31, 31, 31, 31, 31};

struct P {
    const float *x, *c, *mod_w, *mod_b, *norm1_g, *norm2_g, *w_in, *conv_w, *conv_b, *dt_bias, *a_log, *d_skip, *ssm_norm_g, *att_norm_g, *sinks, *rel_bias,
        *w_out, *router_w, *router_bias, *exp_w_gate, *exp_w_up, *exp_w_down, *sh_w_gate, *sh_w_up, *sh_w_down, *final_g;
    float* out; unsigned char* ws;
    int ph_lo, ph_hi, li, pad;
};

namespace pg8 {
#define PG8_LAS __attribute__((address_space(3)))
typedef short bf16x8 __attribute__((ext_vector_type(8)));
typedef float f32x4 __attribute__((ext_vector_type(4)));
typedef unsigned u32x4 __attribute__((ext_vector_type(4)));
constexpr int BM = 256, BK = 64, HALF = 128, HTB = HALF * BK * 2  , STAGE_BYTES = 8 * HTB, NXCD = 8, WGM = 8;

__host__ __device__ __forceinline__ int lds_byte(int r, int c) { const int st = (r >> 4) * 2 + (c >> 5), rr = r & 15, cc = c & 31, ob = rr * 64 + cc * 2; return st * 1024 + (ob ^ (((ob >> 9) & 1) << 5)); }
__host__ __device__ __forceinline__ void stage_rc(int b, int& R, int& C) { const int st = b / 1024, sb = b % 1024, swz = sb ^ (((sb >> 9) & 1) << 5); R = (st >> 1) * 16 + swz / 64; C = (st & 1) * 32 + (swz % 64) / 2; }
__host__ __device__ __forceinline__ int perm32(int rho) { const int n = rho >> 4, i = rho & 15; return 8 * (i >> 2) + 4 * n + (i & 3); }

struct Unit { int pm, pn, e, nrows, lt; };

__device__ __forceinline__ unsigned cvt_pk_bf16(float lo, float hi) { unsigned r; asm volatile("v_cvt_pk_bf16_f32 %0, %1, %2" : "=v"(r) : "v"(lo), "v"(hi)); return r; }

struct DenseOrder {
    typedef pg8::Unit Unit;
    const char* A; const char* Bt; int K; int nM, nN, nwg, G, c;
    __device__ __forceinline__ void init(const void* A_, const void* Bt_, int M_, int N_, int K_, int G_, int c_) { A = (const char*)A_; Bt = (const char*)Bt_; K = K_; nM = M_ / BM; nN = N_ / BM; nwg = nM * nN; G = G_; c = c_; }
    __device__ __forceinline__ bool next(int i, Unit& u) const {
        const long L = (long)i * G + c; if (L >= nwg) return false;
        int wgid = (int)L; { const int q = nwg / NXCD, r = nwg % NXCD, xcd = wgid % NXCD, off = wgid / NXCD; wgid = (xcd < r ? xcd * (q + 1) : r * (q + 1) + (xcd - r) * q) + off; }
        const int nig = WGM * nN, gid = wgid / nig, fm = gid * WGM, gsz = (nM - fm) < WGM ? (nM - fm) : WGM;
        u.pm = fm + ((wgid % nig) % gsz); u.pn = (wgid % nig) / gsz; u.e = 0; u.nrows = 256; u.lt = 0; return true;
    }
    __device__ __forceinline__ const char* a_base(const Unit& u) const { return A + (size_t)u.pm * 512 * K; }
    __device__ __forceinline__ const char* b_base(const Unit& u) const { return Bt + (size_t)u.pn * 512 * K; }
    __device__ __forceinline__ void lane_off(const Unit&, const int (&R)[2], const int (&C)[2], unsigned (&o)[2][2]) const {
#pragma unroll
        for (int h = 0; h < 2; ++h)
#pragma unroll
            for (int i = 0; i < 2; ++i) o[h][i] = (unsigned)(((h * HALF + R[i]) * K + C[i]) * 2);
    }
    __device__ __forceinline__ void a_ready(const Unit&) const {}
    __device__ __forceinline__ void done(const Unit&) const {}
};

template <class Epi, class Sched, bool ALIGN_EPI = false, bool SP2 = false>
__device__ __forceinline__ void gemm_phase(PG8_LAS unsigned char* lds, const int K, const Sched& S, const Epi& E) {
    typedef typename Sched::Unit Unit;
    const int tid = threadIdx.x, wid = __builtin_amdgcn_readfirstlane(tid >> 6), lane = tid & 63, wr = wid >> 2, wc = wid & 3, fr = lane & 15, fq = lane >> 4;
    const int nt = K / BK;
    unsigned voffB[2]; int stR[2], stC[2];
#pragma unroll
    for (int i = 0; i < 2; ++i) { int R, C; stage_rc(tid * 16 + i * 8192, R, C); const int Rb = Epi::PERM ? ((R & ~31) + perm32(R & 31)) : R;
        stR[i] = R; stC[i] = C; voffB[i] = (unsigned)(Rb * K + C) * 2u; }
    const size_t kstep = (size_t)(BK * 2);
    const size_t hstep = (size_t)HALF * K * 2;
    const size_t tstep = 2 * hstep;
    const unsigned ldsw = (unsigned)wid * 1024u;
    const int aoff = lds_byte(wr * 64 + fr, fq * 8), boff = lds_byte(wc * 32 + fr, fq * 8);
#define PG8_SA(b, h) (((b) * 2 + (h)) * HTB)
#define PG8_SB(b, h) ((4 + (b) * 2 + (h)) * HTB)
#define PG8_STAGE(bufoff, gbase, voff) do { _Pragma("unroll") for (int _i = 0; _i < 2; ++_i) \
        __builtin_amdgcn_global_load_lds((const unsigned*)((const char*)(gbase) + (voff)[_i]), (PG8_LAS unsigned*)(lds + (bufoff) + ldsw + _i * 8192), 16, 0, 0); } while (0)
#define PG8_LDA(dst, b, h) do { _Pragma("unroll") for (int m = 0; m < 4; ++m) _Pragma("unroll") for (int k = 0; k < 2; ++k) dst[m][k] = *(const PG8_LAS bf16x8*)(lds + PG8_SA(b, h) + aoff + m * 2048 + k * 1024); } while (0)
#define PG8_LDB(dst, b, h) do { _Pragma("unroll") for (int n = 0; n < 2; ++n) _Pragma("unroll") for (int k = 0; k < 2; ++k) dst[n][k] = *(const PG8_LAS bf16x8*)(lds + PG8_SB(b, h) + boff + n * 2048 + k * 1024); } while (0)
#define PG8_MMA(ai, bj, At, Bt) do { __builtin_amdgcn_s_setprio(1); _Pragma("unroll") for (int m = 0; m < 4; ++m) _Pragma("unroll") for (int n = 0; n < 2; ++n) _Pragma("unroll") for (int k = 0; k < 2; ++k) \
        acc[ai][bj][m][n] = __builtin_amdgcn_mfma_f32_16x16x32_bf16(Bt[n][k], At[m][k], acc[ai][bj][m][n], 0, 0, 0); __builtin_amdgcn_s_setprio(0); } while (0)
#define PG8_WAIT_V(n) asm volatile("s_waitcnt vmcnt(" #n ")" ::: "memory")
#define PG8_WAIT_L(n) asm volatile("s_waitcnt lgkmcnt(" #n ")" ::: "memory")
#define PG8_BAR __builtin_amdgcn_s_barrier()
#define PG8_SCHED __builtin_amdgcn_sched_barrier(0)
    Unit cur, nxt; int ui = 0;
    if (!S.next(0, cur)) return;
    f32x4 acc[2][2][4][2];
#pragma unroll
    for (int a = 0; a < 2; ++a)
#pragma unroll
        for (int b = 0; b < 2; ++b)
#pragma unroll
            for (int m = 0; m < 4; ++m)
#pragma unroll
                for (int n = 0; n < 2; ++n) acc[a][b][m][n] = (f32x4){0.f, 0.f, 0.f, 0.f};
    bf16x8 At[4][2], B0[2][2], B1[2][2];
    const char* cA = S.a_base(cur); const char* cB = S.b_base(cur);
    unsigned oc[2][2], on[2][2];
    S.lane_off(cur, stR, stC, oc);
    S.a_ready(cur);
    if constexpr (SP2) {
        PG8_STAGE(PG8_SB(0, 0), cB, voffB); PG8_STAGE(PG8_SB(0, 1), cB + hstep, voffB); PG8_STAGE(PG8_SA(0, 0), cA, oc[0]); PG8_STAGE(PG8_SA(0, 1), cA, oc[1]);
        if (wr == 1) PG8_BAR;
        PG8_WAIT_V(2); PG8_BAR;
        PG8_STAGE(PG8_SB(1, 0), cB + kstep, voffB); PG8_STAGE(PG8_SA(1, 0), cA + kstep, oc[0]); PG8_STAGE(PG8_SB(1, 1), cB + hstep + kstep, voffB);
        PG8_WAIT_V(6); PG8_BAR;
    } else {
        PG8_STAGE(PG8_SB(0, 0), cB, voffB); PG8_STAGE(PG8_SA(0, 0), cA, oc[0]); PG8_STAGE(PG8_SB(0, 1), cB + hstep, voffB); PG8_STAGE(PG8_SA(0, 1), cA, oc[1]);
        if (wr == 1) PG8_BAR;
        PG8_WAIT_V(4); PG8_BAR;
        PG8_STAGE(PG8_SB(1, 0), cB + kstep, voffB); PG8_STAGE(PG8_SA(1, 0), cA + kstep, oc[0]); PG8_STAGE(PG8_SB(1, 1), cB + hstep + kstep, voffB);
        PG8_WAIT_V(6); PG8_BAR;
    }
    for (;;) {
        const bool has_next = S.next(ui + 1, nxt);
        const char* nA = has_next ? S.a_base(nxt) : cA; const char* nB = has_next ? S.b_base(nxt) : cB;
        if (has_next) S.lane_off(nxt, stR, stC, on); else {
#pragma unroll
            for (int h = 0; h < 2; ++h)
#pragma unroll
                for (int i = 0; i < 2; ++i) on[h][i] = oc[h][i]; }
#pragma unroll 1
        for (int t = 0; t < nt; t += 2) {
            const bool last = (t == nt - 2);
            const char* a1 = cA + (size_t)(t + 1) * kstep;
            const char* a2 = last ? nA : cA + (size_t)(t + 2) * kstep; const char* b2 = last ? nB : cB + (size_t)(t + 2) * kstep;
            const char* a3 = a2 + kstep; const char* b3 = b2 + kstep;
            unsigned o2[2][2];
#pragma unroll
            for (int h = 0; h < 2; ++h)
#pragma unroll
                for (int i = 0; i < 2; ++i) o2[h][i] = last ? on[h][i] : oc[h][i];
            if (last && has_next) S.a_ready(nxt);
            if constexpr (SP2) {
            PG8_LDB(B0, 0, 0); PG8_LDB(B1, 0, 1); PG8_SCHED; PG8_LDA(At, 0, 0); PG8_STAGE(PG8_SA(1, 1), a1, oc[1]);
            PG8_WAIT_V(8); PG8_WAIT_L(0); PG8_BAR; PG8_MMA(0, 0, At, B0); PG8_MMA(0, 1, At, B1); PG8_BAR; PG8_SCHED;
            PG8_LDA(At, 0, 1); PG8_STAGE(PG8_SB(0, 0), b2, voffB); PG8_STAGE(PG8_SB(0, 1), b2 + hstep, voffB); PG8_STAGE(PG8_SA(0, 0), a2, o2[0]);
            PG8_WAIT_V(8); PG8_WAIT_L(0); PG8_BAR; PG8_MMA(1, 0, At, B0); PG8_MMA(1, 1, At, B1); PG8_BAR; PG8_SCHED;
            PG8_LDB(B0, 1, 0); PG8_LDB(B1, 1, 1); PG8_SCHED; PG8_LDA(At, 1, 0); PG8_STAGE(PG8_SA(0, 1), a2, o2[1]);
            PG8_WAIT_V(8); PG8_WAIT_L(0); PG8_BAR; PG8_MMA(0, 0, At, B0); PG8_MMA(0, 1, At, B1); PG8_BAR; PG8_SCHED;
            PG8_LDA(At, 1, 1); PG8_STAGE(PG8_SB(1, 0), b3, voffB); PG8_STAGE(PG8_SB(1, 1), b3 + hstep, voffB); PG8_STAGE(PG8_SA(1, 0), a3, o2[0]);
            PG8_WAIT_V(8); PG8_WAIT_L(0); PG8_BAR; PG8_MMA(1, 0, At, B0); PG8_MMA(1, 1, At, B1); PG8_BAR; PG8_SCHED;
            } else {
            PG8_LDB(B0, 0, 0); PG8_SCHED; PG8_LDA(At, 0, 0); PG8_STAGE(PG8_SA(1, 1), a1, oc[1]);
            PG8_WAIT_L(8); PG8_BAR; PG8_WAIT_L(0); PG8_MMA(0, 0, At, B0); PG8_BAR; PG8_SCHED;
            PG8_LDB(B1, 0, 1); PG8_STAGE(PG8_SB(0, 0), b2, voffB);
            PG8_BAR; PG8_WAIT_L(0); PG8_MMA(0, 1, At, B1); PG8_BAR;
            PG8_LDA(At, 0, 1); PG8_STAGE(PG8_SA(0, 0), a2, o2[0]);
            PG8_BAR; PG8_WAIT_L(0); PG8_MMA(1, 0, At, B0); PG8_BAR; PG8_SCHED;
            PG8_STAGE(PG8_SB(0, 1), b2 + hstep, voffB);
            PG8_WAIT_V(6); PG8_BAR; PG8_MMA(1, 1, At, B1); PG8_BAR;
            PG8_LDB(B0, 1, 0); PG8_SCHED; PG8_LDA(At, 1, 0); PG8_STAGE(PG8_SA(0, 1), a2, o2[1]);
            PG8_WAIT_L(8); PG8_BAR; PG8_WAIT_L(0); PG8_MMA(0, 0, At, B0); PG8_BAR; PG8_SCHED;
            PG8_LDB(B1, 1, 1); PG8_STAGE(PG8_SB(1, 0), b3, voffB);
            PG8_BAR; PG8_WAIT_L(0); PG8_MMA(0, 1, At, B1); PG8_BAR;
            PG8_LDA(At, 1, 1); PG8_STAGE(PG8_SA(1, 0), a3, o2[0]);
            PG8_BAR; PG8_WAIT_L(0); PG8_MMA(1, 0, At, B0); PG8_BAR; PG8_SCHED;
            PG8_STAGE(PG8_SB(1, 1), b3 + hstep, voffB);
            PG8_WAIT_V(6); PG8_BAR; PG8_MMA(1, 1, At, B1); PG8_BAR;
            }
        }
        if constexpr (ALIGN_EPI) { if (wr == 0) PG8_BAR; }
        if constexpr (!Epi::AFTER_DRAIN) { E(acc, cur, wr, wc, fr, fq); S.done(cur); }
        if (!has_next) break;
#pragma unroll
        for (int a = 0; a < 2; ++a)
#pragma unroll
            for (int b = 0; b < 2; ++b)
#pragma unroll
                for (int m = 0; m < 4; ++m)
#pragma unroll
                    for (int n = 0; n < 2; ++n) acc[a][b][m][n] = (f32x4){0.f, 0.f, 0.f, 0.f};
        cur = nxt; cA = nA; cB = nB; ++ui;
#pragma unroll
        for (int h = 0; h < 2; ++h)
#pragma unroll
            for (int i = 0; i < 2; ++i) oc[h][i] = on[h][i];
        if constexpr (ALIGN_EPI) { if (wr == 1) PG8_BAR; }
    }
    PG8_WAIT_V(0);
    if constexpr (!ALIGN_EPI) { if (wr == 0) PG8_BAR; }
    PG8_BAR;
    if constexpr (Epi::AFTER_DRAIN) { E.fused(acc, cur, wr, wc, fr, fq, lds, wid, lane); S.done(cur); }
#undef PG8_SA
#undef PG8_SB
#undef PG8_STAGE
#undef PG8_LDA
#undef PG8_LDB
#undef PG8_MMA
#undef PG8_WAIT_V
#undef PG8_WAIT_L
#undef PG8_BAR
#undef PG8_SCHED
}
}

#define GAS __attribute__((address_space(1)))
#define LAS __attribute__((address_space(3)))
typedef unsigned v4u __attribute__((ext_vector_type(4)));
typedef float f32x4 __attribute__((ext_vector_type(4)));
typedef GAS unsigned gu32;
#define RLX_AGENT __ATOMIC_RELAXED, __HIP_MEMORY_SCOPE_AGENT
#define LDS_WAIT() asm volatile("s_waitcnt lgkmcnt(0)" ::: "memory")
#define VM_WAIT() asm volatile("s_waitcnt vmcnt(0)" ::: "memory")
constexpr int NWAVES = 8;
constexpr int RING_OFF = 0, RING_BYTES = 131072;
constexpr int LDSCTL_OFF = RING_BYTES, MISC_OFF = LDSCTL_OFF + 320;
constexpr int PLAN_OFF = LDSCTL_OFF + 1024;
constexpr int SSD_AUX_OFF = LDSCTL_OFF + 4096;
constexpr int LDS_BYTES = 147456;

#define XB_TMO      128
#define XB_XCNT(j)  (256  + 64 * (j))
#define XB_XSUB(j)  (1280 + 64 * (j))
#define XB_XGEN(j)  (2304 + 64 * (j))
#define XB_TOP      3328
#define XB_TOPGEN   3392
#define XCD_BAR_WORDS 3456
#define XB_SPIN_CAP (1u << 18)

__device__ __forceinline__ unsigned xb_ld(unsigned* p)              { return __hip_atomic_load(p, __ATOMIC_RELAXED, __HIP_MEMORY_SCOPE_AGENT); }
__device__ __forceinline__ unsigned xb_add(unsigned* p, unsigned v) { return __hip_atomic_fetch_add(p, v, __ATOMIC_RELAXED, __HIP_MEMORY_SCOPE_AGENT); }
__device__ __forceinline__ unsigned xb_xcc_id() { return (unsigned)__builtin_amdgcn_s_getreg((3 << 11) | 20) & 0xFu; }
#define XB_SPIN(cond, bar) do { unsigned _sp = 0; while (cond) { __builtin_amdgcn_s_sleep(1); \
    if ((++_sp & 255u) == 0u) { if (xb_ld(&(bar)[XB_TMO])) break; if (_sp > XB_SPIN_CAP) { atomicAdd(&(bar)[XB_TMO], 1u); break; } } } } while (0)

struct XcdBarrier {
    unsigned* bar; unsigned x;
    volatile LAS unsigned* st;
};

__device__ __forceinline__ XcdBarrier xcd_barrier_post(unsigned* bar, volatile LAS unsigned* st) {
    XcdBarrier b; b.bar = bar; b.x = xb_xcc_id(); b.st = st;
    if (threadIdx.x == 0) (void)xb_add(&bar[XB_XCNT(b.x)], 1u);
    return b;
}
__device__ __forceinline__ void xcd_barrier_complete(unsigned* bar, unsigned x, unsigned& nloc, unsigned& nx) {
    const unsigned G = gridDim.x * gridDim.y * gridDim.z;
    unsigned sum, cnt, mine, sp = 0u;
    for (;;) {
        sum = 0u; cnt = 0u; mine = 0u;
#pragma unroll
        for (unsigned j = 0; j < 16; ++j) { const unsigned c = xb_ld(&bar[XB_XCNT(j)]); sum += c; cnt += (c > 0u) ? 1u : 0u; mine = (j == x) ? c : mine; }
        if (sum == G) break;
        __builtin_amdgcn_s_sleep(1);
        if ((++sp & 255u) == 0u) { if (xb_ld(&bar[XB_TMO])) break; if (sp > XB_SPIN_CAP) { atomicAdd(&bar[XB_TMO], 1u); break; } }
    }
    nloc = mine > 0u ? mine : 1u; nx = cnt > 0u ? cnt : 1u;
}

__device__ __forceinline__ void xcd_barrier(const XcdBarrier& b) {
    asm volatile("s_waitcnt vmcnt(0)" ::: "memory");
    __syncthreads();
    if (threadIdx.x == 0) {
        unsigned* bar = b.bar;
        __builtin_amdgcn_s_waitcnt(0);
        unsigned nloc = b.st[0], nx = b.st[1];
        if (nloc == 0u) { xcd_barrier_complete(bar, b.x, nloc, nx); b.st[0] = nloc; b.st[1] = nx; }
        const unsigned old = xb_add(&bar[XB_XSUB(b.x)], 1u);
        const unsigned gen = old / nloc;
        if (old + 1u == (gen + 1u) * nloc) {
            __builtin_amdgcn_fence(__ATOMIC_RELEASE, "agent");
            asm volatile("s_waitcnt vmcnt(0)" ::: "memory");
            const unsigned og = xb_add(&bar[XB_TOP], 1u);
            const unsigned tg = og / nx;
            if (og + 1u == (tg + 1u) * nx) xb_add(&bar[XB_TOPGEN], 1u);
            else XB_SPIN(xb_ld(&bar[XB_TOPGEN]) == tg, bar);
            __builtin_amdgcn_fence(__ATOMIC_ACQUIRE, "agent");
            xb_add(&bar[XB_XGEN(b.x)], 1u);
            asm volatile("s_waitcnt vmcnt(0)" ::: "memory");
        } else {
            XB_SPIN(xb_ld(&bar[XB_XGEN(b.x)]) == gen, bar);
            __builtin_amdgcn_fence(__ATOMIC_ACQUIRE, "agent");
            asm volatile("s_waitcnt vmcnt(0)" ::: "memory");
        }
    }
    __syncthreads();
}

__device__ __forceinline__ float wave_sum(float v) {
#pragma unroll
    for (int o = 1; o < 64; o <<= 1) v += __shfl_xor(v, o);
    return v;
}

struct EpiIn {
    static constexpr bool PERM = true, AFTER_DRAIN = false;
    bf16_t *zq, *xbc, *kk, *vv; float* dt;
    __device__ __forceinline__ void operator()(const pg8::f32x4 (&acc)[2][2][4][2], const pg8::Unit& u, int wr, int wc, int fr, int fq) const {
        const int row0 = u.pm * 256 + wr * 64 + fr, pn = u.pn;
        if (pn == 18) {
            if (wc == 0 && fq < 2) {
#pragma unroll
                for (int ai = 0; ai < 2; ++ai)
#pragma unroll
                    for (int m = 0; m < 4; ++m) { float* o = dt + (size_t)(row0 + ai * 128 + m * 16) * 16 + 8 * fq; *(pg8::f32x4*)o = acc[ai][0][m][0]; *(pg8::f32x4*)(o + 4) = acc[ai][0][m][1]; }
            }
            return;
        }
        bf16_t* base; int ldc, colt;
        if (pn < 4) { base = zq; ldc = 2048; colt = pn * 256; }
        else if (pn < 12) { base = xbc; ldc = 2048; colt = (pn - 4) * 256; }
        else if (pn < 16) { base = zq; ldc = 2048; colt = 1024 + (pn - 12) * 256; }
        else if (pn == 16) { base = kk; ldc = 256; colt = 0; }
        else { base = vv; ldc = 256; colt = 0; }
        const int col0 = colt + wc * 32 + 8 * fq;
#pragma unroll
        for (int ai = 0; ai < 2; ++ai)
#pragma unroll
            for (int m = 0; m < 4; ++m) { bf16_t* rowp = base + (size_t)(row0 + ai * 128 + m * 16) * ldc + col0;
#pragma unroll
                for (int bj = 0; bj < 2; ++bj) { const pg8::f32x4 v0 = acc[ai][bj][m][0], v1 = acc[ai][bj][m][1];
                    pg8::u32x4 w; w.x = pg8::cvt_pk_bf16(v0[0], v0[1]); w.y = pg8::cvt_pk_bf16(v0[2], v0[3]); w.z = pg8::cvt_pk_bf16(v1[0], v1[1]); w.w = pg8::cvt_pk_bf16(v1[2], v1[3]);
                    *(pg8::u32x4*)(rowp + bj * 128) = w; } }
    }
};

struct EpiOut {
    static constexpr bool PERM = true, AFTER_DRAIN = false;
    const float* x; float* x1; const float* mod;
    __device__ __forceinline__ void operator()(const pg8::f32x4 (&acc)[2][2][4][2], const pg8::Unit& u, int wr, int wc, int fr, int fq) const {
        const int row0 = u.pm * 256 + wr * 64 + fr, col0 = u.pn * 256 + wc * 32 + 8 * fq, b = (u.pm * 256) / SEQ;
        const float* g1 = mod + b * 6 * D + 2 * D + col0;
        pg8::f32x4 gv[2][2];
#pragma unroll
        for (int bj = 0; bj < 2; ++bj) { gv[bj][0] = *(const pg8::f32x4*)(g1 + bj * 128); gv[bj][1] = *(const pg8::f32x4*)(g1 + bj * 128 + 4); }
#pragma unroll
        for (int ai = 0; ai < 2; ++ai)
#pragma unroll
            for (int m = 0; m < 4; ++m) { const size_t off = (size_t)(row0 + ai * 128 + m * 16) * D + col0;
#pragma unroll
                for (int bj = 0; bj < 2; ++bj) { const float* xi = x + off + bj * 128; float* xo = x1 + off + bj * 128;
                    *(pg8::f32x4*)xo = *(const pg8::f32x4*)xi + gv[bj][0] * acc[ai][bj][m][0]; *(pg8::f32x4*)(xo + 4) = *(const pg8::f32x4*)(xi + 4) + gv[bj][1] * acc[ai][bj][m][1]; } }
    }
};
struct EpiGU {
    static constexpr bool PERM = true, AFTER_DRAIN = false;
    bf16_t* u;
    __device__ __forceinline__ void operator()(const pg8::f32x4 (&acc)[2][2][4][2], const pg8::Unit& un, int wr, int wc, int fr, int fq) const {
        const int row0 = un.pm * 256 + wr * 64 + fr, col0 = un.pn * 128 + wc * 32 + 8 * fq;
#pragma unroll
        for (int ai = 0; ai < 2; ++ai)
#pragma unroll
            for (int m = 0; m < 4; ++m) { bf16_t* rowp = u + (size_t)(row0 + ai * 128 + m * 16) * ED + col0;
                float o[8];
#pragma unroll
                for (int n = 0; n < 2; ++n)
#pragma unroll
                    for (int j = 0; j < 4; ++j) o[4 * n + j] = silu_f(acc[ai][0][m][n][j]) * acc[ai][1][m][n][j];
                pg8::u32x4 w; w.x = pg8::cvt_pk_bf16(o[0], o[1]); w.y = pg8::cvt_pk_bf16(o[2], o[3]); w.z = pg8::cvt_pk_bf16(o[4], o[5]); w.w = pg8::cvt_pk_bf16(o[6], o[7]);
                *(pg8::u32x4*)rowp = w; }
    }
};
struct EpiDown {
    static constexpr bool PERM = true, AFTER_DRAIN = false;
    bf16_t* yc; const int* list; const float* egate;
    __device__ __forceinline__ void operator()(const pg8::f32x4 (&acc)[2][2][4][2], const pg8::Unit& u, int wr, int wc, int fr, int fq) const {
        const unsigned col0 = (unsigned)(u.pn * 256 + wc * 32 + 8 * fq);
        const int* lp = list + (size_t)u.e * M + u.lt * 256;
#pragma unroll
        for (int ai = 0; ai < 2; ++ai)
#pragma unroll
            for (int m = 0; m < 4; ++m) { const int r = ai * 128 + wr * 64 + m * 16 + fr;
                if (r < u.nrows) { unsigned ts; float gt;
                    if (u.e < NE) { const int a = lp[r]; ts = (unsigned)((a >> 3) * NSLOT + (a & 7)); gt = egate[a]; } else { ts = (unsigned)((u.lt * 256 + r) * NSLOT + 8); gt = 1.f; }
                    bf16_t* rowp = yc + (ts * 512u + col0);
#pragma unroll
                    for (int bj = 0; bj < 2; ++bj) { const pg8::f32x4 v0 = acc[ai][bj][m][0] * gt, v1 = acc[ai][bj][m][1] * gt;
                        pg8::u32x4 w; w.x = pg8::cvt_pk_bf16(v0[0], v0[1]); w.y = pg8::cvt_pk_bf16(v0[2], v0[3]); w.z = pg8::cvt_pk_bf16(v1[0], v1[1]); w.w = pg8::cvt_pk_bf16(v1[2], v1[3]);
                        *(pg8::u32x4*)(rowp + bj * 128) = w; } }
                asm volatile("" ::: "memory"); }
    }
};
template <bool GATHER>
struct GroupedOrder {
    typedef pg8::Unit Unit;
    const char* A; const char* Bt; int K, nN, G, c, total; const LAS int* plan; const int* list; size_t bs_e, bs_pn; int pn0;
    __device__ __forceinline__ void init(const void* A_, const void* Bt_, int K_, int nN_, int G_, int c_, const LAS int* plan_, const int* list_, size_t bs_e_, size_t bs_pn_, int pn0_) {
        A = (const char*)A_; Bt = (const char*)Bt_; K = K_; nN = nN_; G = G_; c = c_; plan = plan_; list = list_; bs_e = bs_e_; bs_pn = bs_pn_; pn0 = pn0_; total = __builtin_amdgcn_readfirstlane(plan[NE + 1]) * nN; }
    __device__ __forceinline__ bool next(int i, Unit& u) const {
        const int L = i * G + c; if (L >= total) return false;
        int wgid = L; { const int q = total / 8, r = total % 8, xcd = wgid % 8, off = wgid / 8; wgid = (xcd < r ? xcd * (q + 1) : r * (q + 1) + (xcd - r) * q) + off; }
        const int tile = wgid / nN; u.pn = wgid % nN; u.pm = tile;
        int e = 0;
        for (int j = 1; j <= NE; ++j) e += (plan[j] <= tile) ? 1 : 0;
        e = __builtin_amdgcn_readfirstlane(e);
        u.e = e; u.lt = __builtin_amdgcn_readfirstlane(tile - plan[e]); const int rem = __builtin_amdgcn_readfirstlane(plan[80 + e]) - u.lt * 256; u.nrows = rem < 256 ? rem : 256; return true;
    }
    __device__ __forceinline__ const char* a_base(const Unit& u) const { return GATHER ? A : A + (size_t)u.pm * 512 * K; }
    __device__ __forceinline__ const char* b_base(const Unit& u) const { return Bt + (size_t)u.e * bs_e + (size_t)(pn0 + u.pn) * bs_pn; }
    __device__ __forceinline__ void lane_off(const Unit& u, const int (&R)[2], const int (&C)[2], unsigned (&o)[2][2]) const {
#pragma unroll
        for (int h = 0; h < 2; ++h)
#pragma unroll
            for (int i = 0; i < 2; ++i) { const int r = h * 128 + R[i];
                if (GATHER) { int tok = 0; if (r < u.nrows) { const int idx = u.lt * 256 + r; tok = u.e < NE ? (list[(size_t)u.e * M + idx] >> 3) : idx; }
                    o[h][i] = (unsigned)((tok * K + C[i]) * 2); }
                else o[h][i] = (unsigned)((r * K + C[i]) * 2); }
    }
    __device__ __forceinline__ void a_ready(const Unit&) const {}
    __device__ __forceinline__ void done(const Unit&) const {}
};

template <class CM>
__device__ __forceinline__ void transpose_item(const float* W, int ldw, bf16_t* WT, int ldt, int k0, int n0, LAS float* scr, int lane, const CM& colmap) {
    const int sc = colmap(n0 + (lane & 31));
#pragma unroll 8
    for (int i = 0; i < 32; ++i) { const int kk = 2 * i + (lane >> 5); scr[kk * 33 + (lane & 31)] = sc >= 0 ? W[(size_t)(k0 + kk) * ldw + sc] : 0.f; }
    LDS_WAIT(); asm volatile("" ::: "memory");
    const int c = lane & 7;
#pragma unroll
    for (int j = 0; j < 4; ++j) { const int n = (lane >> 3) + 8 * j; const LAS float* s = scr + (8 * c) * 33 + n;
        v4u o; o.x = pk2(s[0 * 33], s[1 * 33]); o.y = pk2(s[2 * 33], s[3 * 33]); o.z = pk2(s[4 * 33], s[5 * 33]); o.w = pk2(s[6 * 33], s[7 * 33]);
        *(GAS v4u*)(WT + (size_t)(n0 + n) * ldt + k0 + 8 * c) = o; }
    LDS_WAIT(); asm volatile("" ::: "memory");
}

__device__ __forceinline__ void conv2x8(const bf16_t* xbc, const float* cw, const float* cb, int row, int t, int ch, float (&o0)[8], float (&o1)[8]) {
    float xr[5][8];
#pragma unroll
    for (int k = 0; k < 5; ++k) { v4u raw = (v4u){0u, 0u, 0u, 0u}; if (t - 3 + k >= 0) raw = *(const v4u*)(xbc + (size_t)(row - 3 + k) * CONV_CH + ch);
        const unsigned w4[4] = {raw.x, raw.y, raw.z, raw.w};
#pragma unroll
        for (int j = 0; j < 4; ++j) { xr[k][2 * j] = __uint_as_float(w4[j] << 16); xr[k][2 * j + 1] = __uint_as_float(w4[j] & 0xffff0000u); } }
    float wv[4][8], bv[8];
#pragma unroll
    for (int k = 0; k < 4; ++k) { const f32x4 a = *(const f32x4*)(cw + k * CONV_CH + ch), b = *(const f32x4*)(cw + k * CONV_CH + ch + 4); wv[k][0] = a.x; wv[k][1] = a.y; wv[k][2] = a.z; wv[k][3] = a.w; wv[k][4] = b.x; wv[k][5] = b.y; wv[k][6] = b.z; wv[k][7] = b.w; }
    { const f32x4 a = *(const f32x4*)(cb + ch), b = *(const f32x4*)(cb + ch + 4); bv[0] = a.x; bv[1] = a.y; bv[2] = a.z; bv[3] = a.w; bv[4] = b.x; bv[5] = b.y; bv[6] = b.z; bv[7] = b.w; }
#pragma unroll
    for (int j = 0; j < 8; ++j) { float a0 = bv[j], a1 = bv[j];
#pragma unroll
        for (int k = 0; k < 4; ++k) { a0 += wv[k][j] * xr[k][j]; a1 += wv[k][j] * xr[k + 1][j]; }
        o0[j] = silu_f(a0); o1[j] = silu_f(a1); }
}

constexpr int NPHASE = 14;
__global__ void __launch_bounds__(NWAVES * 64, 2) mega(P p) {
    extern __shared__ __attribute__((aligned(16))) unsigned char lds_raw[];
    LAS unsigned char* lds = (LAS unsigned char*)lds_raw;
    volatile LAS unsigned* MISC = (volatile LAS unsigned*)(lds + MISC_OFF);
    const int tid = threadIdx.x, lane = tid & 63, wave = __builtin_amdgcn_readfirstlane(tid >> 6);
    const int G = gridDim.x; const int bx = blockIdx.x; const int vcu = (G % 8 == 0) ? (bx % 8) * (G / 8) + bx / 8 : bx;
    unsigned char* ws = p.ws;
    gu32* ctl = (gu32*)(ws + WS_CTL);
    for (int u = tid; u < (LDS_BYTES - LDSCTL_OFF) / 4; u += NWAVES * 64) ((LAS unsigned*)(lds + LDSCTL_OFF))[u] = 0u;
    __syncthreads();
    XcdBarrier bar = xcd_barrier_post((unsigned*)(ctl + CW_BAR) + p.li * XCD_BAR_WORDS, MISC + 8);
    const int lo = p.ph_lo, hi = p.ph_hi;
#ifndef PHMASK
#define PHMASK 0xffffffffu
#endif
#define IN(k) (((PHMASK >> (k)) & 1u) && lo <= (k) && (k) < hi)
#define BOTH(k) (IN(k) && IN((k) + 1))
    const int gw = vcu * NWAVES + wave, NGW = G * NWAVES;
    float* modv = (float*)(ws + WS_MOD);

    if (IN(0)) {
        if (bx < 192) {
            LAS float* part = (LAS float*)(lds + RING_OFF);
            const int j0 = bx * 32, cc = lane & 31, ks = wave * 2 + (lane >> 5);
            float a0 = 0.f, a1 = 0.f, a2 = 0.f, a3 = 0.f;
#pragma unroll 8
            for (int k = ks * 64; k < ks * 64 + 64; ++k) { const float wv = p.mod_w[(size_t)k * 6 * D + j0 + cc];
                a0 += silu_f(p.c[k]) * wv; a1 += silu_f(p.c[D + k]) * wv; a2 += silu_f(p.c[2 * D + k]) * wv; a3 += silu_f(p.c[3 * D + k]) * wv; }
            part[(ks * 4 + 0) * 32 + cc] = a0; part[(ks * 4 + 1) * 32 + cc] = a1; part[(ks * 4 + 2) * 32 + cc] = a2; part[(ks * 4 + 3) * 32 + cc] = a3;
            __syncthreads();
            if (tid < 128) { const int b = tid >> 5, c2 = tid & 31; float s = p.mod_b[j0 + c2];
                for (int q = 0; q < 16; ++q) s += part[(q * 4 + b) * 32 + c2];
                modv[b * 6 * D + j0 + c2] = s; }
            __syncthreads();
        }
        LAS float* scr = (LAS float*)(lds + RING_OFF + wave * 16384);
        constexpr int I_IN = (D / 64) * (NWIN / 32), I_OUT = (2048 / 64) * (D / 32);
        bf16_t* WinT = (bf16_t*)(ws + WS_WIN_T); bf16_t* WoutT = (bf16_t*)(ws + WS_WOUT_T);
        for (int it = gw; it < I_IN + I_OUT; it += NGW) {
            if (it < I_IN) { const int nb = it % (NWIN / 32), kb = it / (NWIN / 32);
                transpose_item(p.w_in, IN_COLS, WinT, D, kb * 64, nb * 32, scr, lane, [](int n) { return n < 3072 ? n : (n < 4608 ? n + 16 : (n < 4624 ? n - 1536 : -1)); }); }
            else { const int r = it - I_IN, nb = r % (D / 32), kb = r / (D / 32);
                transpose_item(p.w_out, D, WoutT, 2048, kb * 64, nb * 32, scr, lane, [](int n) { return n; }); }
        }
        if (BOTH(0)) xcd_barrier(bar);
    }

    if (IN(1)) {
        bf16_t* hn = (bf16_t*)(ws + WS_HN);
        for (int m = gw; m < M; m += NGW) {
            const int b = m / SEQ; const GAS f32x4* xr = (const GAS f32x4*)(p.x + (size_t)m * D) + lane;
            f32x4 v[4]; float s = 0.f;
#pragma unroll
            for (int j = 0; j < 4; ++j) { v[j] = xr[64 * j]; s += (v[j].x * v[j].x + v[j].y * v[j].y) + (v[j].z * v[j].z + v[j].w * v[j].w); }
            const float rstd = rsqrtf(wave_sum(s) * (1.f / D) + EPS);
            GAS unsigned long long* o8 = (GAS unsigned long long*)(hn + (size_t)m * D) + lane;
#pragma unroll
            for (int j = 0; j < 4; ++j) { const int d = 4 * lane + 256 * j; const f32x4 g = *(const f32x4*)(p.norm1_g + d), sc = *(const f32x4*)(modv + b * 6 * D + D + d), sh = *(const f32x4*)(modv + b * 6 * D + d);
                const f32x4 h = v[j] * rstd * g * (sc + 1.f) + sh;
                o8[64 * j] = (unsigned long long)pk2(h.x, h.y) | ((unsigned long long)pk2(h.z, h.w) << 32); }
        }
        if (BOTH(1)) xcd_barrier(bar);
    }

    if (IN(2)) {
        pg8::DenseOrder S; S.init(ws + WS_HN, ws + WS_WIN_T, M, NWIN, D, G, bx);
        EpiIn E{(bf16_t*)(ws + WS_ZQ), (bf16_t*)(ws + WS_XBC), (bf16_t*)(ws + WS_K), (bf16_t*)(ws + WS_V), (float*)(ws + WS_DT)};
        pg8::gemm_phase<EpiIn, pg8::DenseOrder, true, true>(lds + RING_OFF, D, S, E);
        if (BOTH(2)) xcd_barrier(bar);
    }

    if (IN(3)) {
        {
            typedef pg8::bf16x8 bf16x8; typedef pg8::f32x4 f4;
            bf16_t* zq = (bf16_t*)(ws + WS_ZQ); const bf16_t* kk = (const bf16_t*)(ws + WS_K); const bf16_t* vv = (const bf16_t*)(ws + WS_V); float* ssq = (float*)(ws + WS_SSQ);
            LAS unsigned char* Kl = lds + RING_OFF; LAS unsigned char* VTl = lds + RING_OFF + 27648; LAS float* biasl = (LAS float*)(lds + RING_OFF + 53248);
            __syncthreads();
            for (int i = tid; i < ATT_HEADS * 128; i += 512) { const int h = i >> 7, dist = i & 127; biasl[i] = p.rel_bias[c_bucket[dist] * ATT_HEADS + h]; }
            const int fr = lane & 15, fg = lane >> 4;
            for (int unit = bx; unit < BATCH * (SEQ / 64); unit += G) {
                const int b = unit / (SEQ / 64), qb = unit % (SEQ / 64), t0 = qb * 64, row0 = b * SEQ + t0;
                for (int kvh = 0; kvh < KV_HEADS; ++kvh) {
                    __syncthreads();
                    for (int i = tid; i < 192 * 8; i += 512) { const int j = i >> 3, ch = i & 7, kt = t0 - 128 + j;
                        v4u val = (v4u){0u, 0u, 0u, 0u}; if (kt >= 0) val = *(const v4u*)(kk + (size_t)(b * SEQ + kt) * D_KV + kvh * HD + ch * 8);
                        *(LAS v4u*)(Kl + j * 144 + ch * 16) = val; }
                    for (int i = tid; i < 96 * 8; i += 512) { const int jp = i >> 3, ch = i & 7, j = 2 * jp, kt = t0 - 128 + j;
                        v4u v0 = (v4u){0u, 0u, 0u, 0u}, v1 = v0;
                        if (kt >= 0) { const bf16_t* vp = vv + (size_t)(b * SEQ + kt) * D_KV + kvh * HD + ch * 8; v0 = *(const v4u*)vp; v1 = *(const v4u*)(vp + D_KV); }
                        const unsigned a0[4] = {v0.x, v0.y, v0.z, v0.w}, a1[4] = {v1.x, v1.y, v1.z, v1.w};
#pragma unroll
                        for (int d2 = 0; d2 < 4; ++d2) {
                            *(LAS unsigned*)(VTl + (ch * 8 + 2 * d2) * 400 + j * 2) = (a0[d2] & 0xffffu) | (a1[d2] << 16);
                            *(LAS unsigned*)(VTl + (ch * 8 + 2 * d2 + 1) * 400 + j * 2) = (a0[d2] >> 16) | (a1[d2] & 0xffff0000u); } }
                    __syncthreads();
                    const int head = kvh * 4 + (wave >> 1), rt0 = 2 * (wave & 1), jt0 = rt0;
                    const float sink = p.sinks[head]; const LAS float* bl = biasl + head * 128;
#pragma unroll 1
                    for (int r2 = 0; r2 < 2; ++r2) {
                        const int qi = 16 * (rt0 + r2) + fr;
                        bf16x8 Qf[2];
#pragma unroll
                        for (int ks = 0; ks < 2; ++ks) Qf[ks] = *(const bf16x8*)(zq + (size_t)(row0 + qi) * 2048 + 1024 + head * HD + ks * 32 + 8 * fg);
                        f4 sacc[10];
#pragma unroll
                        for (int jt = 0; jt < 10; ++jt) sacc[jt] = (f4){0.f, 0.f, 0.f, 0.f};
#pragma unroll
                        for (int jt = 0; jt < 10; ++jt)
#pragma unroll
                            for (int ks = 0; ks < 2; ++ks) { const bf16x8 Kf = *(const LAS bf16x8*)(Kl + (16 * (jt0 + jt) + fr) * 144 + (ks * 32 + 8 * fg) * 2);
                                sacc[jt] = __builtin_amdgcn_mfma_f32_16x16x32_bf16(Kf, Qf[ks], sacc[jt], 0, 0, 0); }
                        float mx = sink;
#pragma unroll
                        for (int jt = 0; jt < 10; ++jt)
#pragma unroll
                            for (int j = 0; j < 4; ++j) { const int kj = 16 * (jt0 + jt) + 4 * fg + j, dist = qi + 128 - kj; const bool ok = dist >= 0 && dist < 128 && (t0 - 128 + kj) >= 0;
                                const float s = ok ? sacc[jt][j] * 0.125f + bl[dist & 127] : -INFINITY; sacc[jt][j] = s; mx = fmaxf(mx, s); }
                        mx = fmaxf(mx, __shfl_xor(mx, 16)); mx = fmaxf(mx, __shfl_xor(mx, 32));
                        float ls = 0.f;
#pragma unroll
                        for (int jt = 0; jt < 10; ++jt)
#pragma unroll
                            for (int j = 0; j < 4; ++j) { const float pe = __expf(sacc[jt][j] - mx); sacc[jt][j] = pe; ls += pe; }
                        ls += __shfl_xor(ls, 16); ls += __shfl_xor(ls, 32); ls += __expf(sink - mx);
                        f4 o[4];
#pragma unroll
                        for (int dt = 0; dt < 4; ++dt) o[dt] = (f4){0.f, 0.f, 0.f, 0.f};
#pragma unroll
                        for (int k5 = 0; k5 < 5; ++k5) { const f4 pa = sacc[2 * k5], pb = sacc[2 * k5 + 1];
                            union { bf16x8 v; unsigned u[4]; } Pf; Pf.u[0] = pg8::cvt_pk_bf16(pa[0], pa[1]); Pf.u[1] = pg8::cvt_pk_bf16(pa[2], pa[3]); Pf.u[2] = pg8::cvt_pk_bf16(pb[0], pb[1]); Pf.u[3] = pg8::cvt_pk_bf16(pb[2], pb[3]);
#pragma unroll
                            for (int dt = 0; dt < 4; ++dt) { const LAS unsigned char* vp = VTl + (16 * dt + fr) * 400 + (16 * (jt0 + 2 * k5) + 4 * fg) * 2;
                                union { bf16x8 v; unsigned long long q[2]; } Vf; Vf.q[0] = *(const LAS unsigned long long*)vp; Vf.q[1] = *(const LAS unsigned long long*)(vp + 32);
                                o[dt] = __builtin_amdgcn_mfma_f32_16x16x32_bf16(Vf.v, Pf.v, o[dt], 0, 0, 0); } }
                        const float inv = 1.f / ls; float ss = 0.f;
                        bf16_t* op = zq + (size_t)(row0 + qi) * 2048 + 1024 + head * HD + 4 * fg;
#pragma unroll
                        for (int dt = 0; dt < 4; ++dt) { const f4 ov = o[dt] * inv; ss += (ov[0] * ov[0] + ov[1] * ov[1]) + (ov[2] * ov[2] + ov[3] * ov[3]);
                            *(unsigned long long*)(op + 16 * dt) = (unsigned long long)pg8::cvt_pk_bf16(ov[0], ov[1]) | ((unsigned long long)pg8::cvt_pk_bf16(ov[2], ov[3]) << 32); }
                        ss += __shfl_xor(ss, 16); ss += __shfl_xor(ss, 32);
                        if (fg == 0) ssq[(row0 + qi) * 16 + head] = ss;
                    }
                }
            }
            __syncthreads();
        }
        if (BOTH(3)) xcd_barrier(bar);
    }

    if (IN(4)) {
        typedef pg8::bf16x8 bf16x8; typedef pg8::f32x4 f4;
        const bf16_t* xbc = (const bf16_t*)(ws + WS_XBC); const float* dtr = (const float*)(ws + WS_DT); float* decg = (float*)(ws + WS_CS);
        LAS unsigned char* XT = lds + RING_OFF; LAS unsigned char* BT = lds + RING_OFF + 65536; LAS float* wl = (LAS float*)(lds + SSD_AUX_OFF);
        const int fr = lane & 15, fg = lane >> 4;
        for (int unit = bx; unit < BATCH * NCHUNK * SSM_GROUPS; unit += G) {
            const int g = unit % SSM_GROUPS, bc = unit / SSM_GROUPS, rowc = bc * CHUNK, tc = rowc % SEQ;
            __syncthreads();
            if (wave < 4) { const int h = g * 4 + wave; const float A = -__expf(p.a_log[h]), bias = p.dt_bias[h];
                const float d0 = softplus_f(dtr[(rowc + lane) * 16 + h] + bias), d1 = softplus_f(dtr[(rowc + lane + 64) * 16 + h] + bias);
                float s0 = d0 * A, s1 = d1 * A;
#pragma unroll
                for (int o = 1; o < 64; o <<= 1) { const float u0 = __shfl_up(s0, o), u1 = __shfl_up(s1, o); if (lane >= o) { s0 += u0; s1 += u1; } }
                s1 += __shfl(s0, 63); const float cl = __shfl(s1, 63);
                wl[wave * 128 + lane] = d0 * __expf(cl - s0); wl[wave * 128 + lane + 64] = d1 * __expf(cl - s1);
                if (lane == 0) decg[bc * 16 + h] = __expf(cl); }
            __syncthreads();
            for (int i = tid; i < 64 * 48; i += 512) { const int co = i % 48, lp = i / 48, l = 2 * lp;
                const int ch = co < 32 ? g * 256 + co * 8 : D_SSM + g * D_STATE + (co - 32) * 8;
                float o0[8], o1[8]; conv2x8(xbc, p.conv_w, p.conv_b, rowc + l, tc + l, ch, o0, o1);
                if (co < 32) { const float w0 = wl[(co >> 3) * 128 + l], w1 = wl[(co >> 3) * 128 + l + 1];
#pragma unroll
                    for (int j = 0; j < 8; ++j) { const int r = co * 8 + j; *(LAS unsigned*)(XT + r * 256 + (((l >> 3) ^ (r & 15)) << 4) + (l & 7) * 2) = pk2(o0[j] * w0, o1[j] * w1); } }
                else {
#pragma unroll
                    for (int j = 0; j < 8; ++j) { const int r = (co - 32) * 8 + j; *(LAS unsigned*)(BT + r * 256 + (((l >> 3) ^ (r & 15)) << 4) + (l & 7) * 2) = pk2(o0[j], o1[j]); } } }
            __syncthreads();
            bf16x8 Bf[4];
#pragma unroll
            for (int kk = 0; kk < 4; ++kk) { const int r = 16 * wave + fr; Bf[kk] = *(const LAS bf16x8*)(BT + r * 256 + (((4 * kk + fg) ^ (r & 15)) << 4)); }
#pragma unroll
            for (int r4 = 0; r4 < 4; ++r4) { const int h = g * 4 + r4; float* S = (float*)(ws + WS_S) + (size_t)(bc * SSM_HEADS + h) * HD * D_STATE;
#pragma unroll
                for (int pt = 0; pt < 4; ++pt) { f4 acc = (f4){0.f, 0.f, 0.f, 0.f}; const int r = r4 * 64 + 16 * pt + fr;
#pragma unroll
                    for (int kk = 0; kk < 4; ++kk) { const bf16x8 Af = *(const LAS bf16x8*)(XT + r * 256 + (((4 * kk + fg) ^ (r & 15)) << 4)); acc = __builtin_amdgcn_mfma_f32_16x16x32_bf16(Af, Bf[kk], acc, 0, 0, 0); }
#pragma unroll
                    for (int j = 0; j < 4; ++j) S[(16 * pt + 4 * fg + j) * D_STATE + 16 * wave + fr] = acc[j]; } }
        }
        if (BOTH(4)) xcd_barrier(bar);
    }

    if (IN(5)) {
        const float* S = (const float*)(ws + WS_S); const float* decg = (const float*)(ws + WS_CS); bf16_t* St = (bf16_t*)(ws + WS_ST);
        for (int i = bx * 512 + tid; i < BATCH * SSM_HEADS * HD * D_STATE / 2; i += G * 512) {
            const int pn = (i % (HD * D_STATE / 2)) * 2, bh = i / (HD * D_STATE / 2), h = bh % SSM_HEADS, b = bh / SSM_HEADS;
            float s0 = 0.f, s1 = 0.f;
#pragma unroll 4
            for (int c = 0; c < NCHUNK; ++c) { const size_t idx = ((size_t)((b * NCHUNK + c) * SSM_HEADS + h)) * HD * D_STATE + pn; const float2 sv = *(const float2*)(S + idx);
                *(unsigned*)(St + idx) = pk2(s0, s1); const float dec = decg[(b * NCHUNK + c) * 16 + h]; s0 = s0 * dec + sv.x; s1 = s1 * dec + sv.y; }
        }
        bf16_t* zq = (bf16_t*)(ws + WS_ZQ); const float* ssq = (const float*)(ws + WS_SSQ);
        for (int m = gw; m < M; m += NGW) {
            float s = lane < 16 ? ssq[m * 16 + lane] : 0.f; s = wave_sum(s); const float r = rsqrtf(s * (1.f / 1024.f) + EPS);
            bf16_t* o = zq + (size_t)m * 2048 + 1024 + lane * 16;
            v4u w0 = *(v4u*)o, w1 = *(v4u*)(o + 8); unsigned w[8] = {w0.x, w0.y, w0.z, w0.w, w1.x, w1.y, w1.z, w1.w};
#pragma unroll
            for (int j = 0; j < 8; ++j) { const int d = lane * 16 + 2 * j; w[j] = pk2(__uint_as_float(w[j] << 16) * r * p.att_norm_g[d], __uint_as_float(w[j] & 0xffff0000u) * r * p.att_norm_g[d + 1]); }
            *(v4u*)o = (v4u){w[0], w[1], w[2], w[3]}; *(v4u*)(o + 8) = (v4u){w[4], w[5], w[6], w[7]};
        }
        if (BOTH(5)) xcd_barrier(bar);
    }

    if (IN(6)) {
        typedef pg8::bf16x8 bf16x8; typedef pg8::f32x4 f4;
        const bf16_t* xbc = (const bf16_t*)(ws + WS_XBC); const float* dtr = (const float*)(ws + WS_DT); bf16_t* zq = (bf16_t*)(ws + WS_ZQ); const bf16_t* Stg = (const bf16_t*)(ws + WS_ST);
        LAS unsigned char* XT = lds + RING_OFF; LAS unsigned char* Bi = lds + RING_OFF + 65536; LAS unsigned char* Ci = lds + RING_OFF + 98304;
        LAS float* csl = (LAS float*)(lds + SSD_AUX_OFF); LAS float* dtl = csl + 512;
        const int fr = lane & 15, fg = lane >> 4;
        for (int unit = bx; unit < BATCH * NCHUNK * SSM_GROUPS; unit += G) {
            const int g = unit % SSM_GROUPS, bc = unit / SSM_GROUPS, rowc = bc * CHUNK, tc = rowc % SEQ;
            __syncthreads();
            if (wave < 4) { const int h = g * 4 + wave; const float A = -__expf(p.a_log[h]), bias = p.dt_bias[h];
                const float d0 = softplus_f(dtr[(rowc + lane) * 16 + h] + bias), d1 = softplus_f(dtr[(rowc + lane + 64) * 16 + h] + bias);
                float s0 = d0 * A, s1 = d1 * A;
#pragma unroll
                for (int o = 1; o < 64; o <<= 1) { const float u0 = __shfl_up(s0, o), u1 = __shfl_up(s1, o); if (lane >= o) { s0 += u0; s1 += u1; } }
                s1 += __shfl(s0, 63);
                csl[wave * 128 + lane] = s0; csl[wave * 128 + lane + 64] = s1; dtl[wave * 128 + lane] = d0; dtl[wave * 128 + lane + 64] = d1; }
            for (int i = tid; i < 64 * 64; i += 512) { const int co = i & 63, lp = i >> 6, l = 2 * lp;
                const int ch = co < 32 ? g * 256 + co * 8 : (co < 48 ? D_SSM + g * D_STATE + (co - 32) * 8 : D_SSM + SSM_GROUPS * D_STATE + g * D_STATE + (co - 48) * 8);
                float o0[8], o1[8]; conv2x8(xbc, p.conv_w, p.conv_b, rowc + l, tc + l, ch, o0, o1);
                if (co < 32) {
#pragma unroll
                    for (int j = 0; j < 8; ++j) { const int r = co * 8 + j; *(LAS unsigned*)(XT + r * 256 + (((l >> 3) ^ (r & 15)) << 4) + (l & 7) * 2) = pk2(o0[j], o1[j]); } }
                else { LAS unsigned char* img = co < 48 ? Bi : Ci; const int cc = (co - 32) & 15;
                    *(LAS v4u*)(img + l * 256 + ((cc ^ (l & 15)) << 4)) = (v4u){pk2(o0[0], o0[1]), pk2(o0[2], o0[3]), pk2(o0[4], o0[5]), pk2(o0[6], o0[7])};
                    *(LAS v4u*)(img + (l + 1) * 256 + ((cc ^ ((l + 1) & 15)) << 4)) = (v4u){pk2(o1[0], o1[1]), pk2(o1[2], o1[3]), pk2(o1[4], o1[5]), pk2(o1[6], o1[7])}; } }
            __syncthreads();
            const int lrow = 16 * wave + fr;
            bf16x8 Cf[4];
#pragma unroll
            for (int kk = 0; kk < 4; ++kk) Cf[kk] = *(const LAS bf16x8*)(Ci + lrow * 256 + (((4 * kk + fg) ^ (lrow & 15)) << 4));
            f4 Gt[8];
#pragma unroll
            for (int st = 0; st < 8; ++st) { Gt[st] = (f4){0.f, 0.f, 0.f, 0.f};
                if (st <= wave) {
#pragma unroll
                    for (int kk = 0; kk < 4; ++kk) { const int r = 16 * st + fr; const bf16x8 Bf = *(const LAS bf16x8*)(Bi + r * 256 + (((4 * kk + fg) ^ (r & 15)) << 4));
                        Gt[st] = __builtin_amdgcn_mfma_f32_16x16x32_bf16(Bf, Cf[kk], Gt[st], 0, 0, 0); } } }
            f4 Y[4][4];
#pragma unroll
            for (int r4 = 0; r4 < 4; ++r4) { const int h = g * 4 + r4; const float cl = csl[r4 * 128 + lrow];
                const bf16_t* Sth = Stg + (size_t)(bc * SSM_HEADS + h) * HD * D_STATE;
#pragma unroll
                for (int pt = 0; pt < 4; ++pt) { f4 acc = (f4){0.f, 0.f, 0.f, 0.f};
#pragma unroll
                    for (int kk = 0; kk < 4; ++kk) { const bf16x8 Sf = *(const bf16x8*)(Sth + (16 * pt + fr) * D_STATE + (4 * kk + fg) * 8); acc = __builtin_amdgcn_mfma_f32_16x16x32_bf16(Sf, Cf[kk], acc, 0, 0, 0); }
                    Y[r4][pt] = acc * __expf(cl); }
#pragma unroll
                for (int k4 = 0; k4 < 4; ++k4) { if (2 * k4 <= wave) {
                    union { bf16x8 v; unsigned u[4]; } Pf;
#pragma unroll
                    for (int hh = 0; hh < 2; ++hh) { const int st = 2 * k4 + hh; const f4 c4 = *(const LAS f4*)(csl + r4 * 128 + 16 * st + 4 * fg), d4 = *(const LAS f4*)(dtl + r4 * 128 + 16 * st + 4 * fg);
                        float mv[4];
#pragma unroll
                        for (int j = 0; j < 4; ++j) { const int s = 16 * st + 4 * fg + j; mv[j] = (s <= lrow) ? Gt[st][j] * __expf(cl - c4[j]) * d4[j] : 0.f; }
                        Pf.u[2 * hh] = pg8::cvt_pk_bf16(mv[0], mv[1]); Pf.u[2 * hh + 1] = pg8::cvt_pk_bf16(mv[2], mv[3]); }
#pragma unroll
                    for (int pt = 0; pt < 4; ++pt) { const int r = r4 * 64 + 16 * pt + fr; const int sb = 32 * k4 + 4 * fg;
                        union { bf16x8 v; unsigned long long q[2]; } Xf;
                        Xf.q[0] = *(const LAS unsigned long long*)(XT + r * 256 + ((((sb) >> 3) ^ (r & 15)) << 4) + (sb & 7) * 2);
                        Xf.q[1] = *(const LAS unsigned long long*)(XT + r * 256 + ((((sb + 16) >> 3) ^ (r & 15)) << 4) + (sb & 7) * 2);
                        Y[r4][pt] = __builtin_amdgcn_mfma_f32_16x16x32_bf16(Xf.v, Pf.v, Y[r4][pt], 0, 0, 0); } } }
                const float dsk = p.d_skip[h];
#pragma unroll
                for (int pt = 0; pt < 4; ++pt)
#pragma unroll
                    for (int j = 0; j < 4; ++j) { const int r = r4 * 64 + 16 * pt + 4 * fg + j; const bf16_t xv = *(const LAS bf16_t*)(XT + r * 256 + (((lrow >> 3) ^ (r & 15)) << 4) + (lrow & 7) * 2); Y[r4][pt][j] += dsk * bf2f(xv); }
            }
            bf16_t* zr = zq + (size_t)(rowc + lrow) * 2048 + g * 256 + 4 * fg; float ss = 0.f;
#pragma unroll
            for (int r4 = 0; r4 < 4; ++r4)
#pragma unroll
                for (int pt = 0; pt < 4; ++pt) { const unsigned long long zz = *(const unsigned long long*)(zr + r4 * 64 + 16 * pt); const unsigned z0 = (unsigned)zz, z1 = (unsigned)(zz >> 32);
                    f4 v = Y[r4][pt]; v[0] *= silu_f(__uint_as_float(z0 << 16)); v[1] *= silu_f(__uint_as_float(z0 & 0xffff0000u)); v[2] *= silu_f(__uint_as_float(z1 << 16)); v[3] *= silu_f(__uint_as_float(z1 & 0xffff0000u));
                    Y[r4][pt] = v; ss += (v[0] * v[0] + v[1] * v[1]) + (v[2] * v[2] + v[3] * v[3]); }
            ss += __shfl_xor(ss, 16); ss += __shfl_xor(ss, 32);
            const float rr = rsqrtf(ss * (1.f / 256.f) + EPS);
#pragma unroll
            for (int r4 = 0; r4 < 4; ++r4)
#pragma unroll
                for (int pt = 0; pt < 4; ++pt) { const f4 gn = *(const f4*)(p.ssm_norm_g + g * 256 + r4 * 64 + 16 * pt + 4 * fg); const f4 v = Y[r4][pt] * rr * gn;
                    *(unsigned long long*)(zr + r4 * 64 + 16 * pt) = (unsigned long long)pg8::cvt_pk_bf16(v[0], v[1]) | ((unsigned long long)pg8::cvt_pk_bf16(v[2], v[3]) << 32); }
        }
        if (BOTH(6)) xcd_barrier(bar);
    }

    if (IN(7)) {
        pg8::DenseOrder S; S.init(ws + WS_ZQ, ws + WS_WOUT_T, M, D, 2048, G, bx);
        EpiOut E{p.x, p.out, modv};
        pg8::gemm_phase<EpiOut, pg8::DenseOrder, true, true>(lds + RING_OFF, 2048, S, E);
        if (BOTH(7)) xcd_barrier(bar);
    }

    if (IN(8)) {
        LAS float* hrow = (LAS float*)(lds + RING_OFF + wave * 16384);
        bf16_t* h2 = (bf16_t*)(ws + WS_H2); int* eidx = (int*)(ws + WS_EIDX); float* eg = (float*)(ws + WS_EGATE); int* cnt = (int*)(ws + WS_CTL) + CW_CNT; int* list = (int*)(ws + WS_LIST);
        const float rbias = p.router_bias[lane];
        for (int m0 = gw * 4; m0 < M; m0 += NGW * 4) {
#pragma unroll
            for (int r = 0; r < 4; ++r) { const int m = m0 + r, b = m / SEQ; const GAS f32x4* xr = (const GAS f32x4*)(p.out + (size_t)m * D) + lane;
                f32x4 v[4]; float s = 0.f;
#pragma unroll
                for (int j = 0; j < 4; ++j) { v[j] = xr[64 * j]; s += (v[j].x * v[j].x + v[j].y * v[j].y) + (v[j].z * v[j].z + v[j].w * v[j].w); }
                const float rstd = rsqrtf(wave_sum(s) * (1.f / D) + EPS);
                GAS unsigned long long* o8 = (GAS unsigned long long*)(h2 + (size_t)m * D) + lane;
#pragma unroll
                for (int j = 0; j < 4; ++j) { const int d = 4 * lane + 256 * j; const f32x4 g = *(const f32x4*)(p.norm2_g + d), sc = *(const f32x4*)(modv + b * 6 * D + 4 * D + d), sh = *(const f32x4*)(modv + b * 6 * D + 3 * D + d);
                    const f32x4 h = v[j] * rstd * g * (sc + 1.f) + sh;
                    *(LAS f32x4*)(hrow + r * 1024 + d) = h;
                    o8[64 * j] = (unsigned long long)pk2(h.x, h.y) | ((unsigned long long)pk2(h.z, h.w) << 32); } }
            LDS_WAIT();
            float lg0 = 0.f, lg1 = 0.f, lg2 = 0.f, lg3 = 0.f;
#pragma unroll 8
            for (int d = 0; d < D; ++d) { const float w = p.router_w[d * NE + lane]; lg0 += hrow[d] * w; lg1 += hrow[1024 + d] * w; lg2 += hrow[2048 + d] * w; lg3 += hrow[3072 + d] * w; }
            const float lgs[4] = {lg0, lg1, lg2, lg3};
#pragma unroll
            for (int r = 0; r < 4; ++r) { const int m = m0 + r;
                const float sc = 1.f / (1.f + __expf(-lgs[r])), sel = sc + rbias;
                float m1 = sel, m2 = -INFINITY;
#pragma unroll
                for (int o = 1; o < 8; o <<= 1) { const float p1 = __shfl_xor(m1, o), p2 = __shfl_xor(m2, o); const float n1 = fmaxf(m1, p1), n2 = fmaxf(fminf(m1, p1), fmaxf(m2, p2)); m1 = n1; m2 = n2; }
                const float gs = m1 + m2; const int myg = lane >> 3;
                int grank = 0;
#pragma unroll
                for (int g2 = 0; g2 < 8; ++g2) { const float og = __shfl(gs, g2 * 8); grank += (og > gs || (og == gs && g2 < myg)) ? 1 : 0; }
                const bool allowed = grank < 4; const float val = allowed ? sel : -INFINITY;
                int rank = 0;
#pragma unroll
                for (int e2 = 0; e2 < NE; ++e2) { const float ov = __shfl(val, e2); rank += (ov > val || (ov == val && e2 < lane)) ? 1 : 0; }
                const bool selb = allowed && rank < TOPK;
                const float wsum = wave_sum(selb ? sc : 0.f);
                if (selb) { const int a = m * 8 + rank; eidx[a] = lane; eg[a] = sc / wsum * 2.5f; const int pos = atomicAdd(&cnt[lane], 1); list[lane * M + pos] = a; }
            }
        }
        LAS float* scr = (LAS float*)(lds + RING_OFF + wave * 16384);
        constexpr int I_GU = 16 * 16, I_D = 4 * 32;
        bf16_t* WguT = (bf16_t*)(ws + WS_WGU); bf16_t* WdT = (bf16_t*)(ws + WS_WD);
        for (int it = gw; it < (NE + 1) * (I_GU + I_D); it += NGW) {
            const int e = it / (I_GU + I_D), r = it % (I_GU + I_D);
            if (r < I_GU) { const int nb = r & 15, kb = r >> 4, up = (nb >> 2) & 1;
                const float* W = e < NE ? (up ? p.exp_w_up : p.exp_w_gate) + (size_t)e * D * ED : (up ? p.sh_w_up : p.sh_w_gate);
                transpose_item(W, ED, WguT + (size_t)e * 512 * D, D, kb * 64, nb * 32, scr, lane, [](int n) { return (n >> 8) * 128 + (n & 127); }); }
            else { const int r2 = r - I_GU, nb = r2 & 31, kb = r2 >> 5;
                const float* W = e < NE ? p.exp_w_down + (size_t)e * ED * D : p.sh_w_down;
                transpose_item(W, D, WdT + (size_t)e * D * ED, ED, kb * 64, nb * 32, scr, lane, [](int n) { return n; }); }
        }
        if (BOTH(8)) xcd_barrier(bar);
    }

    LAS int* plan = (LAS int*)(lds + PLAN_OFF);
#define MAKE_PLAN() do { __syncthreads(); if (tid == 0) { const int* cnt = (const int*)(ws + WS_CTL) + CW_CNT; int off = 0; \
        for (int e = 0; e <= NE; ++e) { const int c = e < NE ? __hip_atomic_load(cnt + e, RLX_AGENT) : M; plan[e] = off; plan[80 + e] = c; off += (c + 255) >> 8; } plan[NE + 1] = off; } __syncthreads(); } while (0)
    if (IN(9)) {
        MAKE_PLAN();
        GroupedOrder<true> S; S.init(ws + WS_H2, ws + WS_WGU, D, 2, G, bx, plan, (const int*)(ws + WS_LIST), (size_t)512 * D * 2, (size_t)256 * D * 2, 0);
        EpiGU E{(bf16_t*)(ws + WS_U)};
        pg8::gemm_phase<EpiGU, GroupedOrder<true>, true, true>(lds + RING_OFF, D, S, E);
        if (BOTH(9)) xcd_barrier(bar);
    }
#define DOWN_PHASE(k, half) if (IN(k)) { MAKE_PLAN(); \
        GroupedOrder<false> S; S.init(ws + WS_U, ws + WS_WD, ED, 2, G, bx, plan, (const int*)(ws + WS_LIST), (size_t)D * ED * 2, (size_t)256 * ED * 2, 2 * (half)); \
        EpiDown E{(bf16_t*)(ws + WS_YC), (const int*)(ws + WS_LIST), (const float*)(ws + WS_EGATE)}; \
        pg8::gemm_phase<EpiDown, GroupedOrder<false>, true, true>(lds + RING_OFF, ED, S, E); \
        if (BOTH(k)) xcd_barrier(bar); }
    DOWN_PHASE(10, 0)
    if (IN(11)) {
        const bf16_t* yc = (const bf16_t*)(ws + WS_YC);
        for (int i = bx * 512 + tid; i < M * 64; i += G * 512) { const int tok = i >> 6, c8 = (i & 63) * 8, b = tok / SEQ;
            float s[8] = {0.f, 0.f, 0.f, 0.f, 0.f, 0.f, 0.f, 0.f};
#pragma unroll
            for (int k = 0; k < NSLOT; ++k) { const v4u raw = *(const v4u*)(yc + ((size_t)tok * NSLOT + k) * 512 + c8); const unsigned w4[4] = {raw.x, raw.y, raw.z, raw.w};
#pragma unroll
                for (int j = 0; j < 4; ++j) { s[2 * j] += __uint_as_float(w4[j] << 16); s[2 * j + 1] += __uint_as_float(w4[j] & 0xffff0000u); } }
            float* xo = p.out + (size_t)tok * D + c8; const float* g2 = modv + b * 6 * D + 5 * D + c8;
            f32x4 x0 = *(f32x4*)xo, x1v = *(f32x4*)(xo + 4);
            x0 = x0 + *(const f32x4*)g2 * (f32x4){s[0], s[1], s[2], s[3]}; x1v = x1v + *(const f32x4*)(g2 + 4) * (f32x4){s[4], s[5], s[6], s[7]};
            *(f32x4*)xo = x0; *(f32x4*)(xo + 4) = x1v; }
        if (BOTH(11)) xcd_barrier(bar);
    }
    DOWN_PHASE(12, 1)
    if (IN(13)) {
        const bf16_t* yc = (const bf16_t*)(ws + WS_YC);
        for (int m = gw; m < M; m += NGW) { const int b = m / SEQ, c8 = lane * 8;
            float s[8] = {0.f, 0.f, 0.f, 0.f, 0.f, 0.f, 0.f, 0.f};
#pragma unroll
            for (int k = 0; k < NSLOT; ++k) { const v4u raw = *(const v4u*)(yc + ((size_t)m * NSLOT + k) * 512 + c8); const unsigned w4[4] = {raw.x, raw.y, raw.z, raw.w};
#pragma unroll
                for (int j = 0; j < 4; ++j) { s[2 * j] += __uint_as_float(w4[j] << 16); s[2 * j + 1] += __uint_as_float(w4[j] & 0xffff0000u); } }
            float* xo = p.out + (size_t)m * D; const float* g2 = modv + b * 6 * D + 5 * D + 512 + c8;
            f32x4 a0 = *(f32x4*)(xo + c8), a1 = *(f32x4*)(xo + c8 + 4), b0 = *(f32x4*)(xo + 512 + c8), b1 = *(f32x4*)(xo + 512 + c8 + 4);
            b0 = b0 + *(const f32x4*)g2 * (f32x4){s[0], s[1], s[2], s[3]}; b1 = b1 + *(const f32x4*)(g2 + 4) * (f32x4){s[4], s[5], s[6], s[7]};
            float ss = (a0.x * a0.x + a0.y * a0.y) + (a0.z * a0.z + a0.w * a0.w) + (a1.x * a1.x + a1.y * a1.y) + (a1.z * a1.z + a1.w * a1.w)
                     + (b0.x * b0.x + b0.y * b0.y) + (b0.z * b0.z + b0.w * b0.w) + (b1.x * b1.x + b1.y * b1.y) + (b1.z * b1.z + b1.w * b1.w);
            const float rstd = rsqrtf(wave_sum(ss) * (1.f / D) + EPS);
            const float* fg = p.final_g;
            *(f32x4*)(xo + c8) = a0 * rstd * *(const f32x4*)(fg + c8); *(f32x4*)(xo + c8 + 4) = a1 * rstd * *(const f32x4*)(fg + c8 + 4);
            *(f32x4*)(xo + 512 + c8) = b0 * rstd * *(const f32x4*)(fg + 512 + c8); *(f32x4*)(xo + 512 + c8 + 4) = b1 * rstd * *(const f32x4*)(fg + 512 + c8 + 4); }
    }
#undef IN
#undef BOTH
}

extern "C" void kernel_launch(void* const* d_in, const int* in_sizes, int n_in, void* d_out, int out_size, void* d_ws, size_t ws_size, hipStream_t stream) {
    static int grid = 0;
    if (grid == 0) {
        int dev = 0, cus = 0;
        if (hipGetDevice(&dev) != hipSuccess || hipDeviceGetAttribute(&cus, hipDeviceAttributeMultiprocessorCount, dev) != hipSuccess) { fprintf(stderr, "device query failed\n"); grid = -1; return; }
        if (hipFuncSetAttribute((const void*)mega, hipFuncAttributeMaxDynamicSharedMemorySize, LDS_BYTES) != hipSuccess) { fprintf(stderr, "hipFuncSetAttribute failed\n"); grid = -1; return; }
        int per_cu = 0;
        if (hipOccupancyMaxActiveBlocksPerMultiprocessor(&per_cu, (const void*)mega, NWAVES * 64, LDS_BYTES) != hipSuccess || per_cu < 1) fprintf(stderr, "occupancy query: %d\n", per_cu);
        (void)hipGetLastError();
        grid = cus;
        if (ws_size < WS_END) fprintf(stderr, "ws too small: %zu < %zu\n", ws_size, (size_t)WS_END);
    }
    if (grid < 0) return;
    P p{};
    const float** f = (const float**)&p;
    for (int i = 0; i < 26; ++i) f[i] = (const float*)d_in[i];
    p.out = (float*)d_out; p.ws = (unsigned char*)d_ws;
    (void)hipMemsetAsync(p.ws + WS_CTL, 0, CTL_BYTES, stream);
    p.ph_lo = 0; p.ph_hi = NPHASE; p.li = 0;
    hipLaunchKernelGGL(mega, dim3(grid), dim3(NWAVES * 64), LDS_BYTES, stream, p);
}
```

```cpp
#include <hip/hip_runtime.h>
#include <stdint.h>
#include <stdio.h>

typedef unsigned short bf16_t;

constexpr int D = 1024, BATCH = 4, SEQ = 4096, M = BATCH * SEQ;
constexpr int D_SSM = 1024, SSM_HEADS = 16, SSM_GROUPS = 4, D_STATE = 128, CONV_K = 4, CONV_CH = 2048, CHUNK = 128, NCHUNK = SEQ / CHUNK;
constexpr int HD = 64, ATT_HEADS = 16, KV_HEADS = 4, D_KV = 256, WINDOW = 128;
constexpr int IN_COLS = 4624;
constexpr int C_Z = 0, C_XBC = 1024, C_DT = 3072, C_Q = 3088, C_K = 4112, C_V = 4368;
constexpr int NE = 64, TOPK = 8, ED = 256;
constexpr float EPS = 1e-6f;
constexpr int NSLOT = 9;
constexpr int NWIN = 4864;

constexpr size_t MiB = 1u << 20;
constexpr size_t WS_CTL = 0;
constexpr size_t CTL_BYTES = 64 * 1024;
constexpr int CW_CNT = 0;
constexpr int CW_BAR = 4096;
constexpr size_t WS_MOD = 1 * MiB;
constexpr size_t WS_RWF = 1 * MiB + 256 * 1024;
constexpr size_t WS_EIDX = 2 * MiB;
constexpr size_t WS_EGATE = 3 * MiB;
constexpr size_t WS_LIST = 4 * MiB;
constexpr size_t WS_WIN_T = 8 * MiB;
constexpr size_t WS_WOUT_T = 18 * MiB;
constexpr size_t WS_SSQ = 22 * MiB;
constexpr size_t WS_ZQ = 24 * MiB;
constexpr size_t WS_XBC = 88 * MiB;
constexpr size_t WS_K = 152 * MiB;
constexpr size_t WS_V = 160 * MiB;
constexpr size_t WS_DT = 168 * MiB;
constexpr size_t WS_CS = 169 * MiB;
constexpr size_t WS_ST = 170 * MiB;
constexpr size_t WS_H2 = 170 * MiB;
constexpr size_t WS_WGU = 202 * MiB;
constexpr size_t WS_YC = 104 * MiB;
constexpr size_t WS_U = 24 * MiB;
constexpr size_t WS_WD = 267 * MiB;
constexpr size_t WS_END = 300 * MiB;
constexpr int UROWS_MAX = 163840;

__device__ __forceinline__ float bf2f(bf16_t v) { return __uint_as_float(((unsigned)v) << 16); }
__device__ __forceinline__ bf16_t f2bf(float f) { unsigned u = __float_as_uint(f); return (bf16_t)((u + 0x7fffu + ((u >> 16) & 1u)) >> 16); }
__device__ __forceinline__ unsigned pk2(float lo, float hi) { return (unsigned)f2bf(lo) | ((unsigned)f2bf(hi) << 16); }
__device__ __forceinline__ float silu_f(float x) { return x / (1.f + __expf(-x)); }
__device__ __forceinline__ float softplus_f(float x) { return x > 20.f ? x : log1pf(__expf(x)); }

__constant__ int c_bucket[128] = {0, 1, 2, 3, 4, 5, 6, 7, 8, 9, 10, 11, 12, 13, 14, 15, 16, 16, 16, 17, 17, 18, 18, 18, 19, 19, 19, 20, 20, 20, 20, 21, 21, 21, 21, 22, 22, 22, 22, 22, 23, 23, 23, 23, 23, 23, 24, 24, 24, 24, 24, 24, 25, 25, 25, 25, 25, 25, 25, 26, 26, 26, 26, 26, 26, 26, 26, 27, 27, 27, 27, 27, 27, 27, 27, 27, 27, 28, 28, 28, 28, 28, 28, 28, 28, 28, 28, 29, 29, 29, 29, 29, 29, 29, 29, 29, 29, 29, 29, 30, 30, 30, 30, 30, 30, 30, 30, 30, 30, 30, 30, 30, 30, 31, 31, 31, 31, 31, 31, 31, 31, 31, 31, 31, 31, 31, 31, 31};

struct P {
    const float *x, *c, *mod_w, *mod_b, *norm1_g, *norm2_g, *w_in, *conv_w, *conv_b, *dt_bias, *a_log, *d_skip, *ssm_norm_g, *att_norm_g, *sinks, *rel_bias,
        *w_out, *router_w, *router_bias, *exp_w_gate, *exp_w_up, *exp_w_down, *sh_w_gate, *sh_w_up, *sh_w_down, *final_g;
    float* out; unsigned char* ws;
    int ph_lo, ph_hi, li, pad;
};

namespace pg8 {
#define PG8_LAS __attribute__((address_space(3)))
typedef short bf16x8 __attribute__((ext_vector_type(8)));
typedef float f32x4 __attribute__((ext_vector_type(4)));
typedef unsigned u32x4 __attribute__((ext_vector_type(4)));
constexpr int BM = 256, BK = 64, HALF = 128, HTB = HALF * BK * 2  , STAGE_BYTES = 8 * HTB, NXCD = 8, WGM = 8;

__host__ __device__ __forceinline__ int lds_byte(int r, int c) { const int st = (r >> 4) * 2 + (c >> 5), rr = r & 15, cc = c & 31, ob = rr * 64 + cc * 2; return st * 1024 + (ob ^ (((ob >> 9) & 1) << 5)); }
__host__ __device__ __forceinline__ void stage_rc(int b, int& R, int& C) { const int st = b / 1024, sb = b % 1024, swz = sb ^ (((sb >> 9) & 1) << 5); R = (st >> 1) * 16 + swz / 64; C = (st & 1) * 32 + (swz % 64) / 2; }
__host__ __device__ __forceinline__ int perm32(int rho) { const int n = rho >> 4, i = rho & 15; return 8 * (i >> 2) + 4 * n + (i & 3); }

struct Unit { int pm, pn, e, nrows, lt; };

__device__ __forceinline__ unsigned cvt_pk_bf16(float lo, float hi) { unsigned r; asm volatile("v_cvt_pk_bf16_f32 %0, %1, %2" : "=v"(r) : "v"(lo), "v"(hi)); return r; }

struct DenseOrder {
    typedef pg8::Unit Unit;
    const char* A; const char* Bt; int K; int nM, nN, nwg, G, c;
    __device__ __forceinline__ void init(const void* A_, const void* Bt_, int M_, int N_, int K_, int G_, int c_) { A = (const char*)A_; Bt = (const char*)Bt_; K = K_; nM = M_ / BM; nN = N_ / BM; nwg = nM * nN; G = G_; c = c_; }
    __device__ __forceinline__ bool next(int i, Unit& u) const {
        const long L = (long)i * G + c; if (L >= nwg) return false;
        int wgid = (int)L; { const int q = nwg / NXCD, r = nwg % NXCD, xcd = wgid % NXCD, off = wgid / NXCD; wgid = (xcd < r ? xcd * (q + 1) : r * (q + 1) + (xcd - r) * q) + off; }
        const int nig = WGM * nN, gid = wgid / nig, fm = gid * WGM, gsz = (nM - fm) < WGM ? (nM - fm) : WGM;
        u.pm = fm + ((wgid % nig) % gsz); u.pn = (wgid % nig) / gsz; u.e = 0; u.nrows = 256; u.lt = 0; return true;
    }
    __device__ __forceinline__ const char* a_base(const Unit& u) const { return A + (size_t)u.pm * 512 * K; }
    __device__ __forceinline__ const char* b_base(const Unit& u) const { return Bt + (size_t)u.pn * 512 * K; }
    __device__ __forceinline__ void lane_off(const Unit&, const int (&R)[2], const int (&C)[2], unsigned (&o)[2][2]) const {
#pragma unroll
        for (int h = 0; h < 2; ++h)
#pragma unroll
            for (int i = 0; i < 2; ++i) o[h][i] = (unsigned)(((h * HALF + R[i]) * K + C[i]) * 2);
    }
    __device__ __forceinline__ void a_ready(const Unit&) const {}
    __device__ __forceinline__ void done(const Unit&) const {}
};

template <class Epi, class Sched, bool ALIGN_EPI = false, bool SP2 = false>
__device__ __forceinline__ void gemm_phase(PG8_LAS unsigned char* lds, const int K, const Sched& S, const Epi& E) {
    typedef typename Sched::Unit Unit;
    const int tid = threadIdx.x, wid = __builtin_amdgcn_readfirstlane(tid >> 6), lane = tid & 63, wr = wid >> 2, wc = wid & 3, fr = lane & 15, fq = lane >> 4;
    const int nt = K / BK;
    unsigned voffB[2]; int stR[2], stC[2];
#pragma unroll
    for (int i = 0; i < 2; ++i) { int R, C; stage_rc(tid * 16 + i * 8192, R, C); const int Rb = Epi::PERM ? ((R & ~31) + perm32(R & 31)) : R;
        stR[i] = R; stC[i] = C; voffB[i] = (unsigned)(Rb * K + C) * 2u; }
    const size_t kstep = (size_t)(BK * 2);
    const size_t hstep = (size_t)HALF * K * 2;
    const size_t tstep = 2 * hstep;
    const unsigned ldsw = (unsigned)wid * 1024u;
    const int aoff = lds_byte(wr * 64 + fr, fq * 8), boff = lds_byte(wc * 32 + fr, fq * 8);
#define PG8_SA(b, h) (((b) * 2 + (h)) * HTB)
#define PG8_SB(b, h) ((4 + (b) * 2 + (h)) * HTB)
#define PG8_STAGE(bufoff, gbase, voff) do { _Pragma("unroll") for (int _i = 0; _i < 2; ++_i) \
        __builtin_amdgcn_global_load_lds((const unsigned*)((const char*)(gbase) + (voff)[_i]), (PG8_LAS unsigned*)(lds + (bufoff) + ldsw + _i * 8192), 16, 0, 0); } while (0)
#define PG8_LDA(dst, b, h) do { _Pragma("unroll") for (int m = 0; m < 4; ++m) _Pragma("unroll") for (int k = 0; k < 2; ++k) dst[m][k] = *(const PG8_LAS bf16x8*)(lds + PG8_SA(b, h) + aoff + m * 2048 + k * 1024); } while (0)
#define PG8_LDB(dst, b, h) do { _Pragma("unroll") for (int n = 0; n < 2; ++n) _Pragma("unroll") for (int k = 0; k < 2; ++k) dst[n][k] = *(const PG8_LAS bf16x8*)(lds + PG8_SB(b, h) + boff + n * 2048 + k * 1024); } while (0)
#define PG8_MMA(ai, bj, At, Bt) do { __builtin_amdgcn_s_setprio(1); _Pragma("unroll") for (int m = 0; m < 4; ++m) _Pragma("unroll") for (int n = 0; n < 2; ++n) _Pragma("unroll") for (int k = 0; k < 2; ++k) \
        acc[ai][bj][m][n] = __builtin_amdgcn_mfma_f32_16x16x32_bf16(Bt[n][k], At[m][k], acc[ai][bj][m][n], 0, 0, 0); __builtin_amdgcn_s_setprio(0); } while (0)
#define PG8_WAIT_V(n) asm volatile("s_waitcnt vmcnt(" #n ")" ::: "memory")
#define PG8_WAIT_L(n) asm volatile("s_waitcnt lgkmcnt(" #n ")" ::: "memory")
#define PG8_BAR __builtin_amdgcn_s_barrier()
#define PG8_SCHED __builtin_amdgcn_sched_barrier(0)
    Unit cur, nxt; int ui = 0;
    if (!S.next(0, cur)) return;
    f32x4 acc[2][2][4][2];
#pragma unroll
    for (int a = 0; a < 2; ++a)
#pragma unroll
        for (int b = 0; b < 2; ++b)
#pragma unroll
            for (int m = 0; m < 4; ++m)
#pragma unroll
                for (int n = 0; n < 2; ++n) acc[a][b][m][n] = (f32x4){0.f, 0.f, 0.f, 0.f};
    bf16x8 At[4][2], B0[2][2], B1[2][2];
    const char* cA = S.a_base(cur); const char* cB = S.b_base(cur);
    unsigned oc[2][2], on[2][2];
    S.lane_off(cur, stR, stC, oc);
    S.a_ready(cur);
    if constexpr (SP2) {
        PG8_STAGE(PG8_SB(0, 0), cB, voffB); PG8_STAGE(PG8_SB(0, 1), cB + hstep, voffB); PG8_STAGE(PG8_SA(0, 0), cA, oc[0]); PG8_STAGE(PG8_SA(0, 1), cA, oc[1]);
        if (wr == 1) PG8_BAR;
        PG8_WAIT_V(2); PG8_BAR;
        PG8_STAGE(PG8_SB(1, 0), cB + kstep, voffB); PG8_STAGE(PG8_SA(1, 0), cA + kstep, oc[0]); PG8_STAGE(PG8_SB(1, 1), cB + hstep + kstep, voffB);
        PG8_WAIT_V(6); PG8_BAR;
    } else {
        PG8_STAGE(PG8_SB(0, 0), cB, voffB); PG8_STAGE(PG8_SA(0, 0), cA, oc[0]); PG8_STAGE(PG8_SB(0, 1), cB + hstep, voffB); PG8_STAGE(PG8_SA(0, 1), cA, oc[1]);
        if (wr == 1) PG8_BAR;
        PG8_WAIT_V(4); PG8_BAR;
        PG8_STAGE(PG8_SB(1, 0), cB + kstep, voffB); PG8_STAGE(PG8_SA(1, 0), cA + kstep, oc[0]); PG8_STAGE(PG8_SB(1, 1), cB + hstep + kstep, voffB);
        PG8_WAIT_V(6); PG8_BAR;
    }
    for (;;) {
        const bool has_next = S.next(ui + 1, nxt);
        const char* nA = has_next ? S.a_base(nxt) : cA; const char* nB = has_next ? S.b_base(nxt) : cB;
        if (has_next) S.lane_off(nxt, stR, stC, on); else {
#pragma unroll
            for (int h = 0; h < 2; ++h)
#pragma unroll
                for (int i = 0; i < 2; ++i) on[h][i] = oc[h][i]; }
#pragma unroll 1
        for (int t = 0; t < nt; t += 2) {
            const bool last = (t == nt - 2);
            const char* a1 = cA + (size_t)(t + 1) * kstep;
            const char* a2 = last ? nA : cA + (size_t)(t + 2) * kstep; const char* b2 = last ? nB : cB + (size_t)(t + 2) * kstep;
            const char* a3 = a2 + kstep; const char* b3 = b2 + kstep;
            unsigned o2[2][2];
#pragma unroll
            for (int h = 0; h < 2; ++h)
#pragma unroll
                for (int i = 0; i < 2; ++i) o2[h][i] = last ? on[h][i] : oc[h][i];
            if (last && has_next) S.a_ready(nxt);
            if constexpr (SP2) {
            PG8_LDB(B0, 0, 0); PG8_LDB(B1, 0, 1); PG8_SCHED; PG8_LDA(At, 0, 0); PG8_STAGE(PG8_SA(1, 1), a1, oc[1]);
            PG8_WAIT_V(8); PG8_WAIT_L(0); PG8_BAR; PG8_MMA(0, 0, At, B0); PG8_MMA(0, 1, At, B1); PG8_BAR; PG8_SCHED;
            PG8_LDA(At, 0, 1); PG8_STAGE(PG8_SB(0, 0), b2, voffB); PG8_STAGE(PG8_SB(0, 1), b2 + hstep, voffB); PG8_STAGE(PG8_SA(0, 0), a2, o2[0]);
            PG8_WAIT_V(8); PG8_WAIT_L(0); PG8_BAR; PG8_MMA(1, 0, At, B0); PG8_MMA(1, 1, At, B1); PG8_BAR; PG8_SCHED;
            PG8_LDB(B0, 1, 0); PG8_LDB(B1, 1, 1); PG8_SCHED; PG8_LDA(At, 1, 0); PG8_STAGE(PG8_SA(0, 1), a2, o2[1]);
            PG8_WAIT_V(8); PG8_WAIT_L(0); PG8_BAR; PG8_MMA(0, 0, At, B0); PG8_MMA(0, 1, At, B1); PG8_BAR; PG8_SCHED;
            PG8_LDA(At, 1, 1); PG8_STAGE(PG8_SB(1, 0), b3, voffB); PG8_STAGE(PG8_SB(1, 1), b3 + hstep, voffB); PG8_STAGE(PG8_SA(1, 0), a3, o2[0]);
            PG8_WAIT_V(8); PG8_WAIT_L(0); PG8_BAR; PG8_MMA(1, 0, At, B0); PG8_MMA(1, 1, At, B1); PG8_BAR; PG8_SCHED;
            } else {
            PG8_LDB(B0, 0, 0); PG8_SCHED; PG8_LDA(At, 0, 0); PG8_STAGE(PG8_SA(1, 1), a1, oc[1]);
            PG8_WAIT_L(8); PG8_BAR; PG8_WAIT_L(0); PG8_MMA(0, 0, At, B0); PG8_BAR; PG8_SCHED;
            PG8_LDB(B1, 0, 1); PG8_STAGE(PG8_SB(0, 0), b2, voffB);
            PG8_BAR; PG8_WAIT_L(0); PG8_MMA(0, 1, At, B1); PG8_BAR;
            PG8_LDA(At, 0, 1); PG8_STAGE(PG8_SA(0, 0), a2, o2[0]);
            PG8_BAR; PG8_WAIT_L(0); PG8_MMA(1, 0, At, B0); PG8_BAR; PG8_SCHED;
            PG8_STAGE(PG8_SB(0, 1), b2 + hstep, voffB);
            PG8_WAIT_V(6); PG8_BAR; PG8_MMA(1, 1, At, B1); PG8_BAR;
            PG8_LDB(B0, 1, 0); PG8_SCHED; PG8_LDA(At, 1, 0); PG8_STAGE(PG8_SA(0, 1), a2, o2[1]);
            PG8_WAIT_L(8); PG8_BAR; PG8_WAIT_L(0); PG8_MMA(0, 0, At, B0); PG8_BAR; PG8_SCHED;
            PG8_LDB(B1, 1, 1); PG8_STAGE(PG8_SB(1, 0), b3, voffB);
            PG8_BAR; PG8_WAIT_L(0); PG8_MMA(0, 1, At, B1); PG8_BAR;
            PG8_LDA(At, 1, 1); PG8_STAGE(PG8_SA(1, 0), a3, o2[0]);
            PG8_BAR; PG8_WAIT_L(0); PG8_MMA(1, 0, At, B0); PG8_BAR; PG8_SCHED;
            PG8_STAGE(PG8_SB(1, 1), b3 + hstep, voffB);
            PG8_WAIT_V(6); PG8_BAR; PG8_MMA(1, 1, At, B1); PG8_BAR;
            }
        }
        if constexpr (ALIGN_EPI) { if (wr == 0) PG8_BAR; }
        if constexpr (!Epi::AFTER_DRAIN) { E(acc, cur, wr, wc, fr, fq); S.done(cur); }
        if (!has_next) break;
#pragma unroll
        for (int a = 0; a < 2; ++a)
#pragma unroll
            for (int b = 0; b < 2; ++b)
#pragma unroll
                for (int m = 0; m < 4; ++m)
#pragma unroll
                    for (int n = 0; n < 2; ++n) acc[a][b][m][n] = (f32x4){0.f, 0.f, 0.f, 0.f};
        cur = nxt; cA = nA; cB = nB; ++ui;
#pragma unroll
        for (int h = 0; h < 2; ++h)
#pragma unroll
            for (int i = 0; i < 2; ++i) oc[h][i] = on[h][i];
        if constexpr (ALIGN_EPI) { if (wr == 1) PG8_BAR; }
    }
    PG8_WAIT_V(0);
    if constexpr (!ALIGN_EPI) { if (wr == 0) PG8_BAR; }
    PG8_BAR;
    if constexpr (Epi::AFTER_DRAIN) { E.fused(acc, cur, wr, wc, fr, fq, lds, wid, lane); S.done(cur); }
#undef PG8_SA
#undef PG8_SB
#undef PG8_STAGE
#undef PG8_LDA
#undef PG8_LDB
#undef PG8_MMA
#undef PG8_WAIT_V
#undef PG8_WAIT_L
#undef PG8_BAR
#undef PG8_SCHED
}
}

#define GAS __attribute__((address_space(1)))
#define LAS __attribute__((address_space(3)))
typedef unsigned v4u __attribute__((ext_vector_type(4)));
typedef float f32x4 __attribute__((ext_vector_type(4)));
typedef GAS unsigned gu32;
#define RLX_AGENT __ATOMIC_RELAXED, __HIP_MEMORY_SCOPE_AGENT
#define LDS_WAIT() asm volatile("s_waitcnt lgkmcnt(0)" ::: "memory")
#define VM_WAIT() asm volatile("s_waitcnt vmcnt(0)" ::: "memory")
constexpr int NWAVES = 8;
constexpr int RING_OFF = 0, RING_BYTES = 131072;
constexpr int LDSCTL_OFF = RING_BYTES, MISC_OFF = LDSCTL_OFF + 320;
constexpr int PLAN_OFF = LDSCTL_OFF + 1024;
constexpr int SSD_AUX_OFF = LDSCTL_OFF + 4096;
constexpr int LDS_BYTES = 147456;

#define XB_TMO      128
#define XB_XCNT(j)  (256  + 64 * (j))
#define XB_XSUB(j)  (1280 + 64 * (j))
#define XB_XGEN(j)  (2304 + 64 * (j))
#define XB_TOP      3328
#define XB_TOPGEN   3392
#define XCD_BAR_WORDS 3456
#define XB_SPIN_CAP (1u << 18)

__device__ __forceinline__ unsigned xb_ld(unsigned* p)              { return __hip_atomic_load(p, __ATOMIC_RELAXED, __HIP_MEMORY_SCOPE_AGENT); }
__device__ __forceinline__ unsigned xb_add(unsigned* p, unsigned v) { return __hip_atomic_fetch_add(p, v, __ATOMIC_RELAXED, __HIP_MEMORY_SCOPE_AGENT); }
__device__ __forceinline__ unsigned xb_xcc_id() { return (unsigned)__builtin_amdgcn_s_getreg((3 << 11) | 20) & 0xFu; }
#define XB_SPIN(cond, bar) do { unsigned _sp = 0; while (cond) { __builtin_amdgcn_s_sleep(1); \
    if ((++_sp & 255u) == 0u) { if (xb_ld(&(bar)[XB_TMO])) break; if (_sp > XB_SPIN_CAP) { atomicAdd(&(bar)[XB_TMO], 1u); break; } } } } while (0)

struct XcdBarrier {
    unsigned* bar; unsigned x;
    volatile LAS unsigned* st;
};

__device__ __forceinline__ XcdBarrier xcd_barrier_post(unsigned* bar, volatile LAS unsigned* st) {
    XcdBarrier b; b.bar = bar; b.x = xb_xcc_id(); b.st = st;
    if (threadIdx.x == 0) (void)xb_add(&bar[XB_XCNT(b.x)], 1u);
    return b;
}
__device__ __forceinline__ void xcd_barrier_complete(unsigned* bar, unsigned x, unsigned& nloc, unsigned& nx) {
    const unsigned G = gridDim.x * gridDim.y * gridDim.z;
    unsigned sum, cnt, mine, sp = 0u;
    for (;;) {
        sum = 0u; cnt = 0u; mine = 0u;
#pragma unroll
        for (unsigned j = 0; j < 16; ++j) { const unsigned c = xb_ld(&bar[XB_XCNT(j)]); sum += c; cnt += (c > 0u) ? 1u : 0u; mine = (j == x) ? c : mine; }
        if (sum == G) break;
        __builtin_amdgcn_s_sleep(1);
        if ((++sp & 255u) == 0u) { if (xb_ld(&bar[XB_TMO])) break; if (sp > XB_SPIN_CAP) { atomicAdd(&bar[XB_TMO], 1u); break; } }
    }
    nloc = mine > 0u ? mine : 1u; nx = cnt > 0u ? cnt : 1u;
}

__device__ __forceinline__ void xcd_barrier(const XcdBarrier& b) {
    asm volatile("s_waitcnt vmcnt(0)" ::: "memory");
    __syncthreads();
    if (threadIdx.x == 0) {
        unsigned* bar = b.bar;
        __builtin_amdgcn_s_waitcnt(0);
        unsigned nloc = b.st[0], nx = b.st[1];
        if (nloc == 0u) { xcd_barrier_complete(bar, b.x, nloc, nx); b.st[0] = nloc; b.st[1] = nx; }
        const unsigned old = xb_add(&bar[XB_XSUB(b.x)], 1u);
        const unsigned gen = old / nloc;
        if (old + 1u == (gen + 1u) * nloc) {
            __builtin_amdgcn_fence(__ATOMIC_RELEASE, "agent");
            asm volatile("s_waitcnt vmcnt(0)" ::: "memory");
            const unsigned og = xb_add(&bar[XB_TOP], 1u);
            const unsigned tg = og / nx;
            if (og + 1u == (tg + 1u) * nx) xb_add(&bar[XB_TOPGEN], 1u);
            else XB_SPIN(xb_ld(&bar[XB_TOPGEN]) == tg, bar);
            __builtin_amdgcn_fence(__ATOMIC_ACQUIRE, "agent");
            xb_add(&bar[XB_XGEN(b.x)], 1u);
            asm volatile("s_waitcnt vmcnt(0)" ::: "memory");
        } else {
            XB_SPIN(xb_ld(&bar[XB_XGEN(b.x)]) == gen, bar);
            __builtin_amdgcn_fence(__ATOMIC_ACQUIRE, "agent");
            asm volatile("s_waitcnt vmcnt(0)" ::: "memory");
        }
    }
    __syncthreads();
}

__device__ __forceinline__ float wave_sum(float v) {
#pragma unroll
    for (int o = 1; o < 64; o <<= 1) v += __shfl_xor(v, o);
    return v;
}

struct EpiIn {
    static constexpr bool PERM = true, AFTER_DRAIN = false;
    bf16_t *zq, *xbc, *kk, *vv; float* dt;
    __device__ __forceinline__ void operator()(const pg8::f32x4 (&acc)[2][2][4][2], const pg8::Unit& u, int wr, int wc, int fr, int fq) const {
        const int row0 = u.pm * 256 + wr * 64 + fr, pn = u.pn;
        if (pn == 18) {
            if (wc == 0 && fq < 2) {
#pragma unroll
                for (int ai = 0; ai < 2; ++ai)
#pragma unroll
                    for (int m = 0; m < 4; ++m) { float* o = dt + (size_t)(row0 + ai * 128 + m * 16) * 16 + 8 * fq; *(pg8::f32x4*)o = acc[ai][0][m][0]; *(pg8::f32x4*)(o + 4) = acc[ai][0][m][1]; }
            }
            return;
        }
        bf16_t* base; int ldc, colt;
        if (pn < 4) { base = zq; ldc = 2048; colt = pn * 256; }
        else if (pn < 12) { base = xbc; ldc = 2048; colt = (pn - 4) * 256; }
        else if (pn < 16) { base = zq; ldc = 2048; colt = 1024 + (pn - 12) * 256; }
        else if (pn == 16) { base = kk; ldc = 256; colt = 0; }
        else { base = vv; ldc = 256; colt = 0; }
        const int col0 = colt + wc * 32 + 8 * fq;
#pragma unroll
        for (int ai = 0; ai < 2; ++ai)
#pragma unroll
            for (int m = 0; m < 4; ++m) { bf16_t* rowp = base + (size_t)(row0 + ai * 128 + m * 16) * ldc + col0;
#pragma unroll
                for (int bj = 0; bj < 2; ++bj) { const pg8::f32x4 v0 = acc[ai][bj][m][0], v1 = acc[ai][bj][m][1];
                    pg8::u32x4 w; w.x = pg8::cvt_pk_bf16(v0[0], v0[1]); w.y = pg8::cvt_pk_bf16(v0[2], v0[3]); w.z = pg8::cvt_pk_bf16(v1[0], v1[1]); w.w = pg8::cvt_pk_bf16(v1[2], v1[3]);
                    *(pg8::u32x4*)(rowp + bj * 128) = w; } }
    }
};

struct EpiOut {
    static constexpr bool PERM = true, AFTER_DRAIN = false;
    const float* x; float* x1; const float* mod;
    __device__ __forceinline__ void operator()(const pg8::f32x4 (&acc)[2][2][4][2], const pg8::Unit& u, int wr, int wc, int fr, int fq) const {
        const int row0 = u.pm * 256 + wr * 64 + fr, col0 = u.pn * 256 + wc * 32 + 8 * fq, b = (u.pm * 256) / SEQ;
        const float* g1 = mod + b * 6 * D + 2 * D + col0;
        pg8::f32x4 gv[2][2];
#pragma unroll
        for (int bj = 0; bj < 2; ++bj) { gv[bj][0] = *(const pg8::f32x4*)(g1 + bj * 128); gv[bj][1] = *(const pg8::f32x4*)(g1 + bj * 128 + 4); }
#pragma unroll
        for (int ai = 0; ai < 2; ++ai)
#pragma unroll
            for (int m = 0; m < 4; ++m) { const size_t off = (size_t)(row0 + ai * 128 + m * 16) * D + col0;
#pragma unroll
                for (int bj = 0; bj < 2; ++bj) { const float* xi = x + off + bj * 128; float* xo = x1 + off + bj * 128;
                    *(pg8::f32x4*)xo = *(const pg8::f32x4*)xi + gv[bj][0] * acc[ai][bj][m][0]; *(pg8::f32x4*)(xo + 4) = *(const pg8::f32x4*)(xi + 4) + gv[bj][1] * acc[ai][bj][m][1]; } }
    }
};
struct EpiGU {
    static constexpr bool PERM = true, AFTER_DRAIN = false;
    bf16_t* u;
    __device__ __forceinline__ void operator()(const pg8::f32x4 (&acc)[2][2][4][2], const pg8::Unit& un, int wr, int wc, int fr, int fq) const {
        const int row0 = un.pm * 256 + wr * 64 + fr, col0 = un.pn * 128 + wc * 32 + 8 * fq;
#pragma unroll
        for (int ai = 0; ai < 2; ++ai)
#pragma unroll
            for (int m = 0; m < 4; ++m) { bf16_t* rowp = u + (size_t)(row0 + ai * 128 + m * 16) * ED + col0;
                float o[8];
#pragma unroll
                for (int n = 0; n < 2; ++n)
#pragma unroll
                    for (int j = 0; j < 4; ++j) o[4 * n + j] = silu_f(acc[ai][0][m][n][j]) * acc[ai][1][m][n][j];
                pg8::u32x4 w; w.x = pg8::cvt_pk_bf16(o[0], o[1]); w.y = pg8::cvt_pk_bf16(o[2], o[3]); w.z = pg8::cvt_pk_bf16(o[4], o[5]); w.w = pg8::cvt_pk_bf16(o[6], o[7]);
                *(pg8::u32x4*)rowp = w; }
    }
};
struct EpiDown {
    static constexpr bool PERM = true, AFTER_DRAIN = false;
    bf16_t* yc; const int* list; const float* egate;
    __device__ __forceinline__ void operator()(const pg8::f32x4 (&acc)[2][2][4][2], const pg8::Unit& u, int wr, int wc, int fr, int fq) const {
        const unsigned col0 = (unsigned)(u.pn * 256 + wc * 32 + 8 * fq);
        const int* lp = list + (size_t)u.e * M + u.lt * 256;
#pragma unroll
        for (int ai = 0; ai < 2; ++ai)
#pragma unroll
            for (int m = 0; m < 4; ++m) { const int r = ai * 128 + wr * 64 + m * 16 + fr;
                if (r < u.nrows) { unsigned ts; float gt;
                    if (u.e < NE) { const int a = lp[r]; ts = (unsigned)((a >> 3) * NSLOT + (a & 7)); gt = egate[a]; } else { ts = (unsigned)((u.lt * 256 + r) * NSLOT + 8); gt = 1.f; }
                    bf16_t* rowp = yc + (ts * 512u + col0);
#pragma unroll
                    for (int bj = 0; bj < 2; ++bj) { const pg8::f32x4 v0 = acc[ai][bj][m][0] * gt, v1 = acc[ai][bj][m][1] * gt;
                        pg8::u32x4 w; w.x = pg8::cvt_pk_bf16(v0[0], v0[1]); w.y = pg8::cvt_pk_bf16(v0[2], v0[3]); w.z = pg8::cvt_pk_bf16(v1[0], v1[1]); w.w = pg8::cvt_pk_bf16(v1[2], v1[3]);
                        *(pg8::u32x4*)(rowp + bj * 128) = w; } }
                asm volatile("" ::: "memory"); }
    }
};
template <bool GATHER>
struct GroupedOrder {
    typedef pg8::Unit Unit;
    const char* A; const char* Bt; int K, nN, G, c, total; const LAS int* plan; const int* list; size_t bs_e, bs_pn; int pn0;
    __device__ __forceinline__ void init(const void* A_, const void* Bt_, int K_, int nN_, int G_, int c_, const LAS int* plan_, const int* list_, size_t bs_e_, size_t bs_pn_, int pn0_) {
        A = (const char*)A_; Bt = (const char*)Bt_; K = K_; nN = nN_; G = G_; c = c_; plan = plan_; list = list_; bs_e = bs_e_; bs_pn = bs_pn_; pn0 = pn0_; total = __builtin_amdgcn_readfirstlane(plan[NE + 1]) * nN; }
    __device__ __forceinline__ bool next(int i, Unit& u) const {
        const int L = i * G + c; if (L >= total) return false;
        int wgid = L; { const int q = total / 8, r = total % 8, xcd = wgid % 8, off = wgid / 8; wgid = (xcd < r ? xcd * (q + 1) : r * (q + 1) + (xcd - r) * q) + off; }
        const int tile = wgid / nN; u.pn = wgid % nN; u.pm = tile;
        int e = 0;
        for (int j = 1; j <= NE; ++j) e += (plan[j] <= tile) ? 1 : 0;
        e = __builtin_amdgcn_readfirstlane(e);
        u.e = e; u.lt = __builtin_amdgcn_readfirstlane(tile - plan[e]); const int rem = __builtin_amdgcn_readfirstlane(plan[80 + e]) - u.lt * 256; u.nrows = rem < 256 ? rem : 256; return true;
    }
    __device__ __forceinline__ const char* a_base(const Unit& u) const { return GATHER ? A : A + (size_t)u.pm * 512 * K; }
    __device__ __forceinline__ const char* b_base(const Unit& u) const { return Bt + (size_t)u.e * bs_e + (size_t)(pn0 + u.pn) * bs_pn; }
    __device__ __forceinline__ void lane_off(const Unit& u, const int (&R)[2], const int (&C)[2], unsigned (&o)[2][2]) const {
#pragma unroll
        for (int h = 0; h < 2; ++h)
#pragma unroll
            for (int i = 0; i < 2; ++i) { const int r = h * 128 + R[i];
                if (GATHER) { int tok = 0; if (r < u.nrows) { const int idx = u.lt * 256 + r; tok = u.e < NE ? (list[(size_t)u.e * M + idx] >> 3) : idx; }
                    o[h][i] = (unsigned)((tok * K + C[i]) * 2); }
                else o[h][i] = (unsigned)((r * K + C[i]) * 2); }
    }
    __device__ __forceinline__ void a_ready(const Unit&) const {}
    __device__ __forceinline__ void done(const Unit&) const {}
};

template <class CM>
__device__ __forceinline__ void transpose_item(const float* W, int ldw, bf16_t* WT, int ldt, int k0, int n0, LAS float* scr, int lane, const CM& colmap) {
    const int sc = colmap(n0 + (lane & 31));
#pragma unroll
    for (int i = 0; i < 32; ++i) { const int kk = 2 * i + (lane >> 5); scr[kk * 33 + (lane & 31)] = sc >= 0 ? W[(size_t)(k0 + kk) * ldw + sc] : 0.f; }
    LDS_WAIT(); asm volatile("" ::: "memory");
    const int c = lane & 7;
#pragma unroll
    for (int j = 0; j < 4; ++j) { const int n = (lane >> 3) + 8 * j; const LAS float* s = scr + (8 * c) * 33 + n;
        v4u o; o.x = pk2(s[0 * 33], s[1 * 33]); o.y = pk2(s[2 * 33], s[3 * 33]); o.z = pk2(s[4 * 33], s[5 * 33]); o.w = pk2(s[6 * 33], s[7 * 33]);
        *(GAS v4u*)(WT + (size_t)(n0 + n) * ldt + k0 + 8 * c) = o; }
    LDS_WAIT(); asm volatile("" ::: "memory");
}

__device__ __forceinline__ void conv2x8(const bf16_t* xbc, const float* cw, const float* cb, int row, int t, int ch, float (&o0)[8], float (&o1)[8]) {
    float xr[5][8];
#pragma unroll
    for (int k = 0; k < 5; ++k) { v4u raw = (v4u){0u, 0u, 0u, 0u}; if (t - 3 + k >= 0) raw = *(const v4u*)(xbc + (size_t)(row - 3 + k) * CONV_CH + ch);
        const unsigned w4[4] = {raw.x, raw.y, raw.z, raw.w};
#pragma unroll
        for (int j = 0; j < 4; ++j) { xr[k][2 * j] = __uint_as_float(w4[j] << 16); xr[k][2 * j + 1] = __uint_as_float(w4[j] & 0xffff0000u); } }
    float wv[4][8], bv[8];
#pragma unroll
    for (int k = 0; k < 4; ++k) { const f32x4 a = *(const f32x4*)(cw + k * CONV_CH + ch), b = *(const f32x4*)(cw + k * CONV_CH + ch + 4); wv[k][0] = a.x; wv[k][1] = a.y; wv[k][2] = a.z; wv[k][3] = a.w; wv[k][4] = b.x; wv[k][5] = b.y; wv[k][6] = b.z; wv[k][7] = b.w; }
    { const f32x4 a = *(const f32x4*)(cb + ch), b = *(const f32x4*)(cb + ch + 4); bv[0] = a.x; bv[1] = a.y; bv[2] = a.z; bv[3] = a.w; bv[4] = b.x; bv[5] = b.y; bv[6] = b.z; bv[7] = b.w; }
#pragma unroll
    for (int j = 0; j < 8; ++j) { float a0 = bv[j], a1 = bv[j];
#pragma unroll
        for (int k = 0; k < 4; ++k) { a0 += wv[k][j] * xr[k][j]; a1 += wv[k][j] * xr[k + 1][j]; }
        o0[j] = silu_f(a0); o1[j] = silu_f(a1); }
}

constexpr int NPHASE = 14;
__global__ void __launch_bounds__(NWAVES * 64, 2) mega(P p) {
    extern __shared__ __attribute__((aligned(16))) unsigned char lds_raw[];
    LAS unsigned char* lds = (LAS unsigned char*)lds_raw;
    volatile LAS unsigned* MISC = (volatile LAS unsigned*)(lds + MISC_OFF);
    const int tid = threadIdx.x, lane = tid & 63, wave = __builtin_amdgcn_readfirstlane(tid >> 6);
    const int G = gridDim.x; const int bx = blockIdx.x; const int vcu = (G % 8 == 0) ? (bx % 8) * (G / 8) + bx / 8 : bx;
    unsigned char* ws = p.ws;
    gu32* ctl = (gu32*)(ws + WS_CTL);
    for (int u = tid; u < (LDS_BYTES - LDSCTL_OFF) / 4; u += NWAVES * 64) ((LAS unsigned*)(lds + LDSCTL_OFF))[u] = 0u;
    __syncthreads();
    XcdBarrier bar = xcd_barrier_post((unsigned*)(ctl + CW_BAR) + p.li * XCD_BAR_WORDS, MISC + 8);
    const int lo = p.ph_lo, hi = p.ph_hi;
#ifndef PHMASK
#define PHMASK 0xffffffffu
#endif
#define IN(k) (((PHMASK >> (k)) & 1u) && lo <= (k) && (k) < hi)
#define BOTH(k) (IN(k) && IN((k) + 1))
#ifdef PROBE_MASK
#define PH_BEGIN() const unsigned long long _pt0 = __builtin_amdgcn_s_memrealtime()
#define PH_END(k) do { if ((PROBE_MASK >> (k)) & 1u) { const unsigned long long _pt1 = __builtin_amdgcn_s_memrealtime(); while (__builtin_amdgcn_s_memrealtime() < _pt1 + (_pt1 - _pt0)) __builtin_amdgcn_s_sleep(8); } } while (0)
#else
#define PH_BEGIN() do {} while (0)
#define PH_END(k) do {} while (0)
#endif
    const int gw = vcu * NWAVES + wave, NGW = G * NWAVES;
    float* modv = (float*)(ws + WS_MOD);

    if (IN(0)) { PH_BEGIN();
        if (bx < 192) {
            LAS float* part = (LAS float*)(lds + RING_OFF);
            const int j0 = bx * 32, cc = lane & 31, ks = wave * 2 + (lane >> 5);
            float a0 = 0.f, a1 = 0.f, a2 = 0.f, a3 = 0.f;
#pragma unroll 8
            for (int k = ks * 64; k < ks * 64 + 64; ++k) { const float wv = p.mod_w[(size_t)k * 6 * D + j0 + cc];
                a0 += silu_f(p.c[k]) * wv; a1 += silu_f(p.c[D + k]) * wv; a2 += silu_f(p.c[2 * D + k]) * wv; a3 += silu_f(p.c[3 * D + k]) * wv; }
            part[(ks * 4 + 0) * 32 + cc] = a0; part[(ks * 4 + 1) * 32 + cc] = a1; part[(ks * 4 + 2) * 32 + cc] = a2; part[(ks * 4 + 3) * 32 + cc] = a3;
            __syncthreads();
            if (tid < 128) { const int b = tid >> 5, c2 = tid & 31; float s = p.mod_b[j0 + c2];
                for (int q = 0; q < 16; ++q) s += part[(q * 4 + b) * 32 + c2];
                modv[b * 6 * D + j0 + c2] = s; }
            __syncthreads();
        }
        LAS float* scr = (LAS float*)(lds + RING_OFF + wave * 16384);
        constexpr int I_IN = (D / 64) * (NWIN / 32), I_OUT = (2048 / 64) * (D / 32);
        bf16_t* WinT = (bf16_t*)(ws + WS_WIN_T); bf16_t* WoutT = (bf16_t*)(ws + WS_WOUT_T);
        for (int it = gw; it < I_IN + I_OUT; it += NGW) {
            if (it < I_IN) { const int nb = it % (NWIN / 32), kb = it / (NWIN / 32);
                transpose_item(p.w_in, IN_COLS, WinT, D, kb * 64, nb * 32, scr, lane, [](int n) { return n < 3072 ? n : (n < 4608 ? n + 16 : (n < 4624 ? n - 1536 : -1)); }); }
            else { const int r = it - I_IN, nb = r % (D / 32), kb = r / (D / 32);
                transpose_item(p.w_out, D, WoutT, 2048, kb * 64, nb * 32, scr, lane, [](int n) { return n; }); }
        }
        {
            v4u* rwf = (v4u*)(ws + WS_RWF);
            for (int i = bx * 512 + tid; i < 32 * 4 * 64; i += G * 512) { const int ln = i & 63, nt = (i >> 6) & 3, ks = i >> 8, c = ln & 15, q = ln >> 4;
                float v[8]; unsigned hi[4], lo[4];
#pragma unroll
                for (int j = 0; j < 8; ++j) v[j] = p.router_w[(32 * ks + 8 * q + j) * NE + 16 * nt + c];
#pragma unroll
                for (int j = 0; j < 4; ++j) { hi[j] = pk2(v[2 * j], v[2 * j + 1]); lo[j] = pk2(v[2 * j] - __uint_as_float(hi[j] << 16), v[2 * j + 1] - __uint_as_float(hi[j] & 0xffff0000u)); }
                rwf[((ks * 4 + nt) * 2) * 64 + ln] = (v4u){hi[0], hi[1], hi[2], hi[3]}; rwf[((ks * 4 + nt) * 2 + 1) * 64 + ln] = (v4u){lo[0], lo[1], lo[2], lo[3]}; }
        }
        constexpr int I_GU = 16 * 16, I_D = 4 * 32;
        bf16_t* WguT = (bf16_t*)(ws + WS_WGU); bf16_t* WdT = (bf16_t*)(ws + WS_WD);
        for (int it = gw; it < (NE + 1) * (I_GU + I_D); it += NGW) {
            const int e = it / (I_GU + I_D), r = it % (I_GU + I_D);
            if (r < I_GU) { const int nb = r & 15, kb = r >> 4, up = (nb >> 2) & 1;
                const float* W = e < NE ? (up ? p.exp_w_up : p.exp_w_gate) + (size_t)e * D * ED : (up ? p.sh_w_up : p.sh_w_gate);
                transpose_item(W, ED, WguT + (size_t)e * 512 * D, D, kb * 64, nb * 32, scr, lane, [](int n) { return (n >> 8) * 128 + (n & 127); }); }
            else { const int r2 = r - I_GU, nb = r2 & 31, kb = r2 >> 5;
                const float* W = e < NE ? p.exp_w_down + (size_t)e * ED * D : p.sh_w_down;
                transpose_item(W, D, WdT + (size_t)e * D * ED, ED, kb * 64, nb * 32, scr, lane, [](int n) { return n; }); }
        }
        if (BOTH(0)) xcd_barrier(bar);
        PH_END(0);
    }

    if (IN(1)) { PH_BEGIN();
        bf16_t* hn = (bf16_t*)p.out;
        for (int m = gw; m < M; m += NGW) {
            const int b = m / SEQ; const GAS f32x4* xr = (const GAS f32x4*)(p.x + (size_t)m * D) + lane;
            f32x4 v[4]; float s = 0.f;
#pragma unroll
            for (int j = 0; j < 4; ++j) { v[j] = xr[64 * j]; s += (v[j].x * v[j].x + v[j].y * v[j].y) + (v[j].z * v[j].z + v[j].w * v[j].w); }
            const float rstd = rsqrtf(wave_sum(s) * (1.f / D) + EPS);
            GAS unsigned long long* o8 = (GAS unsigned long long*)(hn + (size_t)m * D) + lane;
#pragma unroll
            for (int j = 0; j < 4; ++j) { const int d = 4 * lane + 256 * j; const f32x4 g = *(const f32x4*)(p.norm1_g + d), sc = *(const f32x4*)(modv + b * 6 * D + D + d), sh = *(const f32x4*)(modv + b * 6 * D + d);
                const f32x4 h = v[j] * rstd * g * (sc + 1.f) + sh;
                o8[64 * j] = (unsigned long long)pk2(h.x, h.y) | ((unsigned long long)pk2(h.z, h.w) << 32); }
        }
        if (BOTH(1)) xcd_barrier(bar);
        PH_END(1);
    }

    if (IN(2)) { PH_BEGIN();
        pg8::DenseOrder S; S.init(p.out, ws + WS_WIN_T, M, NWIN, D, G, bx);
        EpiIn E{(bf16_t*)(ws + WS_ZQ), (bf16_t*)(ws + WS_XBC), (bf16_t*)(ws + WS_K), (bf16_t*)(ws + WS_V), (float*)(ws + WS_DT)};
        pg8::gemm_phase<EpiIn, pg8::DenseOrder, true, true>(lds + RING_OFF, D, S, E);
        if (BOTH(2)) xcd_barrier(bar);
        PH_END(2);
    }

    if (IN(3)) { PH_BEGIN();
        {
            typedef pg8::bf16x8 bf16x8; typedef pg8::f32x4 f4;
            bf16_t* zq = (bf16_t*)(ws + WS_ZQ); const bf16_t* kk = (const bf16_t*)(ws + WS_K); const bf16_t* vv = (const bf16_t*)(ws + WS_V); float* ssq = (float*)(ws + WS_SSQ);
            LAS unsigned char* Kl = lds + RING_OFF; LAS unsigned char* VTl = lds + RING_OFF + 27648; LAS float* biasl = (LAS float*)(lds + RING_OFF + 53248);
            __syncthreads();
            for (int i = tid; i < ATT_HEADS * 128; i += 512) { const int h = i >> 7, dist = i & 127; biasl[i] = p.rel_bias[c_bucket[dist] * ATT_HEADS + h]; }
            const int fr = lane & 15, fg = lane >> 4;
            for (int unit = bx; unit < BATCH * (SEQ / 64); unit += G) {
                const int b = unit / (SEQ / 64), qb = unit % (SEQ / 64), t0 = qb * 64, row0 = b * SEQ + t0;
                for (int kvh = 0; kvh < KV_HEADS; ++kvh) {
                    __syncthreads();
                    for (int i = tid; i < 192 * 8; i += 512) { const int j = i >> 3, ch = i & 7, kt = t0 - 128 + j;
                        v4u val = (v4u){0u, 0u, 0u, 0u}; if (kt >= 0) val = *(const v4u*)(kk + (size_t)(b * SEQ + kt) * D_KV + kvh * HD + ch * 8);
                        *(LAS v4u*)(Kl + j * 144 + ch * 16) = val; }
                    for (int i = tid; i < 96 * 8; i += 512) { const int jp = i >> 3, ch = i & 7, j = 2 * jp, kt = t0 - 128 + j;
                        v4u v0 = (v4u){0u, 0u, 0u, 0u}, v1 = v0;
                        if (kt >= 0) { const bf16_t* vp = vv + (size_t)(b * SEQ + kt) * D_KV + kvh * HD + ch * 8; v0 = *(const v4u*)vp; v1 = *(const v4u*)(vp + D_KV); }
                        const unsigned a0[4] = {v0.x, v0.y, v0.z, v0.w}, a1[4] = {v1.x, v1.y, v1.z, v1.w};
#pragma unroll
                        for (int d2 = 0; d2 < 4; ++d2) {
                            *(LAS unsigned*)(VTl + (ch * 8 + 2 * d2) * 400 + j * 2) = (a0[d2] & 0xffffu) | (a1[d2] << 16);
                            *(LAS unsigned*)(VTl + (ch * 8 + 2 * d2 + 1) * 400 + j * 2) = (a0[d2] >> 16) | (a1[d2] & 0xffff0000u); } }
                    __syncthreads();
                    const int head = kvh * 4 + (wave >> 1), rt0 = 2 * (wave & 1), jt0 = rt0;
                    const float sink = p.sinks[head]; const LAS float* bl = biasl + head * 128;
#pragma unroll 1
                    for (int r2 = 0; r2 < 2; ++r2) {
                        const int qi = 16 * (rt0 + r2) + fr;
                        bf16x8 Qf[2];
#pragma unroll
                        for (int ks = 0; ks < 2; ++ks) Qf[ks] = *(const bf16x8*)(zq + (size_t)(row0 + qi) * 2048 + 1024 + head * HD + ks * 32 + 8 * fg);
                        f4 sacc[10];
#pragma unroll
                        for (int jt = 0; jt < 10; ++jt) sacc[jt] = (f4){0.f, 0.f, 0.f, 0.f};
#pragma unroll
                        for (int jt = 0; jt < 10; ++jt)
#pragma unroll
                            for (int ks = 0; ks < 2; ++ks) { const bf16x8 Kf = *(const LAS bf16x8*)(Kl + (16 * (jt0 + jt) + fr) * 144 + (ks * 32 + 8 * fg) * 2);
                                sacc[jt] = __builtin_amdgcn_mfma_f32_16x16x32_bf16(Kf, Qf[ks], sacc[jt], 0, 0, 0); }
                        float mx = sink;
#pragma unroll
                        for (int jt = 0; jt < 10; ++jt)
#pragma unroll
                            for (int j = 0; j < 4; ++j) { const int kj = 16 * (jt0 + jt) + 4 * fg + j, dist = qi + 128 - kj; const bool ok = dist >= 0 && dist < 128 && (t0 - 128 + kj) >= 0;
                                const float s = ok ? sacc[jt][j] * 0.125f + bl[dist & 127] : -INFINITY; sacc[jt][j] = s; mx = fmaxf(mx, s); }
                        mx = fmaxf(mx, __shfl_xor(mx, 16)); mx = fmaxf(mx, __shfl_xor(mx, 32));
                        float ls = 0.f;
#pragma unroll
                        for (int jt = 0; jt < 10; ++jt)
#pragma unroll
                            for (int j = 0; j < 4; ++j) { const float pe = __expf(sacc[jt][j] - mx); sacc[jt][j] = pe; ls += pe; }
                        ls += __shfl_xor(ls, 16); ls += __shfl_xor(ls, 32); ls += __expf(sink - mx);
                        f4 o[4];
#pragma unroll
                        for (int dt = 0; dt < 4; ++dt) o[dt] = (f4){0.f, 0.f, 0.f, 0.f};
#pragma unroll
                        for (int k5 = 0; k5 < 5; ++k5) { const f4 pa = sacc[2 * k5], pb = sacc[2 * k5 + 1];
                            union { bf16x8 v; unsigned u[4]; } Pf; Pf.u[0] = pg8::cvt_pk_bf16(pa[0], pa[1]); Pf.u[1] = pg8::cvt_pk_bf16(pa[2], pa[3]); Pf.u[2] = pg8::cvt_pk_bf16(pb[0], pb[1]); Pf.u[3] = pg8::cvt_pk_bf16(pb[2], pb[3]);
#pragma unroll
                            for (int dt = 0; dt < 4; ++dt) { const LAS unsigned char* vp = VTl + (16 * dt + fr) * 400 + (16 * (jt0 + 2 * k5) + 4 * fg) * 2;
                                union { bf16x8 v; unsigned long long q[2]; } Vf; Vf.q[0] = *(const LAS unsigned long long*)vp; Vf.q[1] = *(const LAS unsigned long long*)(vp + 32);
                                o[dt] = __builtin_amdgcn_mfma_f32_16x16x32_bf16(Vf.v, Pf.v, o[dt], 0, 0, 0); } }
                        const float inv = 1.f / ls; float ss = 0.f;
                        bf16_t* op = zq + (size_t)(row0 + qi) * 2048 + 1024 + head * HD + 4 * fg;
#pragma unroll
                        for (int dt = 0; dt < 4; ++dt) { const f4 ov = o[dt] * inv; ss += (ov[0] * ov[0] + ov[1] * ov[1]) + (ov[2] * ov[2] + ov[3] * ov[3]);
                            *(unsigned long long*)(op + 16 * dt) = (unsigned long long)pg8::cvt_pk_bf16(ov[0], ov[1]) | ((unsigned long long)pg8::cvt_pk_bf16(ov[2], ov[3]) << 32); }
                        ss += __shfl_xor(ss, 16); ss += __shfl_xor(ss, 32);
                        if (fg == 0) ssq[(row0 + qi) * 16 + head] = ss;
                    }
                }
            }
            __syncthreads();
        }
        if (BOTH(3)) xcd_barrier(bar);
        PH_END(3);
    }

    if (IN(4)) { PH_BEGIN();
        typedef pg8::bf16x8 bf16x8; typedef pg8::f32x4 f4;
        const bf16_t* xbc = (const bf16_t*)(ws + WS_XBC); const float* dtr = (const float*)(ws + WS_DT); float* decg = (float*)(ws + WS_CS);
        LAS unsigned char* XT = lds + RING_OFF; LAS unsigned char* BT = lds + RING_OFF + 65536; LAS float* wl = (LAS float*)(lds + SSD_AUX_OFF);
        const int fr = lane & 15, fg = lane >> 4;
        for (int unit = bx; unit < BATCH * NCHUNK * SSM_GROUPS; unit += G) {
            const int g = unit % SSM_GROUPS, bc = unit / SSM_GROUPS, rowc = bc * CHUNK, tc = rowc % SEQ;
            __syncthreads();
            if (wave < 4) { const int h = g * 4 + wave; const float A = -__expf(p.a_log[h]), bias = p.dt_bias[h];
                const float d0 = softplus_f(dtr[(rowc + lane) * 16 + h] + bias), d1 = softplus_f(dtr[(rowc + lane + 64) * 16 + h] + bias);
                float s0 = d0 * A, s1 = d1 * A;
#pragma unroll
                for (int o = 1; o < 64; o <<= 1) { const float u0 = __shfl_up(s0, o), u1 = __shfl_up(s1, o); if (lane >= o) { s0 += u0; s1 += u1; } }
                s1 += __shfl(s0, 63); const float cl = __shfl(s1, 63);
                wl[wave * 128 + lane] = d0 * __expf(cl - s0); wl[wave * 128 + lane + 64] = d1 * __expf(cl - s1);
                if (lane == 0) decg[bc * 16 + h] = __expf(cl); }
            __syncthreads();
            for (int i = tid; i < 64 * 48; i += 512) { const int co = i % 48, lp = i / 48, l = 2 * lp;
                const int ch = co < 32 ? g * 256 + co * 8 : D_SSM + g * D_STATE + (co - 32) * 8;
                float o0[8], o1[8]; conv2x8(xbc, p.conv_w, p.conv_b, rowc + l, tc + l, ch, o0, o1);
                if (co < 32) { const float w0 = wl[(co >> 3) * 128 + l], w1 = wl[(co >> 3) * 128 + l + 1];
#pragma unroll
                    for (int j = 0; j < 8; ++j) { const int r = co * 8 + j; *(LAS unsigned*)(XT + r * 256 + (((l >> 3) ^ (r & 15)) << 4) + (l & 7) * 2) = pk2(o0[j] * w0, o1[j] * w1); } }
                else {
#pragma unroll
                    for (int j = 0; j < 8; ++j) { const int r = (co - 32) * 8 + j; *(LAS unsigned*)(BT + r * 256 + (((l >> 3) ^ (r & 15)) << 4) + (l & 7) * 2) = pk2(o0[j], o1[j]); } } }
            __syncthreads();
            bf16x8 Bf[4];
#pragma unroll
            for (int kk = 0; kk < 4; ++kk) { const int r = 16 * wave + fr; Bf[kk] = *(const LAS bf16x8*)(BT + r * 256 + (((4 * kk + fg) ^ (r & 15)) << 4)); }
#pragma unroll
            for (int r4 = 0; r4 < 4; ++r4) { const int h = g * 4 + r4; float* S = p.out + (size_t)(bc * SSM_HEADS + h) * HD * D_STATE;
#pragma unroll
                for (int pt = 0; pt < 4; ++pt) { f4 acc = (f4){0.f, 0.f, 0.f, 0.f}; const int r = r4 * 64 + 16 * pt + fr;
#pragma unroll
                    for (int kk = 0; kk < 4; ++kk) { const bf16x8 Af = *(const LAS bf16x8*)(XT + r * 256 + (((4 * kk + fg) ^ (r & 15)) << 4)); acc = __builtin_amdgcn_mfma_f32_16x16x32_bf16(Af, Bf[kk], acc, 0, 0, 0); }
#pragma unroll
                    for (int j = 0; j < 4; ++j) S[(16 * pt + 4 * fg + j) * D_STATE + 16 * wave + fr] = acc[j]; } }
        }
        if (BOTH(4)) xcd_barrier(bar);
        PH_END(4);
    }

    if (IN(5)) { PH_BEGIN();
        const float* S = p.out; const float* decg = (const float*)(ws + WS_CS); bf16_t* St = (bf16_t*)(ws + WS_ST);
        for (int i = bx * 512 + tid; i < BATCH * SSM_HEADS * HD * D_STATE / 2; i += G * 512) {
            const int pn = (i % (HD * D_STATE / 2)) * 2, bh = i / (HD * D_STATE / 2), h = bh % SSM_HEADS, b = bh / SSM_HEADS;
            float s0 = 0.f, s1 = 0.f;
#pragma unroll 4
            for (int c = 0; c < NCHUNK; ++c) { const size_t idx = ((size_t)((b * NCHUNK + c) * SSM_HEADS + h)) * HD * D_STATE + pn; const float2 sv = *(const float2*)(S + idx);
                *(unsigned*)(St + idx) = pk2(s0, s1); const float dec = decg[(b * NCHUNK + c) * 16 + h]; s0 = s0 * dec + sv.x; s1 = s1 * dec + sv.y; }
        }
        bf16_t* zq = (bf16_t*)(ws + WS_ZQ); const float* ssq = (const float*)(ws + WS_SSQ);
        for (int m = gw; m < M; m += NGW) {
            float s = lane < 16 ? ssq[m * 16 + lane] : 0.f; s = wave_sum(s); const float r = rsqrtf(s * (1.f / 1024.f) + EPS);
            bf16_t* o = zq + (size_t)m * 2048 + 1024 + lane * 16;
            v4u w0 = *(v4u*)o, w1 = *(v4u*)(o + 8); unsigned w[8] = {w0.x, w0.y, w0.z, w0.w, w1.x, w1.y, w1.z, w1.w};
#pragma unroll
            for (int j = 0; j < 8; ++j) { const int d = lane * 16 + 2 * j; w[j] = pk2(__uint_as_float(w[j] << 16) * r * p.att_norm_g[d], __uint_as_float(w[j] & 0xffff0000u) * r * p.att_norm_g[d + 1]); }
            *(v4u*)o = (v4u){w[0], w[1], w[2], w[3]}; *(v4u*)(o + 8) = (v4u){w[4], w[5], w[6], w[7]};
        }
        if (BOTH(5)) xcd_barrier(bar);
        PH_END(5);
    }

    if (IN(6)) { PH_BEGIN();
        typedef pg8::bf16x8 bf16x8; typedef pg8::f32x4 f4;
        const bf16_t* xbc = (const bf16_t*)(ws + WS_XBC); const float* dtr = (const float*)(ws + WS_DT); bf16_t* zq = (bf16_t*)(ws + WS_ZQ); const bf16_t* Stg = (const bf16_t*)(ws + WS_ST);
        LAS unsigned char* XT = lds + RING_OFF; LAS unsigned char* Bi = lds + RING_OFF + 65536; LAS unsigned char* Ci = lds + RING_OFF + 98304;
        LAS float* csl = (LAS float*)(lds + SSD_AUX_OFF); LAS float* dtl = csl + 512;
        const int fr = lane & 15, fg = lane >> 4;
        for (int unit = bx; unit < BATCH * NCHUNK * SSM_GROUPS; unit += G) {
            const int g = unit % SSM_GROUPS, bc = unit / SSM_GROUPS, rowc = bc * CHUNK, tc = rowc % SEQ;
            __syncthreads();
            if (wave < 4) { const int h = g * 4 + wave; const float A = -__expf(p.a_log[h]), bias = p.dt_bias[h];
                const float d0 = softplus_f(dtr[(rowc + lane) * 16 + h] + bias), d1 = softplus_f(dtr[(rowc + lane + 64) * 16 + h] + bias);
                float s0 = d0 * A, s1 = d1 * A;
#pragma unroll
                for (int o = 1; o < 64; o <<= 1) { const float u0 = __shfl_up(s0, o), u1 = __shfl_up(s1, o); if (lane >= o) { s0 += u0; s1 += u1; } }
                s1 += __shfl(s0, 63);
                csl[wave * 128 + lane] = s0; csl[wave * 128 + lane + 64] = s1; dtl[wave * 128 + lane] = d0; dtl[wave * 128 + lane + 64] = d1; }
            for (int i = tid; i < 64 * 64; i += 512) { const int co = i & 63, lp = i >> 6, l = 2 * lp;
                const int ch = co < 32 ? g * 256 + co * 8 : (co < 48 ? D_SSM + g * D_STATE + (co - 32) * 8 : D_SSM + SSM_GROUPS * D_STATE + g * D_STATE + (co - 48) * 8);
                float o0[8], o1[8]; conv2x8(xbc, p.conv_w, p.conv_b, rowc + l, tc + l, ch, o0, o1);
                if (co < 32) {
#pragma unroll
                    for (int j = 0; j < 8; ++j) { const int r = co * 8 + j; *(LAS unsigned*)(XT + r * 256 + (((l >> 3) ^ (r & 15)) << 4) + (l & 7) * 2) = pk2(o0[j], o1[j]); } }
                else { LAS unsigned char* img = co < 48 ? Bi : Ci; const int cc = (co - 32) & 15;
                    *(LAS v4u*)(img + l * 256 + ((cc ^ (l & 15)) << 4)) = (v4u){pk2(o0[0], o0[1]), pk2(o0[2], o0[3]), pk2(o0[4], o0[5]), pk2(o0[6], o0[7])};
                    *(LAS v4u*)(img + (l + 1) * 256 + ((cc ^ ((l + 1) & 15)) << 4)) = (v4u){pk2(o1[0], o1[1]), pk2(o1[2], o1[3]), pk2(o1[4], o1[5]), pk2(o1[6], o1[7])}; } }
            __syncthreads();
            const int lrow = 16 * wave + fr;
            bf16x8 Cf[4];
#pragma unroll
            for (int kk = 0; kk < 4; ++kk) Cf[kk] = *(const LAS bf16x8*)(Ci + lrow * 256 + (((4 * kk + fg) ^ (lrow & 15)) << 4));
            f4 Gt[8];
#pragma unroll
            for (int st = 0; st < 8; ++st) { Gt[st] = (f4){0.f, 0.f, 0.f, 0.f};
                if (st <= wave) {
#pragma unroll
                    for (int kk = 0; kk < 4; ++kk) { const int r = 16 * st + fr; const bf16x8 Bf = *(const LAS bf16x8*)(Bi + r * 256 + (((4 * kk + fg) ^ (r & 15)) << 4));
                        Gt[st] = __builtin_amdgcn_mfma_f32_16x16x32_bf16(Bf, Cf[kk], Gt[st], 0, 0, 0); } } }
            f4 Y[4][4];
#pragma unroll
            for (int r4 = 0; r4 < 4; ++r4) { const int h = g * 4 + r4; const float cl = csl[r4 * 128 + lrow];
                const bf16_t* Sth = Stg + (size_t)(bc * SSM_HEADS + h) * HD * D_STATE;
#pragma unroll
                for (int pt = 0; pt < 4; ++pt) { f4 acc = (f4){0.f, 0.f, 0.f, 0.f};
#pragma unroll
                    for (int kk = 0; kk < 4; ++kk) { const bf16x8 Sf = *(const bf16x8*)(Sth + (16 * pt + fr) * D_STATE + (4 * kk + fg) * 8); acc = __builtin_amdgcn_mfma_f32_16x16x32_bf16(Sf, Cf[kk], acc, 0, 0, 0); }
                    Y[r4][pt] = acc * __expf(cl); }
#pragma unroll
                for (int k4 = 0; k4 < 4; ++k4) { if (2 * k4 <= wave) {
                    union { bf16x8 v; unsigned u[4]; } Pf;
#pragma unroll
                    for (int hh = 0; hh < 2; ++hh) { const int st = 2 * k4 + hh; const f4 c4 = *(const LAS f4*)(csl + r4 * 128 + 16 * st + 4 * fg), d4 = *(const LAS f4*)(dtl + r4 * 128 + 16 * st + 4 * fg);
                        float mv[4];
#pragma unroll
                        for (int j = 0; j < 4; ++j) { const int s = 16 * st + 4 * fg + j; mv[j] = (s <= lrow) ? Gt[st][j] * __expf(cl - c4[j]) * d4[j] : 0.f; }
                        Pf.u[2 * hh] = pg8::cvt_pk_bf16(mv[0], mv[1]); Pf.u[2 * hh + 1] = pg8::cvt_pk_bf16(mv[2], mv[3]); }
#pragma unroll
                    for (int pt = 0; pt < 4; ++pt) { const int r = r4 * 64 + 16 * pt + fr; const int sb = 32 * k4 + 4 * fg;
                        union { bf16x8 v; unsigned long long q[2]; } Xf;
                        Xf.q[0] = *(const LAS unsigned long long*)(XT + r * 256 + ((((sb) >> 3) ^ (r & 15)) << 4) + (sb & 7) * 2);
                        Xf.q[1] = *(const LAS unsigned long long*)(XT + r * 256 + ((((sb + 16) >> 3) ^ (r & 15)) << 4) + (sb & 7) * 2);
                        Y[r4][pt] = __builtin_amdgcn_mfma_f32_16x16x32_bf16(Xf.v, Pf.v, Y[r4][pt], 0, 0, 0); } } }
                const float dsk = p.d_skip[h];
#pragma unroll
                for (int pt = 0; pt < 4; ++pt)
#pragma unroll
                    for (int j = 0; j < 4; ++j) { const int r = r4 * 64 + 16 * pt + 4 * fg + j; const bf16_t xv = *(const LAS bf16_t*)(XT + r * 256 + (((lrow >> 3) ^ (r & 15)) << 4) + (lrow & 7) * 2); Y[r4][pt][j] += dsk * bf2f(xv); }
            }
            bf16_t* zr = zq + (size_t)(rowc + lrow) * 2048 + g * 256 + 4 * fg; float ss = 0.f;
#pragma unroll
            for (int r4 = 0; r4 < 4; ++r4)
#pragma unroll
                for (int pt = 0; pt < 4; ++pt) { const unsigned long long zz = *(const unsigned long long*)(zr + r4 * 64 + 16 * pt); const unsigned z0 = (unsigned)zz, z1 = (unsigned)(zz >> 32);
                    f4 v = Y[r4][pt]; v[0] *= silu_f(__uint_as_float(z0 << 16)); v[1] *= silu_f(__uint_as_float(z0 & 0xffff0000u)); v[2] *= silu_f(__uint_as_float(z1 << 16)); v[3] *= silu_f(__uint_as_float(z1 & 0xffff0000u));
                    Y[r4][pt] = v; ss += (v[0] * v[0] + v[1] * v[1]) + (v[2] * v[2] + v[3] * v[3]); }
            ss += __shfl_xor(ss, 16); ss += __shfl_xor(ss, 32);
            const float rr = rsqrtf(ss * (1.f / 256.f) + EPS);
#pragma unroll
            for (int r4 = 0; r4 < 4; ++r4)
#pragma unroll
                for (int pt = 0; pt < 4; ++pt) { const f4 gn = *(const f4*)(p.ssm_norm_g + g * 256 + r4 * 64 + 16 * pt + 4 * fg); const f4 v = Y[r4][pt] * rr * gn;
                    *(unsigned long long*)(zr + r4 * 64 + 16 * pt) = (unsigned long long)pg8::cvt_pk_bf16(v[0], v[1]) | ((unsigned long long)pg8::cvt_pk_bf16(v[2], v[3]) << 32); }
        }
        if (BOTH(6)) xcd_barrier(bar);
        PH_END(6);
    }

    if (IN(7)) { PH_BEGIN();
        pg8::DenseOrder S; S.init(ws + WS_ZQ, ws + WS_WOUT_T, M, D, 2048, G, bx);
        EpiOut E{p.x, p.out, modv};
        pg8::gemm_phase<EpiOut, pg8::DenseOrder, true, true>(lds + RING_OFF, 2048, S, E);
        if (BOTH(7)) xcd_barrier(bar);
        PH_END(7);
    }

    if (IN(8)) { PH_BEGIN();
        typedef pg8::bf16x8 bf16x8; typedef pg8::f32x4 f4;
        LAS float* part = (LAS float*)(lds + RING_OFF);
        LAS float* red = (LAS float*)(lds + RING_OFF + 32768);
        LAS int* cnt_l = (LAS int*)(lds + RING_OFF + 33280);
        LAS int* base_l = (LAS int*)(lds + RING_OFF + 33536);
        LAS int* asg_e = (LAS int*)(lds + RING_OFF + 33792);
        LAS int* asg_pos = (LAS int*)(lds + RING_OFF + 35840);
        bf16_t* h2 = (bf16_t*)(ws + WS_H2); int* eidx = (int*)(ws + WS_EIDX); float* eg = (float*)(ws + WS_EGATE); int* cnt = (int*)(ws + WS_CTL) + CW_CNT; int* list = (int*)(ws + WS_LIST);
        const v4u* rwf = (const v4u*)(ws + WS_RWF);
        const float rbias = p.router_bias[lane];
        const int fr = lane & 15, fq = lane >> 4;
        for (int grp = bx; grp < M / 64; grp += G) {
            __syncthreads();
            if (tid < NE) cnt_l[tid] = 0;
            for (int tile = 0; tile < 4; ++tile) {
                const int m0 = grp * 64 + tile * 16, row = m0 + fr, b = m0 / SEQ;
                const float* xr = p.out + (size_t)row * D + 128 * wave + 8 * fq;
                f4 xv[4][2]; float ss = 0.f;
#pragma unroll
                for (int kk = 0; kk < 4; ++kk) { xv[kk][0] = *(const f4*)(xr + 32 * kk); xv[kk][1] = *(const f4*)(xr + 32 * kk + 4);
                    ss += (xv[kk][0][0] * xv[kk][0][0] + xv[kk][0][1] * xv[kk][0][1]) + (xv[kk][0][2] * xv[kk][0][2] + xv[kk][0][3] * xv[kk][0][3]);
                    ss += (xv[kk][1][0] * xv[kk][1][0] + xv[kk][1][1] * xv[kk][1][1]) + (xv[kk][1][2] * xv[kk][1][2] + xv[kk][1][3] * xv[kk][1][3]); }
                ss += __shfl_xor(ss, 16); ss += __shfl_xor(ss, 32);
                if (fq == 0) red[wave * 16 + fr] = ss;
                __syncthreads();
                float tot = 0.f;
#pragma unroll
                for (int w2 = 0; w2 < 8; ++w2) tot += red[w2 * 16 + fr];
                const float rstd = rsqrtf(tot * (1.f / D) + EPS);
                f4 acc[4];
#pragma unroll
                for (int nt = 0; nt < 4; ++nt) acc[nt] = (f4){0.f, 0.f, 0.f, 0.f};
#pragma unroll
                for (int kk = 0; kk < 4; ++kk) { const int d = 128 * wave + 32 * kk + 8 * fq;
                    union { bf16x8 v; unsigned u[4]; v4u q; } Hh, Hl;
#pragma unroll
                    for (int hf = 0; hf < 2; ++hf) { const f4 g = *(const f4*)(p.norm2_g + d + 4 * hf), sc = *(const f4*)(modv + b * 6 * D + 4 * D + d + 4 * hf), sh = *(const f4*)(modv + b * 6 * D + 3 * D + d + 4 * hf);
                        const f4 h = xv[kk][hf] * rstd * g * (sc + 1.f) + sh;
                        const unsigned h01 = pk2(h[0], h[1]), h23 = pk2(h[2], h[3]);
                        Hh.u[2 * hf] = h01; Hh.u[2 * hf + 1] = h23;
                        Hl.u[2 * hf] = pk2(h[0] - __uint_as_float(h01 << 16), h[1] - __uint_as_float(h01 & 0xffff0000u)); Hl.u[2 * hf + 1] = pk2(h[2] - __uint_as_float(h23 << 16), h[3] - __uint_as_float(h23 & 0xffff0000u)); }
                    *(v4u*)(h2 + (size_t)row * D + d) = Hh.q;
#pragma unroll
                    for (int nt = 0; nt < 4; ++nt) { const int fi = (((4 * wave + kk) * 4 + nt) * 2) * 64 + lane;
                        union { bf16x8 v; v4u q; } Rh, Rl; Rh.q = rwf[fi]; Rl.q = rwf[fi + 64];
                        acc[nt] = __builtin_amdgcn_mfma_f32_16x16x32_bf16(Hh.v, Rh.v, acc[nt], 0, 0, 0);
                        acc[nt] = __builtin_amdgcn_mfma_f32_16x16x32_bf16(Hh.v, Rl.v, acc[nt], 0, 0, 0);
                        acc[nt] = __builtin_amdgcn_mfma_f32_16x16x32_bf16(Hl.v, Rh.v, acc[nt], 0, 0, 0); } }
#pragma unroll
                for (int nt = 0; nt < 4; ++nt)
#pragma unroll
                    for (int j = 0; j < 4; ++j) part[(wave * 16 + 4 * fq + j) * 64 + 16 * nt + fr] = acc[nt][j];
                __syncthreads();
#pragma unroll
                for (int rr = 0; rr < 2; ++rr) { const int lr = 2 * wave + rr, m = m0 + lr;
                    float lg = 0.f;
#pragma unroll
                    for (int w2 = 0; w2 < 8; ++w2) lg += part[(w2 * 16 + lr) * 64 + lane];
                    const float sc = 1.f / (1.f + __expf(-lg)), sel = sc + rbias;
                    float m1 = sel, m2 = -INFINITY;
#pragma unroll
                    for (int o = 1; o < 8; o <<= 1) { const float p1 = __shfl_xor(m1, o), p2 = __shfl_xor(m2, o); const float n1 = fmaxf(m1, p1), n2 = fmaxf(fminf(m1, p1), fmaxf(m2, p2)); m1 = n1; m2 = n2; }
                    const float gs = m1 + m2; const int myg = lane >> 3;
                    int grank = 0;
#pragma unroll
                    for (int g2 = 0; g2 < 8; ++g2) { const float og = __shfl(gs, g2 * 8); grank += (og > gs || (og == gs && g2 < myg)) ? 1 : 0; }
                    const bool allowed = grank < 4; const float val = allowed ? sel : -INFINITY;
                    int rank = 0;
#pragma unroll
                    for (int e2 = 0; e2 < NE; ++e2) { const float ov = __shfl(val, e2); rank += (ov > val || (ov == val && e2 < lane)) ? 1 : 0; }
                    const bool selb = allowed && rank < TOPK;
                    const float wsum = wave_sum(selb ? sc : 0.f);
                    if (selb) { const int a = m * 8 + rank; eidx[a] = lane; eg[a] = sc / wsum * 2.5f; const int pl = __hip_atomic_fetch_add(cnt_l + lane, 1, __ATOMIC_RELAXED, __HIP_MEMORY_SCOPE_WORKGROUP); const int i = (tile * 16 + lr) * 8 + rank; asg_e[i] = lane; asg_pos[i] = pl; }
                }
            }
            __syncthreads();
            if (tid < NE) { const int c = cnt_l[tid]; base_l[tid] = c > 0 ? atomicAdd(&cnt[tid], c) : 0; }
            __syncthreads();
            { const int e = asg_e[tid]; list[(size_t)e * M + base_l[e] + asg_pos[tid]] = (grp * 64 + (tid >> 3)) * 8 + (tid & 7); }
        }
        if (BOTH(8)) xcd_barrier(bar);
        PH_END(8);
    }

    LAS int* plan = (LAS int*)(lds + PLAN_OFF);
#define MAKE_PLAN() do { __syncthreads(); if (tid == 0) { const int* cnt = (const int*)(ws + WS_CTL) + CW_CNT; int off = 0; \
        for (int e = 0; e <= NE; ++e) { const int c = e < NE ? __hip_atomic_load(cnt + e, RLX_AGENT) : M; plan[e] = off; plan[80 + e] = c; off += (c + 255) >> 8; } plan[NE + 1] = off; } __syncthreads(); } while (0)
    if (IN(9)) { PH_BEGIN();
        MAKE_PLAN();
        GroupedOrder<true> S; S.init(ws + WS_H2, ws + WS_WGU, D, 2, G, bx, plan, (const int*)(ws + WS_LIST), (size_t)512 * D * 2, (size_t)256 * D * 2, 0);
        EpiGU E{(bf16_t*)(ws + WS_U)};
        pg8::gemm_phase<EpiGU, GroupedOrder<true>, true, true>(lds + RING_OFF, D, S, E);
        if (BOTH(9)) xcd_barrier(bar);
        PH_END(9);
    }
#define DOWN_PHASE(k, half) if (IN(k)) { PH_BEGIN(); MAKE_PLAN(); \
        GroupedOrder<false> S; S.init(ws + WS_U, ws + WS_WD, ED, 2, G, bx, plan, (const int*)(ws + WS_LIST), (size_t)D * ED * 2, (size_t)256 * ED * 2, 2 * (half)); \
        EpiDown E{(bf16_t*)(ws + WS_YC), (const int*)(ws + WS_LIST), (const float*)(ws + WS_EGATE)}; \
        pg8::gemm_phase<EpiDown, GroupedOrder<false>, true, true>(lds + RING_OFF, ED, S, E); \
        if (BOTH(k)) xcd_barrier(bar); PH_END(k); }
    DOWN_PHASE(10, 0)
    if (IN(11)) { PH_BEGIN();
        const bf16_t* yc = (const bf16_t*)(ws + WS_YC);
        for (int i = bx * 512 + tid; i < M * 64; i += G * 512) { const int tok = i >> 6, c8 = (i & 63) * 8, b = tok / SEQ;
            float s[8] = {0.f, 0.f, 0.f, 0.f, 0.f, 0.f, 0.f, 0.f};
#pragma unroll
            for (int k = 0; k < NSLOT; ++k) { const v4u raw = *(const v4u*)(yc + ((size_t)tok * NSLOT + k) * 512 + c8); const unsigned w4[4] = {raw.x, raw.y, raw.z, raw.w};
#pragma unroll
                for (int j = 0; j < 4; ++j) { s[2 * j] += __uint_as_float(w4[j] << 16); s[2 * j + 1] += __uint_as_float(w4[j] & 0xffff0000u); } }
            float* xo = p.out + (size_t)tok * D + c8; const float* g2 = modv + b * 6 * D + 5 * D + c8;
            f32x4 x0 = *(f32x4*)xo, x1v = *(f32x4*)(xo + 4);
            x0 = x0 + *(const f32x4*)g2 * (f32x4){s[0], s[1], s[2], s[3]}; x1v = x1v + *(const f32x4*)(g2 + 4) * (f32x4){s[4], s[5], s[6], s[7]};
            *(f32x4*)xo = x0; *(f32x4*)(xo + 4) = x1v; }
        if (BOTH(11)) xcd_barrier(bar);
        PH_END(11);
    }
    DOWN_PHASE(12, 1)
    if (IN(13)) { PH_BEGIN();
        const bf16_t* yc = (const bf16_t*)(ws + WS_YC);
        for (int m = gw; m < M; m += NGW) { const int b = m / SEQ, c8 = lane * 8;
            float s[8] = {0.f, 0.f, 0.f, 0.f, 0.f, 0.f, 0.f, 0.f};
#pragma unroll
            for (int k = 0; k < NSLOT; ++k) { const v4u raw = *(const v4u*)(yc + ((size_t)m * NSLOT + k) * 512 + c8); const unsigned w4[4] = {raw.x, raw.y, raw.z, raw.w};
#pragma unroll
                for (int j = 0; j < 4; ++j) { s[2 * j] += __uint_as_float(w4[j] << 16); s[2 * j + 1] += __uint_as_float(w4[j] & 0xffff0000u); } }
            float* xo = p.out + (size_t)m * D; const float* g2 = modv + b * 6 * D + 5 * D + 512 + c8;
            f32x4 a0 = *(f32x4*)(xo + c8), a1 = *(f32x4*)(xo + c8 + 4), b0 = *(f32x4*)(xo + 512 + c8), b1 = *(f32x4*)(xo + 512 + c8 + 4);
            b0 = b0 + *(const f32x4*)g2 * (f32x4){s[0], s[1], s[2], s[3]}; b1 = b1 + *(const f32x4*)(g2 + 4) * (f32x4){s[4], s[5], s[6], s[7]};
            float ss = (a0.x * a0.x + a0.y * a0.y) + (a0.z * a0.z + a0.w * a0.w) + (a1.x * a1.x + a1.y * a1.y) + (a1.z * a1.z + a1.w * a1.w)
                     + (b0.x * b0.x + b0.y * b0.y) + (b0.z * b0.z + b0.w * b0.w) + (b1.x * b1.x + b1.y * b1.y) + (b1.z * b1.z + b1.w * b1.w);
            const float rstd = rsqrtf(wave_sum(ss) * (1.f / D) + EPS);
            const float* fg = p.final_g;
            *(f32x4*)(xo + c8) = a0 * rstd * *(const f32x4*)(fg + c8); *(f32x4*)(xo + c8 + 4) = a1 * rstd * *(const f32x4*)(fg + c8 + 4);
            *(f32x4*)(xo + 512 + c8) = b0 * rstd * *(const f32x4*)(fg + 512 + c8); *(f32x4*)(xo + 512 + c8 + 4) = b1 * rstd * *(const f32x4*)(fg + 512 + c8 + 4); }
        PH_END(13);
    }
#undef IN
#undef BOTH
}

extern "C" void kernel_launch(void* const* d_in, const int* in_sizes, int n_in, void* d_out, int out_size, void* d_ws, size_t ws_size, hipStream_t stream) {
    static int grid = 0;
    if (grid == 0) {
        int dev = 0, cus = 0;
        if (hipGetDevice(&dev) != hipSuccess || hipDeviceGetAttribute(&cus, hipDeviceAttributeMultiprocessorCount, dev) != hipSuccess) { fprintf(stderr, "device query failed\n"); grid = -1; return; }
        if (hipFuncSetAttribute((const void*)mega, hipFuncAttributeMaxDynamicSharedMemorySize, LDS_BYTES) != hipSuccess) { fprintf(stderr, "hipFuncSetAttribute failed\n"); grid = -1; return; }
        int per_cu = 0;
        if (hipOccupancyMaxActiveBlocksPerMultiprocessor(&per_cu, (const void*)mega, NWAVES * 64, LDS_BYTES) != hipSuccess || per_cu < 1) fprintf(stderr, "occupancy query: %d\n", per_cu);
        (void)hipGetLastError();
        grid = cus;
        if (ws_size < WS_END) fprintf(stderr, "ws too small: %zu < %zu\n", ws_size, (size_t)WS_END);
    }
    if (grid < 0) return;
    P p{};
    const float** f = (const float**)&p;
    for (int i = 0; i < 26; ++i) f[i] = (const float*)d_in[i];
    p.out = (float*)d_out; p.ws = (unsigned char*)d_ws;
    (void)hipMemsetAsync(p.ws + WS_CTL, 0, CTL_BYTES, stream);
    p.ph_lo = 0; p.ph_hi = NPHASE; p.li = 0;
    hipLaunchKernelGGL(mega, dim3(grid), dim3(NWAVES * 64), LDS_BYTES, stream, p);
}
```

```cpp
#include <hip/hip_runtime.h>
#include <stdint.h>
#include <stdio.h>

typedef unsigned short bf16_t;

constexpr int D = 1024, BATCH = 4, SEQ = 4096, M = BATCH * SEQ;
constexpr int D_SSM = 1024, SSM_HEADS = 16, SSM_GROUPS = 4, D_STATE = 128, CONV_K = 4, CONV_CH = 2048, CHUNK = 128, NCHUNK = SEQ / CHUNK;
constexpr int HD = 64, ATT_HEADS = 16, KV_HEADS = 4, D_KV = 256, WINDOW = 128;
constexpr int IN_COLS = 4624;
constexpr int C_Z = 0, C_XBC = 1024, C_DT = 3072, C_Q = 3088, C_K = 4112, C_V = 4368;
constexpr int NE = 64, TOPK = 8, ED = 256;
constexpr float EPS = 1e-6f;
constexpr int NSLOT = 9;
constexpr int NWIN = 4864;

constexpr size_t MiB = 1u << 20;
constexpr size_t WS_CTL = 0;
constexpr size_t CTL_BYTES = 64 * 1024;
constexpr int CW_CNT = 0;
constexpr int CW_BAR = 4096;
constexpr size_t WS_MOD = 1 * MiB;
constexpr size_t WS_RWF = 1 * MiB + 256 * 1024;
constexpr size_t WS_EIDX = 2 * MiB;
constexpr size_t WS_EGATE = 3 * MiB;
constexpr size_t WS_LIST = 4 * MiB;
constexpr size_t WS_WIN_T = 8 * MiB;
constexpr size_t WS_WOUT_T = 18 * MiB;
constexpr size_t WS_SSQ = 22 * MiB;
constexpr size_t WS_ZQ = 24 * MiB;
constexpr size_t WS_XBC = 88 * MiB;
constexpr size_t WS_K = 152 * MiB;
constexpr size_t WS_V = 160 * MiB;
constexpr size_t WS_DT = 168 * MiB;
constexpr size_t WS_CS = 169 * MiB;
constexpr size_t WS_ST = 170 * MiB;
constexpr size_t WS_H2 = 170 * MiB;
constexpr size_t WS_WGU = 202 * MiB;
constexpr size_t WS_YC = 104 * MiB;
constexpr size_t WS_U = 24 * MiB;
constexpr size_t WS_WD = 267 * MiB;
constexpr size_t WS_GLIST = 300 * MiB;
constexpr size_t WS_END = 304 * MiB;
constexpr int UROWS_MAX = 163840;

__device__ __forceinline__ float bf2f(bf16_t v) { return __uint_as_float(((unsigned)v) << 16); }
__device__ __forceinline__ bf16_t f2bf(float f) { unsigned u = __float_as_uint(f); return (bf16_t)((u + 0x7fffu + ((u >> 16) & 1u)) >> 16); }
__device__ __forceinline__ unsigned pk2(float lo, float hi) { return (unsigned)f2bf(lo) | ((unsigned)f2bf(hi) << 16); }
__device__ __forceinline__ float silu_f(float x) { return x * __builtin_amdgcn_rcpf(1.f + __expf(-x)); }
__device__ __forceinline__ float softplus_f(float x) { return x > 20.f ? x : log1pf(__expf(x)); }

__constant__ int c_bucket[128] = {0, 1, 2, 3, 4, 5, 6, 7, 8, 9, 10, 11, 12, 13, 14, 15, 16, 16, 16, 17, 17, 18, 18, 18, 19, 19, 19, 20, 20, 20, 20, 21, 21, 21, 21, 22, 22, 22, 22, 22, 23, 23, 23, 23, 23, 23, 24, 24, 24, 24, 24, 24, 25, 25, 25, 25, 25, 25, 25, 26, 26, 26, 26, 26, 26, 26, 26, 27, 27, 27, 27, 27, 27, 27, 27, 27, 27, 28, 28, 28, 28, 28, 28, 28, 28, 28, 28, 29, 29, 29, 29, 29, 29, 29, 29, 29, 29, 29, 29, 30, 30, 30, 30, 30, 30, 30, 30, 30, 30, 30, 30, 30, 30, 31, 31, 31, 31, 31, 31, 31, 31, 31, 31, 31, 31, 31, 31, 31};

struct P {
    const float *x, *c, *mod_w, *mod_b, *norm1_g, *norm2_g, *w_in, *conv_w, *conv_b, *dt_bias, *a_log, *d_skip, *ssm_norm_g, *att_norm_g, *sinks, *rel_bias,
        *w_out, *router_w, *router_bias, *exp_w_gate, *exp_w_up, *exp_w_down, *sh_w_gate, *sh_w_up, *sh_w_down, *final_g;
    float* out; unsigned char* ws;
    int ph_lo, ph_hi, li, pad;
};

namespace pg8 {
#define PG8_LAS __attribute__((address_space(3)))
typedef short bf16x8 __attribute__((ext_vector_type(8)));
typedef float f32x4 __attribute__((ext_vector_type(4)));
typedef unsigned u32x4 __attribute__((ext_vector_type(4)));
constexpr int BM = 256, BK = 64, HALF = 128, HTB = HALF * BK * 2  , STAGE_BYTES = 8 * HTB, NXCD = 8, WGM = 8;

__host__ __device__ __forceinline__ int lds_byte(int r, int c) { const int st = (r >> 4) * 2 + (c >> 5), rr = r & 15, cc = c & 31, ob = rr * 64 + cc * 2; return st * 1024 + (ob ^ (((ob >> 9) & 1) << 5)); }
__host__ __device__ __forceinline__ void stage_rc(int b, int& R, int& C) { const int st = b / 1024, sb = b % 1024, swz = sb ^ (((sb >> 9) & 1) << 5); R = (st >> 1) * 16 + swz / 64; C = (st & 1) * 32 + (swz % 64) / 2; }
__host__ __device__ __forceinline__ int perm32(int rho) { const int n = rho >> 4, i = rho & 15; return 8 * (i >> 2) + 4 * n + (i & 3); }

struct Unit { int pm, pn, e, nrows, lt; };

__device__ __forceinline__ unsigned cvt_pk_bf16(float lo, float hi) { unsigned r; asm volatile("v_cvt_pk_bf16_f32 %0, %1, %2" : "=v"(r) : "v"(lo), "v"(hi)); return r; }

struct DenseOrder {
    typedef pg8::Unit Unit;
    const char* A; const char* Bt; int K; int nM, nN, nwg, G, c;
    __device__ __forceinline__ void init(const void* A_, const void* Bt_, int M_, int N_, int K_, int G_, int c_) { A = (const char*)A_; Bt = (const char*)Bt_; K = K_; nM = M_ / BM; nN = N_ / BM; nwg = nM * nN; G = G_; c = c_; }
    __device__ __forceinline__ bool next(int i, Unit& u) const {
        const long L = (long)i * G + c; if (L >= nwg) return false;
        int wgid = (int)L; { const int q = nwg / NXCD, r = nwg % NXCD, xcd = wgid % NXCD, off = wgid / NXCD; wgid = (xcd < r ? xcd * (q + 1) : r * (q + 1) + (xcd - r) * q) + off; }
        const int nig = WGM * nN, gid = wgid / nig, fm = gid * WGM, gsz = (nM - fm) < WGM ? (nM - fm) : WGM;
        u.pm = fm + ((wgid % nig) % gsz); u.pn = (wgid % nig) / gsz; u.e = 0; u.nrows = 256; u.lt = 0; return true;
    }
    __device__ __forceinline__ const char* a_base(const Unit& u) const { return A + (size_t)u.pm * 512 * K; }
    __device__ __forceinline__ const char* b_base(const Unit& u) const { return Bt + (size_t)u.pn * 512 * K; }
    __device__ __forceinline__ void lane_off(const Unit&, const int (&R)[2], const int (&C)[2], unsigned (&o)[2][2]) const {
#pragma unroll
        for (int h = 0; h < 2; ++h)
#pragma unroll
            for (int i = 0; i < 2; ++i) o[h][i] = (unsigned)(((h * HALF + R[i]) * K + C[i]) * 2);
    }
    __device__ __forceinline__ void a_ready(const Unit&) const {}
    __device__ __forceinline__ void done(const Unit&) const {}
};

template <class Epi, class Sched, bool ALIGN_EPI = false, bool SP2 = false>
__device__ __forceinline__ void gemm_phase(PG8_LAS unsigned char* lds, const int K, const Sched& S, const Epi& E) {
    typedef typename Sched::Unit Unit;
    const int tid = threadIdx.x, wid = __builtin_amdgcn_readfirstlane(tid >> 6), lane = tid & 63, wr = wid >> 2, wc = wid & 3, fr = lane & 15, fq = lane >> 4;
    const int nt = K / BK;
    unsigned voffB[2]; int stR[2], stC[2];
#pragma unroll
    for (int i = 0; i < 2; ++i) { int R, C; stage_rc(tid * 16 + i * 8192, R, C); const int Rb = Epi::PERM ? ((R & ~31) + perm32(R & 31)) : R;
        stR[i] = R; stC[i] = C; voffB[i] = (unsigned)(Rb * K + C) * 2u; }
    const size_t kstep = (size_t)(BK * 2);
    const size_t hstep = (size_t)HALF * K * 2;
    const size_t tstep = 2 * hstep;
    const unsigned ldsw = (unsigned)wid * 1024u;
    const int aoff = lds_byte(wr * 64 + fr, fq * 8), boff = lds_byte(wc * 32 + fr, fq * 8);
#define PG8_SA(b, h) (((b) * 2 + (h)) * HTB)
#define PG8_SB(b, h) ((4 + (b) * 2 + (h)) * HTB)
#define PG8_STAGE(bufoff, gbase, voff) do { _Pragma("unroll") for (int _i = 0; _i < 2; ++_i) \
        __builtin_amdgcn_global_load_lds((const unsigned*)((const char*)(gbase) + (voff)[_i]), (PG8_LAS unsigned*)(lds + (bufoff) + ldsw + _i * 8192), 16, 0, 0); } while (0)
#define PG8_LDA(dst, b, h) do { _Pragma("unroll") for (int m = 0; m < 4; ++m) _Pragma("unroll") for (int k = 0; k < 2; ++k) dst[m][k] = *(const PG8_LAS bf16x8*)(lds + PG8_SA(b, h) + aoff + m * 2048 + k * 1024); } while (0)
#define PG8_LDB(dst, b, h) do { _Pragma("unroll") for (int n = 0; n < 2; ++n) _Pragma("unroll") for (int k = 0; k < 2; ++k) dst[n][k] = *(const PG8_LAS bf16x8*)(lds + PG8_SB(b, h) + boff + n * 2048 + k * 1024); } while (0)
#define PG8_MMA(ai, bj, At, Bt) do { __builtin_amdgcn_s_setprio(1); _Pragma("unroll") for (int m = 0; m < 4; ++m) _Pragma("unroll") for (int n = 0; n < 2; ++n) _Pragma("unroll") for (int k = 0; k < 2; ++k) \
        acc[ai][bj][m][n] = __builtin_amdgcn_mfma_f32_16x16x32_bf16(Bt[n][k], At[m][k], acc[ai][bj][m][n], 0, 0, 0); __builtin_amdgcn_s_setprio(0); } while (0)
#define PG8_WAIT_V(n) asm volatile("s_waitcnt vmcnt(" #n ")" ::: "memory")
#define PG8_WAIT_L(n) asm volatile("s_waitcnt lgkmcnt(" #n ")" ::: "memory")
#define PG8_BAR __builtin_amdgcn_s_barrier()
#define PG8_SCHED __builtin_amdgcn_sched_barrier(0)
    Unit cur, nxt; int ui = 0;
    if (!S.next(0, cur)) return;
    f32x4 acc[2][2][4][2];
#pragma unroll
    for (int a = 0; a < 2; ++a)
#pragma unroll
        for (int b = 0; b < 2; ++b)
#pragma unroll
            for (int m = 0; m < 4; ++m)
#pragma unroll
                for (int n = 0; n < 2; ++n) acc[a][b][m][n] = (f32x4){0.f, 0.f, 0.f, 0.f};
    bf16x8 At[4][2], B0[2][2], B1[2][2];
    const char* cA = S.a_base(cur); const char* cB = S.b_base(cur);
    unsigned oc[2][2], on[2][2];
    S.lane_off(cur, stR, stC, oc);
    S.a_ready(cur);
    if constexpr (SP2) {
        PG8_STAGE(PG8_SB(0, 0), cB, voffB); PG8_STAGE(PG8_SB(0, 1), cB + hstep, voffB); PG8_STAGE(PG8_SA(0, 0), cA, oc[0]); PG8_STAGE(PG8_SA(0, 1), cA, oc[1]);
        if (wr == 1) PG8_BAR;
        PG8_WAIT_V(2); PG8_BAR;
        PG8_STAGE(PG8_SB(1, 0), cB + kstep, voffB); PG8_STAGE(PG8_SA(1, 0), cA + kstep, oc[0]); PG8_STAGE(PG8_SB(1, 1), cB + hstep + kstep, voffB);
        PG8_WAIT_V(6); PG8_BAR;
    } else {
        PG8_STAGE(PG8_SB(0, 0), cB, voffB); PG8_STAGE(PG8_SA(0, 0), cA, oc[0]); PG8_STAGE(PG8_SB(0, 1), cB + hstep, voffB); PG8_STAGE(PG8_SA(0, 1), cA, oc[1]);
        if (wr == 1) PG8_BAR;
        PG8_WAIT_V(4); PG8_BAR;
        PG8_STAGE(PG8_SB(1, 0), cB + kstep, voffB); PG8_STAGE(PG8_SA(1, 0), cA + kstep, oc[0]); PG8_STAGE(PG8_SB(1, 1), cB + hstep + kstep, voffB);
        PG8_WAIT_V(6); PG8_BAR;
    }
    for (;;) {
        const bool has_next = S.next(ui + 1, nxt);
        const char* nA = has_next ? S.a_base(nxt) : cA; const char* nB = has_next ? S.b_base(nxt) : cB;
        if (has_next) S.lane_off(nxt, stR, stC, on); else {
#pragma unroll
            for (int h = 0; h < 2; ++h)
#pragma unroll
                for (int i = 0; i < 2; ++i) on[h][i] = oc[h][i]; }
#pragma unroll 1
        for (int t = 0; t < nt; t += 2) {
            const bool last = (t == nt - 2);
            const char* a1 = cA + (size_t)(t + 1) * kstep;
            const char* a2 = last ? nA : cA + (size_t)(t + 2) * kstep; const char* b2 = last ? nB : cB + (size_t)(t + 2) * kstep;
            const char* a3 = a2 + kstep; const char* b3 = b2 + kstep;
            unsigned o2[2][2];
#pragma unroll
            for (int h = 0; h < 2; ++h)
#pragma unroll
                for (int i = 0; i < 2; ++i) o2[h][i] = last ? on[h][i] : oc[h][i];
            if (last && has_next) S.a_ready(nxt);
            if constexpr (SP2) {
            PG8_LDB(B0, 0, 0); PG8_LDB(B1, 0, 1); PG8_SCHED; PG8_LDA(At, 0, 0); PG8_STAGE(PG8_SA(1, 1), a1, oc[1]);
            PG8_WAIT_V(8); PG8_WAIT_L(0); PG8_BAR; PG8_MMA(0, 0, At, B0); PG8_MMA(0, 1, At, B1); PG8_BAR; PG8_SCHED;
            PG8_LDA(At, 0, 1); PG8_STAGE(PG8_SB(0, 0), b2, voffB); PG8_STAGE(PG8_SB(0, 1), b2 + hstep, voffB); PG8_STAGE(PG8_SA(0, 0), a2, o2[0]);
            PG8_WAIT_V(8); PG8_WAIT_L(0); PG8_BAR; PG8_MMA(1, 0, At, B0); PG8_MMA(1, 1, At, B1); PG8_BAR; PG8_SCHED;
            PG8_LDB(B0, 1, 0); PG8_LDB(B1, 1, 1); PG8_SCHED; PG8_LDA(At, 1, 0); PG8_STAGE(PG8_SA(0, 1), a2, o2[1]);
            PG8_WAIT_V(8); PG8_WAIT_L(0); PG8_BAR; PG8_MMA(0, 0, At, B0); PG8_MMA(0, 1, At, B1); PG8_BAR; PG8_SCHED;
            PG8_LDA(At, 1, 1); PG8_STAGE(PG8_SB(1, 0), b3, voffB); PG8_STAGE(PG8_SB(1, 1), b3 + hstep, voffB); PG8_STAGE(PG8_SA(1, 0), a3, o2[0]);
            PG8_WAIT_V(8); PG8_WAIT_L(0); PG8_BAR; PG8_MMA(1, 0, At, B0); PG8_MMA(1, 1, At, B1); PG8_BAR; PG8_SCHED;
            } else {
            PG8_LDB(B0, 0, 0); PG8_SCHED; PG8_LDA(At, 0, 0); PG8_STAGE(PG8_SA(1, 1), a1, oc[1]);
            PG8_WAIT_L(8); PG8_BAR; PG8_WAIT_L(0); PG8_MMA(0, 0, At, B0); PG8_BAR; PG8_SCHED;
            PG8_LDB(B1, 0, 1); PG8_STAGE(PG8_SB(0, 0), b2, voffB);
            PG8_BAR; PG8_WAIT_L(0); PG8_MMA(0, 1, At, B1); PG8_BAR;
            PG8_LDA(At, 0, 1); PG8_STAGE(PG8_SA(0, 0), a2, o2[0]);
            PG8_BAR; PG8_WAIT_L(0); PG8_MMA(1, 0, At, B0); PG8_BAR; PG8_SCHED;
            PG8_STAGE(PG8_SB(0, 1), b2 + hstep, voffB);
            PG8_WAIT_V(6); PG8_BAR; PG8_MMA(1, 1, At, B1); PG8_BAR;
            PG8_LDB(B0, 1, 0); PG8_SCHED; PG8_LDA(At, 1, 0); PG8_STAGE(PG8_SA(0, 1), a2, o2[1]);
            PG8_WAIT_L(8); PG8_BAR; PG8_WAIT_L(0); PG8_MMA(0, 0, At, B0); PG8_BAR; PG8_SCHED;
            PG8_LDB(B1, 1, 1); PG8_STAGE(PG8_SB(1, 0), b3, voffB);
            PG8_BAR; PG8_WAIT_L(0); PG8_MMA(0, 1, At, B1); PG8_BAR;
            PG8_LDA(At, 1, 1); PG8_STAGE(PG8_SA(1, 0), a3, o2[0]);
            PG8_BAR; PG8_WAIT_L(0); PG8_MMA(1, 0, At, B0); PG8_BAR; PG8_SCHED;
            PG8_STAGE(PG8_SB(1, 1), b3 + hstep, voffB);
            PG8_WAIT_V(6); PG8_BAR; PG8_MMA(1, 1, At, B1); PG8_BAR;
            }
        }
        if constexpr (ALIGN_EPI) { if (wr == 0) PG8_BAR; }
        if constexpr (!Epi::AFTER_DRAIN) { E(acc, cur, wr, wc, fr, fq); S.done(cur); }
        if (!has_next) break;
#pragma unroll
        for (int a = 0; a < 2; ++a)
#pragma unroll
            for (int b = 0; b < 2; ++b)
#pragma unroll
                for (int m = 0; m < 4; ++m)
#pragma unroll
                    for (int n = 0; n < 2; ++n) acc[a][b][m][n] = (f32x4){0.f, 0.f, 0.f, 0.f};
        cur = nxt; cA = nA; cB = nB; ++ui;
#pragma unroll
        for (int h = 0; h < 2; ++h)
#pragma unroll
            for (int i = 0; i < 2; ++i) oc[h][i] = on[h][i];
        if constexpr (ALIGN_EPI) { if (wr == 1) PG8_BAR; }
    }
    PG8_WAIT_V(0);
    if constexpr (!ALIGN_EPI) { if (wr == 0) PG8_BAR; }
    PG8_BAR;
    if constexpr (Epi::AFTER_DRAIN) { E.fused(acc, cur, wr, wc, fr, fq, lds, wid, lane); S.done(cur); }
#undef PG8_SA
#undef PG8_SB
#undef PG8_STAGE
#undef PG8_LDA
#undef PG8_LDB
#undef PG8_MMA
#undef PG8_WAIT_V
#undef PG8_WAIT_L
#undef PG8_BAR
#undef PG8_SCHED
}
}

#define GAS __attribute__((address_space(1)))
#define LAS __attribute__((address_space(3)))
typedef unsigned v4u __attribute__((ext_vector_type(4)));
typedef float f32x4 __attribute__((ext_vector_type(4)));
typedef GAS unsigned gu32;
#define RLX_AGENT __ATOMIC_RELAXED, __HIP_MEMORY_SCOPE_AGENT
#define LDS_WAIT() asm volatile("s_waitcnt lgkmcnt(0)" ::: "memory")
#define VM_WAIT() asm volatile("s_waitcnt vmcnt(0)" ::: "memory")
constexpr int NWAVES = 8;
constexpr int RING_OFF = 0, RING_BYTES = 131072;
constexpr int LDS_BYTES = 163840;
constexpr int LDSCTL_OFF = LDS_BYTES - 4096, MISC_OFF = LDSCTL_OFF + 320;
constexpr int PLAN_OFF = LDSCTL_OFF + 1024;

#define XB_TMO      128
#define XB_XCNT(j)  (256  + 64 * (j))
#define XB_XSUB(j)  (1280 + 64 * (j))
#define XB_XGEN(j)  (2304 + 64 * (j))
#define XB_TOP      3328
#define XB_TOPGEN   3392
#define XCD_BAR_WORDS 3456
#define XB_SPIN_CAP (1u << 18)

__device__ __forceinline__ unsigned xb_ld(unsigned* p)              { return __hip_atomic_load(p, __ATOMIC_RELAXED, __HIP_MEMORY_SCOPE_AGENT); }
__device__ __forceinline__ unsigned xb_add(unsigned* p, unsigned v) { return __hip_atomic_fetch_add(p, v, __ATOMIC_RELAXED, __HIP_MEMORY_SCOPE_AGENT); }
__device__ __forceinline__ unsigned xb_xcc_id() { return (unsigned)__builtin_amdgcn_s_getreg((3 << 11) | 20) & 0xFu; }
#define XB_SPIN(cond, bar) do { unsigned _sp = 0; while (cond) { __builtin_amdgcn_s_sleep(1); \
    if ((++_sp & 255u) == 0u) { if (xb_ld(&(bar)[XB_TMO])) break; if (_sp > XB_SPIN_CAP) { atomicAdd(&(bar)[XB_TMO], 1u); break; } } } } while (0)

struct XcdBarrier {
    unsigned* bar; unsigned x;
    volatile LAS unsigned* st;
};

__device__ __forceinline__ XcdBarrier xcd_barrier_post(unsigned* bar, volatile LAS unsigned* st) {
    XcdBarrier b; b.bar = bar; b.x = xb_xcc_id(); b.st = st;
    if (threadIdx.x == 0) (void)xb_add(&bar[XB_XCNT(b.x)], 1u);
    return b;
}
__device__ __forceinline__ void xcd_barrier_complete(unsigned* bar, unsigned x, unsigned& nloc, unsigned& nx) {
    const unsigned G = gridDim.x * gridDim.y * gridDim.z;
    unsigned sum, cnt, mine, sp = 0u;
    for (;;) {
        sum = 0u; cnt = 0u; mine = 0u;
#pragma unroll
        for (unsigned j = 0; j < 16; ++j) { const unsigned c = xb_ld(&bar[XB_XCNT(j)]); sum += c; cnt += (c > 0u) ? 1u : 0u; mine = (j == x) ? c : mine; }
        if (sum == G) break;
        __builtin_amdgcn_s_sleep(1);
        if ((++sp & 255u) == 0u) { if (xb_ld(&bar[XB_TMO])) break; if (sp > XB_SPIN_CAP) { atomicAdd(&bar[XB_TMO], 1u); break; } }
    }
    nloc = mine > 0u ? mine : 1u; nx = cnt > 0u ? cnt : 1u;
}

__device__ __forceinline__ void xcd_barrier(const XcdBarrier& b) {
    asm volatile("s_waitcnt vmcnt(0)" ::: "memory");
    __syncthreads();
    if (threadIdx.x == 0) {
        unsigned* bar = b.bar;
        __builtin_amdgcn_s_waitcnt(0);
        unsigned nloc = b.st[0], nx = b.st[1];
        if (nloc == 0u) { xcd_barrier_complete(bar, b.x, nloc, nx); b.st[0] = nloc; b.st[1] = nx; }
        const unsigned old = xb_add(&bar[XB_XSUB(b.x)], 1u);
        const unsigned gen = old / nloc;
        if (old + 1u == (gen + 1u) * nloc) {
            __builtin_amdgcn_fence(__ATOMIC_RELEASE, "agent");
            asm volatile("s_waitcnt vmcnt(0)" ::: "memory");
            const unsigned og = xb_add(&bar[XB_TOP], 1u);
            const unsigned tg = og / nx;
            if (og + 1u == (tg + 1u) * nx) xb_add(&bar[XB_TOPGEN], 1u);
            else XB_SPIN(xb_ld(&bar[XB_TOPGEN]) == tg, bar);
            __builtin_amdgcn_fence(__ATOMIC_ACQUIRE, "agent");
            xb_add(&bar[XB_XGEN(b.x)], 1u);
            asm volatile("s_waitcnt vmcnt(0)" ::: "memory");
        } else {
            XB_SPIN(xb_ld(&bar[XB_XGEN(b.x)]) == gen, bar);
            __builtin_amdgcn_fence(__ATOMIC_ACQUIRE, "agent");
            asm volatile("s_waitcnt vmcnt(0)" ::: "memory");
        }
    }
    __syncthreads();
}

__device__ __forceinline__ float wave_sum(float v) {
#pragma unroll
    for (int o = 1; o < 64; o <<= 1) v += __shfl_xor(v, o);
    return v;
}

struct EpiIn {
    static constexpr bool PERM = true, AFTER_DRAIN = false;
    bf16_t *zq, *xbc, *kk, *vv; float* dt;
    __device__ __forceinline__ void operator()(const pg8::f32x4 (&acc)[2][2][4][2], const pg8::Unit& u, int wr, int wc, int fr, int fq) const {
        const int row0 = u.pm * 256 + wr * 64 + fr, pn = u.pn;
        if (pn == 18) {
            if (wc == 0 && fq < 2) {
#pragma unroll
                for (int ai = 0; ai < 2; ++ai)
#pragma unroll
                    for (int m = 0; m < 4; ++m) { float* o = dt + (size_t)(row0 + ai * 128 + m * 16) * 16 + 8 * fq; *(pg8::f32x4*)o = acc[ai][0][m][0]; *(pg8::f32x4*)(o + 4) = acc[ai][0][m][1]; }
            }
            return;
        }
        bf16_t* base; int ldc, colt;
        if (pn < 4) { base = zq; ldc = 2048; colt = pn * 256; }
        else if (pn < 12) { base = xbc; ldc = 2048; colt = (pn - 4) * 256; }
        else if (pn < 16) { base = zq; ldc = 2048; colt = 1024 + (pn - 12) * 256; }
        else if (pn == 16) { base = kk; ldc = 256; colt = 0; }
        else { base = vv; ldc = 256; colt = 0; }
        const int col0 = colt + wc * 32 + 8 * fq;
#pragma unroll
        for (int ai = 0; ai < 2; ++ai)
#pragma unroll
            for (int m = 0; m < 4; ++m) { bf16_t* rowp = base + (size_t)(row0 + ai * 128 + m * 16) * ldc + col0;
#pragma unroll
                for (int bj = 0; bj < 2; ++bj) { const pg8::f32x4 v0 = acc[ai][bj][m][0], v1 = acc[ai][bj][m][1];
                    pg8::u32x4 w; w.x = pg8::cvt_pk_bf16(v0[0], v0[1]); w.y = pg8::cvt_pk_bf16(v0[2], v0[3]); w.z = pg8::cvt_pk_bf16(v1[0], v1[1]); w.w = pg8::cvt_pk_bf16(v1[2], v1[3]);
                    *(pg8::u32x4*)(rowp + bj * 128) = w; } }
    }
};

struct EpiOut {
    static constexpr bool PERM = true, AFTER_DRAIN = false;
    const float* x; float* x1; const float* mod;
    __device__ __forceinline__ void operator()(const pg8::f32x4 (&acc)[2][2][4][2], const pg8::Unit& u, int wr, int wc, int fr, int fq) const {
        const int row0 = u.pm * 256 + wr * 64 + fr, col0 = u.pn * 256 + wc * 32 + 8 * fq, b = (u.pm * 256) / SEQ;
        const float* g1 = mod + b * 6 * D + 2 * D + col0;
        pg8::f32x4 gv[2][2];
#pragma unroll
        for (int bj = 0; bj < 2; ++bj) { gv[bj][0] = *(const pg8::f32x4*)(g1 + bj * 128); gv[bj][1] = *(const pg8::f32x4*)(g1 + bj * 128 + 4); }
#pragma unroll
        for (int ai = 0; ai < 2; ++ai)
#pragma unroll
            for (int m = 0; m < 4; ++m) { const size_t off = (size_t)(row0 + ai * 128 + m * 16) * D + col0;
#pragma unroll
                for (int bj = 0; bj < 2; ++bj) { const float* xi = x + off + bj * 128; float* xo = x1 + off + bj * 128;
                    *(pg8::f32x4*)xo = *(const pg8::f32x4*)xi + gv[bj][0] * acc[ai][bj][m][0]; *(pg8::f32x4*)(xo + 4) = *(const pg8::f32x4*)(xi + 4) + gv[bj][1] * acc[ai][bj][m][1]; } }
    }
};
struct EpiGU {
    static constexpr bool PERM = true, AFTER_DRAIN = false;
    bf16_t* u;
    __device__ __forceinline__ void operator()(const pg8::f32x4 (&acc)[2][2][4][2], const pg8::Unit& un, int wr, int wc, int fr, int fq) const {
        const int row0 = un.pm * 256 + wr * 64 + fr, col0 = un.pn * 128 + wc * 32 + 8 * fq;
#pragma unroll
        for (int ai = 0; ai < 2; ++ai)
#pragma unroll
            for (int m = 0; m < 4; ++m) { bf16_t* rowp = u + (size_t)(row0 + ai * 128 + m * 16) * ED + col0;
                float o[8];
#pragma unroll
                for (int n = 0; n < 2; ++n)
#pragma unroll
                    for (int j = 0; j < 4; ++j) o[4 * n + j] = silu_f(acc[ai][0][m][n][j]) * acc[ai][1][m][n][j];
                pg8::u32x4 w; w.x = pg8::cvt_pk_bf16(o[0], o[1]); w.y = pg8::cvt_pk_bf16(o[2], o[3]); w.z = pg8::cvt_pk_bf16(o[4], o[5]); w.w = pg8::cvt_pk_bf16(o[6], o[7]);
                *(pg8::u32x4*)rowp = w; }
    }
};
struct EpiDown {
    static constexpr bool PERM = true, AFTER_DRAIN = false;
    bf16_t* yc; const int* list; const float* glist;
    __device__ __forceinline__ void operator()(const pg8::f32x4 (&acc)[2][2][4][2], const pg8::Unit& u, int wr, int wc, int fr, int fq) const {
        const unsigned col0 = (unsigned)(u.pn * 256 + wc * 32 + 8 * fq);
        const int* lp = list + (size_t)u.e * M + u.lt * 256; const float* gp = glist + (size_t)u.e * M + u.lt * 256;
        int a8[8]; float g8[8];
#pragma unroll
        for (int i = 0; i < 8; ++i) { const int r = (i >> 2) * 128 + wr * 64 + (i & 3) * 16 + fr; const bool ok = r < u.nrows;
            if (u.e < NE) { a8[i] = ok ? lp[r] : -1; g8[i] = ok ? gp[r] : 0.f; } else { a8[i] = ok ? ((u.lt * 256 + r) * 8) : -1; g8[i] = 1.f; } }
#pragma unroll
        for (int ai = 0; ai < 2; ++ai)
#pragma unroll
            for (int m = 0; m < 4; ++m) { const int a = a8[ai * 4 + m]; const float gt = g8[ai * 4 + m];
                if (a >= 0) { const unsigned ts = (unsigned)((a >> 3) * NSLOT + (u.e < NE ? (a & 7) : 8));
                    bf16_t* rowp = yc + (ts * 512u + col0);
#pragma unroll
                    for (int bj = 0; bj < 2; ++bj) { const pg8::f32x4 v0 = acc[ai][bj][m][0] * gt, v1 = acc[ai][bj][m][1] * gt;
                        pg8::u32x4 w; w.x = pg8::cvt_pk_bf16(v0[0], v0[1]); w.y = pg8::cvt_pk_bf16(v0[2], v0[3]); w.z = pg8::cvt_pk_bf16(v1[0], v1[1]); w.w = pg8::cvt_pk_bf16(v1[2], v1[3]);
                        *(pg8::u32x4*)(rowp + bj * 128) = w; } } }
    }
};
template <bool GATHER>
struct GroupedOrder {
    typedef pg8::Unit Unit;
    const char* A; const char* Bt; int K, nN, G, c, total; const LAS int* plan; const int* list; size_t bs_e, bs_pn; int pn0;
    __device__ __forceinline__ void init(const void* A_, const void* Bt_, int K_, int nN_, int G_, int c_, const LAS int* plan_, const int* list_, size_t bs_e_, size_t bs_pn_, int pn0_) {
        A = (const char*)A_; Bt = (const char*)Bt_; K = K_; nN = nN_; G = G_; c = c_; plan = plan_; list = list_; bs_e = bs_e_; bs_pn = bs_pn_; pn0 = pn0_; total = __builtin_amdgcn_readfirstlane(plan[NE + 1]) * nN; }
    __device__ __forceinline__ bool next(int i, Unit& u) const {
        const int L = i * G + c; if (L >= total) return false;
        int wgid = L; { const int q = total / 8, r = total % 8, xcd = wgid % 8, off = wgid / 8; wgid = (xcd < r ? xcd * (q + 1) : r * (q + 1) + (xcd - r) * q) + off; }
        const int tile = wgid / nN; u.pn = wgid % nN; u.pm = tile;
        int e = 0;
        for (int j = 1; j <= NE; ++j) e += (plan[j] <= tile) ? 1 : 0;
        e = __builtin_amdgcn_readfirstlane(e);
        u.e = e; u.lt = __builtin_amdgcn_readfirstlane(tile - plan[e]); const int rem = __builtin_amdgcn_readfirstlane(plan[80 + e]) - u.lt * 256; u.nrows = rem < 256 ? rem : 256; return true;
    }
    __device__ __forceinline__ const char* a_base(const Unit& u) const { return GATHER ? A : A + (size_t)u.pm * 512 * K; }
    __device__ __forceinline__ const char* b_base(const Unit& u) const { return Bt + (size_t)u.e * bs_e + (size_t)(pn0 + u.pn) * bs_pn; }
    __device__ __forceinline__ void lane_off(const Unit& u, const int (&R)[2], const int (&C)[2], unsigned (&o)[2][2]) const {
#pragma unroll
        for (int h = 0; h < 2; ++h)
#pragma unroll
            for (int i = 0; i < 2; ++i) { const int r = h * 128 + R[i];
                if (GATHER) { int tok = 0; if (r < u.nrows) { const int idx = u.lt * 256 + r; tok = u.e < NE ? (list[(size_t)u.e * M + idx] >> 3) : idx; }
                    o[h][i] = (unsigned)((tok * K + C[i]) * 2); }
                else o[h][i] = (unsigned)((r * K + C[i]) * 2); }
    }
    __device__ __forceinline__ void a_ready(const Unit&) const {}
    __device__ __forceinline__ void done(const Unit&) const {}
};

template <class CM>
__device__ __forceinline__ void transpose_item(const float* W, int ldw, bf16_t* WT, int ldt, int k0, int n0, LAS float* scr, int lane, const CM& colmap) {
    const int sc = colmap(n0 + (lane & 31));
#pragma unroll
    for (int i = 0; i < 32; ++i) { const int kk = 2 * i + (lane >> 5); scr[kk * 33 + (lane & 31)] = sc >= 0 ? W[(size_t)(k0 + kk) * ldw + sc] : 0.f; }
    LDS_WAIT(); asm volatile("" ::: "memory");
    const int c = lane & 7;
#pragma unroll
    for (int j = 0; j < 4; ++j) { const int n = (lane >> 3) + 8 * j; const LAS float* s = scr + (8 * c) * 33 + n;
        v4u o; o.x = pk2(s[0 * 33], s[1 * 33]); o.y = pk2(s[2 * 33], s[3 * 33]); o.z = pk2(s[4 * 33], s[5 * 33]); o.w = pk2(s[6 * 33], s[7 * 33]);
        *(GAS v4u*)(WT + (size_t)(n0 + n) * ldt + k0 + 8 * c) = o; }
    LDS_WAIT(); asm volatile("" ::: "memory");
}

typedef short v4i16_t __attribute__((ext_vector_type(4)));
__device__ __forceinline__ v4i16_t tr4(const LAS unsigned char* img, int stride, int row0, int col0, int lane) {
    const LAS unsigned char* a = img + (row0 + ((lane & 15) >> 2)) * stride + (col0 + 4 * (lane & 3)) * 2;
    return __builtin_amdgcn_ds_read_tr16_b64_v4i16((LAS v4i16_t*)a);
}
__device__ __forceinline__ pg8::bf16x8 cat44(v4i16_t lo, v4i16_t hi) { return (pg8::bf16x8){lo[0], lo[1], lo[2], lo[3], hi[0], hi[1], hi[2], hi[3]}; }

template <class EMIT>
__device__ __forceinline__ void conv16x8(const bf16_t* xbc, const float* cw, const float* cb, int row0, int t0, int ch, const EMIT& emit) {
    v4u raw[19];
#pragma unroll
    for (int k = 0; k < 19; ++k) { raw[k] = (v4u){0u, 0u, 0u, 0u}; if (t0 - 3 + k >= 0) raw[k] = *(const v4u*)(xbc + (size_t)(row0 - 3 + k) * CONV_CH + ch); }
    float wv[4][8], bv[8];
#pragma unroll
    for (int k = 0; k < 4; ++k) { const f32x4 a = *(const f32x4*)(cw + k * CONV_CH + ch), b = *(const f32x4*)(cw + k * CONV_CH + ch + 4); wv[k][0] = a.x; wv[k][1] = a.y; wv[k][2] = a.z; wv[k][3] = a.w; wv[k][4] = b.x; wv[k][5] = b.y; wv[k][6] = b.z; wv[k][7] = b.w; }
    { const f32x4 a = *(const f32x4*)(cb + ch), b = *(const f32x4*)(cb + ch + 4); bv[0] = a.x; bv[1] = a.y; bv[2] = a.z; bv[3] = a.w; bv[4] = b.x; bv[5] = b.y; bv[6] = b.z; bv[7] = b.w; }
    float win[4][8];
#pragma unroll
    for (int k = 0; k < 3; ++k) { const unsigned w4[4] = {raw[k].x, raw[k].y, raw[k].z, raw[k].w};
#pragma unroll
        for (int j = 0; j < 4; ++j) { win[k][2 * j] = __uint_as_float(w4[j] << 16); win[k][2 * j + 1] = __uint_as_float(w4[j] & 0xffff0000u); } }
#pragma unroll
    for (int r = 0; r < 16; ++r) {
        { const unsigned w4[4] = {raw[r + 3].x, raw[r + 3].y, raw[r + 3].z, raw[r + 3].w};
#pragma unroll
          for (int j = 0; j < 4; ++j) { win[(r + 3) & 3][2 * j] = __uint_as_float(w4[j] << 16); win[(r + 3) & 3][2 * j + 1] = __uint_as_float(w4[j] & 0xffff0000u); } }
        float o[8];
#pragma unroll
        for (int j = 0; j < 8; ++j) { float a = bv[j];
#pragma unroll
            for (int k = 0; k < 4; ++k) a += wv[k][j] * win[(r + k) & 3][j];
            o[j] = silu_f(a); }
        emit(r, o);
    }
}

__device__ __forceinline__ void conv2x8(const bf16_t* xbc, const float* cw, const float* cb, int row, int t, int ch, float (&o0)[8], float (&o1)[8]) {
    float xr[5][8];
#pragma unroll
    for (int k = 0; k < 5; ++k) { v4u raw = (v4u){0u, 0u, 0u, 0u}; if (t - 3 + k >= 0) raw = *(const v4u*)(xbc + (size_t)(row - 3 + k) * CONV_CH + ch);
        const unsigned w4[4] = {raw.x, raw.y, raw.z, raw.w};
#pragma unroll
        for (int j = 0; j < 4; ++j) { xr[k][2 * j] = __uint_as_float(w4[j] << 16); xr[k][2 * j + 1] = __uint_as_float(w4[j] & 0xffff0000u); } }
    float wv[4][8], bv[8];
#pragma unroll
    for (int k = 0; k < 4; ++k) { const f32x4 a = *(const f32x4*)(cw + k * CONV_CH + ch), b = *(const f32x4*)(cw + k * CONV_CH + ch + 4); wv[k][0] = a.x; wv[k][1] = a.y; wv[k][2] = a.z; wv[k][3] = a.w; wv[k][4] = b.x; wv[k][5] = b.y; wv[k][6] = b.z; wv[k][7] = b.w; }
    { const f32x4 a = *(const f32x4*)(cb + ch), b = *(const f32x4*)(cb + ch + 4); bv[0] = a.x; bv[1] = a.y; bv[2] = a.z; bv[3] = a.w; bv[4] = b.x; bv[5] = b.y; bv[6] = b.z; bv[7] = b.w; }
#pragma unroll
    for (int j = 0; j < 8; ++j) { float a0 = bv[j], a1 = bv[j];
#pragma unroll
        for (int k = 0; k < 4; ++k) { a0 += wv[k][j] * xr[k][j]; a1 += wv[k][j] * xr[k + 1][j]; }
        o0[j] = silu_f(a0); o1[j] = silu_f(a1); }
}

constexpr int NPHASE = 14;
__global__ void __launch_bounds__(NWAVES * 64, 2) mega(P p) {
    extern __shared__ __attribute__((aligned(16))) unsigned char lds_raw[];
    LAS unsigned char* lds = (LAS unsigned char*)lds_raw;
    volatile LAS unsigned* MISC = (volatile LAS unsigned*)(lds + MISC_OFF);
    const int tid = threadIdx.x, lane = tid & 63, wave = __builtin_amdgcn_readfirstlane(tid >> 6);
    const int G = gridDim.x; const int bx = blockIdx.x; const int vcu = (G % 8 == 0) ? (bx % 8) * (G / 8) + bx / 8 : bx;
    unsigned char* ws = p.ws;
    gu32* ctl = (gu32*)(ws + WS_CTL);
    for (int u = tid; u < (LDS_BYTES - LDSCTL_OFF) / 4; u += NWAVES * 64) ((LAS unsigned*)(lds + LDSCTL_OFF))[u] = 0u;
    __syncthreads();
    XcdBarrier bar = xcd_barrier_post((unsigned*)(ctl + CW_BAR) + p.li * XCD_BAR_WORDS, MISC + 8);
    const int lo = p.ph_lo, hi = p.ph_hi;
#ifndef PHMASK
#define PHMASK 0xffffffffu
#endif
#define IN(k) (((PHMASK >> (k)) & 1u) && lo <= (k) && (k) < hi)
#define BOTH(k) (IN(k) && IN((k) + 1))
#ifdef PROBE_MASK
#define PH_BEGIN() const unsigned long long _pt0 = __builtin_amdgcn_s_memrealtime()
#define PH_END(k) do { if ((PROBE_MASK >> (k)) & 1u) { const unsigned long long _pt1 = __builtin_amdgcn_s_memrealtime(); while (__builtin_amdgcn_s_memrealtime() < _pt1 + (_pt1 - _pt0)) __builtin_amdgcn_s_sleep(8); } } while (0)
#else
#define PH_BEGIN() do {} while (0)
#define PH_END(k) do {} while (0)
#endif
    const int gw = vcu * NWAVES + wave, NGW = G * NWAVES;
    float* modv = (float*)(ws + WS_MOD);

    if (IN(0)) { PH_BEGIN();
        if (bx < 192) {
            LAS float* part = (LAS float*)(lds + RING_OFF);
            const int j0 = bx * 32, cc = lane & 31, ks = wave * 2 + (lane >> 5);
            float a0 = 0.f, a1 = 0.f, a2 = 0.f, a3 = 0.f;
#pragma unroll 8
            for (int k = ks * 64; k < ks * 64 + 64; ++k) { const float wv = p.mod_w[(size_t)k * 6 * D + j0 + cc];
                a0 += silu_f(p.c[k]) * wv; a1 += silu_f(p.c[D + k]) * wv; a2 += silu_f(p.c[2 * D + k]) * wv; a3 += silu_f(p.c[3 * D + k]) * wv; }
            part[(ks * 4 + 0) * 32 + cc] = a0; part[(ks * 4 + 1) * 32 + cc] = a1; part[(ks * 4 + 2) * 32 + cc] = a2; part[(ks * 4 + 3) * 32 + cc] = a3;
            __syncthreads();
            if (tid < 128) { const int b = tid >> 5, c2 = tid & 31; float s = p.mod_b[j0 + c2];
                for (int q = 0; q < 16; ++q) s += part[(q * 4 + b) * 32 + c2];
                modv[b * 6 * D + j0 + c2] = s; }
            __syncthreads();
        }
        LAS float* scr = (LAS float*)(lds + RING_OFF + wave * 16384);
        constexpr int I_IN = (D / 64) * (NWIN / 32), I_OUT = (2048 / 64) * (D / 32);
        bf16_t* WinT = (bf16_t*)(ws + WS_WIN_T); bf16_t* WoutT = (bf16_t*)(ws + WS_WOUT_T);
        for (int it = gw; it < I_IN + I_OUT; it += NGW) {
            if (it < I_IN) { const int nb = it % (NWIN / 32), kb = it / (NWIN / 32);
                transpose_item(p.w_in, IN_COLS, WinT, D, kb * 64, nb * 32, scr, lane, [](int n) { return n < 3072 ? n : (n < 4608 ? n + 16 : (n < 4624 ? n - 1536 : -1)); }); }
            else { const int r = it - I_IN, nb = r % (D / 32), kb = r / (D / 32);
                transpose_item(p.w_out, D, WoutT, 2048, kb * 64, nb * 32, scr, lane, [](int n) { return n; }); }
        }
        {
            v4u* rwf = (v4u*)(ws + WS_RWF);
            for (int i = bx * 512 + tid; i < 32 * 4 * 64; i += G * 512) { const int ln = i & 63, nt = (i >> 6) & 3, ks = i >> 8, c = ln & 15, q = ln >> 4;
                float v[8]; unsigned hi[4], lo[4];
#pragma unroll
                for (int j = 0; j < 8; ++j) v[j] = p.router_w[(32 * ks + 8 * q + j) * NE + 16 * nt + c];
#pragma unroll
                for (int j = 0; j < 4; ++j) { hi[j] = pk2(v[2 * j], v[2 * j + 1]); lo[j] = pk2(v[2 * j] - __uint_as_float(hi[j] << 16), v[2 * j + 1] - __uint_as_float(hi[j] & 0xffff0000u)); }
                rwf[((ks * 4 + nt) * 2) * 64 + ln] = (v4u){hi[0], hi[1], hi[2], hi[3]}; rwf[((ks * 4 + nt) * 2 + 1) * 64 + ln] = (v4u){lo[0], lo[1], lo[2], lo[3]}; }
        }
        constexpr int I_GU = 16 * 16, I_D = 4 * 32;
        bf16_t* WguT = (bf16_t*)(ws + WS_WGU); bf16_t* WdT = (bf16_t*)(ws + WS_WD);
        for (int it = gw; it < (NE + 1) * (I_GU + I_D); it += NGW) {
            const int e = it / (I_GU + I_D), r = it % (I_GU + I_D);
            if (r < I_GU) { const int nb = r & 15, kb = r >> 4, up = (nb >> 2) & 1;
                const float* W = e < NE ? (up ? p.exp_w_up : p.exp_w_gate) + (size_t)e * D * ED : (up ? p.sh_w_up : p.sh_w_gate);
                transpose_item(W, ED, WguT + (size_t)e * 512 * D, D, kb * 64, nb * 32, scr, lane, [](int n) { return (n >> 8) * 128 + (n & 127); }); }
            else { const int r2 = r - I_GU, nb = r2 & 31, kb = r2 >> 5;
                const float* W = e < NE ? p.exp_w_down + (size_t)e * ED * D : p.sh_w_down;
                transpose_item(W, D, WdT + (size_t)e * D * ED, ED, kb * 64, nb * 32, scr, lane, [](int n) { return n; }); }
        }
        if (BOTH(0)) xcd_barrier(bar);
        PH_END(0);
    }

    if (IN(1)) { PH_BEGIN();
        bf16_t* hn = (bf16_t*)p.out;
        for (int m = gw; m < M; m += NGW) {
            const int b = m / SEQ; const GAS f32x4* xr = (const GAS f32x4*)(p.x + (size_t)m * D) + lane;
            f32x4 v[4]; float s = 0.f;
#pragma unroll
            for (int j = 0; j < 4; ++j) { v[j] = xr[64 * j]; s += (v[j].x * v[j].x + v[j].y * v[j].y) + (v[j].z * v[j].z + v[j].w * v[j].w); }
            const float rstd = rsqrtf(wave_sum(s) * (1.f / D) + EPS);
            GAS unsigned long long* o8 = (GAS unsigned long long*)(hn + (size_t)m * D) + lane;
#pragma unroll
            for (int j = 0; j < 4; ++j) { const int d = 4 * lane + 256 * j; const f32x4 g = *(const f32x4*)(p.norm1_g + d), sc = *(const f32x4*)(modv + b * 6 * D + D + d), sh = *(const f32x4*)(modv + b * 6 * D + d);
                const f32x4 h = v[j] * rstd * g * (sc + 1.f) + sh;
                o8[64 * j] = (unsigned long long)pk2(h.x, h.y) | ((unsigned long long)pk2(h.z, h.w) << 32); }
        }
        if (BOTH(1)) xcd_barrier(bar);
        PH_END(1);
    }

    if (IN(2)) { PH_BEGIN();
        pg8::DenseOrder S; S.init(p.out, ws + WS_WIN_T, M, NWIN, D, G, bx);
        EpiIn E{(bf16_t*)(ws + WS_ZQ), (bf16_t*)(ws + WS_XBC), (bf16_t*)(ws + WS_K), (bf16_t*)(ws + WS_V), (float*)(ws + WS_DT)};
        pg8::gemm_phase<EpiIn, pg8::DenseOrder, true, true>(lds + RING_OFF, D, S, E);
        if (BOTH(2)) xcd_barrier(bar);
        PH_END(2);
    }

    if (IN(3)) { PH_BEGIN();
        {
            typedef pg8::bf16x8 bf16x8; typedef pg8::f32x4 f4;
            bf16_t* zq = (bf16_t*)(ws + WS_ZQ); const bf16_t* kk = (const bf16_t*)(ws + WS_K); const bf16_t* vv = (const bf16_t*)(ws + WS_V); float* ssq = (float*)(ws + WS_SSQ);
            LAS unsigned char* Kl = lds + RING_OFF; LAS unsigned char* Vl = lds + RING_OFF + 27648; LAS float* biasl = (LAS float*)(lds + RING_OFF + 58368);
            __syncthreads();
            for (int i = tid; i < ATT_HEADS * 128; i += 512) { const int h = i >> 7, dist = i & 127; biasl[i] = p.rel_bias[c_bucket[dist] * ATT_HEADS + h]; }
            const int fr = lane & 15, fg = lane >> 4;
            for (int unit = bx; unit < BATCH * (SEQ / 64); unit += G) {
                const int b = unit / (SEQ / 64), qb = unit % (SEQ / 64), t0 = qb * 64, row0 = b * SEQ + t0;
                for (int kvh = 0; kvh < KV_HEADS; ++kvh) {
                    __syncthreads();
                    for (int i = tid; i < 192 * 8; i += 512) { const int j = i >> 3, ch = i & 7, kt = t0 - 128 + j;
                        v4u val = (v4u){0u, 0u, 0u, 0u}; if (kt >= 0) val = *(const v4u*)(kk + (size_t)(b * SEQ + kt) * D_KV + kvh * HD + ch * 8);
                        *(LAS v4u*)(Kl + j * 144 + ch * 16) = val; }
                    for (int i = tid; i < 192 * 8; i += 512) { const int j = i >> 3, ch = i & 7, kt = t0 - 128 + j;
                        v4u val = (v4u){0u, 0u, 0u, 0u}; if (kt >= 0) val = *(const v4u*)(vv + (size_t)(b * SEQ + kt) * D_KV + kvh * HD + ch * 8);
                        *(LAS v4u*)(Vl + j * 160 + ch * 16) = val; }
                    __syncthreads();
                    const int head = kvh * 4 + (wave >> 1), rt0 = 2 * (wave & 1), jt0 = rt0;
                    const float sink = p.sinks[head]; const LAS float* bl = biasl + head * 128;
#pragma unroll 1
                    for (int r2 = 0; r2 < 2; ++r2) {
                        const int qi = 16 * (rt0 + r2) + fr;
                        bf16x8 Qf[2];
#pragma unroll
                        for (int ks = 0; ks < 2; ++ks) Qf[ks] = *(const bf16x8*)(zq + (size_t)(row0 + qi) * 2048 + 1024 + head * HD + ks * 32 + 8 * fg);
                        f4 sacc[10];
#pragma unroll
                        for (int jt = 0; jt < 10; ++jt) sacc[jt] = (f4){0.f, 0.f, 0.f, 0.f};
#pragma unroll
                        for (int jt = 0; jt < 10; ++jt)
#pragma unroll
                            for (int ks = 0; ks < 2; ++ks) { const bf16x8 Kf = *(const LAS bf16x8*)(Kl + (16 * (jt0 + jt) + fr) * 144 + (ks * 32 + 8 * fg) * 2);
                                sacc[jt] = __builtin_amdgcn_mfma_f32_16x16x32_bf16(Kf, Qf[ks], sacc[jt], 0, 0, 0); }
                        float mx = sink;
#pragma unroll
                        for (int jt = 0; jt < 10; ++jt)
#pragma unroll
                            for (int j = 0; j < 4; ++j) { const int kj = 16 * (jt0 + jt) + 4 * fg + j, dist = qi + 128 - kj; const bool ok = dist >= 0 && dist < 128 && (t0 - 128 + kj) >= 0;
                                const float s = ok ? sacc[jt][j] * 0.125f + bl[dist & 127] : -INFINITY; sacc[jt][j] = s; mx = fmaxf(mx, s); }
                        mx = fmaxf(mx, __shfl_xor(mx, 16)); mx = fmaxf(mx, __shfl_xor(mx, 32));
                        float ls = 0.f;
#pragma unroll
                        for (int jt = 0; jt < 10; ++jt)
#pragma unroll
                            for (int j = 0; j < 4; ++j) { const float pe = __expf(sacc[jt][j] - mx); sacc[jt][j] = pe; ls += pe; }
                        ls += __shfl_xor(ls, 16); ls += __shfl_xor(ls, 32); ls += __expf(sink - mx);
                        f4 o[4];
#pragma unroll
                        for (int dt = 0; dt < 4; ++dt) o[dt] = (f4){0.f, 0.f, 0.f, 0.f};
#pragma unroll
                        for (int k5 = 0; k5 < 5; ++k5) { const f4 pa = sacc[2 * k5], pb = sacc[2 * k5 + 1];
                            union { bf16x8 v; unsigned u[4]; } Pf; Pf.u[0] = pg8::cvt_pk_bf16(pa[0], pa[1]); Pf.u[1] = pg8::cvt_pk_bf16(pa[2], pa[3]); Pf.u[2] = pg8::cvt_pk_bf16(pb[0], pb[1]); Pf.u[3] = pg8::cvt_pk_bf16(pb[2], pb[3]);
#pragma unroll
                            for (int dt = 0; dt < 4; ++dt) { const bf16x8 Vf = cat44(tr4(Vl, 160, 16 * (jt0 + 2 * k5) + 4 * fg, 16 * dt, lane), tr4(Vl, 160, 16 * (jt0 + 2 * k5 + 1) + 4 * fg, 16 * dt, lane));
                                o[dt] = __builtin_amdgcn_mfma_f32_16x16x32_bf16(Vf, Pf.v, o[dt], 0, 0, 0); } }
                        const float inv = 1.f / ls; float ss = 0.f;
                        bf16_t* op = zq + (size_t)(row0 + qi) * 2048 + 1024 + head * HD + 4 * fg;
#pragma unroll
                        for (int dt = 0; dt < 4; ++dt) { const f4 ov = o[dt] * inv; ss += (ov[0] * ov[0] + ov[1] * ov[1]) + (ov[2] * ov[2] + ov[3] * ov[3]);
                            *(unsigned long long*)(op + 16 * dt) = (unsigned long long)pg8::cvt_pk_bf16(ov[0], ov[1]) | ((unsigned long long)pg8::cvt_pk_bf16(ov[2], ov[3]) << 32); }
                        ss += __shfl_xor(ss, 16); ss += __shfl_xor(ss, 32);
                        if (fg == 0) ssq[(row0 + qi) * 16 + head] = ss;
                    }
                }
            }
            __syncthreads();
        }
        PH_END(3);
    }

    if (IN(4)) { PH_BEGIN();
        typedef pg8::bf16x8 bf16x8; typedef pg8::f32x4 f4;
        const bf16_t* xbc = (const bf16_t*)(ws + WS_XBC); const float* dtr = (const float*)(ws + WS_DT); float* decg = (float*)(ws + WS_CS);
        LAS unsigned char* Xi = lds + RING_OFF; LAS unsigned char* Bi = lds + RING_OFF + 69632; LAS float* wl = (LAS float*)(lds + RING_OFF + 106496);
        const int fr = lane & 15, fg = lane >> 4;
        for (int unit = bx; unit < BATCH * NCHUNK * SSM_GROUPS; unit += G) {
            const int g = unit % SSM_GROUPS, bc = unit / SSM_GROUPS, rowc = bc * CHUNK, tc = rowc % SEQ;
            __syncthreads();
            if (wave < 4) { const int h = g * 4 + wave; const float A = -__expf(p.a_log[h]), bias = p.dt_bias[h];
                const float d0 = softplus_f(dtr[(rowc + lane) * 16 + h] + bias), d1 = softplus_f(dtr[(rowc + lane + 64) * 16 + h] + bias);
                float s0 = d0 * A, s1 = d1 * A;
#pragma unroll
                for (int o = 1; o < 64; o <<= 1) { const float u0 = __shfl_up(s0, o), u1 = __shfl_up(s1, o); if (lane >= o) { s0 += u0; s1 += u1; } }
                s1 += __shfl(s0, 63); const float cl = __shfl(s1, 63);
                wl[wave * 128 + lane] = d0 * __expf(cl - s0); wl[wave * 128 + lane + 64] = d1 * __expf(cl - s1);
                if (lane == 0) decg[bc * 16 + h] = __expf(cl); }
            __syncthreads();
            if (tid < 384) { const int co = tid % 48, l0 = 16 * (tid / 48);
                const int ch = co < 32 ? g * 256 + co * 8 : D_SSM + g * D_STATE + (co - 32) * 8;
                LAS unsigned char* dst = co < 32 ? Xi + l0 * 544 + co * 16 : Bi + l0 * 288 + (co - 32) * 16; const int st = co < 32 ? 544 : 288;
                const LAS float* wr_ = wl + (co < 32 ? (co >> 3) * 128 : 0) + l0; const bool scale = co < 32;
                conv16x8(xbc, p.conv_w, p.conv_b, rowc + l0, tc + l0, ch, [&](int r, const float (&o)[8]) { const float w = scale ? wr_[r] : 1.f;
                    *(LAS v4u*)(dst + r * st) = (v4u){pk2(o[0] * w, o[1] * w), pk2(o[2] * w, o[3] * w), pk2(o[4] * w, o[5] * w), pk2(o[6] * w, o[7] * w)}; }); }
            __syncthreads();
            bf16x8 Bf[4];
#pragma unroll
            for (int kk = 0; kk < 4; ++kk) Bf[kk] = cat44(tr4(Bi, 288, 32 * kk + 4 * fg, 16 * wave, lane), tr4(Bi, 288, 32 * kk + 16 + 4 * fg, 16 * wave, lane));
#pragma unroll
            for (int r4 = 0; r4 < 4; ++r4) { const int h = g * 4 + r4; float* S = p.out + (size_t)(bc * SSM_HEADS + h) * HD * D_STATE;
#pragma unroll
                for (int pt = 0; pt < 4; ++pt) { f4 acc = (f4){0.f, 0.f, 0.f, 0.f};
#pragma unroll
                    for (int kk = 0; kk < 4; ++kk) { const bf16x8 Af = cat44(tr4(Xi, 544, 32 * kk + 4 * fg, r4 * 64 + 16 * pt, lane), tr4(Xi, 544, 32 * kk + 16 + 4 * fg, r4 * 64 + 16 * pt, lane)); acc = __builtin_amdgcn_mfma_f32_16x16x32_bf16(Af, Bf[kk], acc, 0, 0, 0); }
#pragma unroll
                    for (int j = 0; j < 4; ++j) S[(16 * pt + 4 * fg + j) * D_STATE + 16 * wave + fr] = acc[j]; } }
        }
        if (BOTH(4)) xcd_barrier(bar);
        PH_END(4);
    }

    if (IN(5)) { PH_BEGIN();
        const float* S = p.out; const float* decg = (const float*)(ws + WS_CS); bf16_t* St = (bf16_t*)(ws + WS_ST);
        for (int i = bx * 512 + tid; i < BATCH * SSM_HEADS * HD * D_STATE / 2; i += G * 512) {
            const int pn = (i % (HD * D_STATE / 2)) * 2, bh = i / (HD * D_STATE / 2), h = bh % SSM_HEADS, b = bh / SSM_HEADS;
            float s0 = 0.f, s1 = 0.f;
#pragma unroll 4
            for (int c = 0; c < NCHUNK; ++c) { const size_t idx = ((size_t)((b * NCHUNK + c) * SSM_HEADS + h)) * HD * D_STATE + pn; const float2 sv = *(const float2*)(S + idx);
                *(unsigned*)(St + idx) = pk2(s0, s1); const float dec = decg[(b * NCHUNK + c) * 16 + h]; s0 = s0 * dec + sv.x; s1 = s1 * dec + sv.y; }
        }
        bf16_t* zq = (bf16_t*)(ws + WS_ZQ); const float* ssq = (const float*)(ws + WS_SSQ);
        for (int m = gw; m < M; m += NGW) {
            float s = lane < 16 ? ssq[m * 16 + lane] : 0.f; s = wave_sum(s); const float r = rsqrtf(s * (1.f / 1024.f) + EPS);
            bf16_t* o = zq + (size_t)m * 2048 + 1024 + lane * 16;
            v4u w0 = *(v4u*)o, w1 = *(v4u*)(o + 8); unsigned w[8] = {w0.x, w0.y, w0.z, w0.w, w1.x, w1.y, w1.z, w1.w};
#pragma unroll
            for (int j = 0; j < 8; ++j) { const int d = lane * 16 + 2 * j; w[j] = pk2(__uint_as_float(w[j] << 16) * r * p.att_norm_g[d], __uint_as_float(w[j] & 0xffff0000u) * r * p.att_norm_g[d + 1]); }
            *(v4u*)o = (v4u){w[0], w[1], w[2], w[3]}; *(v4u*)(o + 8) = (v4u){w[4], w[5], w[6], w[7]};
        }
        if (BOTH(5)) xcd_barrier(bar);
        PH_END(5);
    }

    if (IN(6)) { PH_BEGIN();
        typedef pg8::bf16x8 bf16x8; typedef pg8::f32x4 f4;
        const bf16_t* xbc = (const bf16_t*)(ws + WS_XBC); const float* dtr = (const float*)(ws + WS_DT); bf16_t* zq = (bf16_t*)(ws + WS_ZQ); const bf16_t* Stg = (const bf16_t*)(ws + WS_ST);
        LAS unsigned char* Xi = lds + RING_OFF; LAS unsigned char* Bi = lds + RING_OFF + 69632; LAS unsigned char* Ci = lds + RING_OFF + 106496;
        LAS float* csl = (LAS float*)(lds + RING_OFF + 143360); LAS float* dtl = csl + 512;
        const int fr = lane & 15, fg = lane >> 4;
        for (int unit = bx; unit < BATCH * NCHUNK * SSM_GROUPS; unit += G) {
            const int g = unit % SSM_GROUPS, bc = unit / SSM_GROUPS, rowc = bc * CHUNK, tc = rowc % SEQ;
            __syncthreads();
            if (wave < 4) { const int h = g * 4 + wave; const float A = -__expf(p.a_log[h]), bias = p.dt_bias[h];
                const float d0 = softplus_f(dtr[(rowc + lane) * 16 + h] + bias), d1 = softplus_f(dtr[(rowc + lane + 64) * 16 + h] + bias);
                float s0 = d0 * A, s1 = d1 * A;
#pragma unroll
                for (int o = 1; o < 64; o <<= 1) { const float u0 = __shfl_up(s0, o), u1 = __shfl_up(s1, o); if (lane >= o) { s0 += u0; s1 += u1; } }
                s1 += __shfl(s0, 63);
                csl[wave * 128 + lane] = s0; csl[wave * 128 + lane + 64] = s1; dtl[wave * 128 + lane] = d0; dtl[wave * 128 + lane + 64] = d1; }
            { const int co = tid & 63, l0 = 16 * (tid >> 6);
                const int ch = co < 32 ? g * 256 + co * 8 : (co < 48 ? D_SSM + g * D_STATE + (co - 32) * 8 : D_SSM + SSM_GROUPS * D_STATE + g * D_STATE + (co - 48) * 8);
                LAS unsigned char* dst = co < 32 ? Xi + l0 * 544 + co * 16 : (co < 48 ? Bi + l0 * 288 + (co - 32) * 16 : Ci + l0 * 288 + (co - 48) * 16); const int st = co < 32 ? 544 : 288;
                conv16x8(xbc, p.conv_w, p.conv_b, rowc + l0, tc + l0, ch, [&](int r, const float (&o)[8]) {
                    *(LAS v4u*)(dst + r * st) = (v4u){pk2(o[0], o[1]), pk2(o[2], o[3]), pk2(o[4], o[5]), pk2(o[6], o[7])}; }); }
            __syncthreads();
            const int lrow = 16 * wave + fr;
            bf16x8 Cf[4];
#pragma unroll
            for (int kk = 0; kk < 4; ++kk) Cf[kk] = *(const LAS bf16x8*)(Ci + lrow * 288 + (4 * kk + fg) * 16);
            f4 Gt[8];
#pragma unroll
            for (int st = 0; st < 8; ++st) { Gt[st] = (f4){0.f, 0.f, 0.f, 0.f};
                if (st <= wave) {
#pragma unroll
                    for (int kk = 0; kk < 4; ++kk) { const bf16x8 Bf = *(const LAS bf16x8*)(Bi + (16 * st + fr) * 288 + (4 * kk + fg) * 16);
                        Gt[st] = __builtin_amdgcn_mfma_f32_16x16x32_bf16(Bf, Cf[kk], Gt[st], 0, 0, 0); } } }
            f4 Y[4][4];
#pragma unroll
            for (int r4 = 0; r4 < 4; ++r4) { const int h = g * 4 + r4; const float cl = csl[r4 * 128 + lrow];
                const bf16_t* Sth = Stg + (size_t)(bc * SSM_HEADS + h) * HD * D_STATE;
#pragma unroll
                for (int pt = 0; pt < 4; ++pt) { f4 acc = (f4){0.f, 0.f, 0.f, 0.f};
#pragma unroll
                    for (int kk = 0; kk < 4; ++kk) { const bf16x8 Sf = *(const bf16x8*)(Sth + (16 * pt + fr) * D_STATE + (4 * kk + fg) * 8); acc = __builtin_amdgcn_mfma_f32_16x16x32_bf16(Sf, Cf[kk], acc, 0, 0, 0); }
                    Y[r4][pt] = acc * __expf(cl); }
#pragma unroll
                for (int k4 = 0; k4 < 4; ++k4) { if (2 * k4 <= wave) {
                    union { bf16x8 v; unsigned u[4]; } Pf;
#pragma unroll
                    for (int hh = 0; hh < 2; ++hh) { const int st = 2 * k4 + hh; const f4 c4 = *(const LAS f4*)(csl + r4 * 128 + 16 * st + 4 * fg), d4 = *(const LAS f4*)(dtl + r4 * 128 + 16 * st + 4 * fg);
                        float mv[4];
#pragma unroll
                        for (int j = 0; j < 4; ++j) { const int s = 16 * st + 4 * fg + j; mv[j] = (s <= lrow) ? Gt[st][j] * __expf(cl - c4[j]) * d4[j] : 0.f; }
                        Pf.u[2 * hh] = pg8::cvt_pk_bf16(mv[0], mv[1]); Pf.u[2 * hh + 1] = pg8::cvt_pk_bf16(mv[2], mv[3]); }
#pragma unroll
                    for (int pt = 0; pt < 4; ++pt) { const bf16x8 Xf = cat44(tr4(Xi, 544, 32 * k4 + 4 * fg, r4 * 64 + 16 * pt, lane), tr4(Xi, 544, 32 * k4 + 16 + 4 * fg, r4 * 64 + 16 * pt, lane));
                        Y[r4][pt] = __builtin_amdgcn_mfma_f32_16x16x32_bf16(Xf, Pf.v, Y[r4][pt], 0, 0, 0); } } }
                const float dsk = p.d_skip[h];
#pragma unroll
                for (int pt = 0; pt < 4; ++pt) { const unsigned long long xx = *(const LAS unsigned long long*)(Xi + lrow * 544 + (r4 * 64 + 16 * pt + 4 * fg) * 2); const unsigned x0 = (unsigned)xx, x1 = (unsigned)(xx >> 32);
                    Y[r4][pt][0] += dsk * __uint_as_float(x0 << 16); Y[r4][pt][1] += dsk * __uint_as_float(x0 & 0xffff0000u); Y[r4][pt][2] += dsk * __uint_as_float(x1 << 16); Y[r4][pt][3] += dsk * __uint_as_float(x1 & 0xffff0000u); }
            }
            bf16_t* zr = zq + (size_t)(rowc + lrow) * 2048 + g * 256 + 4 * fg; float ss = 0.f;
#pragma unroll
            for (int r4 = 0; r4 < 4; ++r4)
#pragma unroll
                for (int pt = 0; pt < 4; ++pt) { const unsigned long long zz = *(const unsigned long long*)(zr + r4 * 64 + 16 * pt); const unsigned z0 = (unsigned)zz, z1 = (unsigned)(zz >> 32);
                    f4 v = Y[r4][pt]; v[0] *= silu_f(__uint_as_float(z0 << 16)); v[1] *= silu_f(__uint_as_float(z0 & 0xffff0000u)); v[2] *= silu_f(__uint_as_float(z1 << 16)); v[3] *= silu_f(__uint_as_float(z1 & 0xffff0000u));
                    Y[r4][pt] = v; ss += (v[0] * v[0] + v[1] * v[1]) + (v[2] * v[2] + v[3] * v[3]); }
            ss += __shfl_xor(ss, 16); ss += __shfl_xor(ss, 32);
            const float rr = rsqrtf(ss * (1.f / 256.f) + EPS);
#pragma unroll
            for (int r4 = 0; r4 < 4; ++r4)
#pragma unroll
                for (int pt = 0; pt < 4; ++pt) { const f4 gn = *(const f4*)(p.ssm_norm_g + g * 256 + r4 * 64 + 16 * pt + 4 * fg); const f4 v = Y[r4][pt] * rr * gn;
                    *(unsigned long long*)(zr + r4 * 64 + 16 * pt) = (unsigned long long)pg8::cvt_pk_bf16(v[0], v[1]) | ((unsigned long long)pg8::cvt_pk_bf16(v[2], v[3]) << 32); }
        }
        if (BOTH(6)) xcd_barrier(bar);
        PH_END(6);
    }

    if (IN(7)) { PH_BEGIN();
        pg8::DenseOrder S; S.init(ws + WS_ZQ, ws + WS_WOUT_T, M, D, 2048, G, bx);
        EpiOut E{p.x, p.out, modv};
        pg8::gemm_phase<EpiOut, pg8::DenseOrder, true, true>(lds + RING_OFF, 2048, S, E);
        if (BOTH(7)) xcd_barrier(bar);
        PH_END(7);
    }

    if (IN(8)) { PH_BEGIN();
        typedef pg8::bf16x8 bf16x8; typedef pg8::f32x4 f4;
        LAS float* part = (LAS float*)(lds + RING_OFF);
        LAS float* red = (LAS float*)(lds + RING_OFF + 131072);
        LAS int* cnt_l = (LAS int*)(lds + RING_OFF + 133120);
        LAS int* base_l = (LAS int*)(lds + RING_OFF + 133376);
        LAS int* asg_e = (LAS int*)(lds + RING_OFF + 133632);
        LAS int* asg_pos = (LAS int*)(lds + RING_OFF + 135680);
        LAS float* asg_g = (LAS float*)(lds + RING_OFF + 137728);
        bf16_t* h2 = (bf16_t*)(ws + WS_H2); int* eidx = (int*)(ws + WS_EIDX); float* eg = (float*)(ws + WS_EGATE); int* cnt = (int*)(ws + WS_CTL) + CW_CNT; int* list = (int*)(ws + WS_LIST); float* glist = (float*)(ws + WS_GLIST);
        const v4u* rwf = (const v4u*)(ws + WS_RWF);
        const float rbias = p.router_bias[lane];
        const int fr = lane & 15, fq = lane >> 4;
        for (int grp = bx; grp < M / 64; grp += G) {
            const int b = (grp * 64) / SEQ;
            __syncthreads();
            if (tid < NE) cnt_l[tid] = 0;
#pragma unroll 1
            for (int half = 0; half < 2; ++half) {
            f4 xv[2][4][2];
#pragma unroll
            for (int tile = 0; tile < 2; ++tile) { const float* xr = p.out + (size_t)(grp * 64 + half * 32 + tile * 16 + fr) * D + 128 * wave + 8 * fq;
#pragma unroll
                for (int kk = 0; kk < 4; ++kk) { xv[tile][kk][0] = *(const f4*)(xr + 32 * kk); xv[tile][kk][1] = *(const f4*)(xr + 32 * kk + 4); } }
#pragma unroll
            for (int tile = 0; tile < 2; ++tile) { float ss = 0.f;
#pragma unroll
                for (int kk = 0; kk < 4; ++kk)
#pragma unroll
                    for (int hf = 0; hf < 2; ++hf) { const f4 v = xv[tile][kk][hf]; ss += (v[0] * v[0] + v[1] * v[1]) + (v[2] * v[2] + v[3] * v[3]); }
                ss += __shfl_xor(ss, 16); ss += __shfl_xor(ss, 32);
                if (fq == 0) red[(tile * 8 + wave) * 16 + fr] = ss; }
            __syncthreads();
            float rstd2[2]; f4 acc[2][4];
#pragma unroll
            for (int tile = 0; tile < 2; ++tile) { float tot = 0.f;
#pragma unroll
                for (int w2 = 0; w2 < 8; ++w2) tot += red[(tile * 8 + w2) * 16 + fr];
                rstd2[tile] = rsqrtf(tot * (1.f / D) + EPS);
#pragma unroll
                for (int nt = 0; nt < 4; ++nt) acc[tile][nt] = (f4){0.f, 0.f, 0.f, 0.f}; }
#pragma unroll
            for (int kk = 0; kk < 4; ++kk) { const int d = 128 * wave + 32 * kk + 8 * fq;
                f4 gm[2], sm[2];
#pragma unroll
                for (int hf = 0; hf < 2; ++hf) { gm[hf] = *(const f4*)(p.norm2_g + d + 4 * hf) * (*(const f4*)(modv + b * 6 * D + 4 * D + d + 4 * hf) + 1.f); sm[hf] = *(const f4*)(modv + b * 6 * D + 3 * D + d + 4 * hf); }
                union { bf16x8 v; v4u q; } Rh[4], Rl[4];
#pragma unroll
                for (int nt = 0; nt < 4; ++nt) { const int fi = (((4 * wave + kk) * 4 + nt) * 2) * 64 + lane; Rh[nt].q = rwf[fi]; Rl[nt].q = rwf[fi + 64]; }
#pragma unroll
                for (int tile = 0; tile < 2; ++tile) { const int row = grp * 64 + half * 32 + tile * 16 + fr;
                    union { bf16x8 v; unsigned u[4]; v4u q; } Hh, Hl;
#pragma unroll
                    for (int hf = 0; hf < 2; ++hf) { const f4 h = xv[tile][kk][hf] * rstd2[tile] * gm[hf] + sm[hf];
                        const unsigned h01 = pk2(h[0], h[1]), h23 = pk2(h[2], h[3]);
                        Hh.u[2 * hf] = h01; Hh.u[2 * hf + 1] = h23;
                        Hl.u[2 * hf] = pk2(h[0] - __uint_as_float(h01 << 16), h[1] - __uint_as_float(h01 & 0xffff0000u)); Hl.u[2 * hf + 1] = pk2(h[2] - __uint_as_float(h23 << 16), h[3] - __uint_as_float(h23 & 0xffff0000u)); }
                    *(v4u*)(h2 + (size_t)row * D + d) = Hh.q;
#pragma unroll
                    for (int nt = 0; nt < 4; ++nt) {
                        acc[tile][nt] = __builtin_amdgcn_mfma_f32_16x16x32_bf16(Hh.v, Rh[nt].v, acc[tile][nt], 0, 0, 0);
                        acc[tile][nt] = __builtin_amdgcn_mfma_f32_16x16x32_bf16(Hh.v, Rl[nt].v, acc[tile][nt], 0, 0, 0);
                        acc[tile][nt] = __builtin_amdgcn_mfma_f32_16x16x32_bf16(Hl.v, Rh[nt].v, acc[tile][nt], 0, 0, 0); } }
                asm volatile("" ::: "memory"); }
#pragma unroll
            for (int tile = 0; tile < 2; ++tile)
#pragma unroll
                for (int nt = 0; nt < 4; ++nt)
#pragma unroll
                    for (int j = 0; j < 4; ++j) part[((tile * 8 + wave) * 16 + 4 * fq + j) * 64 + 16 * nt + fr] = acc[tile][nt][j];
            __syncthreads();
#pragma unroll 1
            for (int rr = 0; rr < 4; ++rr) { const int lr32 = 4 * wave + rr, tile = lr32 >> 4, lr = lr32 & 15, lr64 = half * 32 + lr32, m = grp * 64 + lr64;
                float lg = 0.f;
#pragma unroll
                for (int w2 = 0; w2 < 8; ++w2) lg += part[((tile * 8 + w2) * 16 + lr) * 64 + lane];
                const float sc = 1.f / (1.f + __expf(-lg)), sel = sc + rbias;
                float m1 = sel, m2 = -INFINITY;
#pragma unroll
                for (int o = 1; o < 8; o <<= 1) { const float p1 = __shfl_xor(m1, o), p2 = __shfl_xor(m2, o); const float n1 = fmaxf(m1, p1), n2 = fmaxf(fminf(m1, p1), fmaxf(m2, p2)); m1 = n1; m2 = n2; }
                const float gs = m1 + m2; const int myg = lane >> 3;
                unsigned gk = __float_as_uint(gs); gk = (gk & 0x80000000u) ? ~gk : (gk | 0x80000000u); gk = (gk & ~7u) | (unsigned)(7 - myg);
                int grank = 0;
#pragma unroll
                for (int g2 = 0; g2 < 8; ++g2) grank += (__builtin_amdgcn_readlane(gk, g2 * 8) > gk) ? 1 : 0;
                const bool allowed = grank < 4;
                unsigned ek = __float_as_uint(sel); ek = (ek & 0x80000000u) ? ~ek : (ek | 0x80000000u); ek = allowed ? ((ek & ~63u) | (unsigned)(63 - lane)) : 0u;
                int rank = 0;
#pragma unroll
                for (int e2 = 0; e2 < NE; ++e2) rank += (__builtin_amdgcn_readlane(ek, e2) > ek) ? 1 : 0;
                const bool selb = allowed && rank < TOPK;
                const float wsum = wave_sum(selb ? sc : 0.f);
                if (selb) { const int a = m * 8 + rank; eidx[a] = lane; const float gate = sc / wsum * 2.5f; eg[a] = gate; const int pl = __hip_atomic_fetch_add(cnt_l + lane, 1, __ATOMIC_RELAXED, __HIP_MEMORY_SCOPE_WORKGROUP); const int i = lr64 * 8 + rank; asg_e[i] = lane; asg_pos[i] = pl; asg_g[i] = gate; }
            }
            __syncthreads();
            }
            if (tid < NE) { const int c = cnt_l[tid]; base_l[tid] = c > 0 ? atomicAdd(&cnt[tid], c) : 0; }
            __syncthreads();
            { const int e = asg_e[tid]; const size_t li = (size_t)e * M + base_l[e] + asg_pos[tid]; list[li] = (grp * 64 + (tid >> 3)) * 8 + (tid & 7); glist[li] = asg_g[tid]; }
        }
        if (BOTH(8)) xcd_barrier(bar);
        PH_END(8);
    }

    LAS int* plan = (LAS int*)(lds + PLAN_OFF);
#define MAKE_PLAN() do { __syncthreads(); if (tid <= NE) plan[80 + tid] = tid < NE ? (int)__hip_atomic_load((const int*)(ws + WS_CTL) + CW_CNT + tid, RLX_AGENT) : M; __syncthreads(); \
        if (tid == 0) { int off = 0; for (int e = 0; e <= NE; ++e) { plan[e] = off; off += (plan[80 + e] + 255) >> 8; } plan[NE + 1] = off; } __syncthreads(); } while (0)
    if (IN(9)) { PH_BEGIN();
        MAKE_PLAN();
        GroupedOrder<true> S; S.init(ws + WS_H2, ws + WS_WGU, D, 2, G, bx, plan, (const int*)(ws + WS_LIST), (size_t)512 * D * 2, (size_t)256 * D * 2, 0);
        EpiGU E{(bf16_t*)(ws + WS_U)};
        pg8::gemm_phase<EpiGU, GroupedOrder<true>, true, true>(lds + RING_OFF, D, S, E);
        if (BOTH(9)) xcd_barrier(bar);
        PH_END(9);
    }
#define DOWN_PHASE(k, half) if (IN(k)) { PH_BEGIN(); MAKE_PLAN(); \
        GroupedOrder<false> S; S.init(ws + WS_U, ws + WS_WD, ED, 2, G, bx, plan, (const int*)(ws + WS_LIST), (size_t)D * ED * 2, (size_t)256 * ED * 2, 2 * (half)); \
        EpiDown E{(bf16_t*)(ws + WS_YC), (const int*)(ws + WS_LIST), (const float*)(ws + WS_GLIST)}; \
        pg8::gemm_phase<EpiDown, GroupedOrder<false>, true, true>(lds + RING_OFF, ED, S, E); \
        if (BOTH(k)) xcd_barrier(bar); PH_END(k); }
    DOWN_PHASE(10, 0)
    if (IN(11)) { PH_BEGIN();
        const bf16_t* yc = (const bf16_t*)(ws + WS_YC);
        for (int i = bx * 512 + tid; i < M * 64; i += G * 512) { const int tok = i >> 6, c8 = (i & 63) * 8, b = tok / SEQ;
            float s[8] = {0.f, 0.f, 0.f, 0.f, 0.f, 0.f, 0.f, 0.f};
#pragma unroll
            for (int k = 0; k < NSLOT; ++k) { const v4u raw = *(const v4u*)(yc + ((size_t)tok * NSLOT + k) * 512 + c8); const unsigned w4[4] = {raw.x, raw.y, raw.z, raw.w};
#pragma unroll
                for (int j = 0; j < 4; ++j) { s[2 * j] += __uint_as_float(w4[j] << 16); s[2 * j + 1] += __uint_as_float(w4[j] & 0xffff0000u); } }
            float* xo = p.out + (size_t)tok * D + c8; const float* g2 = modv + b * 6 * D + 5 * D + c8;
            f32x4 x0 = *(f32x4*)xo, x1v = *(f32x4*)(xo + 4);
            x0 = x0 + *(const f32x4*)g2 * (f32x4){s[0], s[1], s[2], s[3]}; x1v = x1v + *(const f32x4*)(g2 + 4) * (f32x4){s[4], s[5], s[6], s[7]};
            *(f32x4*)xo = x0; *(f32x4*)(xo + 4) = x1v; }
        if (BOTH(11)) xcd_barrier(bar);
        PH_END(11);
    }
    DOWN_PHASE(12, 1)
    if (IN(13)) { PH_BEGIN();
        const bf16_t* yc = (const bf16_t*)(ws + WS_YC);
        for (int m = gw; m < M; m += NGW) { const int b = m / SEQ, c8 = lane * 8;
            float s[8] = {0.f, 0.f, 0.f, 0.f, 0.f, 0.f, 0.f, 0.f};
#pragma unroll
            for (int k = 0; k < NSLOT; ++k) { const v4u raw = *(const v4u*)(yc + ((size_t)m * NSLOT + k) * 512 + c8); const unsigned w4[4] = {raw.x, raw.y, raw.z, raw.w};
#pragma unroll
                for (int j = 0; j < 4; ++j) { s[2 * j] += __uint_as_float(w4[j] << 16); s[2 * j + 1] += __uint_as_float(w4[j] & 0xffff0000u); } }
            float* xo = p.out + (size_t)m * D; const float* g2 = modv + b * 6 * D + 5 * D + 512 + c8;
            f32x4 a0 = *(f32x4*)(xo + c8), a1 = *(f32x4*)(xo + c8 + 4), b0 = *(f32x4*)(xo + 512 + c8), b1 = *(f32x4*)(xo + 512 + c8 + 4);
            b0 = b0 + *(const f32x4*)g2 * (f32x4){s[0], s[1], s[2], s[3]}; b1 = b1 + *(const f32x4*)(g2 + 4) * (f32x4){s[4], s[5], s[6], s[7]};
            float ss = (a0.x * a0.x + a0.y * a0.y) + (a0.z * a0.z + a0.w * a0.w) + (a1.x * a1.x + a1.y * a1.y) + (a1.z * a1.z + a1.w * a1.w)
                     + (b0.x * b0.x + b0.y * b0.y) + (b0.z * b0.z + b0.w * b0.w) + (b1.x * b1.x + b1.y * b1.y) + (b1.z * b1.z + b1.w * b1.w);
            const float rstd = rsqrtf(wave_sum(ss) * (1.f / D) + EPS);
            const float* fg = p.final_g;
            *(f32x4*)(xo + c8) = a0 * rstd * *(const f32x4*)(fg + c8); *(f32x4*)(xo + c8 + 4) = a1 * rstd * *(const f32x4*)(fg + c8 + 4);
            *(f32x4*)(xo + 512 + c8) = b0 * rstd * *(const f32x4*)(fg + 512 + c8); *(f32x4*)(xo + 512 + c8 + 4) = b1 * rstd * *(const f32x4*)(fg + 512 + c8 + 4); }
        PH_END(13);
    }
#undef IN
#undef BOTH
}

extern "C" void kernel_launch(void* const* d_in, const int* in_sizes, int n_in, void* d_out, int out_size, void* d_ws, size_t ws_size, hipStream_t stream) {
    static int grid = 0;
    if (grid == 0) {
        int dev = 0, cus = 0;
        if (hipGetDevice(&dev) != hipSuccess || hipDeviceGetAttribute(&cus, hipDeviceAttributeMultiprocessorCount, dev) != hipSuccess) { fprintf(stderr, "device query failed\n"); grid = -1; return; }
        if (hipFuncSetAttribute((const void*)mega, hipFuncAttributeMaxDynamicSharedMemorySize, LDS_BYTES) != hipSuccess) { fprintf(stderr, "hipFuncSetAttribute failed\n"); grid = -1; return; }
        int per_cu = 0;
        if (hipOccupancyMaxActiveBlocksPerMultiprocessor(&per_cu, (const void*)mega, NWAVES * 64, LDS_BYTES) != hipSuccess || per_cu < 1) fprintf(stderr, "occupancy query: %d\n", per_cu);
        (void)hipGetLastError();
        grid = cus;
        if (ws_size < WS_END) fprintf(stderr, "ws too small: %zu < %zu\n", ws_size, (size_t)WS_END);
    }
    if (grid < 0) return;
    P p{};
    const float** f = (const float**)&p;
    for (int i = 0; i < 26; ++i) f[i] = (const float*)d_in[i];
    p.out = (float*)d_out; p.ws = (unsigned char*)d_ws;
    (void)hipMemsetAsync(p.ws + WS_CTL, 0, CTL_BYTES, stream);
    p.ph_lo = 0; p.ph_hi = NPHASE; p.li = 0;
    hipLaunchKernelGGL(mega, dim3(grid), dim3(NWAVES * 64), LDS_BYTES, stream, p);
}
```

```cpp
#include <hip/hip_runtime.h>
#include <stdint.h>
#include <stdio.h>

typedef unsigned short bf16_t;

constexpr int D = 1024, BATCH = 4, SEQ = 4096, M = BATCH * SEQ;
constexpr int D_SSM = 1024, SSM_HEADS = 16, SSM_GROUPS = 4, D_STATE = 128, CONV_K = 4, CONV_CH = 2048, CHUNK = 128, NCHUNK = SEQ / CHUNK;
constexpr int HD = 64, ATT_HEADS = 16, KV_HEADS = 4, D_KV = 256, WINDOW = 128;
constexpr int IN_COLS = 4624;
constexpr int C_Z = 0, C_XBC = 1024, C_DT = 3072, C_Q = 3088, C_K = 4112, C_V = 4368;
constexpr int NE = 64, TOPK = 8, ED = 256;
constexpr float EPS = 1e-6f;
constexpr int NSLOT = 9;
constexpr int NWIN = 4864;

constexpr size_t MiB = 1u << 20;
constexpr size_t WS_CTL = 0;
constexpr size_t CTL_BYTES = 64 * 1024;
constexpr int CW_CNT = 0;
constexpr int CW_BAR = 4096;
constexpr size_t WS_MOD = 1 * MiB;
constexpr size_t WS_RWF = 1 * MiB + 256 * 1024;
constexpr size_t WS_EIDX = 2 * MiB;
constexpr size_t WS_EGATE = 3 * MiB;
constexpr size_t WS_LIST = 4 * MiB;
constexpr size_t WS_WIN_T = 8 * MiB;
constexpr size_t WS_WOUT_T = 18 * MiB;
constexpr size_t WS_SSQ = 22 * MiB;
constexpr size_t WS_ZQ = 24 * MiB;
constexpr size_t WS_XBC = 88 * MiB;
constexpr size_t WS_K = 152 * MiB;
constexpr size_t WS_V = 160 * MiB;
constexpr size_t WS_DT = 168 * MiB;
constexpr size_t WS_CS = 169 * MiB;
constexpr size_t WS_ST = 170 * MiB;
constexpr size_t WS_H2 = 170 * MiB;
constexpr size_t WS_WGU = 202 * MiB;
constexpr size_t WS_YC = 104 * MiB;
constexpr size_t WS_U = 24 * MiB;
constexpr size_t WS_WD = 267 * MiB;
constexpr size_t WS_GLIST = 300 * MiB;
constexpr size_t WS_END = 304 * MiB;
constexpr int UROWS_MAX = 163840;

__device__ __forceinline__ float bf2f(bf16_t v) { return __uint_as_float(((unsigned)v) << 16); }
__device__ __forceinline__ bf16_t f2bf(float f) { unsigned u = __float_as_uint(f); return (bf16_t)((u + 0x7fffu + ((u >> 16) & 1u)) >> 16); }
__device__ __forceinline__ unsigned pk2(float lo, float hi) { return (unsigned)f2bf(lo) | ((unsigned)f2bf(hi) << 16); }
__device__ __forceinline__ float silu_f(float x) { return x * __builtin_amdgcn_rcpf(1.f + __expf(-x)); }
__device__ __forceinline__ float softplus_f(float x) { return x > 20.f ? x : log1pf(__expf(x)); }

__constant__ int c_bucket[128] = {0, 1, 2, 3, 4, 5, 6, 7, 8, 9, 10, 11, 12, 13, 14, 15, 16, 16, 16, 17, 17, 18, 18, 18, 19, 19, 19, 20, 20, 20, 20, 21, 21, 21, 21, 22, 22, 22, 22, 22, 23, 23, 23, 23, 23, 23, 24, 24, 24, 24, 24, 24, 25, 25, 25, 25, 25, 25, 25, 26, 26, 26, 26, 26, 26, 26, 26, 27, 27, 27, 27, 27, 27, 27, 27, 27, 27, 28, 28, 28, 28, 28, 28, 28, 28, 28, 28, 29, 29, 29, 29, 29, 29, 29, 29, 29, 29, 29, 29, 30, 30, 30, 30, 30, 30, 30, 30, 30, 30, 30, 30, 30, 30, 31, 31, 31, 31, 31, 31, 31, 31, 31, 31, 31, 31, 31, 31, 31};

struct P {
    const float *x, *c, *mod_w, *mod_b, *norm1_g, *norm2_g, *w_in, *conv_w, *conv_b, *dt_bias, *a_log, *d_skip, *ssm_norm_g, *att_norm_g, *sinks, *rel_bias,
        *w_out, *router_w, *router_bias, *exp_w_gate, *exp_w_up, *exp_w_down, *sh_w_gate, *sh_w_up, *sh_w_down, *final_g;
    float* out; unsigned char* ws;
    int ph_lo, ph_hi, li, pad;
};

namespace pg8 {
#define PG8_LAS __attribute__((address_space(3)))
typedef short bf16x8 __attribute__((ext_vector_type(8)));
typedef float f32x4 __attribute__((ext_vector_type(4)));
typedef unsigned u32x4 __attribute__((ext_vector_type(4)));
constexpr int BM = 256, BK = 64, HALF = 128, HTB = HALF * BK * 2  , STAGE_BYTES = 8 * HTB, NXCD = 8, WGM = 8;

__host__ __device__ __forceinline__ int lds_byte(int r, int c) { const int st = (r >> 4) * 2 + (c >> 5), rr = r & 15, cc = c & 31, ob = rr * 64 + cc * 2; return st * 1024 + (ob ^ (((ob >> 9) & 1) << 5)); }
__host__ __device__ __forceinline__ void stage_rc(int b, int& R, int& C) { const int st = b / 1024, sb = b % 1024, swz = sb ^ (((sb >> 9) & 1) << 5); R = (st >> 1) * 16 + swz / 64; C = (st & 1) * 32 + (swz % 64) / 2; }
__host__ __device__ __forceinline__ int perm32(int rho) { const int n = rho >> 4, i = rho & 15; return 8 * (i >> 2) + 4 * n + (i & 3); }

struct Unit { int pm, pn, e, nrows, lt; };

__device__ __forceinline__ unsigned cvt_pk_bf16(float lo, float hi) { unsigned r; asm volatile("v_cvt_pk_bf16_f32 %0, %1, %2" : "=v"(r) : "v"(lo), "v"(hi)); return r; }

struct DenseOrder {
    typedef pg8::Unit Unit;
    const char* A; const char* Bt; int K; int nM, nN, nwg, G, c;
    __device__ __forceinline__ void init(const void* A_, const void* Bt_, int M_, int N_, int K_, int G_, int c_) { A = (const char*)A_; Bt = (const char*)Bt_; K = K_; nM = M_ / BM; nN = N_ / BM; nwg = nM * nN; G = G_; c = c_; }
    __device__ __forceinline__ bool next(int i, Unit& u) const {
        const long L = (long)i * G + c; if (L >= nwg) return false;
        int wgid = (int)L; { const int q = nwg / NXCD, r = nwg % NXCD, xcd = wgid % NXCD, off = wgid / NXCD; wgid = (xcd < r ? xcd * (q + 1) : r * (q + 1) + (xcd - r) * q) + off; }
        const int nig = WGM * nN, gid = wgid / nig, fm = gid * WGM, gsz = (nM - fm) < WGM ? (nM - fm) : WGM;
        u.pm = fm + ((wgid % nig) % gsz); u.pn = (wgid % nig) / gsz; u.e = 0; u.nrows = 256; u.lt = 0; return true;
    }
    __device__ __forceinline__ const char* a_base(const Unit& u) const { return A + (size_t)u.pm * 512 * K; }
    __device__ __forceinline__ const char* b_base(const Unit& u) const { return Bt + (size_t)u.pn * 512 * K; }
    __device__ __forceinline__ void lane_off(const Unit&, const int (&R)[2], const int (&C)[2], unsigned (&o)[2][2]) const {
#pragma unroll
        for (int h = 0; h < 2; ++h)
#pragma unroll
            for (int i = 0; i < 2; ++i) o[h][i] = (unsigned)(((h * HALF + R[i]) * K + C[i]) * 2);
    }
    __device__ __forceinline__ void a_ready(const Unit&) const {}
    __device__ __forceinline__ void done(const Unit&) const {}
};

template <class Epi, class Sched, bool ALIGN_EPI = false, bool SP2 = false>
__device__ __forceinline__ void gemm_phase(PG8_LAS unsigned char* lds, const int K, const Sched& S, const Epi& E) {
    typedef typename Sched::Unit Unit;
    const int tid = threadIdx.x, wid = __builtin_amdgcn_readfirstlane(tid >> 6), lane = tid & 63, wr = wid >> 2, wc = wid & 3, fr = lane & 15, fq = lane >> 4;
    const int nt = K / BK;
    unsigned voffB[2]; int stR[2], stC[2];
#pragma unroll
    for (int i = 0; i < 2; ++i) { int R, C; stage_rc(tid * 16 + i * 8192, R, C); const int Rb = Epi::PERM ? ((R & ~31) + perm32(R & 31)) : R;
        stR[i] = R; stC[i] = C; voffB[i] = (unsigned)(Rb * K + C) * 2u; }
    const size_t kstep = (size_t)(BK * 2);
    const size_t hstep = (size_t)HALF * K * 2;
    const size_t tstep = 2 * hstep;
    const unsigned ldsw = (unsigned)wid * 1024u;
    const int aoff = lds_byte(wr * 64 + fr, fq * 8), boff = lds_byte(wc * 32 + fr, fq * 8);
#define PG8_SA(b, h) (((b) * 2 + (h)) * HTB)
#define PG8_SB(b, h) ((4 + (b) * 2 + (h)) * HTB)
#define PG8_STAGE(bufoff, gbase, voff) do { _Pragma("unroll") for (int _i = 0; _i < 2; ++_i) \
        __builtin_amdgcn_global_load_lds((const unsigned*)((const char*)(gbase) + (voff)[_i]), (PG8_LAS unsigned*)(lds + (bufoff) + ldsw + _i * 8192), 16, 0, 0); } while (0)
#define PG8_LDA(dst, b, h) do { _Pragma("unroll") for (int m = 0; m < 4; ++m) _Pragma("unroll") for (int k = 0; k < 2; ++k) dst[m][k] = *(const PG8_LAS bf16x8*)(lds + PG8_SA(b, h) + aoff + m * 2048 + k * 1024); } while (0)
#define PG8_LDB(dst, b, h) do { _Pragma("unroll") for (int n = 0; n < 2; ++n) _Pragma("unroll") for (int k = 0; k < 2; ++k) dst[n][k] = *(const PG8_LAS bf16x8*)(lds + PG8_SB(b, h) + boff + n * 2048 + k * 1024); } while (0)
#define PG8_MMA(ai, bj, At, Bt) do { __builtin_amdgcn_s_setprio(1); _Pragma("unroll") for (int m = 0; m < 4; ++m) _Pragma("unroll") for (int n = 0; n < 2; ++n) _Pragma("unroll") for (int k = 0; k < 2; ++k) \
        acc[ai][bj][m][n] = __builtin_amdgcn_mfma_f32_16x16x32_bf16(Bt[n][k], At[m][k], acc[ai][bj][m][n], 0, 0, 0); __builtin_amdgcn_s_setprio(0); } while (0)
#define PG8_WAIT_V(n) asm volatile("s_waitcnt vmcnt(" #n ")" ::: "memory")
#define PG8_WAIT_L(n) asm volatile("s_waitcnt lgkmcnt(" #n ")" ::: "memory")
#define PG8_BAR __builtin_amdgcn_s_barrier()
#define PG8_SCHED __builtin_amdgcn_sched_barrier(0)
    Unit cur, nxt; int ui = 0;
    if (!S.next(0, cur)) return;
    f32x4 acc[2][2][4][2];
#pragma unroll
    for (int a = 0; a < 2; ++a)
#pragma unroll
        for (int b = 0; b < 2; ++b)
#pragma unroll
            for (int m = 0; m < 4; ++m)
#pragma unroll
                for (int n = 0; n < 2; ++n) acc[a][b][m][n] = (f32x4){0.f, 0.f, 0.f, 0.f};
    bf16x8 At[4][2], B0[2][2], B1[2][2];
    const char* cA = S.a_base(cur); const char* cB = S.b_base(cur);
    unsigned oc[2][2], on[2][2];
    S.lane_off(cur, stR, stC, oc);
    S.a_ready(cur);
    if constexpr (SP2) {
        PG8_STAGE(PG8_SB(0, 0), cB, voffB); PG8_STAGE(PG8_SB(0, 1), cB + hstep, voffB); PG8_STAGE(PG8_SA(0, 0), cA, oc[0]); PG8_STAGE(PG8_SA(0, 1), cA, oc[1]);
        if (wr == 1) PG8_BAR;
        PG8_WAIT_V(2); PG8_BAR;
        PG8_STAGE(PG8_SB(1, 0), cB + kstep, voffB); PG8_STAGE(PG8_SA(1, 0), cA + kstep, oc[0]); PG8_STAGE(PG8_SB(1, 1), cB + hstep + kstep, voffB);
        PG8_WAIT_V(6); PG8_BAR;
    } else {
        PG8_STAGE(PG8_SB(0, 0), cB, voffB); PG8_STAGE(PG8_SA(0, 0), cA, oc[0]); PG8_STAGE(PG8_SB(0, 1), cB + hstep, voffB); PG8_STAGE(PG8_SA(0, 1), cA, oc[1]);
        if (wr == 1) PG8_BAR;
        PG8_WAIT_V(4); PG8_BAR;
        PG8_STAGE(PG8_SB(1, 0), cB + kstep, voffB); PG8_STAGE(PG8_SA(1, 0), cA + kstep, oc[0]); PG8_STAGE(PG8_SB(1, 1), cB + hstep + kstep, voffB);
        PG8_WAIT_V(6); PG8_BAR;
    }
    for (;;) {
        const bool has_next = S.next(ui + 1, nxt);
        const char* nA = has_next ? S.a_base(nxt) : cA; const char* nB = has_next ? S.b_base(nxt) : cB;
        if (has_next) S.lane_off(nxt, stR, stC, on); else {
#pragma unroll
            for (int h = 0; h < 2; ++h)
#pragma unroll
                for (int i = 0; i < 2; ++i) on[h][i] = oc[h][i]; }
#pragma unroll 1
        for (int t = 0; t < nt; t += 2) {
            const bool last = (t == nt - 2);
            const char* a1 = cA + (size_t)(t + 1) * kstep;
            const char* a2 = last ? nA : cA + (size_t)(t + 2) * kstep; const char* b2 = last ? nB : cB + (size_t)(t + 2) * kstep;
            const char* a3 = a2 + kstep; const char* b3 = b2 + kstep;
            unsigned o2[2][2];
#pragma unroll
            for (int h = 0; h < 2; ++h)
#pragma unroll
                for (int i = 0; i < 2; ++i) o2[h][i] = last ? on[h][i] : oc[h][i];
            if (last && has_next) S.a_ready(nxt);
            if constexpr (SP2) {
            PG8_LDB(B0, 0, 0); PG8_LDB(B1, 0, 1); PG8_SCHED; PG8_LDA(At, 0, 0); PG8_STAGE(PG8_SA(1, 1), a1, oc[1]);
            PG8_WAIT_V(8); PG8_WAIT_L(0); PG8_BAR; PG8_MMA(0, 0, At, B0); PG8_MMA(0, 1, At, B1); PG8_BAR; PG8_SCHED;
            PG8_LDA(At, 0, 1); PG8_STAGE(PG8_SB(0, 0), b2, voffB); PG8_STAGE(PG8_SB(0, 1), b2 + hstep, voffB); PG8_STAGE(PG8_SA(0, 0), a2, o2[0]);
            PG8_WAIT_V(8); PG8_WAIT_L(0); PG8_BAR; PG8_MMA(1, 0, At, B0); PG8_MMA(1, 1, At, B1); PG8_BAR; PG8_SCHED;
            PG8_LDB(B0, 1, 0); PG8_LDB(B1, 1, 1); PG8_SCHED; PG8_LDA(At, 1, 0); PG8_STAGE(PG8_SA(0, 1), a2, o2[1]);
            PG8_WAIT_V(8); PG8_WAIT_L(0); PG8_BAR; PG8_MMA(0, 0, At, B0); PG8_MMA(0, 1, At, B1); PG8_BAR; PG8_SCHED;
            PG8_LDA(At, 1, 1); PG8_STAGE(PG8_SB(1, 0), b3, voffB); PG8_STAGE(PG8_SB(1, 1), b3 + hstep, voffB); PG8_STAGE(PG8_SA(1, 0), a3, o2[0]);
            PG8_WAIT_V(8); PG8_WAIT_L(0); PG8_BAR; PG8_MMA(1, 0, At, B0); PG8_MMA(1, 1, At, B1); PG8_BAR; PG8_SCHED;
            } else {
            PG8_LDB(B0, 0, 0); PG8_SCHED; PG8_LDA(At, 0, 0); PG8_STAGE(PG8_SA(1, 1), a1, oc[1]);
            PG8_WAIT_L(8); PG8_BAR; PG8_WAIT_L(0); PG8_MMA(0, 0, At, B0); PG8_BAR; PG8_SCHED;
            PG8_LDB(B1, 0, 1); PG8_STAGE(PG8_SB(0, 0), b2, voffB);
            PG8_BAR; PG8_WAIT_L(0); PG8_MMA(0, 1, At, B1); PG8_BAR;
            PG8_LDA(At, 0, 1); PG8_STAGE(PG8_SA(0, 0), a2, o2[0]);
            PG8_BAR; PG8_WAIT_L(0); PG8_MMA(1, 0, At, B0); PG8_BAR; PG8_SCHED;
            PG8_STAGE(PG8_SB(0, 1), b2 + hstep, voffB);
            PG8_WAIT_V(6); PG8_BAR; PG8_MMA(1, 1, At, B1); PG8_BAR;
            PG8_LDB(B0, 1, 0); PG8_SCHED; PG8_LDA(At, 1, 0); PG8_STAGE(PG8_SA(0, 1), a2, o2[1]);
            PG8_WAIT_L(8); PG8_BAR; PG8_WAIT_L(0); PG8_MMA(0, 0, At, B0); PG8_BAR; PG8_SCHED;
            PG8_LDB(B1, 1, 1); PG8_STAGE(PG8_SB(1, 0), b3, voffB);
            PG8_BAR; PG8_WAIT_L(0); PG8_MMA(0, 1, At, B1); PG8_BAR;
            PG8_LDA(At, 1, 1); PG8_STAGE(PG8_SA(1, 0), a3, o2[0]);
            PG8_BAR; PG8_WAIT_L(0); PG8_MMA(1, 0, At, B0); PG8_BAR; PG8_SCHED;
            PG8_STAGE(PG8_SB(1, 1), b3 + hstep, voffB);
            PG8_WAIT_V(6); PG8_BAR; PG8_MMA(1, 1, At, B1); PG8_BAR;
            }
        }
        if constexpr (ALIGN_EPI) { if (wr == 0) PG8_BAR; }
        if constexpr (!Epi::AFTER_DRAIN) { E(acc, cur, wr, wc, fr, fq); S.done(cur); }
        if (!has_next) break;
#pragma unroll
        for (int a = 0; a < 2; ++a)
#pragma unroll
            for (int b = 0; b < 2; ++b)
#pragma unroll
                for (int m = 0; m < 4; ++m)
#pragma unroll
                    for (int n = 0; n < 2; ++n) acc[a][b][m][n] = (f32x4){0.f, 0.f, 0.f, 0.f};
        cur = nxt; cA = nA; cB = nB; ++ui;
#pragma unroll
        for (int h = 0; h < 2; ++h)
#pragma unroll
            for (int i = 0; i < 2; ++i) oc[h][i] = on[h][i];
        if constexpr (ALIGN_EPI) { if (wr == 1) PG8_BAR; }
    }
    PG8_WAIT_V(0);
    if constexpr (!ALIGN_EPI) { if (wr == 0) PG8_BAR; }
    PG8_BAR;
    if constexpr (Epi::AFTER_DRAIN) { E.fused(acc, cur, wr, wc, fr, fq, lds, wid, lane); S.done(cur); }
#undef PG8_SA
#undef PG8_SB
#undef PG8_STAGE
#undef PG8_LDA
#undef PG8_LDB
#undef PG8_MMA
#undef PG8_WAIT_V
#undef PG8_WAIT_L
#undef PG8_BAR
#undef PG8_SCHED
}
}

#define GAS __attribute__((address_space(1)))
#define LAS __attribute__((address_space(3)))
typedef unsigned v4u __attribute__((ext_vector_type(4)));
typedef float f32x4 __attribute__((ext_vector_type(4)));
typedef GAS unsigned gu32;
#define RLX_AGENT __ATOMIC_RELAXED, __HIP_MEMORY_SCOPE_AGENT
#define LDS_WAIT() asm volatile("s_waitcnt lgkmcnt(0)" ::: "memory")
#define VM_WAIT() asm volatile("s_waitcnt vmcnt(0)" ::: "memory")
constexpr int NWAVES = 8;
constexpr int RING_OFF = 0, RING_BYTES = 131072;
constexpr int LDS_BYTES = 163840;
constexpr int LDSCTL_OFF = LDS_BYTES - 4096, MISC_OFF = LDSCTL_OFF + 320;
constexpr int PLAN_OFF = LDSCTL_OFF + 1024;

#define XB_TMO      128
#define XB_XCNT(j)  (256  + 64 * (j))
#define XB_XSUB(j)  (1280 + 64 * (j))
#define XB_XGEN(j)  (2304 + 64 * (j))
#define XB_TOP      3328
#define XB_TOPGEN   3392
#define XCD_BAR_WORDS 3456
#define XB_SPIN_CAP (1u << 18)

__device__ __forceinline__ unsigned xb_ld(unsigned* p)              { return __hip_atomic_load(p, __ATOMIC_RELAXED, __HIP_MEMORY_SCOPE_AGENT); }
__device__ __forceinline__ unsigned xb_add(unsigned* p, unsigned v) { return __hip_atomic_fetch_add(p, v, __ATOMIC_RELAXED, __HIP_MEMORY_SCOPE_AGENT); }
__device__ __forceinline__ unsigned xb_xcc_id() { return (unsigned)__builtin_amdgcn_s_getreg((3 << 11) | 20) & 0xFu; }
#define XB_SPIN(cond, bar) do { unsigned _sp = 0; while (cond) { __builtin_amdgcn_s_sleep(1); \
    if ((++_sp & 255u) == 0u) { if (xb_ld(&(bar)[XB_TMO])) break; if (_sp > XB_SPIN_CAP) { atomicAdd(&(bar)[XB_TMO], 1u); break; } } } } while (0)

struct XcdBarrier {
    unsigned* bar; unsigned x;
    volatile LAS unsigned* st;
};

__device__ __forceinline__ XcdBarrier xcd_barrier_post(unsigned* bar, volatile LAS unsigned* st) {
    XcdBarrier b; b.bar = bar; b.x = xb_xcc_id(); b.st = st;
    if (threadIdx.x == 0) (void)xb_add(&bar[XB_XCNT(b.x)], 1u);
    return b;
}
__device__ __forceinline__ void xcd_barrier_complete(unsigned* bar, unsigned x, unsigned& nloc, unsigned& nx) {
    const unsigned G = gridDim.x * gridDim.y * gridDim.z;
    unsigned sum, cnt, mine, sp = 0u;
    for (;;) {
        sum = 0u; cnt = 0u; mine = 0u;
#pragma unroll
        for (unsigned j = 0; j < 16; ++j) { const unsigned c = xb_ld(&bar[XB_XCNT(j)]); sum += c; cnt += (c > 0u) ? 1u : 0u; mine = (j == x) ? c : mine; }
        if (sum == G) break;
        __builtin_amdgcn_s_sleep(1);
        if ((++sp & 255u) == 0u) { if (xb_ld(&bar[XB_TMO])) break; if (sp > XB_SPIN_CAP) { atomicAdd(&bar[XB_TMO], 1u); break; } }
    }
    nloc = mine > 0u ? mine : 1u; nx = cnt > 0u ? cnt : 1u;
}

__device__ __forceinline__ void xcd_barrier(const XcdBarrier& b) {
    asm volatile("s_waitcnt vmcnt(0)" ::: "memory");
    __syncthreads();
    if (threadIdx.x == 0) {
        unsigned* bar = b.bar;
        __builtin_amdgcn_s_waitcnt(0);
        unsigned nloc = b.st[0], nx = b.st[1];
        if (nloc == 0u) { xcd_barrier_complete(bar, b.x, nloc, nx); b.st[0] = nloc; b.st[1] = nx; }
        const unsigned old = xb_add(&bar[XB_XSUB(b.x)], 1u);
        const unsigned gen = old / nloc;
        if (old + 1u == (gen + 1u) * nloc) {
            __builtin_amdgcn_fence(__ATOMIC_RELEASE, "agent");
            asm volatile("s_waitcnt vmcnt(0)" ::: "memory");
            const unsigned og = xb_add(&bar[XB_TOP], 1u);
            const unsigned tg = og / nx;
            if (og + 1u == (tg + 1u) * nx) xb_add(&bar[XB_TOPGEN], 1u);
            else XB_SPIN(xb_ld(&bar[XB_TOPGEN]) == tg, bar);
            __builtin_amdgcn_fence(__ATOMIC_ACQUIRE, "agent");
            xb_add(&bar[XB_XGEN(b.x)], 1u);
            asm volatile("s_waitcnt vmcnt(0)" ::: "memory");
        } else {
            XB_SPIN(xb_ld(&bar[XB_XGEN(b.x)]) == gen, bar);
            __builtin_amdgcn_fence(__ATOMIC_ACQUIRE, "agent");
            asm volatile("s_waitcnt vmcnt(0)" ::: "memory");
        }
    }
    __syncthreads();
}

__device__ __forceinline__ float wave_sum(float v) {
#pragma unroll
    for (int o = 1; o < 64; o <<= 1) v += __shfl_xor(v, o);
    return v;
}

struct EpiIn {
    static constexpr bool PERM = true, AFTER_DRAIN = false;
    bf16_t *zq, *xbc, *kk, *vv; float* dt;
    __device__ __forceinline__ void operator()(const pg8::f32x4 (&acc)[2][2][4][2], const pg8::Unit& u, int wr, int wc, int fr, int fq) const {
        const int row0 = u.pm * 256 + wr * 64 + fr, pn = u.pn;
        if (pn == 18) {
            if (wc == 0 && fq < 2) {
#pragma unroll
                for (int ai = 0; ai < 2; ++ai)
#pragma unroll
                    for (int m = 0; m < 4; ++m) { float* o = dt + (size_t)(row0 + ai * 128 + m * 16) * 16 + 8 * fq; *(pg8::f32x4*)o = acc[ai][0][m][0]; *(pg8::f32x4*)(o + 4) = acc[ai][0][m][1]; }
            }
            return;
        }
        bf16_t* base; int ldc, colt;
        if (pn < 4) { base = zq; ldc = 2048; colt = pn * 256; }
        else if (pn < 12) { base = xbc; ldc = 2048; colt = (pn - 4) * 256; }
        else if (pn < 16) { base = zq; ldc = 2048; colt = 1024 + (pn - 12) * 256; }
        else if (pn == 16) { base = kk; ldc = 256; colt = 0; }
        else { base = vv; ldc = 256; colt = 0; }
        const int col0 = colt + wc * 32 + 8 * fq;
#pragma unroll
        for (int ai = 0; ai < 2; ++ai)
#pragma unroll
            for (int m = 0; m < 4; ++m) { bf16_t* rowp = base + (size_t)(row0 + ai * 128 + m * 16) * ldc + col0;
#pragma unroll
                for (int bj = 0; bj < 2; ++bj) { const pg8::f32x4 v0 = acc[ai][bj][m][0], v1 = acc[ai][bj][m][1];
                    pg8::u32x4 w; w.x = pg8::cvt_pk_bf16(v0[0], v0[1]); w.y = pg8::cvt_pk_bf16(v0[2], v0[3]); w.z = pg8::cvt_pk_bf16(v1[0], v1[1]); w.w = pg8::cvt_pk_bf16(v1[2], v1[3]);
                    *(pg8::u32x4*)(rowp + bj * 128) = w; } }
    }
};

struct EpiOut {
    static constexpr bool PERM = true, AFTER_DRAIN = false;
    const float* x; float* x1; const float* mod;
    __device__ __forceinline__ void operator()(const pg8::f32x4 (&acc)[2][2][4][2], const pg8::Unit& u, int wr, int wc, int fr, int fq) const {
        const int row0 = u.pm * 256 + wr * 64 + fr, col0 = u.pn * 256 + wc * 32 + 8 * fq, b = (u.pm * 256) / SEQ;
        const float* g1 = mod + b * 6 * D + 2 * D + col0;
        pg8::f32x4 gv[2][2];
#pragma unroll
        for (int bj = 0; bj < 2; ++bj) { gv[bj][0] = *(const pg8::f32x4*)(g1 + bj * 128); gv[bj][1] = *(const pg8::f32x4*)(g1 + bj * 128 + 4); }
#pragma unroll
        for (int ai = 0; ai < 2; ++ai)
#pragma unroll
            for (int m = 0; m < 4; ++m) { const size_t off = (size_t)(row0 + ai * 128 + m * 16) * D + col0;
#pragma unroll
                for (int bj = 0; bj < 2; ++bj) { const float* xi = x + off + bj * 128; float* xo = x1 + off + bj * 128;
                    *(pg8::f32x4*)xo = *(const pg8::f32x4*)xi + gv[bj][0] * acc[ai][bj][m][0]; *(pg8::f32x4*)(xo + 4) = *(const pg8::f32x4*)(xi + 4) + gv[bj][1] * acc[ai][bj][m][1]; } }
    }
};
struct EpiGU {
    static constexpr bool PERM = true, AFTER_DRAIN = false;
    bf16_t* u;
    __device__ __forceinline__ void operator()(const pg8::f32x4 (&acc)[2][2][4][2], const pg8::Unit& un, int wr, int wc, int fr, int fq) const {
        const int row0 = un.pm * 256 + wr * 64 + fr, col0 = un.pn * 128 + wc * 32 + 8 * fq;
#pragma unroll
        for (int ai = 0; ai < 2; ++ai)
#pragma unroll
            for (int m = 0; m < 4; ++m) { bf16_t* rowp = u + (size_t)(row0 + ai * 128 + m * 16) * ED + col0;
                float o[8];
#pragma unroll
                for (int n = 0; n < 2; ++n)
#pragma unroll
                    for (int j = 0; j < 4; ++j) o[4 * n + j] = silu_f(acc[ai][0][m][n][j]) * acc[ai][1][m][n][j];
                pg8::u32x4 w; w.x = pg8::cvt_pk_bf16(o[0], o[1]); w.y = pg8::cvt_pk_bf16(o[2], o[3]); w.z = pg8::cvt_pk_bf16(o[4], o[5]); w.w = pg8::cvt_pk_bf16(o[6], o[7]);
                *(pg8::u32x4*)rowp = w; }
    }
};
constexpr float YC_SCALE = 16.f;
struct EpiDown {
    static constexpr bool PERM = true, AFTER_DRAIN = false;
    unsigned char* yc; const int* list; const float* glist;
    __device__ __forceinline__ void operator()(const pg8::f32x4 (&acc)[2][2][4][2], const pg8::Unit& u, int wr, int wc, int fr, int fq) const {
        const unsigned pos0 = (unsigned)(u.pn * 256 + wc * 64 + fq * 16);
        const int* lp = list + (size_t)u.e * M + u.lt * 256; const float* gp = glist + (size_t)u.e * M + u.lt * 256;
        int a8[8]; float g8[8];
#pragma unroll
        for (int i = 0; i < 8; ++i) { const int r = (i >> 2) * 128 + wr * 64 + (i & 3) * 16 + fr; const bool ok = r < u.nrows;
            if (u.e < NE) { a8[i] = ok ? lp[r] : -1; g8[i] = ok ? gp[r] : 0.f; } else { a8[i] = ok ? ((u.lt * 256 + r) * 8) : -1; g8[i] = 1.f; } }
#pragma unroll
        for (int ai = 0; ai < 2; ++ai)
#pragma unroll
            for (int m = 0; m < 4; ++m) { const int a = a8[ai * 4 + m]; const float gt = g8[ai * 4 + m] * YC_SCALE;
                if (a >= 0) { const unsigned ts = (unsigned)((a >> 3) * NSLOT + (u.e < NE ? (a & 7) : 8));
                    pg8::u32x4 w;
#pragma unroll
                    for (int bj = 0; bj < 2; ++bj)
#pragma unroll
                        for (int n = 0; n < 2; ++n) { const pg8::f32x4 v = acc[ai][bj][m][n] * gt; int q = __builtin_amdgcn_cvt_pk_fp8_f32(v[0], v[1], 0, false); q = __builtin_amdgcn_cvt_pk_fp8_f32(v[2], v[3], q, true); w[bj * 2 + n] = (unsigned)q; }
                    *(pg8::u32x4*)(yc + ((size_t)ts * 1024u + pos0)) = w; } }
    }
};
template <bool GATHER>
struct GroupedOrder {
    typedef pg8::Unit Unit;
    const char* A; const char* Bt; int K, nN, G, c, total; const LAS int* plan; const int* list; size_t bs_e, bs_pn; int pn0;
    __device__ __forceinline__ void init(const void* A_, const void* Bt_, int K_, int nN_, int G_, int c_, const LAS int* plan_, const int* list_, size_t bs_e_, size_t bs_pn_, int pn0_) {
        A = (const char*)A_; Bt = (const char*)Bt_; K = K_; nN = nN_; G = G_; c = c_; plan = plan_; list = list_; bs_e = bs_e_; bs_pn = bs_pn_; pn0 = pn0_; total = __builtin_amdgcn_readfirstlane(plan[NE + 1]) * nN; }
    __device__ __forceinline__ bool next(int i, Unit& u) const {
        const int L = i * G + c; if (L >= total) return false;
        int wgid = L; { const int q = total / 8, r = total % 8, xcd = wgid % 8, off = wgid / 8; wgid = (xcd < r ? xcd * (q + 1) : r * (q + 1) + (xcd - r) * q) + off; }
        const int tile = wgid / nN; u.pn = wgid % nN; u.pm = tile;
        int e = 0;
        for (int j = 1; j <= NE; ++j) e += (plan[j] <= tile) ? 1 : 0;
        e = __builtin_amdgcn_readfirstlane(e);
        u.e = e; u.lt = __builtin_amdgcn_readfirstlane(tile - plan[e]); const int rem = __builtin_amdgcn_readfirstlane(plan[80 + e]) - u.lt * 256; u.nrows = rem < 256 ? rem : 256; return true;
    }
    __device__ __forceinline__ const char* a_base(const Unit& u) const { return GATHER ? A : A + (size_t)u.pm * 512 * K; }
    __device__ __forceinline__ const char* b_base(const Unit& u) const { return Bt + (size_t)u.e * bs_e + (size_t)(pn0 + u.pn) * bs_pn; }
    __device__ __forceinline__ void lane_off(const Unit& u, const int (&R)[2], const int (&C)[2], unsigned (&o)[2][2]) const {
#pragma unroll
        for (int h = 0; h < 2; ++h)
#pragma unroll
            for (int i = 0; i < 2; ++i) { const int r = h * 128 + R[i];
                if (GATHER) { int tok = 0; if (r < u.nrows) { const int idx = u.lt * 256 + r; tok = u.e < NE ? (list[(size_t)u.e * M + idx] >> 3) : idx; }
                    o[h][i] = (unsigned)((tok * K + C[i]) * 2); }
                else o[h][i] = (unsigned)((r * K + C[i]) * 2); }
    }
    __device__ __forceinline__ void a_ready(const Unit&) const {}
    __device__ __forceinline__ void done(const Unit&) const {}
};

template <class CM>
__device__ __forceinline__ void transpose_item(const float* W, int ldw, bf16_t* WT, int ldt, int k0, int n0, LAS float* scr, int lane, const CM& colmap) {
    const int sc = colmap(n0 + (lane & 31));
#pragma unroll
    for (int i = 0; i < 32; ++i) { const int kk = 2 * i + (lane >> 5); scr[kk * 33 + (lane & 31)] = sc >= 0 ? W[(size_t)(k0 + kk) * ldw + sc] : 0.f; }
    LDS_WAIT(); asm volatile("" ::: "memory");
    const int c = lane & 7;
#pragma unroll
    for (int j = 0; j < 4; ++j) { const int n = (lane >> 3) + 8 * j; const LAS float* s = scr + (8 * c) * 33 + n;
        v4u o; o.x = pk2(s[0 * 33], s[1 * 33]); o.y = pk2(s[2 * 33], s[3 * 33]); o.z = pk2(s[4 * 33], s[5 * 33]); o.w = pk2(s[6 * 33], s[7 * 33]);
        *(GAS v4u*)(WT + (size_t)(n0 + n) * ldt + k0 + 8 * c) = o; }
    LDS_WAIT(); asm volatile("" ::: "memory");
}

typedef short v4i16_t __attribute__((ext_vector_type(4)));
__device__ __forceinline__ v4i16_t tr4(const LAS unsigned char* img, int stride, int row0, int col0, int lane) {
    const LAS unsigned char* a = img + (row0 + ((lane & 15) >> 2)) * stride + (col0 + 4 * (lane & 3)) * 2;
    return __builtin_amdgcn_ds_read_tr16_b64_v4i16((LAS v4i16_t*)a);
}
__device__ __forceinline__ pg8::bf16x8 cat44(v4i16_t lo, v4i16_t hi) { return (pg8::bf16x8){lo[0], lo[1], lo[2], lo[3], hi[0], hi[1], hi[2], hi[3]}; }

template <class EMIT>
__device__ __forceinline__ void conv16x8(const bf16_t* xbc, const float* cw, const float* cb, int row0, int t0, int ch, const EMIT& emit) {
    v4u raw[19];
#pragma unroll
    for (int k = 0; k < 19; ++k) { raw[k] = (v4u){0u, 0u, 0u, 0u}; if (t0 - 3 + k >= 0) raw[k] = *(const v4u*)(xbc + (size_t)(row0 - 3 + k) * CONV_CH + ch); }
    float wv[4][8], bv[8];
#pragma unroll
    for (int k = 0; k < 4; ++k) { const f32x4 a = *(const f32x4*)(cw + k * CONV_CH + ch), b = *(const f32x4*)(cw + k * CONV_CH + ch + 4); wv[k][0] = a.x; wv[k][1] = a.y; wv[k][2] = a.z; wv[k][3] = a.w; wv[k][4] = b.x; wv[k][5] = b.y; wv[k][6] = b.z; wv[k][7] = b.w; }
    { const f32x4 a = *(const f32x4*)(cb + ch), b = *(const f32x4*)(cb + ch + 4); bv[0] = a.x; bv[1] = a.y; bv[2] = a.z; bv[3] = a.w; bv[4] = b.x; bv[5] = b.y; bv[6] = b.z; bv[7] = b.w; }
    float win[4][8];
#pragma unroll
    for (int k = 0; k < 3; ++k) { const unsigned w4[4] = {raw[k].x, raw[k].y, raw[k].z, raw[k].w};
#pragma unroll
        for (int j = 0; j < 4; ++j) { win[k][2 * j] = __uint_as_float(w4[j] << 16); win[k][2 * j + 1] = __uint_as_float(w4[j] & 0xffff0000u); } }
#pragma unroll
    for (int r = 0; r < 16; ++r) {
        { const unsigned w4[4] = {raw[r + 3].x, raw[r + 3].y, raw[r + 3].z, raw[r + 3].w};
#pragma unroll
          for (int j = 0; j < 4; ++j) { win[(r + 3) & 3][2 * j] = __uint_as_float(w4[j] << 16); win[(r + 3) & 3][2 * j + 1] = __uint_as_float(w4[j] & 0xffff0000u); } }
        float o[8];
#pragma unroll
        for (int j = 0; j < 8; ++j) { float a = bv[j];
#pragma unroll
            for (int k = 0; k < 4; ++k) a += wv[k][j] * win[(r + k) & 3][j];
            o[j] = silu_f(a); }
        emit(r, o);
    }
}

__device__ __forceinline__ void conv2x8(const bf16_t* xbc, const float* cw, const float* cb, int row, int t, int ch, float (&o0)[8], float (&o1)[8]) {
    float xr[5][8];
#pragma unroll
    for (int k = 0; k < 5; ++k) { v4u raw = (v4u){0u, 0u, 0u, 0u}; if (t - 3 + k >= 0) raw = *(const v4u*)(xbc + (size_t)(row - 3 + k) * CONV_CH + ch);
        const unsigned w4[4] = {raw.x, raw.y, raw.z, raw.w};
#pragma unroll
        for (int j = 0; j < 4; ++j) { xr[k][2 * j] = __uint_as_float(w4[j] << 16); xr[k][2 * j + 1] = __uint_as_float(w4[j] & 0xffff0000u); } }
    float wv[4][8], bv[8];
#pragma unroll
    for (int k = 0; k < 4; ++k) { const f32x4 a = *(const f32x4*)(cw + k * CONV_CH + ch), b = *(const f32x4*)(cw + k * CONV_CH + ch + 4); wv[k][0] = a.x; wv[k][1] = a.y; wv[k][2] = a.z; wv[k][3] = a.w; wv[k][4] = b.x; wv[k][5] = b.y; wv[k][6] = b.z; wv[k][7] = b.w; }
    { const f32x4 a = *(const f32x4*)(cb + ch), b = *(const f32x4*)(cb + ch + 4); bv[0] = a.x; bv[1] = a.y; bv[2] = a.z; bv[3] = a.w; bv[4] = b.x; bv[5] = b.y; bv[6] = b.z; bv[7] = b.w; }
#pragma unroll
    for (int j = 0; j < 8; ++j) { float a0 = bv[j], a1 = bv[j];
#pragma unroll
        for (int k = 0; k < 4; ++k) { a0 += wv[k][j] * xr[k][j]; a1 += wv[k][j] * xr[k + 1][j]; }
        o0[j] = silu_f(a0); o1[j] = silu_f(a1); }
}

constexpr int NPHASE = 12;
__global__ void __launch_bounds__(NWAVES * 64, 2) mega(P p) {
    extern __shared__ __attribute__((aligned(16))) unsigned char lds_raw[];
    LAS unsigned char* lds = (LAS unsigned char*)lds_raw;
    volatile LAS unsigned* MISC = (volatile LAS unsigned*)(lds + MISC_OFF);
    const int tid = threadIdx.x, lane = tid & 63, wave = __builtin_amdgcn_readfirstlane(tid >> 6);
    const int G = gridDim.x; const int bx = blockIdx.x; const int vcu = (G % 8 == 0) ? (bx % 8) * (G / 8) + bx / 8 : bx;
    unsigned char* ws = p.ws;
    gu32* ctl = (gu32*)(ws + WS_CTL);
    for (int u = tid; u < (LDS_BYTES - LDSCTL_OFF) / 4; u += NWAVES * 64) ((LAS unsigned*)(lds + LDSCTL_OFF))[u] = 0u;
    __syncthreads();
    XcdBarrier bar = xcd_barrier_post((unsigned*)(ctl + CW_BAR) + p.li * XCD_BAR_WORDS, MISC + 8);
    const int lo = p.ph_lo, hi = p.ph_hi;
#ifndef PHMASK
#define PHMASK 0xffffffffu
#endif
#define IN(k) (((PHMASK >> (k)) & 1u) && lo <= (k) && (k) < hi)
#define BOTH(k) (IN(k) && IN((k) + 1))
#ifdef PROBE_MASK
#define PH_BEGIN() const unsigned long long _pt0 = __builtin_amdgcn_s_memrealtime()
#define PH_END(k) do { if ((PROBE_MASK >> (k)) & 1u) { const unsigned long long _pt1 = __builtin_amdgcn_s_memrealtime(); while (__builtin_amdgcn_s_memrealtime() < _pt1 + (_pt1 - _pt0)) __builtin_amdgcn_s_sleep(8); } } while (0)
#else
#define PH_BEGIN() do {} while (0)
#define PH_END(k) do {} while (0)
#endif
#ifdef PROBE_SUB
#define SUB_T() __builtin_amdgcn_s_memrealtime()
#define SUB_END(id, t0) do { if ((PROBE_SUB >> (id)) & 1u) { const unsigned long long _st1 = __builtin_amdgcn_s_memrealtime(); while (__builtin_amdgcn_s_memrealtime() < _st1 + (_st1 - (t0))) __builtin_amdgcn_s_sleep(4); } } while (0)
#else
#define SUB_T() 0ull
#define SUB_END(id, t0) do {} while (0)
#endif
    const int gw = vcu * NWAVES + wave, NGW = G * NWAVES;
    float* modv = (float*)(ws + WS_MOD);

    if (IN(0)) { PH_BEGIN();
        if (bx < 192) {
            LAS float* part = (LAS float*)(lds + RING_OFF);
            const int j0 = bx * 32, cc = lane & 31, ks = wave * 2 + (lane >> 5);
            float a0 = 0.f, a1 = 0.f, a2 = 0.f, a3 = 0.f;
#pragma unroll 8
            for (int k = ks * 64; k < ks * 64 + 64; ++k) { const float wv = p.mod_w[(size_t)k * 6 * D + j0 + cc];
                a0 += silu_f(p.c[k]) * wv; a1 += silu_f(p.c[D + k]) * wv; a2 += silu_f(p.c[2 * D + k]) * wv; a3 += silu_f(p.c[3 * D + k]) * wv; }
            part[(ks * 4 + 0) * 32 + cc] = a0; part[(ks * 4 + 1) * 32 + cc] = a1; part[(ks * 4 + 2) * 32 + cc] = a2; part[(ks * 4 + 3) * 32 + cc] = a3;
            __syncthreads();
            if (tid < 128) { const int b = tid >> 5, c2 = tid & 31; float s = p.mod_b[j0 + c2];
                for (int q = 0; q < 16; ++q) s += part[(q * 4 + b) * 32 + c2];
                modv[b * 6 * D + j0 + c2] = s; }
            __syncthreads();
        }
        LAS float* scr = (LAS float*)(lds + RING_OFF + wave * 16384);
        constexpr int I_IN = (D / 64) * (NWIN / 32), I_OUT = (2048 / 64) * (D / 32);
        bf16_t* WinT = (bf16_t*)(ws + WS_WIN_T); bf16_t* WoutT = (bf16_t*)(ws + WS_WOUT_T);
        for (int it = gw; it < I_IN + I_OUT; it += NGW) {
            if (it < I_IN) { const int nb = it % (NWIN / 32), kb = it / (NWIN / 32);
                transpose_item(p.w_in, IN_COLS, WinT, D, kb * 64, nb * 32, scr, lane, [](int n) { return n < 3072 ? n : (n < 4608 ? n + 16 : (n < 4624 ? n - 1536 : -1)); }); }
            else { const int r = it - I_IN, nb = r % (D / 32), kb = r / (D / 32);
                transpose_item(p.w_out, D, WoutT, 2048, kb * 64, nb * 32, scr, lane, [](int n) { return n; }); }
        }
        {
            v4u* rwf = (v4u*)(ws + WS_RWF);
            for (int i = bx * 512 + tid; i < 32 * 4 * 64; i += G * 512) { const int ln = i & 63, nt = (i >> 6) & 3, ks = i >> 8, c = ln & 15, q = ln >> 4;
                float v[8]; unsigned hi[4], lo[4];
#pragma unroll
                for (int j = 0; j < 8; ++j) v[j] = p.router_w[(32 * ks + 8 * q + j) * NE + 16 * nt + c];
#pragma unroll
                for (int j = 0; j < 4; ++j) { hi[j] = pk2(v[2 * j], v[2 * j + 1]); lo[j] = pk2(v[2 * j] - __uint_as_float(hi[j] << 16), v[2 * j + 1] - __uint_as_float(hi[j] & 0xffff0000u)); }
                rwf[((ks * 4 + nt) * 2) * 64 + ln] = (v4u){hi[0], hi[1], hi[2], hi[3]}; rwf[((ks * 4 + nt) * 2 + 1) * 64 + ln] = (v4u){lo[0], lo[1], lo[2], lo[3]}; }
        }
        constexpr int I_GU = 16 * 16, I_D = 4 * 32;
        bf16_t* WguT = (bf16_t*)(ws + WS_WGU); bf16_t* WdT = (bf16_t*)(ws + WS_WD);
        for (int it = gw; it < (NE + 1) * (I_GU + I_D); it += NGW) {
            const int e = it / (I_GU + I_D), r = it % (I_GU + I_D);
            if (r < I_GU) { const int nb = r & 15, kb = r >> 4, up = (nb >> 2) & 1;
                const float* W = e < NE ? (up ? p.exp_w_up : p.exp_w_gate) + (size_t)e * D * ED : (up ? p.sh_w_up : p.sh_w_gate);
                transpose_item(W, ED, WguT + (size_t)e * 512 * D, D, kb * 64, nb * 32, scr, lane, [](int n) { return (n >> 8) * 128 + (n & 127); }); }
            else { const int r2 = r - I_GU, nb = r2 & 31, kb = r2 >> 5;
                const float* W = e < NE ? p.exp_w_down + (size_t)e * ED * D : p.sh_w_down;
                transpose_item(W, D, WdT + (size_t)e * D * ED, ED, kb * 64, nb * 32, scr, lane, [](int n) { return n; }); }
        }
        if (BOTH(0)) xcd_barrier(bar);
        PH_END(0);
    }

    if (IN(1)) { PH_BEGIN();
        bf16_t* hn = (bf16_t*)p.out;
        for (int m = gw; m < M; m += NGW) {
            const int b = m / SEQ; const GAS f32x4* xr = (const GAS f32x4*)(p.x + (size_t)m * D) + lane;
            f32x4 v[4]; float s = 0.f;
#pragma unroll
            for (int j = 0; j < 4; ++j) { v[j] = xr[64 * j]; s += (v[j].x * v[j].x + v[j].y * v[j].y) + (v[j].z * v[j].z + v[j].w * v[j].w); }
            const float rstd = rsqrtf(wave_sum(s) * (1.f / D) + EPS);
            GAS unsigned long long* o8 = (GAS unsigned long long*)(hn + (size_t)m * D) + lane;
#pragma unroll
            for (int j = 0; j < 4; ++j) { const int d = 4 * lane + 256 * j; const f32x4 g = *(const f32x4*)(p.norm1_g + d), sc = *(const f32x4*)(modv + b * 6 * D + D + d), sh = *(const f32x4*)(modv + b * 6 * D + d);
                const f32x4 h = v[j] * rstd * g * (sc + 1.f) + sh;
                o8[64 * j] = (unsigned long long)pk2(h.x, h.y) | ((unsigned long long)pk2(h.z, h.w) << 32); }
        }
        if (BOTH(1)) xcd_barrier(bar);
        PH_END(1);
    }

    if (IN(2)) { PH_BEGIN();
        pg8::DenseOrder S; S.init(p.out, ws + WS_WIN_T, M, NWIN, D, G, bx);
        EpiIn E{(bf16_t*)(ws + WS_ZQ), (bf16_t*)(ws + WS_XBC), (bf16_t*)(ws + WS_K), (bf16_t*)(ws + WS_V), (float*)(ws + WS_DT)};
        pg8::gemm_phase<EpiIn, pg8::DenseOrder, true, true>(lds + RING_OFF, D, S, E);
        if (BOTH(2)) xcd_barrier(bar);
        PH_END(2);
    }

    if (IN(3)) { PH_BEGIN();
        {
            typedef pg8::bf16x8 bf16x8; typedef pg8::f32x4 f4;
            bf16_t* zq = (bf16_t*)(ws + WS_ZQ); const bf16_t* kk = (const bf16_t*)(ws + WS_K); const bf16_t* vv = (const bf16_t*)(ws + WS_V); float* ssq = (float*)(ws + WS_SSQ);
            LAS unsigned char* Kl = lds + RING_OFF; LAS unsigned char* Vl = lds + RING_OFF + 27648; LAS float* biasl = (LAS float*)(lds + RING_OFF + 58368);
            __syncthreads();
            for (int i = tid; i < ATT_HEADS * 128; i += 512) { const int h = i >> 7, dist = i & 127; biasl[i] = p.rel_bias[c_bucket[dist] * ATT_HEADS + h]; }
            const int fr = lane & 15, fg = lane >> 4;
            for (int unit = bx; unit < BATCH * (SEQ / 64); unit += G) {
                const int b = unit / (SEQ / 64), qb = unit % (SEQ / 64), t0 = qb * 64, row0 = b * SEQ + t0;
                for (int kvh = 0; kvh < KV_HEADS; ++kvh) {
                    __syncthreads();
                    for (int i = tid; i < 192 * 8; i += 512) { const int j = i >> 3, ch = i & 7, kt = t0 - 128 + j;
                        v4u val = (v4u){0u, 0u, 0u, 0u}; if (kt >= 0) val = *(const v4u*)(kk + (size_t)(b * SEQ + kt) * D_KV + kvh * HD + ch * 8);
                        *(LAS v4u*)(Kl + j * 144 + ch * 16) = val; }
                    for (int i = tid; i < 192 * 8; i += 512) { const int j = i >> 3, ch = i & 7, kt = t0 - 128 + j;
                        v4u val = (v4u){0u, 0u, 0u, 0u}; if (kt >= 0) val = *(const v4u*)(vv + (size_t)(b * SEQ + kt) * D_KV + kvh * HD + ch * 8);
                        *(LAS v4u*)(Vl + j * 160 + ch * 16) = val; }
                    __syncthreads();
                    const int head = kvh * 4 + (wave >> 1), rt0 = 2 * (wave & 1), jt0 = rt0;
                    const float sink = p.sinks[head]; const LAS float* bl = biasl + head * 128;
#pragma unroll 1
                    for (int r2 = 0; r2 < 2; ++r2) {
                        const int qi = 16 * (rt0 + r2) + fr;
                        bf16x8 Qf[2];
#pragma unroll
                        for (int ks = 0; ks < 2; ++ks) Qf[ks] = *(const bf16x8*)(zq + (size_t)(row0 + qi) * 2048 + 1024 + head * HD + ks * 32 + 8 * fg);
                        f4 sacc[10];
#pragma unroll
                        for (int jt = 0; jt < 10; ++jt) sacc[jt] = (f4){0.f, 0.f, 0.f, 0.f};
#pragma unroll
                        for (int jt = 0; jt < 10; ++jt)
#pragma unroll
                            for (int ks = 0; ks < 2; ++ks) { const bf16x8 Kf = *(const LAS bf16x8*)(Kl + (16 * (jt0 + jt) + fr) * 144 + (ks * 32 + 8 * fg) * 2);
                                sacc[jt] = __builtin_amdgcn_mfma_f32_16x16x32_bf16(Kf, Qf[ks], sacc[jt], 0, 0, 0); }
                        float mx = sink;
#pragma unroll
                        for (int jt = 0; jt < 10; ++jt)
#pragma unroll
                            for (int j = 0; j < 4; ++j) { const int kj = 16 * (jt0 + jt) + 4 * fg + j, dist = qi + 128 - kj; const bool ok = dist >= 0 && dist < 128 && (t0 - 128 + kj) >= 0;
                                const float s = ok ? sacc[jt][j] * 0.125f + bl[dist & 127] : -INFINITY; sacc[jt][j] = s; mx = fmaxf(mx, s); }
                        mx = fmaxf(mx, __shfl_xor(mx, 16)); mx = fmaxf(mx, __shfl_xor(mx, 32));
                        float ls = 0.f;
#pragma unroll
                        for (int jt = 0; jt < 10; ++jt)
#pragma unroll
                            for (int j = 0; j < 4; ++j) { const float pe = __expf(sacc[jt][j] - mx); sacc[jt][j] = pe; ls += pe; }
                        ls += __shfl_xor(ls, 16); ls += __shfl_xor(ls, 32); ls += __expf(sink - mx);
                        f4 o[4];
#pragma unroll
                        for (int dt = 0; dt < 4; ++dt) o[dt] = (f4){0.f, 0.f, 0.f, 0.f};
#pragma unroll
                        for (int k5 = 0; k5 < 5; ++k5) { const f4 pa = sacc[2 * k5], pb = sacc[2 * k5 + 1];
                            union { bf16x8 v; unsigned u[4]; } Pf; Pf.u[0] = pg8::cvt_pk_bf16(pa[0], pa[1]); Pf.u[1] = pg8::cvt_pk_bf16(pa[2], pa[3]); Pf.u[2] = pg8::cvt_pk_bf16(pb[0], pb[1]); Pf.u[3] = pg8::cvt_pk_bf16(pb[2], pb[3]);
#pragma unroll
                            for (int dt = 0; dt < 4; ++dt) { const bf16x8 Vf = cat44(tr4(Vl, 160, 16 * (jt0 + 2 * k5) + 4 * fg, 16 * dt, lane), tr4(Vl, 160, 16 * (jt0 + 2 * k5 + 1) + 4 * fg, 16 * dt, lane));
                                o[dt] = __builtin_amdgcn_mfma_f32_16x16x32_bf16(Vf, Pf.v, o[dt], 0, 0, 0); } }
                        const float inv = 1.f / ls; float ss = 0.f;
                        bf16_t* op = zq + (size_t)(row0 + qi) * 2048 + 1024 + head * HD + 4 * fg;
#pragma unroll
                        for (int dt = 0; dt < 4; ++dt) { const f4 ov = o[dt] * inv; ss += (ov[0] * ov[0] + ov[1] * ov[1]) + (ov[2] * ov[2] + ov[3] * ov[3]);
                            *(unsigned long long*)(op + 16 * dt) = (unsigned long long)pg8::cvt_pk_bf16(ov[0], ov[1]) | ((unsigned long long)pg8::cvt_pk_bf16(ov[2], ov[3]) << 32); }
                        ss += __shfl_xor(ss, 16); ss += __shfl_xor(ss, 32);
                        if (fg == 0) ssq[(row0 + qi) * 16 + head] = ss;
                    }
                }
            }
            __syncthreads();
        }
        PH_END(3);
    }

    if (IN(4)) { PH_BEGIN();
        typedef pg8::bf16x8 bf16x8; typedef pg8::f32x4 f4;
        const bf16_t* xbc = (const bf16_t*)(ws + WS_XBC); const float* dtr = (const float*)(ws + WS_DT); float* decg = (float*)(ws + WS_CS);
        LAS unsigned char* Xi = lds + RING_OFF; LAS unsigned char* Bi = lds + RING_OFF + 69632; LAS float* wl = (LAS float*)(lds + RING_OFF + 106496);
        const int fr = lane & 15, fg = lane >> 4;
        for (int unit = bx; unit < BATCH * NCHUNK * SSM_GROUPS; unit += G) {
            const int g = unit % SSM_GROUPS, bc = unit / SSM_GROUPS, rowc = bc * CHUNK, tc = rowc % SEQ;
            __syncthreads();
            if (wave < 4) { const int h = g * 4 + wave; const float A = -__expf(p.a_log[h]), bias = p.dt_bias[h];
                const float d0 = softplus_f(dtr[(rowc + lane) * 16 + h] + bias), d1 = softplus_f(dtr[(rowc + lane + 64) * 16 + h] + bias);
                float s0 = d0 * A, s1 = d1 * A;
#pragma unroll
                for (int o = 1; o < 64; o <<= 1) { const float u0 = __shfl_up(s0, o), u1 = __shfl_up(s1, o); if (lane >= o) { s0 += u0; s1 += u1; } }
                s1 += __shfl(s0, 63); const float cl = __shfl(s1, 63);
                wl[wave * 128 + lane] = d0 * __expf(cl - s0); wl[wave * 128 + lane + 64] = d1 * __expf(cl - s1);
                if (lane == 0) decg[bc * 16 + h] = __expf(cl); }
            __syncthreads();
            if (tid < 384) { const int co = tid % 48, l0 = 16 * (tid / 48);
                const int ch = co < 32 ? g * 256 + co * 8 : D_SSM + g * D_STATE + (co - 32) * 8;
                LAS unsigned char* dst = co < 32 ? Xi + l0 * 544 + co * 16 : Bi + l0 * 288 + (co - 32) * 16; const int st = co < 32 ? 544 : 288;
                const LAS float* wr_ = wl + (co < 32 ? (co >> 3) * 128 : 0) + l0; const bool scale = co < 32;
                conv16x8(xbc, p.conv_w, p.conv_b, rowc + l0, tc + l0, ch, [&](int r, const float (&o)[8]) { const float w = scale ? wr_[r] : 1.f;
                    *(LAS v4u*)(dst + r * st) = (v4u){pk2(o[0] * w, o[1] * w), pk2(o[2] * w, o[3] * w), pk2(o[4] * w, o[5] * w), pk2(o[6] * w, o[7] * w)}; }); }
            __syncthreads();
            bf16x8 Bf[4];
#pragma unroll
            for (int kk = 0; kk < 4; ++kk) Bf[kk] = cat44(tr4(Bi, 288, 32 * kk + 4 * fg, 16 * wave, lane), tr4(Bi, 288, 32 * kk + 16 + 4 * fg, 16 * wave, lane));
#pragma unroll
            for (int r4 = 0; r4 < 4; ++r4) { const int h = g * 4 + r4; float* S = p.out + (size_t)(bc * SSM_HEADS + h) * HD * D_STATE;
#pragma unroll
                for (int pt = 0; pt < 4; ++pt) { f4 acc = (f4){0.f, 0.f, 0.f, 0.f};
#pragma unroll
                    for (int kk = 0; kk < 4; ++kk) { const bf16x8 Af = cat44(tr4(Xi, 544, 32 * kk + 4 * fg, r4 * 64 + 16 * pt, lane), tr4(Xi, 544, 32 * kk + 16 + 4 * fg, r4 * 64 + 16 * pt, lane)); acc = __builtin_amdgcn_mfma_f32_16x16x32_bf16(Af, Bf[kk], acc, 0, 0, 0); }
#pragma unroll
                    for (int j = 0; j < 4; ++j) S[(16 * pt + 4 * fg + j) * D_STATE + 16 * wave + fr] = acc[j]; } }
        }
        if (BOTH(4)) xcd_barrier(bar);
        PH_END(4);
    }

    if (IN(5)) { PH_BEGIN();
        const float* S = p.out; const float* decg = (const float*)(ws + WS_CS); bf16_t* St = (bf16_t*)(ws + WS_ST);
        for (int i = bx * 512 + tid; i < BATCH * SSM_HEADS * HD * D_STATE / 2; i += G * 512) {
            const int pn = (i % (HD * D_STATE / 2)) * 2, bh = i / (HD * D_STATE / 2), h = bh % SSM_HEADS, b = bh / SSM_HEADS;
            float s0 = 0.f, s1 = 0.f;
#pragma unroll 4
            for (int c = 0; c < NCHUNK; ++c) { const size_t idx = ((size_t)((b * NCHUNK + c) * SSM_HEADS + h)) * HD * D_STATE + pn; const float2 sv = *(const float2*)(S + idx);
                *(unsigned*)(St + idx) = pk2(s0, s1); const float dec = decg[(b * NCHUNK + c) * 16 + h]; s0 = s0 * dec + sv.x; s1 = s1 * dec + sv.y; }
        }
        bf16_t* zq = (bf16_t*)(ws + WS_ZQ); const float* ssq = (const float*)(ws + WS_SSQ);
        for (int m = gw; m < M; m += NGW) {
            float s = lane < 16 ? ssq[m * 16 + lane] : 0.f; s = wave_sum(s); const float r = rsqrtf(s * (1.f / 1024.f) + EPS);
            bf16_t* o = zq + (size_t)m * 2048 + 1024 + lane * 16;
            v4u w0 = *(v4u*)o, w1 = *(v4u*)(o + 8); unsigned w[8] = {w0.x, w0.y, w0.z, w0.w, w1.x, w1.y, w1.z, w1.w};
#pragma unroll
            for (int j = 0; j < 8; ++j) { const int d = lane * 16 + 2 * j; w[j] = pk2(__uint_as_float(w[j] << 16) * r * p.att_norm_g[d], __uint_as_float(w[j] & 0xffff0000u) * r * p.att_norm_g[d + 1]); }
            *(v4u*)o = (v4u){w[0], w[1], w[2], w[3]}; *(v4u*)(o + 8) = (v4u){w[4], w[5], w[6], w[7]};
        }
        if (BOTH(5)) xcd_barrier(bar);
        PH_END(5);
    }

    if (IN(6)) { PH_BEGIN();
        typedef pg8::bf16x8 bf16x8; typedef pg8::f32x4 f4;
        const bf16_t* xbc = (const bf16_t*)(ws + WS_XBC); const float* dtr = (const float*)(ws + WS_DT); bf16_t* zq = (bf16_t*)(ws + WS_ZQ); const bf16_t* Stg = (const bf16_t*)(ws + WS_ST);
        LAS unsigned char* Xi = lds + RING_OFF; LAS unsigned char* Bi = lds + RING_OFF + 69632; LAS unsigned char* Ci = lds + RING_OFF + 106496;
        LAS float* csl = (LAS float*)(lds + RING_OFF + 143360); LAS float* dtl = csl + 512;
        const int fr = lane & 15, fg = lane >> 4;
        for (int unit = bx; unit < BATCH * NCHUNK * SSM_GROUPS; unit += G) {
            const int g = unit % SSM_GROUPS, bc = unit / SSM_GROUPS, rowc = bc * CHUNK, tc = rowc % SEQ;
            __syncthreads();
            const unsigned long long _s0 = SUB_T();
            if (wave < 4) { const int h = g * 4 + wave; const float A = -__expf(p.a_log[h]), bias = p.dt_bias[h];
                const float d0 = softplus_f(dtr[(rowc + lane) * 16 + h] + bias), d1 = softplus_f(dtr[(rowc + lane + 64) * 16 + h] + bias);
                float s0 = d0 * A, s1 = d1 * A;
#pragma unroll
                for (int o = 1; o < 64; o <<= 1) { const float u0 = __shfl_up(s0, o), u1 = __shfl_up(s1, o); if (lane >= o) { s0 += u0; s1 += u1; } }
                s1 += __shfl(s0, 63);
                csl[wave * 128 + lane] = s0; csl[wave * 128 + lane + 64] = s1; dtl[wave * 128 + lane] = d0; dtl[wave * 128 + lane + 64] = d1; }
            { const int co = tid & 63, l0 = 16 * (tid >> 6);
                const int ch = co < 32 ? g * 256 + co * 8 : (co < 48 ? D_SSM + g * D_STATE + (co - 32) * 8 : D_SSM + SSM_GROUPS * D_STATE + g * D_STATE + (co - 48) * 8);
                LAS unsigned char* dst = co < 32 ? Xi + l0 * 544 + co * 16 : (co < 48 ? Bi + l0 * 288 + (co - 32) * 16 : Ci + l0 * 288 + (co - 48) * 16); const int st = co < 32 ? 544 : 288;
                conv16x8(xbc, p.conv_w, p.conv_b, rowc + l0, tc + l0, ch, [&](int r, const float (&o)[8]) {
                    *(LAS v4u*)(dst + r * st) = (v4u){pk2(o[0], o[1]), pk2(o[2], o[3]), pk2(o[4], o[5]), pk2(o[6], o[7])}; }); }
            __syncthreads();
            SUB_END(0, _s0); const unsigned long long _s1 = SUB_T();
            const int lrow = 16 * wave + fr;
            bf16x8 Cf[4];
#pragma unroll
            for (int kk = 0; kk < 4; ++kk) Cf[kk] = *(const LAS bf16x8*)(Ci + lrow * 288 + (4 * kk + fg) * 16);
            f4 Gt[8];
#pragma unroll
            for (int st = 0; st < 8; ++st) { Gt[st] = (f4){0.f, 0.f, 0.f, 0.f};
                if (st <= wave) {
#pragma unroll
                    for (int kk = 0; kk < 4; ++kk) { const bf16x8 Bf = *(const LAS bf16x8*)(Bi + (16 * st + fr) * 288 + (4 * kk + fg) * 16);
                        Gt[st] = __builtin_amdgcn_mfma_f32_16x16x32_bf16(Bf, Cf[kk], Gt[st], 0, 0, 0); } } }
            SUB_END(1, _s1); const unsigned long long _s2 = SUB_T();
            f4 Y[4][4];
            const bf16_t* zr0 = zq + (size_t)(rowc + lrow) * 2048 + g * 256 + 4 * fg; unsigned long long zz[4][4];
#pragma unroll
            for (int r4 = 0; r4 < 4; ++r4)
#pragma unroll
                for (int pt = 0; pt < 4; ++pt) zz[r4][pt] = *(const unsigned long long*)(zr0 + r4 * 64 + 16 * pt);
#pragma unroll
            for (int r4 = 0; r4 < 4; ++r4) { const int h = g * 4 + r4; const float ecl = __expf(csl[r4 * 128 + lrow]);
                const bf16_t* Sth = Stg + (size_t)(bc * SSM_HEADS + h) * HD * D_STATE;
#pragma unroll
                for (int pt = 0; pt < 4; ++pt) { f4 acc = (f4){0.f, 0.f, 0.f, 0.f};
#pragma unroll
                    for (int kk = 0; kk < 4; ++kk) { const bf16x8 Sf = *(const bf16x8*)(Sth + (16 * pt + fr) * D_STATE + (4 * kk + fg) * 8); acc = __builtin_amdgcn_mfma_f32_16x16x32_bf16(Sf, Cf[kk], acc, 0, 0, 0); }
                    Y[r4][pt] = acc * ecl; } }
#pragma unroll
            for (int r4 = 0; r4 < 4; ++r4) { const int h = g * 4 + r4; const float cl = csl[r4 * 128 + lrow];
#pragma unroll
                for (int k4 = 0; k4 < 4; ++k4) { if (2 * k4 <= wave) {
                    union { bf16x8 v; unsigned u[4]; } Pf;
#pragma unroll
                    for (int hh = 0; hh < 2; ++hh) { const int st = 2 * k4 + hh; const f4 c4 = *(const LAS f4*)(csl + r4 * 128 + 16 * st + 4 * fg), d4 = *(const LAS f4*)(dtl + r4 * 128 + 16 * st + 4 * fg);
                        float mv[4];
#pragma unroll
                        for (int j = 0; j < 4; ++j) { const int s = 16 * st + 4 * fg + j; mv[j] = (s <= lrow) ? Gt[st][j] * __expf(cl - c4[j]) * d4[j] : 0.f; }
                        Pf.u[2 * hh] = pg8::cvt_pk_bf16(mv[0], mv[1]); Pf.u[2 * hh + 1] = pg8::cvt_pk_bf16(mv[2], mv[3]); }
#pragma unroll
                    for (int pt = 0; pt < 4; ++pt) { const bf16x8 Xf = cat44(tr4(Xi, 544, 32 * k4 + 4 * fg, r4 * 64 + 16 * pt, lane), tr4(Xi, 544, 32 * k4 + 16 + 4 * fg, r4 * 64 + 16 * pt, lane));
                        Y[r4][pt] = __builtin_amdgcn_mfma_f32_16x16x32_bf16(Xf, Pf.v, Y[r4][pt], 0, 0, 0); } } }
                const float dsk = p.d_skip[h];
#pragma unroll
                for (int pt = 0; pt < 4; ++pt) { const unsigned long long xx = *(const LAS unsigned long long*)(Xi + lrow * 544 + (r4 * 64 + 16 * pt + 4 * fg) * 2); const unsigned x0 = (unsigned)xx, x1 = (unsigned)(xx >> 32);
                    Y[r4][pt][0] += dsk * __uint_as_float(x0 << 16); Y[r4][pt][1] += dsk * __uint_as_float(x0 & 0xffff0000u); Y[r4][pt][2] += dsk * __uint_as_float(x1 << 16); Y[r4][pt][3] += dsk * __uint_as_float(x1 & 0xffff0000u); }
            }
            SUB_END(2, _s2); const unsigned long long _s3 = SUB_T();
            bf16_t* zr = zq + (size_t)(rowc + lrow) * 2048 + g * 256 + 4 * fg; float ss = 0.f;
#pragma unroll
            for (int r4 = 0; r4 < 4; ++r4)
#pragma unroll
                for (int pt = 0; pt < 4; ++pt) { const unsigned z0 = (unsigned)zz[r4][pt], z1 = (unsigned)(zz[r4][pt] >> 32);
                    f4 v = Y[r4][pt]; v[0] *= silu_f(__uint_as_float(z0 << 16)); v[1] *= silu_f(__uint_as_float(z0 & 0xffff0000u)); v[2] *= silu_f(__uint_as_float(z1 << 16)); v[3] *= silu_f(__uint_as_float(z1 & 0xffff0000u));
                    Y[r4][pt] = v; ss += (v[0] * v[0] + v[1] * v[1]) + (v[2] * v[2] + v[3] * v[3]); }
            ss += __shfl_xor(ss, 16); ss += __shfl_xor(ss, 32);
            const float rr = rsqrtf(ss * (1.f / 256.f) + EPS);
#pragma unroll
            for (int r4 = 0; r4 < 4; ++r4)
#pragma unroll
                for (int pt = 0; pt < 4; ++pt) { const f4 gn = *(const f4*)(p.ssm_norm_g + g * 256 + r4 * 64 + 16 * pt + 4 * fg); const f4 v = Y[r4][pt] * rr * gn;
                    *(unsigned long long*)(zr + r4 * 64 + 16 * pt) = (unsigned long long)pg8::cvt_pk_bf16(v[0], v[1]) | ((unsigned long long)pg8::cvt_pk_bf16(v[2], v[3]) << 32); }
            SUB_END(3, _s3);
        }
        if (BOTH(6)) xcd_barrier(bar);
        PH_END(6);
    }

    if (IN(7)) { PH_BEGIN();
        pg8::DenseOrder S; S.init(ws + WS_ZQ, ws + WS_WOUT_T, M, D, 2048, G, bx);
        EpiOut E{p.x, p.out, modv};
        pg8::gemm_phase<EpiOut, pg8::DenseOrder, true, true>(lds + RING_OFF, 2048, S, E);
        if (BOTH(7)) xcd_barrier(bar);
        PH_END(7);
    }

    if (IN(8)) { PH_BEGIN();
        typedef pg8::bf16x8 bf16x8; typedef pg8::f32x4 f4;
        LAS float* part = (LAS float*)(lds + RING_OFF);
        LAS float* red = (LAS float*)(lds + RING_OFF + 131072);
        LAS int* cnt_l = (LAS int*)(lds + RING_OFF + 133120);
        LAS int* base_l = (LAS int*)(lds + RING_OFF + 133376);
        LAS int* asg_e = (LAS int*)(lds + RING_OFF + 133632);
        LAS int* asg_pos = (LAS int*)(lds + RING_OFF + 135680);
        LAS float* asg_g = (LAS float*)(lds + RING_OFF + 137728);
        bf16_t* h2 = (bf16_t*)(ws + WS_H2); int* eidx = (int*)(ws + WS_EIDX); float* eg = (float*)(ws + WS_EGATE); int* cnt = (int*)(ws + WS_CTL) + CW_CNT; int* list = (int*)(ws + WS_LIST); float* glist = (float*)(ws + WS_GLIST);
        const v4u* rwf = (const v4u*)(ws + WS_RWF);
        const float rbias = p.router_bias[lane];
        const int fr = lane & 15, fq = lane >> 4;
        for (int grp = bx; grp < M / 64; grp += G) {
            const int b = (grp * 64) / SEQ;
            __syncthreads();
            if (tid < NE) cnt_l[tid] = 0;
#pragma unroll 1
            for (int half = 0; half < 2; ++half) {
            f4 xv[2][4][2];
#pragma unroll
            for (int tile = 0; tile < 2; ++tile) { const float* xr = p.out + (size_t)(grp * 64 + half * 32 + tile * 16 + fr) * D + 128 * wave + 8 * fq;
#pragma unroll
                for (int kk = 0; kk < 4; ++kk) { xv[tile][kk][0] = *(const f4*)(xr + 32 * kk); xv[tile][kk][1] = *(const f4*)(xr + 32 * kk + 4); } }
#pragma unroll
            for (int tile = 0; tile < 2; ++tile) { float ss = 0.f;
#pragma unroll
                for (int kk = 0; kk < 4; ++kk)
#pragma unroll
                    for (int hf = 0; hf < 2; ++hf) { const f4 v = xv[tile][kk][hf]; ss += (v[0] * v[0] + v[1] * v[1]) + (v[2] * v[2] + v[3] * v[3]); }
                ss += __shfl_xor(ss, 16); ss += __shfl_xor(ss, 32);
                if (fq == 0) red[(tile * 8 + wave) * 16 + fr] = ss; }
            __syncthreads();
            float rstd2[2]; f4 acc[2][4];
#pragma unroll
            for (int tile = 0; tile < 2; ++tile) { float tot = 0.f;
#pragma unroll
                for (int w2 = 0; w2 < 8; ++w2) tot += red[(tile * 8 + w2) * 16 + fr];
                rstd2[tile] = rsqrtf(tot * (1.f / D) + EPS);
#pragma unroll
                for (int nt = 0; nt < 4; ++nt) acc[tile][nt] = (f4){0.f, 0.f, 0.f, 0.f}; }
#pragma unroll
            for (int kk = 0; kk < 4; ++kk) { const int d = 128 * wave + 32 * kk + 8 * fq;
                f4 gm[2], sm[2];
#pragma unroll
                for (int hf = 0; hf < 2; ++hf) { gm[hf] = *(const f4*)(p.norm2_g + d + 4 * hf) * (*(const f4*)(modv + b * 6 * D + 4 * D + d + 4 * hf) + 1.f); sm[hf] = *(const f4*)(modv + b * 6 * D + 3 * D + d + 4 * hf); }
                union { bf16x8 v; v4u q; } Rh[4], Rl[4];
#pragma unroll
                for (int nt = 0; nt < 4; ++nt) { const int fi = (((4 * wave + kk) * 4 + nt) * 2) * 64 + lane; Rh[nt].q = rwf[fi]; Rl[nt].q = rwf[fi + 64]; }
#pragma unroll
                for (int tile = 0; tile < 2; ++tile) { const int row = grp * 64 + half * 32 + tile * 16 + fr;
                    union { bf16x8 v; unsigned u[4]; v4u q; } Hh, Hl;
#pragma unroll
                    for (int hf = 0; hf < 2; ++hf) { const f4 h = xv[tile][kk][hf] * rstd2[tile] * gm[hf] + sm[hf];
                        const unsigned h01 = pk2(h[0], h[1]), h23 = pk2(h[2], h[3]);
                        Hh.u[2 * hf] = h01; Hh.u[2 * hf + 1] = h23;
                        Hl.u[2 * hf] = pk2(h[0] - __uint_as_float(h01 << 16), h[1] - __uint_as_float(h01 & 0xffff0000u)); Hl.u[2 * hf + 1] = pk2(h[2] - __uint_as_float(h23 << 16), h[3] - __uint_as_float(h23 & 0xffff0000u)); }
                    *(v4u*)(h2 + (size_t)row * D + d) = Hh.q;
#pragma unroll
                    for (int nt = 0; nt < 4; ++nt) {
                        acc[tile][nt] = __builtin_amdgcn_mfma_f32_16x16x32_bf16(Hh.v, Rh[nt].v, acc[tile][nt], 0, 0, 0);
                        acc[tile][nt] = __builtin_amdgcn_mfma_f32_16x16x32_bf16(Hh.v, Rl[nt].v, acc[tile][nt], 0, 0, 0);
                        acc[tile][nt] = __builtin_amdgcn_mfma_f32_16x16x32_bf16(Hl.v, Rh[nt].v, acc[tile][nt], 0, 0, 0); } }
                asm volatile("" ::: "memory"); }
#pragma unroll
            for (int tile = 0; tile < 2; ++tile)
#pragma unroll
                for (int nt = 0; nt < 4; ++nt)
#pragma unroll
                    for (int j = 0; j < 4; ++j) part[((tile * 8 + wave) * 16 + 4 * fq + j) * 64 + 16 * nt + fr] = acc[tile][nt][j];
            __syncthreads();
#pragma unroll 1
            for (int rr = 0; rr < 4; ++rr) { const int lr32 = 4 * wave + rr, tile = lr32 >> 4, lr = lr32 & 15, lr64 = half * 32 + lr32, m = grp * 64 + lr64;
                float lg = 0.f;
#pragma unroll
                for (int w2 = 0; w2 < 8; ++w2) lg += part[((tile * 8 + w2) * 16 + lr) * 64 + lane];
                const float sc = 1.f / (1.f + __expf(-lg)), sel = sc + rbias;
                float m1 = sel, m2 = -INFINITY;
#pragma unroll
                for (int o = 1; o < 8; o <<= 1) { const float p1 = __shfl_xor(m1, o), p2 = __shfl_xor(m2, o); const float n1 = fmaxf(m1, p1), n2 = fmaxf(fminf(m1, p1), fmaxf(m2, p2)); m1 = n1; m2 = n2; }
                const float gs = m1 + m2; const int myg = lane >> 3;
                unsigned gk = __float_as_uint(gs); gk = (gk & 0x80000000u) ? ~gk : (gk | 0x80000000u); gk = (gk & ~7u) | (unsigned)(7 - myg);
                int grank = 0;
#pragma unroll
                for (int g2 = 0; g2 < 8; ++g2) grank += (__builtin_amdgcn_readlane(gk, g2 * 8) > gk) ? 1 : 0;
                const bool allowed = grank < 4;
                unsigned ek = __float_as_uint(sel); ek = (ek & 0x80000000u) ? ~ek : (ek | 0x80000000u); ek = allowed ? ((ek & ~63u) | (unsigned)(63 - lane)) : 0u;
                int rank = 0;
#pragma unroll
                for (int e2 = 0; e2 < NE; ++e2) rank += (__builtin_amdgcn_readlane(ek, e2) > ek) ? 1 : 0;
                const bool selb = allowed && rank < TOPK;
                const float wsum = wave_sum(selb ? sc : 0.f);
                if (selb) { const int a = m * 8 + rank; eidx[a] = lane; const float gate = sc / wsum * 2.5f; eg[a] = gate; const int pl = __hip_atomic_fetch_add(cnt_l + lane, 1, __ATOMIC_RELAXED, __HIP_MEMORY_SCOPE_WORKGROUP); const int i = lr64 * 8 + rank; asg_e[i] = lane; asg_pos[i] = pl; asg_g[i] = gate; }
            }
            __syncthreads();
            }
            if (tid < NE) { const int c = cnt_l[tid]; base_l[tid] = c > 0 ? atomicAdd(&cnt[tid], c) : 0; }
            __syncthreads();
            { const int e = asg_e[tid]; const size_t li = (size_t)e * M + base_l[e] + asg_pos[tid]; list[li] = (grp * 64 + (tid >> 3)) * 8 + (tid & 7); glist[li] = asg_g[tid]; }
        }
        if (BOTH(8)) xcd_barrier(bar);
        PH_END(8);
    }

    LAS int* plan = (LAS int*)(lds + PLAN_OFF);
#define MAKE_PLAN() do { __syncthreads(); if (tid <= NE) plan[80 + tid] = tid < NE ? (int)__hip_atomic_load((const int*)(ws + WS_CTL) + CW_CNT + tid, RLX_AGENT) : M; __syncthreads(); \
        if (tid == 0) { int off = 0; for (int e = 0; e <= NE; ++e) { plan[e] = off; off += (plan[80 + e] + 255) >> 8; } plan[NE + 1] = off; } __syncthreads(); } while (0)
    if (IN(9)) { PH_BEGIN();
        MAKE_PLAN();
        GroupedOrder<true> S; S.init(ws + WS_H2, ws + WS_WGU, D, 2, G, bx, plan, (const int*)(ws + WS_LIST), (size_t)512 * D * 2, (size_t)256 * D * 2, 0);
        EpiGU E{(bf16_t*)(ws + WS_U)};
        pg8::gemm_phase<EpiGU, GroupedOrder<true>, true, true>(lds + RING_OFF, D, S, E);
        if (BOTH(9)) xcd_barrier(bar);
        PH_END(9);
    }
    if (IN(10)) { PH_BEGIN(); MAKE_PLAN();
        GroupedOrder<false> S; S.init(ws + WS_U, ws + WS_WD, ED, 4, G, bx, plan, (const int*)(ws + WS_LIST), (size_t)D * ED * 2, (size_t)256 * ED * 2, 0);
        EpiDown E{(unsigned char*)(ws + WS_YC), (const int*)(ws + WS_LIST), (const float*)(ws + WS_GLIST)};
        pg8::gemm_phase<EpiDown, GroupedOrder<false>, true, true>(lds + RING_OFF, ED, S, E);
        if (BOTH(10)) xcd_barrier(bar);
        PH_END(10);
    }
    if (IN(11)) { PH_BEGIN();
        typedef float f2 __attribute__((ext_vector_type(2)));
        const unsigned char* yc = (const unsigned char*)(ws + WS_YC);
        const int c0 = (lane >> 4) * 256 + ((lane >> 2) & 3) * 32 + (lane & 3) * 8;
        for (int m = gw; m < M; m += NGW) { const int b = m / SEQ;
            float s[16];
#pragma unroll
            for (int j = 0; j < 16; ++j) s[j] = 0.f;
#pragma unroll
            for (int k = 0; k < NSLOT; ++k) { const v4u raw = *(const v4u*)(yc + ((size_t)m * NSLOT + k) * 1024 + lane * 16); const unsigned w4[4] = {raw.x, raw.y, raw.z, raw.w};
#pragma unroll
                for (int q = 0; q < 4; ++q) { const f2 lo = __builtin_amdgcn_cvt_pk_f32_fp8((int)w4[q], false), hi = __builtin_amdgcn_cvt_pk_f32_fp8((int)w4[q], true);
                    s[4 * q] += lo.x; s[4 * q + 1] += lo.y; s[4 * q + 2] += hi.x; s[4 * q + 3] += hi.y; } }
            float* xo = p.out + (size_t)m * D; const float* g2 = modv + b * 6 * D + 5 * D;
            f32x4 xv[4]; float ss = 0.f;
#pragma unroll
            for (int q = 0; q < 4; ++q) { const int c = c0 + (q >> 1) * 128 + (q & 1) * 4; const f32x4 gv = *(const f32x4*)(g2 + c) * (1.f / YC_SCALE);
                xv[q] = *(const f32x4*)(xo + c) + gv * (f32x4){s[4 * q], s[4 * q + 1], s[4 * q + 2], s[4 * q + 3]};
                ss += (xv[q].x * xv[q].x + xv[q].y * xv[q].y) + (xv[q].z * xv[q].z + xv[q].w * xv[q].w); }
            const float rstd = rsqrtf(wave_sum(ss) * (1.f / D) + EPS);
#pragma unroll
            for (int q = 0; q < 4; ++q) { const int c = c0 + (q >> 1) * 128 + (q & 1) * 4; *(f32x4*)(xo + c) = xv[q] * rstd * *(const f32x4*)(p.final_g + c); }
        }
        PH_END(11);
    }
#undef IN
#undef BOTH
}

extern "C" void kernel_launch(void* const* d_in, const int* in_sizes, int n_in, void* d_out, int out_size, void* d_ws, size_t ws_size, hipStream_t stream) {
    static int grid = 0;
    if (grid == 0) {
        int dev = 0, cus = 0;
        if (hipGetDevice(&dev) != hipSuccess || hipDeviceGetAttribute(&cus, hipDeviceAttributeMultiprocessorCount, dev) != hipSuccess) { fprintf(stderr, "device query failed\n"); grid = -1; return; }
        if (hipFuncSetAttribute((const void*)mega, hipFuncAttributeMaxDynamicSharedMemorySize, LDS_BYTES) != hipSuccess) { fprintf(stderr, "hipFuncSetAttribute failed\n"); grid = -1; return; }
        int per_cu = 0;
        if (hipOccupancyMaxActiveBlocksPerMultiprocessor(&per_cu, (const void*)mega, NWAVES * 64, LDS_BYTES) != hipSuccess || per_cu < 1) fprintf(stderr, "occupancy query: %d\n", per_cu);
        (void)hipGetLastError();
        grid = cus;
        if (ws_size < WS_END) fprintf(stderr, "ws too small: %zu < %zu\n", ws_size, (size_t)WS_END);
    }
    if (grid < 0) return;
    P p{};
    const float** f = (const float**)&p;
    for (int i = 0; i < 26; ++i) f[i] = (const float*)d_in[i];
    p.out = (float*)d_out; p.ws = (unsigned char*)d_ws;
    (void)hipMemsetAsync(p.ws + WS_CTL, 0, CTL_BYTES, stream);
    p.ph_lo = 0; p.ph_hi = NPHASE; p.li = 0;
    hipLaunchKernelGGL(mega, dim3(grid), dim3(NWAVES * 64), LDS_BYTES, stream, p);
}
```

```cpp
#include <hip/hip_runtime.h>
#include <stdint.h>
#include <stdio.h>

typedef unsigned short bf16_t;

constexpr int D = 1024, BATCH = 4, SEQ = 4096, M = BATCH * SEQ;
constexpr int D_SSM = 1024, SSM_HEADS = 16, SSM_GROUPS = 4, D_STATE = 128, CONV_K = 4, CONV_CH = 2048, CHUNK = 128, NCHUNK = SEQ / CHUNK;
constexpr int HD = 64, ATT_HEADS = 16, KV_HEADS = 4, D_KV = 256, WINDOW = 128;
constexpr int IN_COLS = 4624;
constexpr int C_Z = 0, C_XBC = 1024, C_DT = 3072, C_Q = 3088, C_K = 4112, C_V = 4368;
constexpr int NE = 64, TOPK = 8, ED = 256;
constexpr float EPS = 1e-6f;
constexpr int NSLOT = 9;
constexpr int NWIN = 4864;

constexpr size_t MiB = 1u << 20;
constexpr size_t WS_CTL = 0;
constexpr size_t CTL_BYTES = 64 * 1024;
constexpr int CW_CNT = 0;
constexpr int CW_Q1 = 128, CW_Q2 = 192;
constexpr int CW_BAR = 4096;
constexpr size_t WS_MOD = 1 * MiB;
constexpr size_t WS_DUMP = 2 * MiB;
constexpr size_t WS_RWF = 1 * MiB + 256 * 1024;
constexpr size_t WS_LIST = 4 * MiB;
constexpr size_t WS_WIN_T = 8 * MiB;
constexpr size_t WS_WOUT_T = 18 * MiB;
constexpr size_t WS_SSQ = 22 * MiB;
constexpr size_t WS_ZQ = 24 * MiB;
constexpr size_t WS_XBC = 88 * MiB;
constexpr size_t WS_K = 152 * MiB;
constexpr size_t WS_V = 160 * MiB;
constexpr size_t WS_DT = 168 * MiB;
constexpr size_t WS_CS = 169 * MiB;
constexpr size_t WS_ST = 170 * MiB;
constexpr size_t WS_H2 = 170 * MiB;
constexpr size_t WS_WGU = 202 * MiB;
constexpr size_t WS_YC = 104 * MiB;
constexpr size_t WS_U = 24 * MiB;
constexpr size_t WS_WD = 267 * MiB;
constexpr size_t WS_GLIST = 300 * MiB;
constexpr size_t WS_END = 304 * MiB;
constexpr int UROWS_MAX = 163840;

__device__ __forceinline__ float bf2f(bf16_t v) { return __uint_as_float(((unsigned)v) << 16); }
__device__ __forceinline__ bf16_t f2bf(float f) { unsigned u = __float_as_uint(f); return (bf16_t)((u + 0x7fffu + ((u >> 16) & 1u)) >> 16); }
__device__ __forceinline__ unsigned pk2(float lo, float hi) { return (unsigned)f2bf(lo) | ((unsigned)f2bf(hi) << 16); }
__device__ __forceinline__ float silu_f(float x) { return x * __builtin_amdgcn_rcpf(1.f + __expf(-x)); }
__device__ __forceinline__ float softplus_f(float x) { return x > 20.f ? x : log1pf(__expf(x)); }

__constant__ int c_bucket[128] = {0, 1, 2, 3, 4, 5, 6, 7, 8, 9, 10, 11, 12, 13, 14, 15, 16, 16, 16, 17, 17, 18, 18, 18, 19, 19, 19, 20, 20, 20, 20, 21, 21, 21, 21, 22, 22, 22, 22, 22, 23, 23, 23, 23, 23, 23, 24, 24, 24, 24, 24, 24, 25, 25, 25, 25, 25, 25, 25, 26, 26, 26, 26, 26, 26, 26, 26, 27, 27, 27, 27, 27, 27, 27, 27, 27, 27, 28, 28, 28, 28, 28, 28, 28, 28, 28, 28, 29, 29, 29, 29, 29, 29, 29, 29, 29, 29, 29, 29, 30, 30, 30, 30, 30, 30, 30, 30, 30, 30, 30, 30, 30, 30, 31, 31, 31, 31, 31, 31, 31, 31, 31, 31, 31, 31, 31, 31, 31};

struct P {
    const float *x, *c, *mod_w, *mod_b, *norm1_g, *norm2_g, *w_in, *conv_w, *conv_b, *dt_bias, *a_log, *d_skip, *ssm_norm_g, *att_norm_g, *sinks, *rel_bias,
        *w_out, *router_w, *router_bias, *exp_w_gate, *exp_w_up, *exp_w_down, *sh_w_gate, *sh_w_up, *sh_w_down, *final_g;
    float* out; unsigned char* ws;
    int ph_lo, ph_hi, li, pad;
};

#ifdef PROBE_SUB
#define SUB_T() __builtin_amdgcn_s_memrealtime()
#define SUB_END(id, t0) do { if ((PROBE_SUB >> (id)) & 1u) { const unsigned long long _st1 = __builtin_amdgcn_s_memrealtime(); while (__builtin_amdgcn_s_memrealtime() < _st1 + (_st1 - (t0))) __builtin_amdgcn_s_sleep(4); } } while (0)
#else
#define SUB_T() 0ull
#define SUB_END(id, t0) do {} while (0)
#endif
namespace pg8 {
#define PG8_LAS __attribute__((address_space(3)))
typedef short bf16x8 __attribute__((ext_vector_type(8)));
typedef float f32x4 __attribute__((ext_vector_type(4)));
typedef unsigned u32x4 __attribute__((ext_vector_type(4)));
constexpr int BM = 256, BK = 64, HALF = 128, HTB = HALF * BK * 2  , STAGE_BYTES = 8 * HTB, NXCD = 8, WGM = 8;

__host__ __device__ __forceinline__ int lds_byte(int r, int c) { const int st = (r >> 4) * 2 + (c >> 5), rr = r & 15, cc = c & 31, ob = rr * 64 + cc * 2; return st * 1024 + (ob ^ (((ob >> 9) & 1) << 5)); }
__host__ __device__ __forceinline__ void stage_rc(int b, int& R, int& C) { const int st = b / 1024, sb = b % 1024, swz = sb ^ (((sb >> 9) & 1) << 5); R = (st >> 1) * 16 + swz / 64; C = (st & 1) * 32 + (swz % 64) / 2; }
__host__ __device__ __forceinline__ int perm32(int rho) { const int n = rho >> 4, i = rho & 15; return 8 * (i >> 2) + 4 * n + (i & 3); }

struct Unit { int pm, pn, e, nrows, lt; };

__device__ __forceinline__ unsigned cvt_pk_bf16(float lo, float hi) { unsigned r; asm volatile("v_cvt_pk_bf16_f32 %0, %1, %2" : "=v"(r) : "v"(lo), "v"(hi)); return r; }

struct DenseOrder {
    typedef pg8::Unit Unit;
    const char* A; const char* Bt; int K; int nM, nN, nwg, G, c;
    __device__ __forceinline__ void init(const void* A_, const void* Bt_, int M_, int N_, int K_, int G_, int c_) { A = (const char*)A_; Bt = (const char*)Bt_; K = K_; nM = M_ / BM; nN = N_ / BM; nwg = nM * nN; G = G_; c = c_; }
    __device__ __forceinline__ bool next(int i, Unit& u) const {
        const long L = (long)i * G + c; if (L >= nwg) return false;
        int wgid = (int)L; { const int q = nwg / NXCD, r = nwg % NXCD, xcd = wgid % NXCD, off = wgid / NXCD; wgid = (xcd < r ? xcd * (q + 1) : r * (q + 1) + (xcd - r) * q) + off; }
        const int nig = WGM * nN, gid = wgid / nig, fm = gid * WGM, gsz = (nM - fm) < WGM ? (nM - fm) : WGM;
        u.pm = fm + ((wgid % nig) % gsz); u.pn = (wgid % nig) / gsz; u.e = 0; u.nrows = 256; u.lt = 0; return true;
    }
    __device__ __forceinline__ const char* a_base(const Unit& u) const { return A + (size_t)u.pm * 512 * K; }
    __device__ __forceinline__ const char* b_base(const Unit& u) const { return Bt + (size_t)u.pn * 512 * K; }
    __device__ __forceinline__ void lane_off(const Unit&, const int (&R)[2], const int (&C)[2], unsigned (&o)[2][2]) const {
#pragma unroll
        for (int h = 0; h < 2; ++h)
#pragma unroll
            for (int i = 0; i < 2; ++i) o[h][i] = (unsigned)(((h * HALF + R[i]) * K + C[i]) * 2);
    }
    __device__ __forceinline__ void a_ready(const Unit&) const {}
    __device__ __forceinline__ void done(const Unit&) const {}
};

template <class Epi, class Sched, bool ALIGN_EPI = false, bool SP2 = false, bool ALLOW = false>
__device__ __forceinline__ void gemm_phase(PG8_LAS unsigned char* lds, const int K, const Sched& S, const Epi& E) {
    typedef typename Sched::Unit Unit;
    const int tid = threadIdx.x, wid = __builtin_amdgcn_readfirstlane(tid >> 6), lane = tid & 63, wr = wid >> 2, wc = wid & 3, fr = lane & 15, fq = lane >> 4;
    const int nt = K / BK;
    unsigned voffB[2]; int stR[2], stC[2];
#pragma unroll
    for (int i = 0; i < 2; ++i) { int R, C; stage_rc(tid * 16 + i * 8192, R, C); const int Rb = Epi::PERM ? ((R & ~31) + perm32(R & 31)) : R;
        stR[i] = R; stC[i] = C; voffB[i] = (unsigned)(Rb * K + C) * 2u; }
    const size_t kstep = (size_t)(BK * 2);
    const size_t hstep = (size_t)HALF * K * 2;
    const size_t tstep = 2 * hstep;
    const unsigned ldsw = (unsigned)wid * 1024u;
    const int aoff = lds_byte(wr * 64 + fr, fq * 8), boff = lds_byte(wc * 32 + fr, fq * 8);
#define PG8_SA(b, h) (((b) * 2 + (h)) * HTB)
#define PG8_SB(b, h) ((4 + (b) * 2 + (h)) * HTB)
#define PG8_STAGE(bufoff, gbase, voff) do { _Pragma("unroll") for (int _i = 0; _i < 2; ++_i) \
        __builtin_amdgcn_global_load_lds((const unsigned*)((const char*)(gbase) + (voff)[_i]), (PG8_LAS unsigned*)(lds + (bufoff) + ldsw + _i * 8192), 16, 0, 0); } while (0)
#define PG8_LDA(dst, b, h) do { _Pragma("unroll") for (int m = 0; m < 4; ++m) _Pragma("unroll") for (int k = 0; k < 2; ++k) dst[m][k] = *(const PG8_LAS bf16x8*)(lds + PG8_SA(b, h) + aoff + m * 2048 + k * 1024); } while (0)
#define PG8_LDB(dst, b, h) do { _Pragma("unroll") for (int n = 0; n < 2; ++n) _Pragma("unroll") for (int k = 0; k < 2; ++k) dst[n][k] = *(const PG8_LAS bf16x8*)(lds + PG8_SB(b, h) + boff + n * 2048 + k * 1024); } while (0)
#define PG8_MMA(ai, bj, At, Bt) do { __builtin_amdgcn_s_setprio(1); _Pragma("unroll") for (int m = 0; m < 4; ++m) _Pragma("unroll") for (int n = 0; n < 2; ++n) _Pragma("unroll") for (int k = 0; k < 2; ++k) \
        acc[ai][bj][m][n] = __builtin_amdgcn_mfma_f32_16x16x32_bf16(Bt[n][k], At[m][k], acc[ai][bj][m][n], 0, 0, 0); __builtin_amdgcn_s_setprio(0); } while (0)
#define PG8_WAIT_V(n) asm volatile("s_waitcnt vmcnt(" #n ")" ::: "memory")
#define PG8_WAIT_L(n) asm volatile("s_waitcnt lgkmcnt(" #n ")" ::: "memory")
#define PG8_WAIT_VA() do { if (ALLOW && t == 0 && ns_pending >= 8) { if (ns_pending >= 16) PG8_WAIT_V(24); else PG8_WAIT_V(16); } else PG8_WAIT_V(8); } while (0)
#define PG8_BAR __builtin_amdgcn_s_barrier()
#define PG8_SCHED __builtin_amdgcn_sched_barrier(0)
    Unit cur, nxt; int ui = 0; int ns_pending = 0; typename Epi::State est;
    if (!S.next(0, cur)) return;
    f32x4 acc[2][2][4][2];
#pragma unroll
    for (int a = 0; a < 2; ++a)
#pragma unroll
        for (int b = 0; b < 2; ++b)
#pragma unroll
            for (int m = 0; m < 4; ++m)
#pragma unroll
                for (int n = 0; n < 2; ++n) acc[a][b][m][n] = (f32x4){0.f, 0.f, 0.f, 0.f};
    bf16x8 At[4][2], B0[2][2], B1[2][2];
    const char* cA = S.a_base(cur); const char* cB = S.b_base(cur);
    unsigned oc[2][2], on[2][2];
    S.lane_off(cur, stR, stC, oc);
    S.a_ready(cur);
    if constexpr (SP2) {
        PG8_STAGE(PG8_SB(0, 0), cB, voffB); PG8_STAGE(PG8_SB(0, 1), cB + hstep, voffB); PG8_STAGE(PG8_SA(0, 0), cA, oc[0]); PG8_STAGE(PG8_SA(0, 1), cA, oc[1]);
        if (wr == 1) PG8_BAR;
        PG8_WAIT_V(2); PG8_BAR;
        PG8_STAGE(PG8_SB(1, 0), cB + kstep, voffB); PG8_STAGE(PG8_SA(1, 0), cA + kstep, oc[0]); PG8_STAGE(PG8_SB(1, 1), cB + hstep + kstep, voffB);
        PG8_WAIT_V(6); PG8_BAR;
    } else {
        PG8_STAGE(PG8_SB(0, 0), cB, voffB); PG8_STAGE(PG8_SA(0, 0), cA, oc[0]); PG8_STAGE(PG8_SB(0, 1), cB + hstep, voffB); PG8_STAGE(PG8_SA(0, 1), cA, oc[1]);
        if (wr == 1) PG8_BAR;
        PG8_WAIT_V(4); PG8_BAR;
        PG8_STAGE(PG8_SB(1, 0), cB + kstep, voffB); PG8_STAGE(PG8_SA(1, 0), cA + kstep, oc[0]); PG8_STAGE(PG8_SB(1, 1), cB + hstep + kstep, voffB);
        PG8_WAIT_V(6); PG8_BAR;
    }
    for (;;) {
        const bool has_next = S.next(ui + 1, nxt);
        E.pre(cur, wr, wc, fr, fq, est);
        const char* nA = has_next ? S.a_base(nxt) : cA; const char* nB = has_next ? S.b_base(nxt) : cB;
        if (has_next) S.lane_off(nxt, stR, stC, on); else {
#pragma unroll
            for (int h = 0; h < 2; ++h)
#pragma unroll
                for (int i = 0; i < 2; ++i) on[h][i] = oc[h][i]; }
        const unsigned long long _gs0 = SUB_T();
        asm volatile(".p2align 8" ::: "memory");
#pragma unroll 1
        for (int t = 0; t < nt; t += 2) {
            const bool last = (t == nt - 2);
            const char* a1 = cA + (size_t)(t + 1) * kstep;
            const char* a2 = last ? nA : cA + (size_t)(t + 2) * kstep; const char* b2 = last ? nB : cB + (size_t)(t + 2) * kstep;
            const char* a3 = a2 + kstep; const char* b3 = b2 + kstep;
            unsigned o2[2][2];
#pragma unroll
            for (int h = 0; h < 2; ++h)
#pragma unroll
                for (int i = 0; i < 2; ++i) o2[h][i] = last ? on[h][i] : oc[h][i];
            if (last && has_next) S.a_ready(nxt);
            if constexpr (SP2) {
            PG8_LDB(B0, 0, 0); PG8_LDB(B1, 0, 1); PG8_SCHED; PG8_LDA(At, 0, 0); PG8_STAGE(PG8_SA(1, 1), a1, oc[1]);
            PG8_WAIT_VA(); PG8_WAIT_L(0); PG8_BAR; PG8_MMA(0, 0, At, B0); PG8_MMA(0, 1, At, B1); PG8_BAR; PG8_SCHED;
            PG8_LDA(At, 0, 1); PG8_STAGE(PG8_SB(0, 0), b2, voffB); PG8_STAGE(PG8_SB(0, 1), b2 + hstep, voffB); PG8_STAGE(PG8_SA(0, 0), a2, o2[0]);
            PG8_WAIT_VA(); PG8_WAIT_L(0); PG8_BAR; PG8_MMA(1, 0, At, B0); PG8_MMA(1, 1, At, B1); PG8_BAR; PG8_SCHED;
            PG8_LDB(B0, 1, 0); PG8_LDB(B1, 1, 1); PG8_SCHED; PG8_LDA(At, 1, 0); PG8_STAGE(PG8_SA(0, 1), a2, o2[1]);
            PG8_WAIT_V(8); PG8_WAIT_L(0); PG8_BAR; PG8_MMA(0, 0, At, B0); PG8_MMA(0, 1, At, B1); PG8_BAR; PG8_SCHED;
            PG8_LDA(At, 1, 1); PG8_STAGE(PG8_SB(1, 0), b3, voffB); PG8_STAGE(PG8_SB(1, 1), b3 + hstep, voffB); PG8_STAGE(PG8_SA(1, 0), a3, o2[0]);
            PG8_WAIT_V(8); PG8_WAIT_L(0); PG8_BAR; PG8_MMA(1, 0, At, B0); PG8_MMA(1, 1, At, B1); PG8_BAR; PG8_SCHED;
            } else {
            PG8_LDB(B0, 0, 0); PG8_SCHED; PG8_LDA(At, 0, 0); PG8_STAGE(PG8_SA(1, 1), a1, oc[1]);
            PG8_WAIT_L(8); PG8_BAR; PG8_WAIT_L(0); PG8_MMA(0, 0, At, B0); PG8_BAR; PG8_SCHED;
            PG8_LDB(B1, 0, 1); PG8_STAGE(PG8_SB(0, 0), b2, voffB);
            PG8_BAR; PG8_WAIT_L(0); PG8_MMA(0, 1, At, B1); PG8_BAR;
            PG8_LDA(At, 0, 1); PG8_STAGE(PG8_SA(0, 0), a2, o2[0]);
            PG8_BAR; PG8_WAIT_L(0); PG8_MMA(1, 0, At, B0); PG8_BAR; PG8_SCHED;
            PG8_STAGE(PG8_SB(0, 1), b2 + hstep, voffB);
            PG8_WAIT_V(6); PG8_BAR; PG8_MMA(1, 1, At, B1); PG8_BAR;
            PG8_LDB(B0, 1, 0); PG8_SCHED; PG8_LDA(At, 1, 0); PG8_STAGE(PG8_SA(0, 1), a2, o2[1]);
            PG8_WAIT_L(8); PG8_BAR; PG8_WAIT_L(0); PG8_MMA(0, 0, At, B0); PG8_BAR; PG8_SCHED;
            PG8_LDB(B1, 1, 1); PG8_STAGE(PG8_SB(1, 0), b3, voffB);
            PG8_BAR; PG8_WAIT_L(0); PG8_MMA(0, 1, At, B1); PG8_BAR;
            PG8_LDA(At, 1, 1); PG8_STAGE(PG8_SA(1, 0), a3, o2[0]);
            PG8_BAR; PG8_WAIT_L(0); PG8_MMA(1, 0, At, B0); PG8_BAR; PG8_SCHED;
            PG8_STAGE(PG8_SB(1, 1), b3 + hstep, voffB);
            PG8_WAIT_V(6); PG8_BAR; PG8_MMA(1, 1, At, B1); PG8_BAR;
            }
        }
        if constexpr (Epi::PROBE_TAG == 1) { SUB_END(0, _gs0); }
        const unsigned long long _gs1 = SUB_T();
        if constexpr (ALIGN_EPI) { if (wr == 0) PG8_BAR; }
        if constexpr (!Epi::AFTER_DRAIN) { E(acc, cur, wr, wc, fr, fq, est); S.done(cur); ns_pending = E.nstore(cur); }
        if constexpr (Epi::PROBE_TAG == 1) { SUB_END(1, _gs1); }
        if (!has_next) break;
#pragma unroll
        for (int a = 0; a < 2; ++a)
#pragma unroll
            for (int b = 0; b < 2; ++b)
#pragma unroll
                for (int m = 0; m < 4; ++m)
#pragma unroll
                    for (int n = 0; n < 2; ++n) acc[a][b][m][n] = (f32x4){0.f, 0.f, 0.f, 0.f};
        cur = nxt; cA = nA; cB = nB; ++ui;
#pragma unroll
        for (int h = 0; h < 2; ++h)
#pragma unroll
            for (int i = 0; i < 2; ++i) oc[h][i] = on[h][i];
        if constexpr (ALIGN_EPI) { if (wr == 1) PG8_BAR; }
    }
    PG8_WAIT_V(0);
    if constexpr (!ALIGN_EPI) { if (wr == 0) PG8_BAR; }
    PG8_BAR;
    if constexpr (Epi::AFTER_DRAIN) { E.fused(acc, cur, wr, wc, fr, fq, lds, wid, lane); S.done(cur); }
#undef PG8_SA
#undef PG8_SB
#undef PG8_STAGE
#undef PG8_LDA
#undef PG8_LDB
#undef PG8_MMA
#undef PG8_WAIT_V
#undef PG8_WAIT_L
#undef PG8_WAIT_VA
#undef PG8_BAR
#undef PG8_SCHED
}
}

#define GAS __attribute__((address_space(1)))
#define LAS __attribute__((address_space(3)))
typedef unsigned v4u __attribute__((ext_vector_type(4)));
typedef float f32x4 __attribute__((ext_vector_type(4)));
typedef GAS unsigned gu32;
#define RLX_AGENT __ATOMIC_RELAXED, __HIP_MEMORY_SCOPE_AGENT
#define LDS_WAIT() asm volatile("s_waitcnt lgkmcnt(0)" ::: "memory")
#define VM_WAIT() asm volatile("s_waitcnt vmcnt(0)" ::: "memory")
constexpr int NWAVES = 8;
constexpr int RING_OFF = 0, RING_BYTES = 131072;
constexpr int LDS_BYTES = 163840;
constexpr int LDSCTL_OFF = LDS_BYTES - 4096, MISC_OFF = LDSCTL_OFF + 320;
constexpr int PLAN_OFF = LDSCTL_OFF + 1024;

#define XB_TMO      128
#define XB_XCNT(j)  (256  + 64 * (j))
#define XB_XSUB(j)  (1280 + 64 * (j))
#define XB_XGEN(j)  (2304 + 64 * (j))
#define XB_TOP      3328
#define XB_TOPGEN   3392
#define XCD_BAR_WORDS 3456
#define XB_SPIN_CAP (1u << 18)

__device__ __forceinline__ unsigned xb_ld(unsigned* p)              { return __hip_atomic_load(p, __ATOMIC_RELAXED, __HIP_MEMORY_SCOPE_AGENT); }
__device__ __forceinline__ unsigned xb_add(unsigned* p, unsigned v) { return __hip_atomic_fetch_add(p, v, __ATOMIC_RELAXED, __HIP_MEMORY_SCOPE_AGENT); }
__device__ __forceinline__ unsigned xb_xcc_id() { return (unsigned)__builtin_amdgcn_s_getreg((3 << 11) | 20) & 0xFu; }
#define XB_SPIN(cond, bar) do { unsigned _sp = 0; while (cond) { __builtin_amdgcn_s_sleep(1); \
    if ((++_sp & 255u) == 0u) { if (xb_ld(&(bar)[XB_TMO])) break; if (_sp > XB_SPIN_CAP) { atomicAdd(&(bar)[XB_TMO], 1u); break; } } } } while (0)

struct XcdBarrier {
    unsigned* bar; unsigned x;
    volatile LAS unsigned* st;
};

__device__ __forceinline__ XcdBarrier xcd_barrier_post(unsigned* bar, volatile LAS unsigned* st) {
    XcdBarrier b; b.bar = bar; b.x = xb_xcc_id(); b.st = st;
    if (threadIdx.x == 0) (void)xb_add(&bar[XB_XCNT(b.x)], 1u);
    return b;
}
__device__ __forceinline__ void xcd_barrier_complete(unsigned* bar, unsigned x, unsigned& nloc, unsigned& nx) {
    const unsigned G = gridDim.x * gridDim.y * gridDim.z;
    unsigned sum, cnt, mine, sp = 0u;
    for (;;) {
        sum = 0u; cnt = 0u; mine = 0u;
#pragma unroll
        for (unsigned j = 0; j < 16; ++j) { const unsigned c = xb_ld(&bar[XB_XCNT(j)]); sum += c; cnt += (c > 0u) ? 1u : 0u; mine = (j == x) ? c : mine; }
        if (sum == G) break;
        __builtin_amdgcn_s_sleep(1);
        if ((++sp & 255u) == 0u) { if (xb_ld(&bar[XB_TMO])) break; if (sp > XB_SPIN_CAP) { atomicAdd(&bar[XB_TMO], 1u); break; } }
    }
    nloc = mine > 0u ? mine : 1u; nx = cnt > 0u ? cnt : 1u;
}

__device__ __forceinline__ void xcd_barrier(const XcdBarrier& b) {
    asm volatile("s_waitcnt vmcnt(0)" ::: "memory");
    __syncthreads();
    if (threadIdx.x == 0) {
        unsigned* bar = b.bar;
        __builtin_amdgcn_s_waitcnt(0);
        unsigned nloc = b.st[0], nx = b.st[1];
        if (nloc == 0u) { xcd_barrier_complete(bar, b.x, nloc, nx); b.st[0] = nloc; b.st[1] = nx; }
        const unsigned old = xb_add(&bar[XB_XSUB(b.x)], 1u);
        const unsigned gen = old / nloc;
        if (old + 1u == (gen + 1u) * nloc) {
            __builtin_amdgcn_fence(__ATOMIC_RELEASE, "agent");
            asm volatile("s_waitcnt vmcnt(0)" ::: "memory");
            const unsigned og = xb_add(&bar[XB_TOP], 1u);
            const unsigned tg = og / nx;
            if (og + 1u == (tg + 1u) * nx) xb_add(&bar[XB_TOPGEN], 1u);
            else XB_SPIN(xb_ld(&bar[XB_TOPGEN]) == tg, bar);
            __builtin_amdgcn_fence(__ATOMIC_ACQUIRE, "agent");
            xb_add(&bar[XB_XGEN(b.x)], 1u);
            asm volatile("s_waitcnt vmcnt(0)" ::: "memory");
        } else {
            XB_SPIN(xb_ld(&bar[XB_XGEN(b.x)]) == gen, bar);
            __builtin_amdgcn_fence(__ATOMIC_ACQUIRE, "agent");
            asm volatile("s_waitcnt vmcnt(0)" ::: "memory");
        }
    }
    __syncthreads();
}

__device__ __forceinline__ float wave_sum(float v) {
#pragma unroll
    for (int o = 1; o < 64; o <<= 1) v += __shfl_xor(v, o);
    return v;
}

struct EpiIn { static constexpr int PROBE_TAG = 0; struct State {}; __device__ __forceinline__ void pre(const pg8::Unit&, int, int, int, int, State&) const {}
    static constexpr bool PERM = true, AFTER_DRAIN = false;
    __device__ __forceinline__ int nstore(const pg8::Unit& u) const { return u.pn == 18 ? 0 : 16; }
    bf16_t *zq, *xbc, *kk, *vv; float* dt;
    __device__ __forceinline__ void operator()(const pg8::f32x4 (&acc)[2][2][4][2], const pg8::Unit& u, int wr, int wc, int fr, int fq, const State&) const {
        const int row0 = u.pm * 256 + wr * 64 + fr, pn = u.pn;
        if (pn == 18) {
            if (wc == 0 && fq < 2) {
#pragma unroll
                for (int ai = 0; ai < 2; ++ai)
#pragma unroll
                    for (int m = 0; m < 4; ++m) { float* o = dt + (size_t)(row0 + ai * 128 + m * 16) * 16 + 8 * fq; *(pg8::f32x4*)o = acc[ai][0][m][0]; *(pg8::f32x4*)(o + 4) = acc[ai][0][m][1]; }
            }
            return;
        }
        bf16_t* base; int ldc, colt;
        if (pn < 4) { base = zq; ldc = 2048; colt = pn * 256; }
        else if (pn < 12) { base = xbc; ldc = 2048; colt = (pn - 4) * 256; }
        else if (pn < 16) { base = zq; ldc = 2048; colt = 1024 + (pn - 12) * 256; }
        else if (pn == 16) { base = kk; ldc = 256; colt = 0; }
        else { base = vv; ldc = 256; colt = 0; }
        const int col0 = colt + wc * 32 + 8 * fq;
#pragma unroll
        for (int ai = 0; ai < 2; ++ai)
#pragma unroll
            for (int m = 0; m < 4; ++m) { bf16_t* rowp = base + (size_t)(row0 + ai * 128 + m * 16) * ldc + col0;
#pragma unroll
                for (int bj = 0; bj < 2; ++bj) { const pg8::f32x4 v0 = acc[ai][bj][m][0], v1 = acc[ai][bj][m][1];
                    pg8::u32x4 w; w.x = pg8::cvt_pk_bf16(v0[0], v0[1]); w.y = pg8::cvt_pk_bf16(v0[2], v0[3]); w.z = pg8::cvt_pk_bf16(v1[0], v1[1]); w.w = pg8::cvt_pk_bf16(v1[2], v1[3]);
                    *(pg8::u32x4*)(rowp + bj * 128) = w; } }
    }
};

struct EpiOut { static constexpr int PROBE_TAG = 0; struct State {}; __device__ __forceinline__ void pre(const pg8::Unit&, int, int, int, int, State&) const {}
    static constexpr bool PERM = true, AFTER_DRAIN = false;
    __device__ __forceinline__ int nstore(const pg8::Unit&) const { return 16; }
    const float* x; float* x1; const float* mod;
    __device__ __forceinline__ void operator()(const pg8::f32x4 (&acc)[2][2][4][2], const pg8::Unit& u, int wr, int wc, int fr, int fq, const State&) const {
        const int row0 = u.pm * 256 + wr * 64 + fr, col0 = u.pn * 256 + wc * 32 + 8 * fq, b = (u.pm * 256) / SEQ;
        const float* g1 = mod + b * 6 * D + 2 * D + col0;
        pg8::f32x4 gv[2][2];
#pragma unroll
        for (int bj = 0; bj < 2; ++bj) { gv[bj][0] = *(const pg8::f32x4*)(g1 + bj * 128); gv[bj][1] = *(const pg8::f32x4*)(g1 + bj * 128 + 4); }
#pragma unroll
        for (int ai = 0; ai < 2; ++ai)
#pragma unroll
            for (int m = 0; m < 4; ++m) { const size_t off = (size_t)(row0 + ai * 128 + m * 16) * D + col0;
#pragma unroll
                for (int bj = 0; bj < 2; ++bj) { const float* xi = x + off + bj * 128; float* xo = x1 + off + bj * 128;
                    *(pg8::f32x4*)xo = *(const pg8::f32x4*)xi + gv[bj][0] * acc[ai][bj][m][0]; *(pg8::f32x4*)(xo + 4) = *(const pg8::f32x4*)(xi + 4) + gv[bj][1] * acc[ai][bj][m][1]; } }
    }
};
struct EpiGU { static constexpr int PROBE_TAG = 0; struct State {}; __device__ __forceinline__ void pre(const pg8::Unit&, int, int, int, int, State&) const {}
    static constexpr bool PERM = true, AFTER_DRAIN = false;
    __device__ __forceinline__ int nstore(const pg8::Unit&) const { return 8; }
    bf16_t* u;
    __device__ __forceinline__ void operator()(const pg8::f32x4 (&acc)[2][2][4][2], const pg8::Unit& un, int wr, int wc, int fr, int fq, const State&) const {
        const int row0 = un.pm * 256 + wr * 64 + fr, col0 = un.pn * 128 + wc * 32 + 8 * fq;
#pragma unroll
        for (int ai = 0; ai < 2; ++ai)
#pragma unroll
            for (int m = 0; m < 4; ++m) { bf16_t* rowp = u + (size_t)(row0 + ai * 128 + m * 16) * ED + col0;
                float o[8];
#pragma unroll
                for (int n = 0; n < 2; ++n)
#pragma unroll
                    for (int j = 0; j < 4; ++j) o[4 * n + j] = silu_f(acc[ai][0][m][n][j]) * acc[ai][1][m][n][j];
                pg8::u32x4 w; w.x = pg8::cvt_pk_bf16(o[0], o[1]); w.y = pg8::cvt_pk_bf16(o[2], o[3]); w.z = pg8::cvt_pk_bf16(o[4], o[5]); w.w = pg8::cvt_pk_bf16(o[6], o[7]);
                *(pg8::u32x4*)rowp = w; }
    }
};
constexpr float YC_SCALE = 16.f;
struct EpiDown {
    static constexpr bool PERM = true, AFTER_DRAIN = false;
    static constexpr int PROBE_TAG = 1; struct State { unsigned pm[8]; };
    unsigned char* yc; const unsigned* pmeta; unsigned char* dump;
    __device__ __forceinline__ int nstore(const pg8::Unit&) const { return 8; }
    __device__ __forceinline__ void pre(const pg8::Unit& u, int wr, int wc, int fr, int fq, State& st) const {
        if (u.e < NE) { const unsigned* lp = pmeta + (size_t)u.e * M + u.lt * 256;
#pragma unroll
            for (int i = 0; i < 8; ++i) { const int r = (i >> 2) * 128 + wr * 64 + (i & 3) * 16 + fr; st.pm[i] = lp[r < u.nrows ? r : 0]; }
#pragma unroll
            for (int i = 0; i < 8; ++i) { const int r = (i >> 2) * 128 + wr * 64 + (i & 3) * 16 + fr; if (r >= u.nrows) st.pm[i] = 0xffffffffu; }
        } else {
#pragma unroll
            for (int i = 0; i < 8; ++i) { const int r = (i >> 2) * 128 + wr * 64 + (i & 3) * 16 + fr; st.pm[i] = r < u.nrows ? ((unsigned)((u.lt * 256 + r) * NSLOT + 8) << 14) | 4096u : 0xffffffffu; }
        }
    }
    __device__ __forceinline__ void operator()(const pg8::f32x4 (&acc)[2][2][4][2], const pg8::Unit& u, int wr, int wc, int fr, int fq, const State& st) const {
        const unsigned pos0 = (unsigned)(u.pn * 256 + wc * 64 + fq * 16);
#pragma unroll
        for (int ai = 0; ai < 2; ++ai)
#pragma unroll
            for (int m = 0; m < 4; ++m) { const unsigned pmv = st.pm[ai * 4 + m]; const float gt = (float)(pmv & 0x3fffu) * (YC_SCALE / 4096.f);
                unsigned char* dst = pmv != 0xffffffffu ? yc + ((size_t)(pmv >> 14) * 1024u + pos0) : dump + (threadIdx.x & 511) * 16;
                pg8::u32x4 w;
#pragma unroll
                for (int bj = 0; bj < 2; ++bj)
#pragma unroll
                    for (int n = 0; n < 2; ++n) { const pg8::f32x4 v = acc[ai][bj][m][n] * gt; int q = __builtin_amdgcn_cvt_pk_fp8_f32(v[0], v[1], 0, false); q = __builtin_amdgcn_cvt_pk_fp8_f32(v[2], v[3], q, true); w[bj * 2 + n] = (unsigned)q; }
                *(pg8::u32x4*)dst = w; }
    }
};
template <bool GATHER>
struct GroupedOrder {
    typedef pg8::Unit Unit;
    const char* A; const char* Bt; int K, nN, G, c, total; const LAS int* plan; const int* list; size_t bs_e, bs_pn; int pn0;
    __device__ __forceinline__ void init(const void* A_, const void* Bt_, int K_, int nN_, int G_, int c_, const LAS int* plan_, const int* list_, size_t bs_e_, size_t bs_pn_, int pn0_) {
        A = (const char*)A_; Bt = (const char*)Bt_; K = K_; nN = nN_; G = G_; c = c_; plan = plan_; list = list_; bs_e = bs_e_; bs_pn = bs_pn_; pn0 = pn0_; total = __builtin_amdgcn_readfirstlane(plan[NE + 1]) * nN; }
    __device__ __forceinline__ bool next(int i, Unit& u) const {
        const int L = i * G + c; if (L >= total) return false;
        int wgid = L; { const int q = total / 8, r = total % 8, xcd = wgid % 8, off = wgid / 8; wgid = (xcd < r ? xcd * (q + 1) : r * (q + 1) + (xcd - r) * q) + off; }
        const int tile = wgid / nN; u.pn = wgid % nN; u.pm = tile;
        int e = 0;
        for (int j = 1; j <= NE; ++j) e += (plan[j] <= tile) ? 1 : 0;
        e = __builtin_amdgcn_readfirstlane(e);
        u.e = e; u.lt = __builtin_amdgcn_readfirstlane(tile - plan[e]); const int rem = __builtin_amdgcn_readfirstlane(plan[80 + e]) - u.lt * 256; u.nrows = rem < 256 ? rem : 256; return true;
    }
    __device__ __forceinline__ const char* a_base(const Unit& u) const { return GATHER ? A : A + (size_t)u.pm * 512 * K; }
    __device__ __forceinline__ const char* b_base(const Unit& u) const { return Bt + (size_t)u.e * bs_e + (size_t)(pn0 + u.pn) * bs_pn; }
    __device__ __forceinline__ void lane_off(const Unit& u, const int (&R)[2], const int (&C)[2], unsigned (&o)[2][2]) const {
#pragma unroll
        for (int h = 0; h < 2; ++h)
#pragma unroll
            for (int i = 0; i < 2; ++i) { const int r = h * 128 + R[i];
                if (GATHER) { int tok = 0; if (r < u.nrows) { const int idx = u.lt * 256 + r; tok = u.e < NE ? (list[(size_t)u.e * M + idx] >> 3) : idx; }
                    o[h][i] = (unsigned)((tok * K + C[i]) * 2); }
                else o[h][i] = (unsigned)((r * K + C[i]) * 2); }
    }
    __device__ __forceinline__ void a_ready(const Unit&) const {}
    __device__ __forceinline__ void done(const Unit&) const {}
};

template <class CM>
__device__ __forceinline__ void transpose_item(const float* W, int ldw, bf16_t* WT, int ldt, int k0, int n0, LAS float* scr, int lane, const CM& colmap) {
    const int sc = colmap(n0 + (lane & 31));
#pragma unroll
    for (int i = 0; i < 32; ++i) { const int kk = 2 * i + (lane >> 5); scr[kk * 33 + (lane & 31)] = sc >= 0 ? W[(size_t)(k0 + kk) * ldw + sc] : 0.f; }
    LDS_WAIT(); asm volatile("" ::: "memory");
    const int c = lane & 7;
#pragma unroll
    for (int j = 0; j < 4; ++j) { const int n = (lane >> 3) + 8 * j; const LAS float* s = scr + (8 * c) * 33 + n;
        v4u o; o.x = pk2(s[0 * 33], s[1 * 33]); o.y = pk2(s[2 * 33], s[3 * 33]); o.z = pk2(s[4 * 33], s[5 * 33]); o.w = pk2(s[6 * 33], s[7 * 33]);
        *(GAS v4u*)(WT + (size_t)(n0 + n) * ldt + k0 + 8 * c) = o; }
    LDS_WAIT(); asm volatile("" ::: "memory");
}

typedef short v4i16_t __attribute__((ext_vector_type(4)));
__device__ __forceinline__ v4i16_t tr4(const LAS unsigned char* img, int stride, int row0, int col0, int lane) {
    const LAS unsigned char* a = img + (row0 + ((lane & 15) >> 2)) * stride + (col0 + 4 * (lane & 3)) * 2;
    return __builtin_amdgcn_ds_read_tr16_b64_v4i16((LAS v4i16_t*)a);
}
__device__ __forceinline__ pg8::bf16x8 cat44(v4i16_t lo, v4i16_t hi) { return (pg8::bf16x8){lo[0], lo[1], lo[2], lo[3], hi[0], hi[1], hi[2], hi[3]}; }

template <class EMIT>
__device__ __forceinline__ void conv16x8(const bf16_t* xbc, const float* cw, const float* cb, int row0, int t0, int ch, const EMIT& emit) {
    v4u raw[19];
#pragma unroll
    for (int k = 0; k < 19; ++k) { raw[k] = (v4u){0u, 0u, 0u, 0u}; if (t0 - 3 + k >= 0) raw[k] = *(const v4u*)(xbc + (size_t)(row0 - 3 + k) * CONV_CH + ch); }
    float wv[4][8], bv[8];
#pragma unroll
    for (int k = 0; k < 4; ++k) { const f32x4 a = *(const f32x4*)(cw + k * CONV_CH + ch), b = *(const f32x4*)(cw + k * CONV_CH + ch + 4); wv[k][0] = a.x; wv[k][1] = a.y; wv[k][2] = a.z; wv[k][3] = a.w; wv[k][4] = b.x; wv[k][5] = b.y; wv[k][6] = b.z; wv[k][7] = b.w; }
    { const f32x4 a = *(const f32x4*)(cb + ch), b = *(const f32x4*)(cb + ch + 4); bv[0] = a.x; bv[1] = a.y; bv[2] = a.z; bv[3] = a.w; bv[4] = b.x; bv[5] = b.y; bv[6] = b.z; bv[7] = b.w; }
    float win[4][8];
#pragma unroll
    for (int k = 0; k < 3; ++k) { const unsigned w4[4] = {raw[k].x, raw[k].y, raw[k].z, raw[k].w};
#pragma unroll
        for (int j = 0; j < 4; ++j) { win[k][2 * j] = __uint_as_float(w4[j] << 16); win[k][2 * j + 1] = __uint_as_float(w4[j] & 0xffff0000u); } }
#pragma unroll
    for (int r = 0; r < 16; ++r) {
        { const unsigned w4[4] = {raw[r + 3].x, raw[r + 3].y, raw[r + 3].z, raw[r + 3].w};
#pragma unroll
          for (int j = 0; j < 4; ++j) { win[(r + 3) & 3][2 * j] = __uint_as_float(w4[j] << 16); win[(r + 3) & 3][2 * j + 1] = __uint_as_float(w4[j] & 0xffff0000u); } }
        float o[8];
#pragma unroll
        for (int j = 0; j < 8; ++j) { float a = bv[j];
#pragma unroll
            for (int k = 0; k < 4; ++k) a += wv[k][j] * win[(r + k) & 3][j];
            o[j] = silu_f(a); }
        emit(r, o);
    }
}

__device__ __forceinline__ void conv2x8(const bf16_t* xbc, const float* cw, const float* cb, int row, int t, int ch, float (&o0)[8], float (&o1)[8]) {
    float xr[5][8];
#pragma unroll
    for (int k = 0; k < 5; ++k) { v4u raw = (v4u){0u, 0u, 0u, 0u}; if (t - 3 + k >= 0) raw = *(const v4u*)(xbc + (size_t)(row - 3 + k) * CONV_CH + ch);
        const unsigned w4[4] = {raw.x, raw.y, raw.z, raw.w};
#pragma unroll
        for (int j = 0; j < 4; ++j) { xr[k][2 * j] = __uint_as_float(w4[j] << 16); xr[k][2 * j + 1] = __uint_as_float(w4[j] & 0xffff0000u); } }
    float wv[4][8], bv[8];
#pragma unroll
    for (int k = 0; k < 4; ++k) { const f32x4 a = *(const f32x4*)(cw + k * CONV_CH + ch), b = *(const f32x4*)(cw + k * CONV_CH + ch + 4); wv[k][0] = a.x; wv[k][1] = a.y; wv[k][2] = a.z; wv[k][3] = a.w; wv[k][4] = b.x; wv[k][5] = b.y; wv[k][6] = b.z; wv[k][7] = b.w; }
    { const f32x4 a = *(const f32x4*)(cb + ch), b = *(const f32x4*)(cb + ch + 4); bv[0] = a.x; bv[1] = a.y; bv[2] = a.z; bv[3] = a.w; bv[4] = b.x; bv[5] = b.y; bv[6] = b.z; bv[7] = b.w; }
#pragma unroll
    for (int j = 0; j < 8; ++j) { float a0 = bv[j], a1 = bv[j];
#pragma unroll
        for (int k = 0; k < 4; ++k) { a0 += wv[k][j] * xr[k][j]; a1 += wv[k][j] * xr[k + 1][j]; }
        o0[j] = silu_f(a0); o1[j] = silu_f(a1); }
}

constexpr int NPHASE = 12;
__global__ void __launch_bounds__(NWAVES * 64, 2) mega(P p) {
    extern __shared__ __attribute__((aligned(16))) unsigned char lds_raw[];
    LAS unsigned char* lds = (LAS unsigned char*)lds_raw;
    volatile LAS unsigned* MISC = (volatile LAS unsigned*)(lds + MISC_OFF);
    const int tid = threadIdx.x, lane = tid & 63, wave = __builtin_amdgcn_readfirstlane(tid >> 6);
    const int G = gridDim.x; const int bx = blockIdx.x; const int vcu = (G % 8 == 0) ? (bx % 8) * (G / 8) + bx / 8 : bx;
    unsigned char* ws = p.ws;
    gu32* ctl = (gu32*)(ws + WS_CTL);
    for (int u = tid; u < (LDS_BYTES - LDSCTL_OFF) / 4; u += NWAVES * 64) ((LAS unsigned*)(lds + LDSCTL_OFF))[u] = 0u;
    __syncthreads();
    XcdBarrier bar = xcd_barrier_post((unsigned*)(ctl + CW_BAR) + p.li * XCD_BAR_WORDS, MISC + 8);
    const int lo = p.ph_lo, hi = p.ph_hi;
#ifndef PHMASK
#define PHMASK 0xffffffffu
#endif
#define IN(k) (((PHMASK >> (k)) & 1u) && lo <= (k) && (k) < hi)
#define BOTH(k) (IN(k) && IN((k) + 1))
#ifdef PROBE_MASK
#define PH_BEGIN() const unsigned long long _pt0 = __builtin_amdgcn_s_memrealtime()
#define PH_END(k) do { if ((PROBE_MASK >> (k)) & 1u) { const unsigned long long _pt1 = __builtin_amdgcn_s_memrealtime(); while (__builtin_amdgcn_s_memrealtime() < _pt1 + (_pt1 - _pt0)) __builtin_amdgcn_s_sleep(8); } } while (0)
#else
#define PH_BEGIN() do {} while (0)
#define PH_END(k) do {} while (0)
#endif
    const int gw = vcu * NWAVES + wave, NGW = G * NWAVES;
    float* modv = (float*)(ws + WS_MOD);

    constexpr int I_GU = 16 * 16, I_D = 4 * 32, QBATCH = 16;
    LAS int* qslot = (LAS int*)(lds + PLAN_OFF + 1024);
#define STEAL_ITEMS(qword, NITEMS, ITEM_BODY) do { LAS float* scr = (LAS float*)(lds + RING_OFF + wave * 16384); \
        for (;;) { __syncthreads(); if (tid == 0) *qslot = (int)atomicAdd((unsigned*)(ws + WS_CTL) + (qword), (unsigned)QBATCH); __syncthreads(); \
            const int qb_ = __builtin_amdgcn_readfirstlane(*qslot); if (qb_ >= (NITEMS)) break; \
            for (int it = qb_ + wave; it < qb_ + QBATCH && it < (NITEMS); it += NWAVES) { ITEM_BODY } } } while (0)
#define ITEM_WGU { const int e = it / I_GU, r = it % I_GU, nb = r & 15, kb = r >> 4, up = (nb >> 2) & 1; \
        const float* W = e < NE ? (up ? p.exp_w_up : p.exp_w_gate) + (size_t)e * D * ED : (up ? p.sh_w_up : p.sh_w_gate); \
        transpose_item(W, ED, (bf16_t*)(ws + WS_WGU) + (size_t)e * 512 * D, D, kb * 64, nb * 32, scr, lane, [](int n) { return (n >> 8) * 128 + (n & 127); }); }
#define ITEM_WD { const int e = it / I_D, r2 = it % I_D, nb = r2 & 31, kb = r2 >> 5; \
        const float* W = e < NE ? p.exp_w_down + (size_t)e * ED * D : p.sh_w_down; \
        transpose_item(W, D, (bf16_t*)(ws + WS_WD) + (size_t)e * D * ED, ED, kb * 64, nb * 32, scr, lane, [](int n) { return n; }); }

    if (IN(0)) { PH_BEGIN();
        {
            LAS float* scl = (LAS float*)(lds + RING_OFF);
            LAS float* part = (LAS float*)(lds + RING_OFF + 16384);
            for (int i = tid; i < BATCH * D; i += 512) scl[i] = silu_f(p.c[i]);
            __syncthreads();
            const int cc = tid & 15, ks = tid >> 4;
            for (int item = bx; item < 6 * D / 16; item += G) { const int j0 = item * 16;
                float wv[32];
#pragma unroll
                for (int k = 0; k < 32; ++k) wv[k] = p.mod_w[(size_t)(ks * 32 + k) * 6 * D + j0 + cc];
                float a0 = 0.f, a1 = 0.f, a2 = 0.f, a3 = 0.f;
#pragma unroll
                for (int k = 0; k < 32; ++k) { const int kk = ks * 32 + k; a0 += scl[kk] * wv[k]; a1 += scl[D + kk] * wv[k]; a2 += scl[2 * D + kk] * wv[k]; a3 += scl[3 * D + kk] * wv[k]; }
                part[(ks * 4 + 0) * 16 + cc] = a0; part[(ks * 4 + 1) * 16 + cc] = a1; part[(ks * 4 + 2) * 16 + cc] = a2; part[(ks * 4 + 3) * 16 + cc] = a3;
                __syncthreads();
                if (tid < 64) { const int b = tid >> 4, c2 = tid & 15; float sacc = p.mod_b[j0 + c2];
                    for (int q = 0; q < 32; ++q) sacc += part[(q * 4 + b) * 16 + c2];
                    modv[b * 6 * D + j0 + c2] = sacc; }
                __syncthreads();
            }
        }
        LAS float* scr = (LAS float*)(lds + RING_OFF + wave * 16384);
        constexpr int I_IN = (D / 64) * (NWIN / 32), I_OUT = (2048 / 64) * (D / 32);
        bf16_t* WinT = (bf16_t*)(ws + WS_WIN_T); bf16_t* WoutT = (bf16_t*)(ws + WS_WOUT_T);
        for (int it = gw; it < I_IN + I_OUT; it += NGW) {
            if (it < I_IN) { const int nb = it % (NWIN / 32), kb = it / (NWIN / 32);
                transpose_item(p.w_in, IN_COLS, WinT, D, kb * 64, nb * 32, scr, lane, [](int n) { return n < 3072 ? n : (n < 4608 ? n + 16 : (n < 4624 ? n - 1536 : -1)); }); }
            else { const int r = it - I_IN, nb = r % (D / 32), kb = r / (D / 32);
                transpose_item(p.w_out, D, WoutT, 2048, kb * 64, nb * 32, scr, lane, [](int n) { return n; }); }
        }
        {
            v4u* rwf = (v4u*)(ws + WS_RWF);
            for (int i = bx * 512 + tid; i < 32 * 4 * 64; i += G * 512) { const int ln = i & 63, nt = (i >> 6) & 3, ks = i >> 8, c = ln & 15, q = ln >> 4;
                float v[8]; unsigned hi[4], lo[4];
#pragma unroll
                for (int j = 0; j < 8; ++j) v[j] = p.router_w[(32 * ks + 8 * q + j) * NE + 16 * nt + c];
#pragma unroll
                for (int j = 0; j < 4; ++j) { hi[j] = pk2(v[2 * j], v[2 * j + 1]); lo[j] = pk2(v[2 * j] - __uint_as_float(hi[j] << 16), v[2 * j + 1] - __uint_as_float(hi[j] & 0xffff0000u)); }
                rwf[((ks * 4 + nt) * 2) * 64 + ln] = (v4u){hi[0], hi[1], hi[2], hi[3]}; rwf[((ks * 4 + nt) * 2 + 1) * 64 + ln] = (v4u){lo[0], lo[1], lo[2], lo[3]}; }
        }
        if (BOTH(0)) xcd_barrier(bar);
        PH_END(0);
    }

    if (IN(1)) { PH_BEGIN();
        bf16_t* hn = (bf16_t*)p.out;
        for (int m = gw; m < M; m += NGW) {
            const int b = m / SEQ; const GAS f32x4* xr = (const GAS f32x4*)(p.x + (size_t)m * D) + lane;
            f32x4 v[4]; float s = 0.f;
#pragma unroll
            for (int j = 0; j < 4; ++j) { v[j] = xr[64 * j]; s += (v[j].x * v[j].x + v[j].y * v[j].y) + (v[j].z * v[j].z + v[j].w * v[j].w); }
            const float rstd = rsqrtf(wave_sum(s) * (1.f / D) + EPS);
            GAS unsigned long long* o8 = (GAS unsigned long long*)(hn + (size_t)m * D) + lane;
#pragma unroll
            for (int j = 0; j < 4; ++j) { const int d = 4 * lane + 256 * j; const f32x4 g = *(const f32x4*)(p.norm1_g + d), sc = *(const f32x4*)(modv + b * 6 * D + D + d), sh = *(const f32x4*)(modv + b * 6 * D + d);
                const f32x4 h = v[j] * rstd * g * (sc + 1.f) + sh;
                o8[64 * j] = (unsigned long long)pk2(h.x, h.y) | ((unsigned long long)pk2(h.z, h.w) << 32); }
        }
        if (BOTH(1)) xcd_barrier(bar);
        PH_END(1);
    }

    if (IN(2)) { PH_BEGIN();
        pg8::DenseOrder S; S.init(p.out, ws + WS_WIN_T, M, NWIN, D, G, bx);
        EpiIn E{(bf16_t*)(ws + WS_ZQ), (bf16_t*)(ws + WS_XBC), (bf16_t*)(ws + WS_K), (bf16_t*)(ws + WS_V), (float*)(ws + WS_DT)};
        pg8::gemm_phase<EpiIn, pg8::DenseOrder, true, true>(lds + RING_OFF, D, S, E);
        STEAL_ITEMS(CW_Q1, (NE + 1) * I_GU, ITEM_WGU);
        if (BOTH(2)) xcd_barrier(bar);
        PH_END(2);
    }

    if (IN(3)) { PH_BEGIN();
        {
            typedef pg8::bf16x8 bf16x8; typedef pg8::f32x4 f4;
            bf16_t* zq = (bf16_t*)(ws + WS_ZQ); const bf16_t* kk = (const bf16_t*)(ws + WS_K); const bf16_t* vv = (const bf16_t*)(ws + WS_V); float* ssq = (float*)(ws + WS_SSQ);
            LAS unsigned char* Kl = lds + RING_OFF; LAS unsigned char* Vl = lds + RING_OFF + 27648; LAS float* biasl = (LAS float*)(lds + RING_OFF + 58368);
            __syncthreads();
            for (int i = tid; i < ATT_HEADS * 128; i += 512) { const int h = i >> 7, dist = i & 127; biasl[i] = p.rel_bias[c_bucket[dist] * ATT_HEADS + h]; }
            const int fr = lane & 15, fg = lane >> 4;
            for (int unit = bx; unit < BATCH * (SEQ / 64); unit += G) {
                const int b = unit / (SEQ / 64), qb = unit % (SEQ / 64), t0 = qb * 64, row0 = b * SEQ + t0;
                v4u kreg[3], vreg[3]; bf16x8 Qn[2][2];
#define ATT_LOADS(KVH) do { _Pragma("unroll") for (int q3 = 0; q3 < 3; ++q3) { const int i = tid + 512 * q3, j = i >> 3, ch = i & 7, kt = t0 - 128 + j; \
                        kreg[q3] = (v4u){0u, 0u, 0u, 0u}; vreg[q3] = (v4u){0u, 0u, 0u, 0u}; \
                        if (kt >= 0) { kreg[q3] = *(const v4u*)(kk + (size_t)(b * SEQ + kt) * D_KV + (KVH) * HD + ch * 8); vreg[q3] = *(const v4u*)(vv + (size_t)(b * SEQ + kt) * D_KV + (KVH) * HD + ch * 8); } } \
                    _Pragma("unroll") for (int r2 = 0; r2 < 2; ++r2) _Pragma("unroll") for (int ks = 0; ks < 2; ++ks) \
                        Qn[r2][ks] = *(const bf16x8*)(zq + (size_t)(row0 + 16 * (2 * (wave & 1) + r2) + fr) * 2048 + 1024 + ((KVH) * 4 + (wave >> 1)) * HD + ks * 32 + 8 * fg); } while (0)
                ATT_LOADS(0);
                for (int kvh = 0; kvh < KV_HEADS; ++kvh) {
                    __syncthreads();
#pragma unroll
                    for (int q3 = 0; q3 < 3; ++q3) { const int i = tid + 512 * q3, j = i >> 3, ch = i & 7; *(LAS v4u*)(Kl + j * 144 + ch * 16) = kreg[q3]; *(LAS v4u*)(Vl + j * 160 + ch * 16) = vreg[q3]; }
                    bf16x8 Qc[2][2];
#pragma unroll
                    for (int r2 = 0; r2 < 2; ++r2)
#pragma unroll
                        for (int ks = 0; ks < 2; ++ks) Qc[r2][ks] = Qn[r2][ks];
                    __syncthreads();
                    if (kvh + 1 < KV_HEADS) ATT_LOADS(kvh + 1);
                    const int head = kvh * 4 + (wave >> 1), rt0 = 2 * (wave & 1), jt0 = rt0;
                    const float sink = p.sinks[head]; const LAS float* bl = biasl + head * 128;
#pragma unroll 1
                    for (int r2 = 0; r2 < 2; ++r2) {
                        const int qi = 16 * (rt0 + r2) + fr;
                        bf16x8 Qf[2];
#pragma unroll
                        for (int ks = 0; ks < 2; ++ks) Qf[ks] = r2 ? Qc[1][ks] : Qc[0][ks];
                        f4 sacc[10];
#pragma unroll
                        for (int jt = 0; jt < 10; ++jt) sacc[jt] = (f4){0.f, 0.f, 0.f, 0.f};
#pragma unroll
                        for (int jt = 0; jt < 10; ++jt)
#pragma unroll
                            for (int ks = 0; ks < 2; ++ks) { const bf16x8 Kf = *(const LAS bf16x8*)(Kl + (16 * (jt0 + jt) + fr) * 144 + (ks * 32 + 8 * fg) * 2);
                                sacc[jt] = __builtin_amdgcn_mfma_f32_16x16x32_bf16(Kf, Qf[ks], sacc[jt], 0, 0, 0); }
                        float mx = sink;
#pragma unroll
                        for (int jt = 0; jt < 10; ++jt)
#pragma unroll
                            for (int j = 0; j < 4; ++j) { const int kj = 16 * (jt0 + jt) + 4 * fg + j, dist = qi + 128 - kj; const bool ok = dist >= 0 && dist < 128 && (t0 - 128 + kj) >= 0;
                                const float s = ok ? sacc[jt][j] * 0.125f + bl[dist & 127] : -INFINITY; sacc[jt][j] = s; mx = fmaxf(mx, s); }
                        mx = fmaxf(mx, __shfl_xor(mx, 16)); mx = fmaxf(mx, __shfl_xor(mx, 32));
                        float ls = 0.f;
#pragma unroll
                        for (int jt = 0; jt < 10; ++jt)
#pragma unroll
                            for (int j = 0; j < 4; ++j) { const float pe = __expf(sacc[jt][j] - mx); sacc[jt][j] = pe; ls += pe; }
                        ls += __shfl_xor(ls, 16); ls += __shfl_xor(ls, 32); ls += __expf(sink - mx);
                        f4 o[4];
#pragma unroll
                        for (int dt = 0; dt < 4; ++dt) o[dt] = (f4){0.f, 0.f, 0.f, 0.f};
#pragma unroll
                        for (int k5 = 0; k5 < 5; ++k5) { const f4 pa = sacc[2 * k5], pb = sacc[2 * k5 + 1];
                            union { bf16x8 v; unsigned u[4]; } Pf; Pf.u[0] = pg8::cvt_pk_bf16(pa[0], pa[1]); Pf.u[1] = pg8::cvt_pk_bf16(pa[2], pa[3]); Pf.u[2] = pg8::cvt_pk_bf16(pb[0], pb[1]); Pf.u[3] = pg8::cvt_pk_bf16(pb[2], pb[3]);
#pragma unroll
                            for (int dt = 0; dt < 4; ++dt) { const bf16x8 Vf = cat44(tr4(Vl, 160, 16 * (jt0 + 2 * k5) + 4 * fg, 16 * dt, lane), tr4(Vl, 160, 16 * (jt0 + 2 * k5 + 1) + 4 * fg, 16 * dt, lane));
                                o[dt] = __builtin_amdgcn_mfma_f32_16x16x32_bf16(Vf, Pf.v, o[dt], 0, 0, 0); } }
                        const float inv = 1.f / ls; float ss = 0.f;
                        bf16_t* op = zq + (size_t)(row0 + qi) * 2048 + 1024 + head * HD + 4 * fg;
#pragma unroll
                        for (int dt = 0; dt < 4; ++dt) { const f4 ov = o[dt] * inv; ss += (ov[0] * ov[0] + ov[1] * ov[1]) + (ov[2] * ov[2] + ov[3] * ov[3]);
                            *(unsigned long long*)(op + 16 * dt) = (unsigned long long)pg8::cvt_pk_bf16(ov[0], ov[1]) | ((unsigned long long)pg8::cvt_pk_bf16(ov[2], ov[3]) << 32); }
                        ss += __shfl_xor(ss, 16); ss += __shfl_xor(ss, 32);
                        if (fg == 0) ssq[(row0 + qi) * 16 + head] = ss;
                    }
                }
            }
            __syncthreads();
        }
        PH_END(3);
    }

    if (IN(4)) { PH_BEGIN();
        typedef pg8::bf16x8 bf16x8; typedef pg8::f32x4 f4;
        const bf16_t* xbc = (const bf16_t*)(ws + WS_XBC); const float* dtr = (const float*)(ws + WS_DT); float* decg = (float*)(ws + WS_CS);
        LAS unsigned char* Xi = lds + RING_OFF; LAS unsigned char* Bi = lds + RING_OFF + 69632; LAS float* wl = (LAS float*)(lds + RING_OFF + 106496);
        const int fr = lane & 15, fg = lane >> 4;
        for (int unit = bx; unit < BATCH * NCHUNK * SSM_GROUPS; unit += G) {
            const int g = unit % SSM_GROUPS, bc = unit / SSM_GROUPS, rowc = bc * CHUNK, tc = rowc % SEQ;
            __syncthreads();
            if (wave < 4) { const int h = g * 4 + wave; const float A = -__expf(p.a_log[h]), bias = p.dt_bias[h];
                const float d0 = softplus_f(dtr[(rowc + lane) * 16 + h] + bias), d1 = softplus_f(dtr[(rowc + lane + 64) * 16 + h] + bias);
                float s0 = d0 * A, s1 = d1 * A;
#pragma unroll
                for (int o = 1; o < 64; o <<= 1) { const float u0 = __shfl_up(s0, o), u1 = __shfl_up(s1, o); if (lane >= o) { s0 += u0; s1 += u1; } }
                s1 += __shfl(s0, 63); const float cl = __shfl(s1, 63);
                wl[wave * 128 + lane] = d0 * __expf(cl - s0); wl[wave * 128 + lane + 64] = d1 * __expf(cl - s1);
                if (lane == 0) decg[bc * 16 + h] = __expf(cl); }
            __syncthreads();
            if (tid < 384) { const int co = tid % 48, l0 = 16 * (tid / 48);
                const int ch = co < 32 ? g * 256 + co * 8 : D_SSM + g * D_STATE + (co - 32) * 8;
                LAS unsigned char* dst = co < 32 ? Xi + l0 * 544 + co * 16 : Bi + l0 * 288 + (co - 32) * 16; const int st = co < 32 ? 544 : 288;
                const LAS float* wr_ = wl + (co < 32 ? (co >> 3) * 128 : 0) + l0; const bool scale = co < 32;
                conv16x8(xbc, p.conv_w, p.conv_b, rowc + l0, tc + l0, ch, [&](int r, const float (&o)[8]) { const float w = scale ? wr_[r] : 1.f;
                    *(LAS v4u*)(dst + r * st) = (v4u){pk2(o[0] * w, o[1] * w), pk2(o[2] * w, o[3] * w), pk2(o[4] * w, o[5] * w), pk2(o[6] * w, o[7] * w)}; }); }
            __syncthreads();
            bf16x8 Bf[4];
#pragma unroll
            for (int kk = 0; kk < 4; ++kk) Bf[kk] = cat44(tr4(Bi, 288, 32 * kk + 4 * fg, 16 * wave, lane), tr4(Bi, 288, 32 * kk + 16 + 4 * fg, 16 * wave, lane));
#pragma unroll
            for (int r4 = 0; r4 < 4; ++r4) { const int h = g * 4 + r4; float* S = p.out + (size_t)(bc * SSM_HEADS + h) * HD * D_STATE;
#pragma unroll
                for (int pt = 0; pt < 4; ++pt) { f4 acc = (f4){0.f, 0.f, 0.f, 0.f};
#pragma unroll
                    for (int kk = 0; kk < 4; ++kk) { const bf16x8 Af = cat44(tr4(Xi, 544, 32 * kk + 4 * fg, r4 * 64 + 16 * pt, lane), tr4(Xi, 544, 32 * kk + 16 + 4 * fg, r4 * 64 + 16 * pt, lane)); acc = __builtin_amdgcn_mfma_f32_16x16x32_bf16(Af, Bf[kk], acc, 0, 0, 0); }
#pragma unroll
                    for (int j = 0; j < 4; ++j) S[(16 * pt + 4 * fg + j) * D_STATE + 16 * wave + fr] = acc[j]; } }
        }
        if (BOTH(4)) xcd_barrier(bar);
        PH_END(4);
    }

    if (IN(5)) { PH_BEGIN();
        const float* S = p.out; const float* decg = (const float*)(ws + WS_CS); bf16_t* St = (bf16_t*)(ws + WS_ST);
        for (int i = bx * 512 + tid; i < BATCH * SSM_HEADS * HD * D_STATE / 2; i += G * 512) {
            const int pn = (i % (HD * D_STATE / 2)) * 2, bh = i / (HD * D_STATE / 2), h = bh % SSM_HEADS, b = bh / SSM_HEADS;
            float s0 = 0.f, s1 = 0.f;
#pragma unroll 4
            for (int c = 0; c < NCHUNK; ++c) { const size_t idx = ((size_t)((b * NCHUNK + c) * SSM_HEADS + h)) * HD * D_STATE + pn; const float2 sv = *(const float2*)(S + idx);
                *(unsigned*)(St + idx) = pk2(s0, s1); const float dec = decg[(b * NCHUNK + c) * 16 + h]; s0 = s0 * dec + sv.x; s1 = s1 * dec + sv.y; }
        }
        bf16_t* zq = (bf16_t*)(ws + WS_ZQ); const float* ssq = (const float*)(ws + WS_SSQ);
        for (int m = gw; m < M; m += NGW) {
            float s = lane < 16 ? ssq[m * 16 + lane] : 0.f; s = wave_sum(s); const float r = rsqrtf(s * (1.f / 1024.f) + EPS);
            bf16_t* o = zq + (size_t)m * 2048 + 1024 + lane * 16;
            v4u w0 = *(v4u*)o, w1 = *(v4u*)(o + 8); unsigned w[8] = {w0.x, w0.y, w0.z, w0.w, w1.x, w1.y, w1.z, w1.w};
#pragma unroll
            for (int j = 0; j < 8; ++j) { const int d = lane * 16 + 2 * j; w[j] = pk2(__uint_as_float(w[j] << 16) * r * p.att_norm_g[d], __uint_as_float(w[j] & 0xffff0000u) * r * p.att_norm_g[d + 1]); }
            *(v4u*)o = (v4u){w[0], w[1], w[2], w[3]}; *(v4u*)(o + 8) = (v4u){w[4], w[5], w[6], w[7]};
        }
        if (BOTH(5)) xcd_barrier(bar);
        PH_END(5);
    }

    if (IN(6)) { PH_BEGIN();
        typedef pg8::bf16x8 bf16x8; typedef pg8::f32x4 f4;
        const bf16_t* xbc = (const bf16_t*)(ws + WS_XBC); const float* dtr = (const float*)(ws + WS_DT); bf16_t* zq = (bf16_t*)(ws + WS_ZQ); const bf16_t* Stg = (const bf16_t*)(ws + WS_ST);
        LAS unsigned char* Xi = lds + RING_OFF; LAS unsigned char* Bi = lds + RING_OFF + 69632; LAS unsigned char* Ci = lds + RING_OFF + 106496;
        LAS float* csl = (LAS float*)(lds + RING_OFF + 143360); LAS float* dtl = csl + 512;
        const int fr = lane & 15, fg = lane >> 4;
        for (int unit = bx; unit < BATCH * NCHUNK * SSM_GROUPS; unit += G) {
            const int g = unit % SSM_GROUPS, bc = unit / SSM_GROUPS, rowc = bc * CHUNK, tc = rowc % SEQ;
            __syncthreads();
            const unsigned long long _s0 = SUB_T();
            if (wave < 4) { const int h = g * 4 + wave; const float A = -__expf(p.a_log[h]), bias = p.dt_bias[h];
                const float d0 = softplus_f(dtr[(rowc + lane) * 16 + h] + bias), d1 = softplus_f(dtr[(rowc + lane + 64) * 16 + h] + bias);
                float s0 = d0 * A, s1 = d1 * A;
#pragma unroll
                for (int o = 1; o < 64; o <<= 1) { const float u0 = __shfl_up(s0, o), u1 = __shfl_up(s1, o); if (lane >= o) { s0 += u0; s1 += u1; } }
                s1 += __shfl(s0, 63);
                csl[wave * 128 + lane] = s0; csl[wave * 128 + lane + 64] = s1; dtl[wave * 128 + lane] = d0; dtl[wave * 128 + lane + 64] = d1; }
            { const int co = tid & 63, l0 = 16 * (tid >> 6);
                const int ch = co < 32 ? g * 256 + co * 8 : (co < 48 ? D_SSM + g * D_STATE + (co - 32) * 8 : D_SSM + SSM_GROUPS * D_STATE + g * D_STATE + (co - 48) * 8);
                LAS unsigned char* dst = co < 32 ? Xi + l0 * 544 + co * 16 : (co < 48 ? Bi + l0 * 288 + (co - 32) * 16 : Ci + l0 * 288 + (co - 48) * 16); const int st = co < 32 ? 544 : 288;
                conv16x8(xbc, p.conv_w, p.conv_b, rowc + l0, tc + l0, ch, [&](int r, const float (&o)[8]) {
                    *(LAS v4u*)(dst + r * st) = (v4u){pk2(o[0], o[1]), pk2(o[2], o[3]), pk2(o[4], o[5]), pk2(o[6], o[7])}; }); }
            __syncthreads();
            SUB_END(0, _s0); const unsigned long long _s1 = SUB_T();
            const int lrow = 16 * wave + fr;
            bf16x8 Cf[4];
#pragma unroll
            for (int kk = 0; kk < 4; ++kk) Cf[kk] = *(const LAS bf16x8*)(Ci + lrow * 288 + (4 * kk + fg) * 16);
            f4 Gt[8];
#pragma unroll
            for (int st = 0; st < 8; ++st) { Gt[st] = (f4){0.f, 0.f, 0.f, 0.f};
                if (st <= wave) {
#pragma unroll
                    for (int kk = 0; kk < 4; ++kk) { const bf16x8 Bf = *(const LAS bf16x8*)(Bi + (16 * st + fr) * 288 + (4 * kk + fg) * 16);
                        Gt[st] = __builtin_amdgcn_mfma_f32_16x16x32_bf16(Bf, Cf[kk], Gt[st], 0, 0, 0); } } }
            SUB_END(1, _s1); const unsigned long long _s2 = SUB_T();
            f4 Y[4][4];
            const bf16_t* zr0 = zq + (size_t)(rowc + lrow) * 2048 + g * 256 + 4 * fg; unsigned long long zz[4][4];
#pragma unroll
            for (int r4 = 0; r4 < 4; ++r4)
#pragma unroll
                for (int pt = 0; pt < 4; ++pt) zz[r4][pt] = *(const unsigned long long*)(zr0 + r4 * 64 + 16 * pt);
#pragma unroll
            for (int r4 = 0; r4 < 4; ++r4) { const int h = g * 4 + r4; const float ecl = __expf(csl[r4 * 128 + lrow]);
                const bf16_t* Sth = Stg + (size_t)(bc * SSM_HEADS + h) * HD * D_STATE;
#pragma unroll
                for (int pt = 0; pt < 4; ++pt) { f4 acc = (f4){0.f, 0.f, 0.f, 0.f};
#pragma unroll
                    for (int kk = 0; kk < 4; ++kk) { const bf16x8 Sf = *(const bf16x8*)(Sth + (16 * pt + fr) * D_STATE + (4 * kk + fg) * 8); acc = __builtin_amdgcn_mfma_f32_16x16x32_bf16(Sf, Cf[kk], acc, 0, 0, 0); }
                    Y[r4][pt] = acc * ecl; } }
#pragma unroll
            for (int r4 = 0; r4 < 4; ++r4) { const int h = g * 4 + r4; const float cl = csl[r4 * 128 + lrow];
#pragma unroll
                for (int k4 = 0; k4 < 4; ++k4) { if (2 * k4 <= wave) {
                    union { bf16x8 v; unsigned u[4]; } Pf;
#pragma unroll
                    for (int hh = 0; hh < 2; ++hh) { const int st = 2 * k4 + hh; const f4 c4 = *(const LAS f4*)(csl + r4 * 128 + 16 * st + 4 * fg), d4 = *(const LAS f4*)(dtl + r4 * 128 + 16 * st + 4 * fg);
                        float mv[4];
#pragma unroll
                        for (int j = 0; j < 4; ++j) { const int s = 16 * st + 4 * fg + j; mv[j] = (s <= lrow) ? Gt[st][j] * __expf(cl - c4[j]) * d4[j] : 0.f; }
                        Pf.u[2 * hh] = pg8::cvt_pk_bf16(mv[0], mv[1]); Pf.u[2 * hh + 1] = pg8::cvt_pk_bf16(mv[2], mv[3]); }
#pragma unroll
                    for (int pt = 0; pt < 4; ++pt) { const bf16x8 Xf = cat44(tr4(Xi, 544, 32 * k4 + 4 * fg, r4 * 64 + 16 * pt, lane), tr4(Xi, 544, 32 * k4 + 16 + 4 * fg, r4 * 64 + 16 * pt, lane));
                        Y[r4][pt] = __builtin_amdgcn_mfma_f32_16x16x32_bf16(Xf, Pf.v, Y[r4][pt], 0, 0, 0); } } }
                const float dsk = p.d_skip[h];
#pragma unroll
                for (int pt = 0; pt < 4; ++pt) { const unsigned long long xx = *(const LAS unsigned long long*)(Xi + lrow * 544 + (r4 * 64 + 16 * pt + 4 * fg) * 2); const unsigned x0 = (unsigned)xx, x1 = (unsigned)(xx >> 32);
                    Y[r4][pt][0] += dsk * __uint_as_float(x0 << 16); Y[r4][pt][1] += dsk * __uint_as_float(x0 & 0xffff0000u); Y[r4][pt][2] += dsk * __uint_as_float(x1 << 16); Y[r4][pt][3] += dsk * __uint_as_float(x1 & 0xffff0000u); }
            }
            SUB_END(2, _s2); const unsigned long long _s3 = SUB_T();
            bf16_t* zr = zq + (size_t)(rowc + lrow) * 2048 + g * 256 + 4 * fg; float ss = 0.f;
#pragma unroll
            for (int r4 = 0; r4 < 4; ++r4)
#pragma unroll
                for (int pt = 0; pt < 4; ++pt) { const unsigned z0 = (unsigned)zz[r4][pt], z1 = (unsigned)(zz[r4][pt] >> 32);
                    f4 v = Y[r4][pt]; v[0] *= silu_f(__uint_as_float(z0 << 16)); v[1] *= silu_f(__uint_as_float(z0 & 0xffff0000u)); v[2] *= silu_f(__uint_as_float(z1 << 16)); v[3] *= silu_f(__uint_as_float(z1 & 0xffff0000u));
                    Y[r4][pt] = v; ss += (v[0] * v[0] + v[1] * v[1]) + (v[2] * v[2] + v[3] * v[3]); }
            ss += __shfl_xor(ss, 16); ss += __shfl_xor(ss, 32);
            const float rr = rsqrtf(ss * (1.f / 256.f) + EPS);
#pragma unroll
            for (int r4 = 0; r4 < 4; ++r4)
#pragma unroll
                for (int pt = 0; pt < 4; ++pt) { const f4 gn = *(const f4*)(p.ssm_norm_g + g * 256 + r4 * 64 + 16 * pt + 4 * fg); const f4 v = Y[r4][pt] * rr * gn;
                    *(unsigned long long*)(zr + r4 * 64 + 16 * pt) = (unsigned long long)pg8::cvt_pk_bf16(v[0], v[1]) | ((unsigned long long)pg8::cvt_pk_bf16(v[2], v[3]) << 32); }
            SUB_END(3, _s3);
        }
        if (BOTH(6)) xcd_barrier(bar);
        PH_END(6);
    }

    if (IN(7)) { PH_BEGIN();
        pg8::DenseOrder S; S.init(ws + WS_ZQ, ws + WS_WOUT_T, M, D, 2048, G, bx);
        EpiOut E{p.x, p.out, modv};
        pg8::gemm_phase<EpiOut, pg8::DenseOrder, true, true>(lds + RING_OFF, 2048, S, E);
        if (BOTH(7)) xcd_barrier(bar);
        PH_END(7);
    }

    if (IN(8)) { PH_BEGIN();
        typedef pg8::bf16x8 bf16x8; typedef pg8::f32x4 f4;
        LAS float* part = (LAS float*)(lds + RING_OFF);
        LAS float* red = (LAS float*)(lds + RING_OFF + 131072);
        LAS int* cnt_l = (LAS int*)(lds + RING_OFF + 133120);
        LAS int* base_l = (LAS int*)(lds + RING_OFF + 133376);
        LAS int* asg_e = (LAS int*)(lds + RING_OFF + 133632);
        LAS int* asg_pos = (LAS int*)(lds + RING_OFF + 135680);
        LAS float* asg_g = (LAS float*)(lds + RING_OFF + 137728);
        bf16_t* h2 = (bf16_t*)(ws + WS_H2); int* cnt = (int*)(ws + WS_CTL) + CW_CNT; int* list = (int*)(ws + WS_LIST); unsigned* pmeta = (unsigned*)(ws + WS_GLIST);
        const v4u* rwf = (const v4u*)(ws + WS_RWF);
        const float rbias = p.router_bias[lane];
        const int fr = lane & 15, fq = lane >> 4;
        for (int grp = bx; grp < M / 64; grp += G) {
            const int b = (grp * 64) / SEQ;
            __syncthreads();
            if (tid < NE) cnt_l[tid] = 0;
#pragma unroll 1
            for (int half = 0; half < 2; ++half) {
            f4 xv[2][4][2];
#pragma unroll
            for (int tile = 0; tile < 2; ++tile) { const float* xr = p.out + (size_t)(grp * 64 + half * 32 + tile * 16 + fr) * D + 128 * wave + 8 * fq;
#pragma unroll
                for (int kk = 0; kk < 4; ++kk) { xv[tile][kk][0] = *(const f4*)(xr + 32 * kk); xv[tile][kk][1] = *(const f4*)(xr + 32 * kk + 4); } }
#pragma unroll
            for (int tile = 0; tile < 2; ++tile) { float ss = 0.f;
#pragma unroll
                for (int kk = 0; kk < 4; ++kk)
#pragma unroll
                    for (int hf = 0; hf < 2; ++hf) { const f4 v = xv[tile][kk][hf]; ss += (v[0] * v[0] + v[1] * v[1]) + (v[2] * v[2] + v[3] * v[3]); }
                ss += __shfl_xor(ss, 16); ss += __shfl_xor(ss, 32);
                if (fq == 0) red[(tile * 8 + wave) * 16 + fr] = ss; }
            __syncthreads();
            float rstd2[2]; f4 acc[2][4];
#pragma unroll
            for (int tile = 0; tile < 2; ++tile) { float tot = 0.f;
#pragma unroll
                for (int w2 = 0; w2 < 8; ++w2) tot += red[(tile * 8 + w2) * 16 + fr];
                rstd2[tile] = rsqrtf(tot * (1.f / D) + EPS);
#pragma unroll
                for (int nt = 0; nt < 4; ++nt) acc[tile][nt] = (f4){0.f, 0.f, 0.f, 0.f}; }
#pragma unroll
            for (int kk = 0; kk < 4; ++kk) { const int d = 128 * wave + 32 * kk + 8 * fq;
                f4 gm[2], sm[2];
#pragma unroll
                for (int hf = 0; hf < 2; ++hf) { gm[hf] = *(const f4*)(p.norm2_g + d + 4 * hf) * (*(const f4*)(modv + b * 6 * D + 4 * D + d + 4 * hf) + 1.f); sm[hf] = *(const f4*)(modv + b * 6 * D + 3 * D + d + 4 * hf); }
                union { bf16x8 v; v4u q; } Rh[4], Rl[4];
#pragma unroll
                for (int nt = 0; nt < 4; ++nt) { const int fi = (((4 * wave + kk) * 4 + nt) * 2) * 64 + lane; Rh[nt].q = rwf[fi]; Rl[nt].q = rwf[fi + 64]; }
#pragma unroll
                for (int tile = 0; tile < 2; ++tile) { const int row = grp * 64 + half * 32 + tile * 16 + fr;
                    union { bf16x8 v; unsigned u[4]; v4u q; } Hh, Hl;
#pragma unroll
                    for (int hf = 0; hf < 2; ++hf) { const f4 h = xv[tile][kk][hf] * rstd2[tile] * gm[hf] + sm[hf];
                        const unsigned h01 = pk2(h[0], h[1]), h23 = pk2(h[2], h[3]);
                        Hh.u[2 * hf] = h01; Hh.u[2 * hf + 1] = h23;
                        Hl.u[2 * hf] = pk2(h[0] - __uint_as_float(h01 << 16), h[1] - __uint_as_float(h01 & 0xffff0000u)); Hl.u[2 * hf + 1] = pk2(h[2] - __uint_as_float(h23 << 16), h[3] - __uint_as_float(h23 & 0xffff0000u)); }
                    *(v4u*)(h2 + (size_t)row * D + d) = Hh.q;
#pragma unroll
                    for (int nt = 0; nt < 4; ++nt) {
                        acc[tile][nt] = __builtin_amdgcn_mfma_f32_16x16x32_bf16(Hh.v, Rh[nt].v, acc[tile][nt], 0, 0, 0);
                        acc[tile][nt] = __builtin_amdgcn_mfma_f32_16x16x32_bf16(Hh.v, Rl[nt].v, acc[tile][nt], 0, 0, 0);
                        acc[tile][nt] = __builtin_amdgcn_mfma_f32_16x16x32_bf16(Hl.v, Rh[nt].v, acc[tile][nt], 0, 0, 0); } }
                asm volatile("" ::: "memory"); }
#pragma unroll
            for (int tile = 0; tile < 2; ++tile)
#pragma unroll
                for (int nt = 0; nt < 4; ++nt)
#pragma unroll
                    for (int j = 0; j < 4; ++j) part[((tile * 8 + wave) * 16 + 4 * fq + j) * 64 + 16 * nt + fr] = acc[tile][nt][j];
            __syncthreads();
#pragma unroll 1
            for (int rr = 0; rr < 4; ++rr) { const int lr32 = 4 * wave + rr, tile = lr32 >> 4, lr = lr32 & 15, lr64 = half * 32 + lr32, m = grp * 64 + lr64;
                float lg = 0.f;
#pragma unroll
                for (int w2 = 0; w2 < 8; ++w2) lg += part[((tile * 8 + w2) * 16 + lr) * 64 + lane];
                const float sc = 1.f / (1.f + __expf(-lg)), sel = sc + rbias;
                float m1 = sel, m2 = -INFINITY;
#pragma unroll
                for (int o = 1; o < 8; o <<= 1) { const float p1 = __shfl_xor(m1, o), p2 = __shfl_xor(m2, o); const float n1 = fmaxf(m1, p1), n2 = fmaxf(fminf(m1, p1), fmaxf(m2, p2)); m1 = n1; m2 = n2; }
                const float gs = m1 + m2; const int myg = lane >> 3;
                unsigned gk = __float_as_uint(gs); gk = (gk & 0x80000000u) ? ~gk : (gk | 0x80000000u); gk = (gk & ~7u) | (unsigned)(7 - myg);
                int grank = 0;
#pragma unroll
                for (int g2 = 0; g2 < 8; ++g2) grank += (__builtin_amdgcn_readlane(gk, g2 * 8) > gk) ? 1 : 0;
                const bool allowed = grank < 4;
                unsigned ek = __float_as_uint(sel); ek = (ek & 0x80000000u) ? ~ek : (ek | 0x80000000u); ek = allowed ? ((ek & ~63u) | (unsigned)(63 - lane)) : 0u;
                int rank = 0;
#pragma unroll
                for (int e2 = 0; e2 < NE; ++e2) rank += (__builtin_amdgcn_readlane(ek, e2) > ek) ? 1 : 0;
                const bool selb = allowed && rank < TOPK;
                const float wsum = wave_sum(selb ? sc : 0.f);
                if (selb) { const float gate = sc / wsum * 2.5f; const int pl = __hip_atomic_fetch_add(cnt_l + lane, 1, __ATOMIC_RELAXED, __HIP_MEMORY_SCOPE_WORKGROUP); const int i = lr64 * 8 + rank; asg_e[i] = lane; asg_pos[i] = pl; asg_g[i] = gate; }
            }
            __syncthreads();
            }
            if (tid < NE) { int t2 = tid; asm volatile("" : "+v"(t2)); const int c = cnt_l[t2]; base_l[t2] = c > 0 ? atomicAdd(&cnt[t2], c) : 0; }
            __syncthreads();
            { const int e = asg_e[tid]; const size_t li = (size_t)e * M + base_l[e] + asg_pos[tid]; list[li] = (grp * 64 + (tid >> 3)) * 8 + (tid & 7); pmeta[li] = ((unsigned)((grp * 64 + (tid >> 3)) * NSLOT + (tid & 7)) << 14) | (unsigned)__float2int_rn(asg_g[tid] * 4096.f); }
        }
        if (BOTH(8)) xcd_barrier(bar);
        PH_END(8);
    }

    LAS int* plan = (LAS int*)(lds + PLAN_OFF);
#define MAKE_PLAN() do { __syncthreads(); if (tid <= NE) plan[80 + tid] = tid < NE ? (int)__hip_atomic_load((const int*)(ws + WS_CTL) + CW_CNT + tid, RLX_AGENT) : M; __syncthreads(); \
        if (tid == 0) { int off = 0; for (int e = 0; e <= NE; ++e) { plan[e] = off; off += (plan[80 + e] + 255) >> 8; } plan[NE + 1] = off; } __syncthreads(); } while (0)
    if (IN(9)) { PH_BEGIN();
        MAKE_PLAN();
        GroupedOrder<true> S; S.init(ws + WS_H2, ws + WS_WGU, D, 2, G, bx, plan, (const int*)(ws + WS_LIST), (size_t)512 * D * 2, (size_t)256 * D * 2, 0);
        EpiGU E{(bf16_t*)(ws + WS_U)};
        pg8::gemm_phase<EpiGU, GroupedOrder<true>, true, true>(lds + RING_OFF, D, S, E);
        STEAL_ITEMS(CW_Q2, (NE + 1) * I_D, ITEM_WD);
        if (BOTH(9)) xcd_barrier(bar);
        PH_END(9);
    }
    if (IN(10)) { PH_BEGIN(); MAKE_PLAN();
        GroupedOrder<false> S; S.init(ws + WS_U, ws + WS_WD, ED, 4, G, bx, plan, (const int*)(ws + WS_LIST), (size_t)D * ED * 2, (size_t)256 * ED * 2, 0);
        EpiDown E{(unsigned char*)(ws + WS_YC), (const unsigned*)(ws + WS_GLIST), ws + WS_DUMP + (size_t)bx * 8192};
        pg8::gemm_phase<EpiDown, GroupedOrder<false>, true, true, true>(lds + RING_OFF, ED, S, E);
        if (BOTH(10)) xcd_barrier(bar);
        PH_END(10);
    }
    if (IN(11)) { PH_BEGIN();
        typedef float f2 __attribute__((ext_vector_type(2)));
        const unsigned char* yc = (const unsigned char*)(ws + WS_YC);
        const int c0 = (lane >> 4) * 256 + ((lane >> 2) & 3) * 32 + (lane & 3) * 8;
        for (int m = gw; m < M; m += NGW) { const int b = m / SEQ;
            float s[16];
#pragma unroll
            for (int j = 0; j < 16; ++j) s[j] = 0.f;
#pragma unroll
            for (int k = 0; k < NSLOT; ++k) { const v4u raw = *(const v4u*)(yc + ((size_t)m * NSLOT + k) * 1024 + lane * 16); const unsigned w4[4] = {raw.x, raw.y, raw.z, raw.w};
#pragma unroll
                for (int q = 0; q < 4; ++q) { const f2 lo = __builtin_amdgcn_cvt_pk_f32_fp8((int)w4[q], false), hi = __builtin_amdgcn_cvt_pk_f32_fp8((int)w4[q], true);
                    s[4 * q] += lo.x; s[4 * q + 1] += lo.y; s[4 * q + 2] += hi.x; s[4 * q + 3] += hi.y; } }
            float* xo = p.out + (size_t)m * D; const float* g2 = modv + b * 6 * D + 5 * D;
            f32x4 xv[4]; float ss = 0.f;
#pragma unroll
            for (int q = 0; q < 4; ++q) { const int c = c0 + (q >> 1) * 128 + (q & 1) * 4; const f32x4 gv = *(const f32x4*)(g2 + c) * (1.f / YC_SCALE);
                xv[q] = *(const f32x4*)(xo + c) + gv * (f32x4){s[4 * q], s[4 * q + 1], s[4 * q + 2], s[4 * q + 3]};
                ss += (xv[q].x * xv[q].x + xv[q].y * xv[q].y) + (xv[q].z * xv[q].z + xv[q].w * xv[q].w); }
            const float rstd = rsqrtf(wave_sum(ss) * (1.f / D) + EPS);
#pragma unroll
            for (int q = 0; q < 4; ++q) { const int c = c0 + (q >> 1) * 128 + (q & 1) * 4; *(f32x4*)(xo + c) = xv[q] * rstd * *(const f32x4*)(p.final_g + c); }
        }
        PH_END(11);
    }
#undef IN
#undef BOTH
}

extern "C" void kernel_launch(void* const* d_in, const int* in_sizes, int n_in, void* d_out, int out_size, void* d_ws, size_t ws_size, hipStream_t stream) {
    static int grid = 0;
    if (grid == 0) {
        int dev = 0, cus = 0;
        if (hipGetDevice(&dev) != hipSuccess || hipDeviceGetAttribute(&cus, hipDeviceAttributeMultiprocessorCount, dev) != hipSuccess) { fprintf(stderr, "device query failed\n"); grid = -1; return; }
        if (hipFuncSetAttribute((const void*)mega, hipFuncAttributeMaxDynamicSharedMemorySize, LDS_BYTES) != hipSuccess) { fprintf(stderr, "hipFuncSetAttribute failed\n"); grid = -1; return; }
        int per_cu = 0;
        if (hipOccupancyMaxActiveBlocksPerMultiprocessor(&per_cu, (const void*)mega, NWAVES * 64, LDS_BYTES) != hipSuccess || per_cu < 1) fprintf(stderr, "occupancy query: %d\n", per_cu);
        (void)hipGetLastError();
        grid = cus;
        if (ws_size < WS_END) fprintf(stderr, "ws too small: %zu < %zu\n", ws_size, (size_t)WS_END);
    }
    if (grid < 0) return;
    P p{};
    const float** f = (const float**)&p;
    for (int i = 0; i < 26; ++i) f[i] = (const float*)d_in[i];
    p.out = (float*)d_out; p.ws = (unsigned char*)d_ws;
    (void)hipMemsetAsync(p.ws + WS_CTL, 0, CTL_BYTES, stream);
    p.ph_lo = 0; p.ph_hi = NPHASE; p.li = 0;
    hipLaunchKernelGGL(mega, dim3(grid), dim3(NWAVES * 64), LDS_BYTES, stream, p);
}
```

```cpp
#include <hip/hip_runtime.h>
#include <stdint.h>
#include <stdio.h>

typedef unsigned short bf16_t;

constexpr int D = 1024, BATCH = 4, SEQ = 4096, M = BATCH * SEQ;
constexpr int D_SSM = 1024, SSM_HEADS = 16, SSM_GROUPS = 4, D_STATE = 128, CONV_K = 4, CONV_CH = 2048, CHUNK = 128, NCHUNK = SEQ / CHUNK;
constexpr int HD = 64, ATT_HEADS = 16, KV_HEADS = 4, D_KV = 256, WINDOW = 128;
constexpr int IN_COLS = 4624;
constexpr int C_Z = 0, C_XBC = 1024, C_DT = 3072, C_Q = 3088, C_K = 4112, C_V = 4368;
constexpr int NE = 64, TOPK = 8, ED = 256;
constexpr float EPS = 1e-6f;
constexpr int NSLOT = 9;
constexpr int ZQ_Q = 0, ZQ_Z = 1024;
constexpr int NWIN = 4864;

constexpr size_t MiB = 1u << 20;
constexpr size_t WS_CTL = 0;
constexpr size_t CTL_BYTES = 64 * 1024;
constexpr int CW_CNT = 0;
constexpr int CW_Q1 = 128, CW_Q2 = 192;
constexpr int CW_BAR = 4096;
constexpr size_t WS_MOD = 1 * MiB;
constexpr size_t WS_DUMP = 2 * MiB;
constexpr size_t WS_RWF = 1 * MiB + 256 * 1024;
constexpr size_t WS_LIST = 4 * MiB;
constexpr size_t WS_WIN_T = 8 * MiB;
constexpr size_t WS_WOUT_T = 18 * MiB;
constexpr size_t WS_SSQ = 22 * MiB;
constexpr size_t WS_RATT = 23 * MiB;
constexpr size_t WS_ZQ = 24 * MiB;
constexpr size_t WS_XBC = 88 * MiB;
constexpr size_t WS_K = 152 * MiB;
constexpr size_t WS_V = 160 * MiB;
constexpr size_t WS_DT = 168 * MiB;
constexpr size_t WS_CS = 169 * MiB;
constexpr size_t WS_ST = 170 * MiB;
constexpr size_t WS_H2 = 170 * MiB;
constexpr size_t WS_WGU = 202 * MiB;
constexpr size_t WS_YC = 104 * MiB;
constexpr size_t WS_U = 24 * MiB;
constexpr size_t WS_WD = 267 * MiB;
constexpr size_t WS_GLIST = 300 * MiB;
constexpr size_t WS_END = 304 * MiB;
constexpr int UROWS_MAX = 163840;

__device__ __forceinline__ float bf2f(bf16_t v) { return __uint_as_float(((unsigned)v) << 16); }
__device__ __forceinline__ bf16_t f2bf(float f) { unsigned u = __float_as_uint(f); return (bf16_t)((u + 0x7fffu + ((u >> 16) & 1u)) >> 16); }
__device__ __forceinline__ unsigned pk2(float lo, float hi) { return (unsigned)f2bf(lo) | ((unsigned)f2bf(hi) << 16); }
__device__ __forceinline__ float silu_f(float x) { return x * __builtin_amdgcn_rcpf(1.f + __expf(-x)); }
__device__ __forceinline__ float softplus_f(float x) { return x > 20.f ? x : log1pf(__expf(x)); }

__constant__ int c_bucket[128] = {0, 1, 2, 3, 4, 5, 6, 7, 8, 9, 10, 11, 12, 13, 14, 15, 16, 16, 16, 17, 17, 18, 18, 18, 19, 19, 19, 20, 20, 20, 20, 21, 21, 21, 21, 22, 22, 22, 22, 22, 23, 23, 23, 23, 23, 23, 24, 24, 24, 24, 24, 24, 25, 25, 25, 25, 25, 25, 25, 26, 26, 26, 26, 26, 26, 26, 26, 27, 27, 27, 27, 27, 27, 27, 27, 27, 27, 28, 28, 28, 28, 28, 28, 28, 28, 28, 28, 29, 29, 29, 29, 29, 29, 29, 29, 29, 29, 29, 29, 30, 30, 30, 30, 30, 30, 30, 30, 30, 30, 30, 30, 30, 30, 31, 31, 31, 31, 31, 31, 31, 31, 31, 31, 31, 31, 31, 31, 31};

struct P {
    const float *x, *c, *mod_w, *mod_b, *norm1_g, *norm2_g, *w_in, *conv_w, *conv_b, *dt_bias, *a_log, *d_skip, *ssm_norm_g, *att_norm_g, *sinks, *rel_bias,
        *w_out, *router_w, *router_bias, *exp_w_gate, *exp_w_up, *exp_w_down, *sh_w_gate, *sh_w_up, *sh_w_down, *final_g;
    float* out; unsigned char* ws;
    int ph_lo, ph_hi, li, pad;
};

#ifdef PROBE_SUB
#define SUB_T() __builtin_amdgcn_s_memrealtime()
#define SUB_END(id, t0) do { if ((PROBE_SUB >> (id)) & 1u) { const unsigned long long _st1 = __builtin_amdgcn_s_memrealtime(); while (__builtin_amdgcn_s_memrealtime() < _st1 + (_st1 - (t0))) __builtin_amdgcn_s_sleep(4); } } while (0)
#else
#define SUB_T() 0ull
#define SUB_END(id, t0) do {} while (0)
#endif
namespace pg8 {
#define PG8_LAS __attribute__((address_space(3)))
typedef short bf16x8 __attribute__((ext_vector_type(8)));
typedef float f32x4 __attribute__((ext_vector_type(4)));
typedef unsigned u32x4 __attribute__((ext_vector_type(4)));
constexpr int BM = 256, BK = 64, HALF = 128, HTB = HALF * BK * 2  , STAGE_BYTES = 8 * HTB, NXCD = 8, WGM = 8;

__host__ __device__ __forceinline__ int lds_byte(int r, int c) { const int st = (r >> 4) * 2 + (c >> 5), rr = r & 15, cc = c & 31, ob = rr * 64 + cc * 2; return st * 1024 + (ob ^ (((ob >> 9) & 1) << 5)); }
__host__ __device__ __forceinline__ void stage_rc(int b, int& R, int& C) { const int st = b / 1024, sb = b % 1024, swz = sb ^ (((sb >> 9) & 1) << 5); R = (st >> 1) * 16 + swz / 64; C = (st & 1) * 32 + (swz % 64) / 2; }
__host__ __device__ __forceinline__ int perm32(int rho) { const int n = rho >> 4, i = rho & 15; return 8 * (i >> 2) + 4 * n + (i & 3); }

struct Unit { int pm, pn, e, nrows, lt; };

__device__ __forceinline__ unsigned cvt_pk_bf16(float lo, float hi) { unsigned r; asm volatile("v_cvt_pk_bf16_f32 %0, %1, %2" : "=v"(r) : "v"(lo), "v"(hi)); return r; }

struct DenseOrder {
    typedef pg8::Unit Unit;
    const char* A; const char* Bt; int K; int nM, nN, nwg, G, c;
    __device__ __forceinline__ void init(const void* A_, const void* Bt_, int M_, int N_, int K_, int G_, int c_) { A = (const char*)A_; Bt = (const char*)Bt_; K = K_; nM = M_ / BM; nN = N_ / BM; nwg = nM * nN; G = G_; c = c_; }
    __device__ __forceinline__ bool next(int i, Unit& u) const {
        const long L = (long)i * G + c; if (L >= nwg) return false;
        int wgid = (int)L; { const int q = nwg / NXCD, r = nwg % NXCD, xcd = wgid % NXCD, off = wgid / NXCD; wgid = (xcd < r ? xcd * (q + 1) : r * (q + 1) + (xcd - r) * q) + off; }
        const int nig = WGM * nN, gid = wgid / nig, fm = gid * WGM, gsz = (nM - fm) < WGM ? (nM - fm) : WGM;
        u.pm = fm + ((wgid % nig) % gsz); u.pn = (wgid % nig) / gsz; u.e = 0; u.nrows = 256; u.lt = 0; return true;
    }
    __device__ __forceinline__ const char* a_base(const Unit& u) const { return A + (size_t)u.pm * 512 * K; }
    __device__ __forceinline__ const char* b_base(const Unit& u) const { return Bt + (size_t)u.pn * 512 * K; }
    __device__ __forceinline__ void lane_off(const Unit&, const int (&R)[2], const int (&C)[2], unsigned (&o)[2][2]) const {
#pragma unroll
        for (int h = 0; h < 2; ++h)
#pragma unroll
            for (int i = 0; i < 2; ++i) o[h][i] = (unsigned)(((h * HALF + R[i]) * K + C[i]) * 2);
    }
    __device__ __forceinline__ void a_ready(const Unit&) const {}
    __device__ __forceinline__ void done(const Unit&) const {}
};

template <class Epi, class Sched, bool ALIGN_EPI = false, bool SP2 = false, bool ALLOW = false>
__device__ __forceinline__ void gemm_phase(PG8_LAS unsigned char* lds, const int K, const Sched& S, const Epi& E) {
    typedef typename Sched::Unit Unit;
    const int tid = threadIdx.x, wid = __builtin_amdgcn_readfirstlane(tid >> 6), lane = tid & 63, wr = wid >> 2, wc = wid & 3, fr = lane & 15, fq = lane >> 4;
    const int nt = K / BK;
    unsigned voffB[2]; int stR[2], stC[2];
#pragma unroll
    for (int i = 0; i < 2; ++i) { int R, C; stage_rc(tid * 16 + i * 8192, R, C); const int Rb = Epi::PERM ? ((R & ~31) + perm32(R & 31)) : R;
        stR[i] = R; stC[i] = C; voffB[i] = (unsigned)(Rb * K + C) * 2u; }
    const size_t kstep = (size_t)(BK * 2);
    const size_t hstep = (size_t)HALF * K * 2;
    const size_t tstep = 2 * hstep;
    const unsigned ldsw = (unsigned)wid * 1024u;
    const int aoff = lds_byte(wr * 64 + fr, fq * 8), boff = lds_byte(wc * 32 + fr, fq * 8);
#define PG8_SA(b, h) (((b) * 2 + (h)) * HTB)
#define PG8_SB(b, h) ((4 + (b) * 2 + (h)) * HTB)
#define PG8_STAGE(bufoff, gbase, voff) do { _Pragma("unroll") for (int _i = 0; _i < 2; ++_i) \
        __builtin_amdgcn_global_load_lds((const unsigned*)((const char*)(gbase) + (voff)[_i]), (PG8_LAS unsigned*)(lds + (bufoff) + ldsw + _i * 8192), 16, 0, 0); } while (0)
#define PG8_LDA(dst, b, h) do { _Pragma("unroll") for (int m = 0; m < 4; ++m) _Pragma("unroll") for (int k = 0; k < 2; ++k) dst[m][k] = *(const PG8_LAS bf16x8*)(lds + PG8_SA(b, h) + aoff + m * 2048 + k * 1024); } while (0)
#define PG8_LDB(dst, b, h) do { _Pragma("unroll") for (int n = 0; n < 2; ++n) _Pragma("unroll") for (int k = 0; k < 2; ++k) dst[n][k] = *(const PG8_LAS bf16x8*)(lds + PG8_SB(b, h) + boff + n * 2048 + k * 1024); } while (0)
#define PG8_MMA(ai, bj, At, Bt) do { __builtin_amdgcn_s_setprio(1); _Pragma("unroll") for (int m = 0; m < 4; ++m) _Pragma("unroll") for (int n = 0; n < 2; ++n) _Pragma("unroll") for (int k = 0; k < 2; ++k) \
        acc[ai][bj][m][n] = __builtin_amdgcn_mfma_f32_16x16x32_bf16(Bt[n][k], At[m][k], acc[ai][bj][m][n], 0, 0, 0); __builtin_amdgcn_s_setprio(0); } while (0)
#define PG8_WAIT_V(n) asm volatile("s_waitcnt vmcnt(" #n ")" ::: "memory")
#define PG8_WAIT_L(n) asm volatile("s_waitcnt lgkmcnt(" #n ")" ::: "memory")
#define PG8_WAIT_VA() do { if (ALLOW && t == 0 && ns_pending >= 8) { if (ns_pending >= 16) PG8_WAIT_V(24); else PG8_WAIT_V(16); } else PG8_WAIT_V(8); } while (0)
#define PG8_BAR __builtin_amdgcn_s_barrier()
#define PG8_SCHED __builtin_amdgcn_sched_barrier(0)
    Unit cur, nxt; int ui = 0; int ns_pending = 0; typename Epi::State est;
    if (!S.next(0, cur)) return;
    f32x4 acc[2][2][4][2];
#pragma unroll
    for (int a = 0; a < 2; ++a)
#pragma unroll
        for (int b = 0; b < 2; ++b)
#pragma unroll
            for (int m = 0; m < 4; ++m)
#pragma unroll
                for (int n = 0; n < 2; ++n) acc[a][b][m][n] = (f32x4){0.f, 0.f, 0.f, 0.f};
    bf16x8 At[4][2], B0[2][2], B1[2][2];
    const char* cA = S.a_base(cur); const char* cB = S.b_base(cur);
    unsigned oc[2][2], on[2][2];
    S.lane_off(cur, stR, stC, oc);
    S.a_ready(cur);
    if constexpr (SP2) {
        PG8_STAGE(PG8_SB(0, 0), cB, voffB); PG8_STAGE(PG8_SB(0, 1), cB + hstep, voffB); PG8_STAGE(PG8_SA(0, 0), cA, oc[0]); PG8_STAGE(PG8_SA(0, 1), cA, oc[1]);
        if (wr == 1) PG8_BAR;
        PG8_WAIT_V(2); PG8_BAR;
        PG8_STAGE(PG8_SB(1, 0), cB + kstep, voffB); PG8_STAGE(PG8_SA(1, 0), cA + kstep, oc[0]); PG8_STAGE(PG8_SB(1, 1), cB + hstep + kstep, voffB);
        PG8_WAIT_V(6); PG8_BAR;
    } else {
        PG8_STAGE(PG8_SB(0, 0), cB, voffB); PG8_STAGE(PG8_SA(0, 0), cA, oc[0]); PG8_STAGE(PG8_SB(0, 1), cB + hstep, voffB); PG8_STAGE(PG8_SA(0, 1), cA, oc[1]);
        if (wr == 1) PG8_BAR;
        PG8_WAIT_V(4); PG8_BAR;
        PG8_STAGE(PG8_SB(1, 0), cB + kstep, voffB); PG8_STAGE(PG8_SA(1, 0), cA + kstep, oc[0]); PG8_STAGE(PG8_SB(1, 1), cB + hstep + kstep, voffB);
        PG8_WAIT_V(6); PG8_BAR;
    }
    for (;;) {
        const bool has_next = S.next(ui + 1, nxt);
        E.pre(cur, wr, wc, fr, fq, est);
        const char* nA = has_next ? S.a_base(nxt) : cA; const char* nB = has_next ? S.b_base(nxt) : cB;
        if (has_next) S.lane_off(nxt, stR, stC, on); else {
#pragma unroll
            for (int h = 0; h < 2; ++h)
#pragma unroll
                for (int i = 0; i < 2; ++i) on[h][i] = oc[h][i]; }
        const unsigned long long _gs0 = SUB_T();
        asm volatile(".p2align 8" ::: "memory");
#pragma unroll 1
        for (int t = 0; t < nt; t += 2) {
            const bool last = (t == nt - 2);
            const char* a1 = cA + (size_t)(t + 1) * kstep;
            const char* a2 = last ? nA : cA + (size_t)(t + 2) * kstep; const char* b2 = last ? nB : cB + (size_t)(t + 2) * kstep;
            const char* a3 = a2 + kstep; const char* b3 = b2 + kstep;
            unsigned o2[2][2];
#pragma unroll
            for (int h = 0; h < 2; ++h)
#pragma unroll
                for (int i = 0; i < 2; ++i) o2[h][i] = last ? on[h][i] : oc[h][i];
            if (last && has_next) S.a_ready(nxt);
            if constexpr (Epi::MIDSCALE) { if (t == nt / 2) E.mid(acc, cur, wr, fr); }
            if constexpr (SP2) {
            PG8_LDB(B0, 0, 0); PG8_LDB(B1, 0, 1); PG8_SCHED; PG8_LDA(At, 0, 0); PG8_STAGE(PG8_SA(1, 1), a1, oc[1]);
            PG8_WAIT_VA(); PG8_WAIT_L(0); PG8_BAR; PG8_MMA(0, 0, At, B0); PG8_MMA(0, 1, At, B1); PG8_BAR; PG8_SCHED;
            PG8_LDA(At, 0, 1); PG8_STAGE(PG8_SB(0, 0), b2, voffB); PG8_STAGE(PG8_SB(0, 1), b2 + hstep, voffB); PG8_STAGE(PG8_SA(0, 0), a2, o2[0]);
            PG8_WAIT_VA(); PG8_WAIT_L(0); PG8_BAR; PG8_MMA(1, 0, At, B0); PG8_MMA(1, 1, At, B1); PG8_BAR; PG8_SCHED;
            PG8_LDB(B0, 1, 0); PG8_LDB(B1, 1, 1); PG8_SCHED; PG8_LDA(At, 1, 0); PG8_STAGE(PG8_SA(0, 1), a2, o2[1]);
            PG8_WAIT_V(8); PG8_WAIT_L(0); PG8_BAR; PG8_MMA(0, 0, At, B0); PG8_MMA(0, 1, At, B1); PG8_BAR; PG8_SCHED;
            PG8_LDA(At, 1, 1); PG8_STAGE(PG8_SB(1, 0), b3, voffB); PG8_STAGE(PG8_SB(1, 1), b3 + hstep, voffB); PG8_STAGE(PG8_SA(1, 0), a3, o2[0]);
            PG8_WAIT_V(8); PG8_WAIT_L(0); PG8_BAR; PG8_MMA(1, 0, At, B0); PG8_MMA(1, 1, At, B1); PG8_BAR; PG8_SCHED;
            } else {
            PG8_LDB(B0, 0, 0); PG8_SCHED; PG8_LDA(At, 0, 0); PG8_STAGE(PG8_SA(1, 1), a1, oc[1]);
            PG8_WAIT_L(8); PG8_BAR; PG8_WAIT_L(0); PG8_MMA(0, 0, At, B0); PG8_BAR; PG8_SCHED;
            PG8_LDB(B1, 0, 1); PG8_STAGE(PG8_SB(0, 0), b2, voffB);
            PG8_BAR; PG8_WAIT_L(0); PG8_MMA(0, 1, At, B1); PG8_BAR;
            PG8_LDA(At, 0, 1); PG8_STAGE(PG8_SA(0, 0), a2, o2[0]);
            PG8_BAR; PG8_WAIT_L(0); PG8_MMA(1, 0, At, B0); PG8_BAR; PG8_SCHED;
            PG8_STAGE(PG8_SB(0, 1), b2 + hstep, voffB);
            PG8_WAIT_V(6); PG8_BAR; PG8_MMA(1, 1, At, B1); PG8_BAR;
            PG8_LDB(B0, 1, 0); PG8_SCHED; PG8_LDA(At, 1, 0); PG8_STAGE(PG8_SA(0, 1), a2, o2[1]);
            PG8_WAIT_L(8); PG8_BAR; PG8_WAIT_L(0); PG8_MMA(0, 0, At, B0); PG8_BAR; PG8_SCHED;
            PG8_LDB(B1, 1, 1); PG8_STAGE(PG8_SB(1, 0), b3, voffB);
            PG8_BAR; PG8_WAIT_L(0); PG8_MMA(0, 1, At, B1); PG8_BAR;
            PG8_LDA(At, 1, 1); PG8_STAGE(PG8_SA(1, 0), a3, o2[0]);
            PG8_BAR; PG8_WAIT_L(0); PG8_MMA(1, 0, At, B0); PG8_BAR; PG8_SCHED;
            PG8_STAGE(PG8_SB(1, 1), b3 + hstep, voffB);
            PG8_WAIT_V(6); PG8_BAR; PG8_MMA(1, 1, At, B1); PG8_BAR;
            }
        }
        if constexpr (Epi::PROBE_TAG == 1) { SUB_END(0, _gs0); }
        const unsigned long long _gs1 = SUB_T();
        if constexpr (ALIGN_EPI) { if (wr == 0) PG8_BAR; }
        if constexpr (!Epi::AFTER_DRAIN) { E(acc, cur, wr, wc, fr, fq, est); S.done(cur); ns_pending = E.nstore(cur); }
        if constexpr (Epi::PROBE_TAG == 1) { SUB_END(1, _gs1); }
        if (!has_next) break;
#pragma unroll
        for (int a = 0; a < 2; ++a)
#pragma unroll
            for (int b = 0; b < 2; ++b)
#pragma unroll
                for (int m = 0; m < 4; ++m)
#pragma unroll
                    for (int n = 0; n < 2; ++n) acc[a][b][m][n] = (f32x4){0.f, 0.f, 0.f, 0.f};
        cur = nxt; cA = nA; cB = nB; ++ui;
#pragma unroll
        for (int h = 0; h < 2; ++h)
#pragma unroll
            for (int i = 0; i < 2; ++i) oc[h][i] = on[h][i];
        if constexpr (ALIGN_EPI) { if (wr == 1) PG8_BAR; }
    }
    PG8_WAIT_V(0);
    if constexpr (!ALIGN_EPI) { if (wr == 0) PG8_BAR; }
    PG8_BAR;
    if constexpr (Epi::AFTER_DRAIN) { E.fused(acc, cur, wr, wc, fr, fq, lds, wid, lane); S.done(cur); }
#undef PG8_SA
#undef PG8_SB
#undef PG8_STAGE
#undef PG8_LDA
#undef PG8_LDB
#undef PG8_MMA
#undef PG8_WAIT_V
#undef PG8_WAIT_L
#undef PG8_WAIT_VA
#undef PG8_BAR
#undef PG8_SCHED
}
}

#define GAS __attribute__((address_space(1)))
#define LAS __attribute__((address_space(3)))
typedef unsigned v4u __attribute__((ext_vector_type(4)));
typedef float f32x4 __attribute__((ext_vector_type(4)));
typedef GAS unsigned gu32;
#define RLX_AGENT __ATOMIC_RELAXED, __HIP_MEMORY_SCOPE_AGENT
#define LDS_WAIT() asm volatile("s_waitcnt lgkmcnt(0)" ::: "memory")
#define VM_WAIT() asm volatile("s_waitcnt vmcnt(0)" ::: "memory")
constexpr int NWAVES = 8;
constexpr int RING_OFF = 0, RING_BYTES = 131072;
constexpr int LDS_BYTES = 163840;
constexpr int LDSCTL_OFF = LDS_BYTES - 4096, MISC_OFF = LDSCTL_OFF + 320;
constexpr int PLAN_OFF = LDSCTL_OFF + 1024;

#define XB_TMO      128
#define XB_XCNT(j)  (256  + 64 * (j))
#define XB_XSUB(j)  (1280 + 64 * (j))
#define XB_XGEN(j)  (2304 + 64 * (j))
#define XB_TOP      3328
#define XB_TOPGEN   3392
#define XCD_BAR_WORDS 3456
#define XB_SPIN_CAP (1u << 18)

__device__ __forceinline__ unsigned xb_ld(unsigned* p)              { return __hip_atomic_load(p, __ATOMIC_RELAXED, __HIP_MEMORY_SCOPE_AGENT); }
__device__ __forceinline__ unsigned xb_add(unsigned* p, unsigned v) { return __hip_atomic_fetch_add(p, v, __ATOMIC_RELAXED, __HIP_MEMORY_SCOPE_AGENT); }
__device__ __forceinline__ unsigned xb_xcc_id() { return (unsigned)__builtin_amdgcn_s_getreg((3 << 11) | 20) & 0xFu; }
#define XB_SPIN(cond, bar) do { unsigned _sp = 0; while (cond) { __builtin_amdgcn_s_sleep(1); \
    if ((++_sp & 255u) == 0u) { if (xb_ld(&(bar)[XB_TMO])) break; if (_sp > XB_SPIN_CAP) { atomicAdd(&(bar)[XB_TMO], 1u); break; } } } } while (0)

struct XcdBarrier {
    unsigned* bar; unsigned x;
    volatile LAS unsigned* st;
};

__device__ __forceinline__ XcdBarrier xcd_barrier_post(unsigned* bar, volatile LAS unsigned* st) {
    XcdBarrier b; b.bar = bar; b.x = xb_xcc_id(); b.st = st;
    if (threadIdx.x == 0) (void)xb_add(&bar[XB_XCNT(b.x)], 1u);
    return b;
}
__device__ __forceinline__ void xcd_barrier_complete(unsigned* bar, unsigned x, unsigned& nloc, unsigned& nx) {
    const unsigned G = gridDim.x * gridDim.y * gridDim.z;
    unsigned sum, cnt, mine, sp = 0u;
    for (;;) {
        sum = 0u; cnt = 0u; mine = 0u;
#pragma unroll
        for (unsigned j = 0; j < 16; ++j) { const unsigned c = xb_ld(&bar[XB_XCNT(j)]); sum += c; cnt += (c > 0u) ? 1u : 0u; mine = (j == x) ? c : mine; }
        if (sum == G) break;
        __builtin_amdgcn_s_sleep(1);
        if ((++sp & 255u) == 0u) { if (xb_ld(&bar[XB_TMO])) break; if (sp > XB_SPIN_CAP) { atomicAdd(&bar[XB_TMO], 1u); break; } }
    }
    nloc = mine > 0u ? mine : 1u; nx = cnt > 0u ? cnt : 1u;
}

__device__ __forceinline__ void xcd_barrier(const XcdBarrier& b) {
    asm volatile("s_waitcnt vmcnt(0)" ::: "memory");
    __syncthreads();
    if (threadIdx.x == 0) {
        unsigned* bar = b.bar;
        __builtin_amdgcn_s_waitcnt(0);
        unsigned nloc = b.st[0], nx = b.st[1];
        if (nloc == 0u) { xcd_barrier_complete(bar, b.x, nloc, nx); b.st[0] = nloc; b.st[1] = nx; }
        const unsigned old = xb_add(&bar[XB_XSUB(b.x)], 1u);
        const unsigned gen = old / nloc;
        if (old + 1u == (gen + 1u) * nloc) {
            __builtin_amdgcn_fence(__ATOMIC_RELEASE, "agent");
            asm volatile("s_waitcnt vmcnt(0)" ::: "memory");
            const unsigned og = xb_add(&bar[XB_TOP], 1u);
            const unsigned tg = og / nx;
            if (og + 1u == (tg + 1u) * nx) xb_add(&bar[XB_TOPGEN], 1u);
            else XB_SPIN(xb_ld(&bar[XB_TOPGEN]) == tg, bar);
            __builtin_amdgcn_fence(__ATOMIC_ACQUIRE, "agent");
            xb_add(&bar[XB_XGEN(b.x)], 1u);
            asm volatile("s_waitcnt vmcnt(0)" ::: "memory");
        } else {
            XB_SPIN(xb_ld(&bar[XB_XGEN(b.x)]) == gen, bar);
            __builtin_amdgcn_fence(__ATOMIC_ACQUIRE, "agent");
            asm volatile("s_waitcnt vmcnt(0)" ::: "memory");
        }
    }
    __syncthreads();
}

__device__ __forceinline__ float wave_sum(float v) {
#pragma unroll
    for (int o = 1; o < 64; o <<= 1) v += __shfl_xor(v, o);
    return v;
}

struct EpiIn { static constexpr int PROBE_TAG = 0; static constexpr bool MIDSCALE = false; struct State {}; __device__ __forceinline__ void pre(const pg8::Unit&, int, int, int, int, State&) const {}
    static constexpr bool PERM = true, AFTER_DRAIN = false;
    __device__ __forceinline__ int nstore(const pg8::Unit& u) const { return u.pn == 18 ? 0 : 16; }
    bf16_t *zq, *xbc, *kk, *vv; float* dt;
    __device__ __forceinline__ void operator()(const pg8::f32x4 (&acc)[2][2][4][2], const pg8::Unit& u, int wr, int wc, int fr, int fq, const State&) const {
        const int row0 = u.pm * 256 + wr * 64 + fr, pn = u.pn;
        if (pn == 18) {
            if (wc == 0 && fq < 2) {
#pragma unroll
                for (int ai = 0; ai < 2; ++ai)
#pragma unroll
                    for (int m = 0; m < 4; ++m) { float* o = dt + (size_t)(row0 + ai * 128 + m * 16) * 16 + 8 * fq; *(pg8::f32x4*)o = acc[ai][0][m][0]; *(pg8::f32x4*)(o + 4) = acc[ai][0][m][1]; }
            }
            return;
        }
        bf16_t* base; int ldc, colt;
        if (pn < 4) { base = zq; ldc = 2048; colt = ZQ_Z + pn * 256; }
        else if (pn < 12) { base = xbc; ldc = 2048; colt = (pn - 4) * 256; }
        else if (pn < 16) { base = zq; ldc = 2048; colt = ZQ_Q + (pn - 12) * 256; }
        else if (pn == 16) { base = kk; ldc = 256; colt = 0; }
        else { base = vv; ldc = 256; colt = 0; }
        const int col0 = colt + wc * 32 + 8 * fq;
#pragma unroll
        for (int ai = 0; ai < 2; ++ai)
#pragma unroll
            for (int m = 0; m < 4; ++m) { bf16_t* rowp = base + (size_t)(row0 + ai * 128 + m * 16) * ldc + col0;
#pragma unroll
                for (int bj = 0; bj < 2; ++bj) { const pg8::f32x4 v0 = acc[ai][bj][m][0], v1 = acc[ai][bj][m][1];
                    pg8::u32x4 w; w.x = pg8::cvt_pk_bf16(v0[0], v0[1]); w.y = pg8::cvt_pk_bf16(v0[2], v0[3]); w.z = pg8::cvt_pk_bf16(v1[0], v1[1]); w.w = pg8::cvt_pk_bf16(v1[2], v1[3]);
                    *(pg8::u32x4*)(rowp + bj * 128) = w; } }
    }
};

struct EpiOut { static constexpr int PROBE_TAG = 0; static constexpr bool MIDSCALE = true; struct State {}; __device__ __forceinline__ void pre(const pg8::Unit&, int, int, int, int, State&) const {}
    static constexpr bool PERM = true, AFTER_DRAIN = false;
    __device__ __forceinline__ int nstore(const pg8::Unit&) const { return 16; }
    const float* x; float* x1; const float* mod; const float* ratt;
    __device__ __forceinline__ void mid(pg8::f32x4 (&acc)[2][2][4][2], const pg8::Unit& u, int wr, int fr) const {
        float rs[2][4];
#pragma unroll
        for (int ai = 0; ai < 2; ++ai)
#pragma unroll
            for (int m = 0; m < 4; ++m) rs[ai][m] = ratt[u.pm * 256 + ai * 128 + wr * 64 + m * 16 + fr];
#pragma unroll
        for (int ai = 0; ai < 2; ++ai)
#pragma unroll
            for (int bj = 0; bj < 2; ++bj)
#pragma unroll
                for (int m = 0; m < 4; ++m)
#pragma unroll
                    for (int n = 0; n < 2; ++n) acc[ai][bj][m][n] = acc[ai][bj][m][n] * rs[ai][m];
    }
    __device__ __forceinline__ void operator()(const pg8::f32x4 (&acc)[2][2][4][2], const pg8::Unit& u, int wr, int wc, int fr, int fq, const State&) const {
        const int row0 = u.pm * 256 + wr * 64 + fr, col0 = u.pn * 256 + wc * 32 + 8 * fq, b = (u.pm * 256) / SEQ;
        const float* g1 = mod + b * 6 * D + 2 * D + col0;
        pg8::f32x4 gv[2][2];
#pragma unroll
        for (int bj = 0; bj < 2; ++bj) { gv[bj][0] = *(const pg8::f32x4*)(g1 + bj * 128); gv[bj][1] = *(const pg8::f32x4*)(g1 + bj * 128 + 4); }
#pragma unroll
        for (int ai = 0; ai < 2; ++ai)
#pragma unroll
            for (int m = 0; m < 4; ++m) { const size_t off = (size_t)(row0 + ai * 128 + m * 16) * D + col0;
#pragma unroll
                for (int bj = 0; bj < 2; ++bj) { const float* xi = x + off + bj * 128; float* xo = x1 + off + bj * 128;
                    *(pg8::f32x4*)xo = *(const pg8::f32x4*)xi + gv[bj][0] * acc[ai][bj][m][0]; *(pg8::f32x4*)(xo + 4) = *(const pg8::f32x4*)(xi + 4) + gv[bj][1] * acc[ai][bj][m][1]; } }
    }
};
struct EpiGU { static constexpr int PROBE_TAG = 0; static constexpr bool MIDSCALE = false; struct State {}; __device__ __forceinline__ void pre(const pg8::Unit&, int, int, int, int, State&) const {}
    static constexpr bool PERM = true, AFTER_DRAIN = false;
    __device__ __forceinline__ int nstore(const pg8::Unit&) const { return 8; }
    bf16_t* u;
    __device__ __forceinline__ void operator()(const pg8::f32x4 (&acc)[2][2][4][2], const pg8::Unit& un, int wr, int wc, int fr, int fq, const State&) const {
        const int row0 = un.pm * 256 + wr * 64 + fr, col0 = un.pn * 128 + wc * 32 + 8 * fq;
#pragma unroll
        for (int ai = 0; ai < 2; ++ai)
#pragma unroll
            for (int m = 0; m < 4; ++m) { bf16_t* rowp = u + (size_t)(row0 + ai * 128 + m * 16) * ED + col0;
                float o[8];
#pragma unroll
                for (int n = 0; n < 2; ++n)
#pragma unroll
                    for (int j = 0; j < 4; ++j) o[4 * n + j] = silu_f(acc[ai][0][m][n][j]) * acc[ai][1][m][n][j];
                pg8::u32x4 w; w.x = pg8::cvt_pk_bf16(o[0], o[1]); w.y = pg8::cvt_pk_bf16(o[2], o[3]); w.z = pg8::cvt_pk_bf16(o[4], o[5]); w.w = pg8::cvt_pk_bf16(o[6], o[7]);
                *(pg8::u32x4*)rowp = w; }
    }
};
constexpr float YC_SCALE = 16.f;
struct EpiDown {
    static constexpr bool PERM = true, AFTER_DRAIN = false;
    static constexpr int PROBE_TAG = 1; static constexpr bool MIDSCALE = false; struct State { unsigned pm[8]; };
    unsigned char* yc; const unsigned* pmeta; unsigned char* dump;
    __device__ __forceinline__ int nstore(const pg8::Unit&) const { return 8; }
    __device__ __forceinline__ void pre(const pg8::Unit& u, int wr, int wc, int fr, int fq, State& st) const {
        if (u.e < NE) { const unsigned* lp = pmeta + (size_t)u.e * M + u.lt * 256;
#pragma unroll
            for (int i = 0; i < 8; ++i) { const int r = (i >> 2) * 128 + wr * 64 + (i & 3) * 16 + fr; st.pm[i] = lp[r < u.nrows ? r : 0]; }
#pragma unroll
            for (int i = 0; i < 8; ++i) { const int r = (i >> 2) * 128 + wr * 64 + (i & 3) * 16 + fr; if (r >= u.nrows) st.pm[i] = 0xffffffffu; }
        } else {
#pragma unroll
            for (int i = 0; i < 8; ++i) { const int r = (i >> 2) * 128 + wr * 64 + (i & 3) * 16 + fr; st.pm[i] = r < u.nrows ? ((unsigned)((u.lt * 256 + r) * NSLOT + 8) << 14) | 4096u : 0xffffffffu; }
        }
    }
    __device__ __forceinline__ void operator()(const pg8::f32x4 (&acc)[2][2][4][2], const pg8::Unit& u, int wr, int wc, int fr, int fq, const State& st) const {
        const unsigned pos0 = (unsigned)(u.pn * 256 + wc * 64 + fq * 16);
#pragma unroll
        for (int ai = 0; ai < 2; ++ai)
#pragma unroll
            for (int m = 0; m < 4; ++m) { const unsigned pmv = st.pm[ai * 4 + m]; const float gt = (float)(pmv & 0x3fffu) * (YC_SCALE / 4096.f);
                unsigned char* dst = pmv != 0xffffffffu ? yc + ((size_t)(pmv >> 14) * 1024u + pos0) : dump + (threadIdx.x & 511) * 16;
                pg8::u32x4 w;
#pragma unroll
                for (int bj = 0; bj < 2; ++bj)
#pragma unroll
                    for (int n = 0; n < 2; ++n) { const pg8::f32x4 v = acc[ai][bj][m][n] * gt; int q = __builtin_amdgcn_cvt_pk_fp8_f32(v[0], v[1], 0, false); q = __builtin_amdgcn_cvt_pk_fp8_f32(v[2], v[3], q, true); w[bj * 2 + n] = (unsigned)q; }
                *(pg8::u32x4*)dst = w; }
    }
};
template <bool GATHER>
struct GroupedOrder {
    typedef pg8::Unit Unit;
    const char* A; const char* Bt; int K, nN, G, c, total; const LAS int* plan; const int* list; size_t bs_e, bs_pn; int pn0;
    __device__ __forceinline__ void init(const void* A_, const void* Bt_, int K_, int nN_, int G_, int c_, const LAS int* plan_, const int* list_, size_t bs_e_, size_t bs_pn_, int pn0_) {
        A = (const char*)A_; Bt = (const char*)Bt_; K = K_; nN = nN_; G = G_; c = c_; plan = plan_; list = list_; bs_e = bs_e_; bs_pn = bs_pn_; pn0 = pn0_; total = __builtin_amdgcn_readfirstlane(plan[NE + 1]) * nN; }
    __device__ __forceinline__ bool next(int i, Unit& u) const {
        const int L = i * G + c; if (L >= total) return false;
        int wgid = L; { const int q = total / 8, r = total % 8, xcd = wgid % 8, off = wgid / 8; wgid = (xcd < r ? xcd * (q + 1) : r * (q + 1) + (xcd - r) * q) + off; }
        const int tile = wgid / nN; u.pn = wgid % nN; u.pm = tile;
        int e = 0;
        for (int j = 1; j <= NE; ++j) e += (plan[j] <= tile) ? 1 : 0;
        e = __builtin_amdgcn_readfirstlane(e);
        u.e = e; u.lt = __builtin_amdgcn_readfirstlane(tile - plan[e]); const int rem = __builtin_amdgcn_readfirstlane(plan[80 + e]) - u.lt * 256; u.nrows = rem < 256 ? rem : 256; return true;
    }
    __device__ __forceinline__ const char* a_base(const Unit& u) const { return GATHER ? A : A + (size_t)u.pm * 512 * K; }
    __device__ __forceinline__ const char* b_base(const Unit& u) const { return Bt + (size_t)u.e * bs_e + (size_t)(pn0 + u.pn) * bs_pn; }
    __device__ __forceinline__ void lane_off(const Unit& u, const int (&R)[2], const int (&C)[2], unsigned (&o)[2][2]) const {
#pragma unroll
        for (int h = 0; h < 2; ++h)
#pragma unroll
            for (int i = 0; i < 2; ++i) { const int r = h * 128 + R[i];
                if (GATHER) { int tok = 0; if (r < u.nrows) { const int idx = u.lt * 256 + r; tok = u.e < NE ? (list[(size_t)u.e * M + idx] >> 3) : idx; }
                    o[h][i] = (unsigned)((tok * K + C[i]) * 2); }
                else o[h][i] = (unsigned)((r * K + C[i]) * 2); }
    }
    __device__ __forceinline__ void a_ready(const Unit&) const {}
    __device__ __forceinline__ void done(const Unit&) const {}
};

template <class CM>
__device__ __forceinline__ void transpose_item(const float* W, int ldw, bf16_t* WT, int ldt, int k0, int n0, LAS float* scr, int lane, const CM& colmap, int ksrc0 = -1, const float* kscale = nullptr) {
    const int sc = colmap(n0 + (lane & 31)); if (ksrc0 < 0) ksrc0 = k0;
#pragma unroll
    for (int i = 0; i < 32; ++i) { const int kk = 2 * i + (lane >> 5); scr[kk * 33 + (lane & 31)] = sc >= 0 ? W[(size_t)(ksrc0 + kk) * ldw + sc] * (kscale ? kscale[kk] : 1.f) : 0.f; }
    LDS_WAIT(); asm volatile("" ::: "memory");
    const int c = lane & 7;
#pragma unroll
    for (int j = 0; j < 4; ++j) { const int n = (lane >> 3) + 8 * j; const LAS float* s = scr + (8 * c) * 33 + n;
        v4u o; o.x = pk2(s[0 * 33], s[1 * 33]); o.y = pk2(s[2 * 33], s[3 * 33]); o.z = pk2(s[4 * 33], s[5 * 33]); o.w = pk2(s[6 * 33], s[7 * 33]);
        *(GAS v4u*)(WT + (size_t)(n0 + n) * ldt + k0 + 8 * c) = o; }
    LDS_WAIT(); asm volatile("" ::: "memory");
}

typedef short v4i16_t __attribute__((ext_vector_type(4)));
__device__ __forceinline__ v4i16_t tr4(const LAS unsigned char* img, int stride, int row0, int col0, int lane) {
    const LAS unsigned char* a = img + (row0 + ((lane & 15) >> 2)) * stride + (col0 + 4 * (lane & 3)) * 2;
    return __builtin_amdgcn_ds_read_tr16_b64_v4i16((LAS v4i16_t*)a);
}
__device__ __forceinline__ pg8::bf16x8 cat44(v4i16_t lo, v4i16_t hi) { return (pg8::bf16x8){lo[0], lo[1], lo[2], lo[3], hi[0], hi[1], hi[2], hi[3]}; }

template <class EMIT>
__device__ __forceinline__ void conv16x8(const bf16_t* xbc, const float* cw, const float* cb, int row0, int t0, int ch, const EMIT& emit) {
    v4u raw[19];
#pragma unroll
    for (int k = 0; k < 19; ++k) { raw[k] = (v4u){0u, 0u, 0u, 0u}; if (t0 - 3 + k >= 0) raw[k] = *(const v4u*)(xbc + (size_t)(row0 - 3 + k) * CONV_CH + ch); }
    float wv[4][8], bv[8];
#pragma unroll
    for (int k = 0; k < 4; ++k) { const f32x4 a = *(const f32x4*)(cw + k * CONV_CH + ch), b = *(const f32x4*)(cw + k * CONV_CH + ch + 4); wv[k][0] = a.x; wv[k][1] = a.y; wv[k][2] = a.z; wv[k][3] = a.w; wv[k][4] = b.x; wv[k][5] = b.y; wv[k][6] = b.z; wv[k][7] = b.w; }
    { const f32x4 a = *(const f32x4*)(cb + ch), b = *(const f32x4*)(cb + ch + 4); bv[0] = a.x; bv[1] = a.y; bv[2] = a.z; bv[3] = a.w; bv[4] = b.x; bv[5] = b.y; bv[6] = b.z; bv[7] = b.w; }
    float win[4][8];
#pragma unroll
    for (int k = 0; k < 3; ++k) { const unsigned w4[4] = {raw[k].x, raw[k].y, raw[k].z, raw[k].w};
#pragma unroll
        for (int j = 0; j < 4; ++j) { win[k][2 * j] = __uint_as_float(w4[j] << 16); win[k][2 * j + 1] = __uint_as_float(w4[j] & 0xffff0000u); } }
#pragma unroll
    for (int r = 0; r < 16; ++r) {
        { const unsigned w4[4] = {raw[r + 3].x, raw[r + 3].y, raw[r + 3].z, raw[r + 3].w};
#pragma unroll
          for (int j = 0; j < 4; ++j) { win[(r + 3) & 3][2 * j] = __uint_as_float(w4[j] << 16); win[(r + 3) & 3][2 * j + 1] = __uint_as_float(w4[j] & 0xffff0000u); } }
        float o[8];
#pragma unroll
        for (int j = 0; j < 8; ++j) { float a = bv[j];
#pragma unroll
            for (int k = 0; k < 4; ++k) a += wv[k][j] * win[(r + k) & 3][j];
            o[j] = silu_f(a); }
        emit(r, o);
    }
}

__device__ __forceinline__ void conv2x8(const bf16_t* xbc, const float* cw, const float* cb, int row, int t, int ch, float (&o0)[8], float (&o1)[8]) {
    float xr[5][8];
#pragma unroll
    for (int k = 0; k < 5; ++k) { v4u raw = (v4u){0u, 0u, 0u, 0u}; if (t - 3 + k >= 0) raw = *(const v4u*)(xbc + (size_t)(row - 3 + k) * CONV_CH + ch);
        const unsigned w4[4] = {raw.x, raw.y, raw.z, raw.w};
#pragma unroll
        for (int j = 0; j < 4; ++j) { xr[k][2 * j] = __uint_as_float(w4[j] << 16); xr[k][2 * j + 1] = __uint_as_float(w4[j] & 0xffff0000u); } }
    float wv[4][8], bv[8];
#pragma unroll
    for (int k = 0; k < 4; ++k) { const f32x4 a = *(const f32x4*)(cw + k * CONV_CH + ch), b = *(const f32x4*)(cw + k * CONV_CH + ch + 4); wv[k][0] = a.x; wv[k][1] = a.y; wv[k][2] = a.z; wv[k][3] = a.w; wv[k][4] = b.x; wv[k][5] = b.y; wv[k][6] = b.z; wv[k][7] = b.w; }
    { const f32x4 a = *(const f32x4*)(cb + ch), b = *(const f32x4*)(cb + ch + 4); bv[0] = a.x; bv[1] = a.y; bv[2] = a.z; bv[3] = a.w; bv[4] = b.x; bv[5] = b.y; bv[6] = b.z; bv[7] = b.w; }
#pragma unroll
    for (int j = 0; j < 8; ++j) { float a0 = bv[j], a1 = bv[j];
#pragma unroll
        for (int k = 0; k < 4; ++k) { a0 += wv[k][j] * xr[k][j]; a1 += wv[k][j] * xr[k + 1][j]; }
        o0[j] = silu_f(a0); o1[j] = silu_f(a1); }
}

constexpr int NPHASE = 12;
__global__ void __launch_bounds__(NWAVES * 64, 2) mega(P p) {
    extern __shared__ __attribute__((aligned(16))) unsigned char lds_raw[];
    LAS unsigned char* lds = (LAS unsigned char*)lds_raw;
    volatile LAS unsigned* MISC = (volatile LAS unsigned*)(lds + MISC_OFF);
    const int tid = threadIdx.x, lane = tid & 63, wave = __builtin_amdgcn_readfirstlane(tid >> 6);
    const int G = gridDim.x; const int bx = blockIdx.x; const int vcu = (G % 8 == 0) ? (bx % 8) * (G / 8) + bx / 8 : bx;
    unsigned char* ws = p.ws;
    gu32* ctl = (gu32*)(ws + WS_CTL);
    for (int u = tid; u < (LDS_BYTES - LDSCTL_OFF) / 4; u += NWAVES * 64) ((LAS unsigned*)(lds + LDSCTL_OFF))[u] = 0u;
    __syncthreads();
    XcdBarrier bar = xcd_barrier_post((unsigned*)(ctl + CW_BAR) + p.li * XCD_BAR_WORDS, MISC + 8);
    const int lo = p.ph_lo, hi = p.ph_hi;
#ifndef PHMASK
#define PHMASK 0xffffffffu
#endif
#define IN(k) (((PHMASK >> (k)) & 1u) && lo <= (k) && (k) < hi)
#define BOTH(k) (IN(k) && IN((k) + 1))
#ifdef PROBE_MASK
#define PH_BEGIN() const unsigned long long _pt0 = __builtin_amdgcn_s_memrealtime()
#define PH_END(k) do { if ((PROBE_MASK >> (k)) & 1u) { const unsigned long long _pt1 = __builtin_amdgcn_s_memrealtime(); while (__builtin_amdgcn_s_memrealtime() < _pt1 + (_pt1 - _pt0)) __builtin_amdgcn_s_sleep(8); } } while (0)
#else
#define PH_BEGIN() do {} while (0)
#define PH_END(k) do {} while (0)
#endif
    const int gw = vcu * NWAVES + wave, NGW = G * NWAVES;
    float* modv = (float*)(ws + WS_MOD);

    constexpr int I_GU = 16 * 16, I_D = 4 * 32, QBATCH = 16;
    LAS int* qslot = (LAS int*)(lds + PLAN_OFF + 1024);
#define STEAL_ITEMS(qword, NITEMS, ITEM_BODY) do { LAS float* scr = (LAS float*)(lds + RING_OFF + wave * 16384); \
        for (;;) { __syncthreads(); if (tid == 0) *qslot = (int)atomicAdd((unsigned*)(ws + WS_CTL) + (qword), (unsigned)QBATCH); __syncthreads(); \
            const int qb_ = __builtin_amdgcn_readfirstlane(*qslot); if (qb_ >= (NITEMS)) break; \
            for (int it = qb_ + wave; it < qb_ + QBATCH && it < (NITEMS); it += NWAVES) { ITEM_BODY } } } while (0)
#define ITEM_WGU { const int e = it / I_GU, r = it % I_GU, nb = r & 15, kb = r >> 4, up = (nb >> 2) & 1; \
        const float* W = e < NE ? (up ? p.exp_w_up : p.exp_w_gate) + (size_t)e * D * ED : (up ? p.sh_w_up : p.sh_w_gate); \
        transpose_item(W, ED, (bf16_t*)(ws + WS_WGU) + (size_t)e * 512 * D, D, kb * 64, nb * 32, scr, lane, [](int n) { return (n >> 8) * 128 + (n & 127); }); }
#define ITEM_WD { const int e = it / I_D, r2 = it % I_D, nb = r2 & 31, kb = r2 >> 5; \
        const float* W = e < NE ? p.exp_w_down + (size_t)e * ED * D : p.sh_w_down; \
        transpose_item(W, D, (bf16_t*)(ws + WS_WD) + (size_t)e * D * ED, ED, kb * 64, nb * 32, scr, lane, [](int n) { return n; }); }

    if (IN(0)) { PH_BEGIN();
        {
            LAS float* scl = (LAS float*)(lds + RING_OFF);
            LAS float* part = (LAS float*)(lds + RING_OFF + 16384);
            for (int i = tid; i < BATCH * D; i += 512) scl[i] = silu_f(p.c[i]);
            __syncthreads();
            const int cc = tid & 15, ks = tid >> 4;
            for (int item = bx; item < 6 * D / 16; item += G) { const int j0 = item * 16;
                float wv[32];
#pragma unroll
                for (int k = 0; k < 32; ++k) wv[k] = p.mod_w[(size_t)(ks * 32 + k) * 6 * D + j0 + cc];
                float a0 = 0.f, a1 = 0.f, a2 = 0.f, a3 = 0.f;
#pragma unroll
                for (int k = 0; k < 32; ++k) { const int kk = ks * 32 + k; a0 += scl[kk] * wv[k]; a1 += scl[D + kk] * wv[k]; a2 += scl[2 * D + kk] * wv[k]; a3 += scl[3 * D + kk] * wv[k]; }
                part[(ks * 4 + 0) * 16 + cc] = a0; part[(ks * 4 + 1) * 16 + cc] = a1; part[(ks * 4 + 2) * 16 + cc] = a2; part[(ks * 4 + 3) * 16 + cc] = a3;
                __syncthreads();
                if (tid < 64) { const int b = tid >> 4, c2 = tid & 15; float sacc = p.mod_b[j0 + c2];
                    for (int q = 0; q < 32; ++q) sacc += part[(q * 4 + b) * 16 + c2];
                    modv[b * 6 * D + j0 + c2] = sacc; }
                __syncthreads();
            }
        }
        LAS float* scr = (LAS float*)(lds + RING_OFF + wave * 16384);
        constexpr int I_IN = (D / 64) * (NWIN / 32), I_OUT = (2048 / 64) * (D / 32);
        bf16_t* WinT = (bf16_t*)(ws + WS_WIN_T); bf16_t* WoutT = (bf16_t*)(ws + WS_WOUT_T);
        for (int it = gw; it < I_IN + I_OUT; it += NGW) {
            if (it < I_IN) { const int nb = it % (NWIN / 32), kb = it / (NWIN / 32);
                transpose_item(p.w_in, IN_COLS, WinT, D, kb * 64, nb * 32, scr, lane, [](int n) { return n < 3072 ? n : (n < 4608 ? n + 16 : (n < 4624 ? n - 1536 : -1)); }); }
            else { const int r = it - I_IN, nb = r % (D / 32), kb = r / (D / 32);
                const int k0 = kb * 64;
                transpose_item(p.w_out, D, WoutT, 2048, k0, nb * 32, scr, lane, [](int n) { return n; }, k0 < 1024 ? k0 + 1024 : k0 - 1024, k0 < 1024 ? p.att_norm_g + k0 : nullptr); }
        }
        {
            v4u* rwf = (v4u*)(ws + WS_RWF);
            for (int i = bx * 512 + tid; i < 32 * 4 * 64; i += G * 512) { const int ln = i & 63, nt = (i >> 6) & 3, ks = i >> 8, c = ln & 15, q = ln >> 4;
                float v[8]; unsigned hi[4], lo[4];
#pragma unroll
                for (int j = 0; j < 8; ++j) v[j] = p.router_w[(32 * ks + 8 * q + j) * NE + 16 * nt + c];
#pragma unroll
                for (int j = 0; j < 4; ++j) { hi[j] = pk2(v[2 * j], v[2 * j + 1]); lo[j] = pk2(v[2 * j] - __uint_as_float(hi[j] << 16), v[2 * j + 1] - __uint_as_float(hi[j] & 0xffff0000u)); }
                rwf[((ks * 4 + nt) * 2) * 64 + ln] = (v4u){hi[0], hi[1], hi[2], hi[3]}; rwf[((ks * 4 + nt) * 2 + 1) * 64 + ln] = (v4u){lo[0], lo[1], lo[2], lo[3]}; }
        }
        if (BOTH(0)) xcd_barrier(bar);
        PH_END(0);
    }

    if (IN(1)) { PH_BEGIN();
        bf16_t* hn = (bf16_t*)p.out;
        for (int m = gw; m < M; m += NGW) {
            const int b = m / SEQ; const GAS f32x4* xr = (const GAS f32x4*)(p.x + (size_t)m * D) + lane;
            f32x4 v[4]; float s = 0.f;
#pragma unroll
            for (int j = 0; j < 4; ++j) { v[j] = xr[64 * j]; s += (v[j].x * v[j].x + v[j].y * v[j].y) + (v[j].z * v[j].z + v[j].w * v[j].w); }
            const float rstd = rsqrtf(wave_sum(s) * (1.f / D) + EPS);
            GAS unsigned long long* o8 = (GAS unsigned long long*)(hn + (size_t)m * D) + lane;
#pragma unroll
            for (int j = 0; j < 4; ++j) { const int d = 4 * lane + 256 * j; const f32x4 g = *(const f32x4*)(p.norm1_g + d), sc = *(const f32x4*)(modv + b * 6 * D + D + d), sh = *(const f32x4*)(modv + b * 6 * D + d);
                const f32x4 h = v[j] * rstd * g * (sc + 1.f) + sh;
                o8[64 * j] = (unsigned long long)pk2(h.x, h.y) | ((unsigned long long)pk2(h.z, h.w) << 32); }
        }
        if (BOTH(1)) xcd_barrier(bar);
        PH_END(1);
    }

    if (IN(2)) { PH_BEGIN();
        pg8::DenseOrder S; S.init(p.out, ws + WS_WIN_T, M, NWIN, D, G, bx);
        EpiIn E{(bf16_t*)(ws + WS_ZQ), (bf16_t*)(ws + WS_XBC), (bf16_t*)(ws + WS_K), (bf16_t*)(ws + WS_V), (float*)(ws + WS_DT)};
        pg8::gemm_phase<EpiIn, pg8::DenseOrder, true, true>(lds + RING_OFF, D, S, E);
        STEAL_ITEMS(CW_Q1, (NE + 1) * I_GU, ITEM_WGU);
        if (BOTH(2)) xcd_barrier(bar);
        PH_END(2);
    }

    if (IN(3)) { PH_BEGIN();
        {
            typedef pg8::bf16x8 bf16x8; typedef pg8::f32x4 f4;
            bf16_t* zq = (bf16_t*)(ws + WS_ZQ); const bf16_t* kk = (const bf16_t*)(ws + WS_K); const bf16_t* vv = (const bf16_t*)(ws + WS_V); float* ssq = (float*)(ws + WS_SSQ);
            LAS unsigned char* Kl = lds + RING_OFF; LAS unsigned char* Vl = lds + RING_OFF + 27648; LAS float* biasl = (LAS float*)(lds + RING_OFF + 58368);
            __syncthreads();
            for (int i = tid; i < ATT_HEADS * 128; i += 512) { const int h = i >> 7, dist = i & 127; biasl[i] = p.rel_bias[c_bucket[dist] * ATT_HEADS + h]; }
            const int fr = lane & 15, fg = lane >> 4;
            for (int unit = bx; unit < BATCH * (SEQ / 64); unit += G) {
                const int b = unit / (SEQ / 64), qb = unit % (SEQ / 64), t0 = qb * 64, row0 = b * SEQ + t0;
                v4u kreg[3], vreg[3]; bf16x8 Qn[2][2];
#define ATT_LOADS(KVH) do { _Pragma("unroll") for (int q3 = 0; q3 < 3; ++q3) { const int i = tid + 512 * q3, j = i >> 3, ch = i & 7, kt = t0 - 128 + j; \
                        kreg[q3] = (v4u){0u, 0u, 0u, 0u}; vreg[q3] = (v4u){0u, 0u, 0u, 0u}; \
                        if (kt >= 0) { kreg[q3] = *(const v4u*)(kk + (size_t)(b * SEQ + kt) * D_KV + (KVH) * HD + ch * 8); vreg[q3] = *(const v4u*)(vv + (size_t)(b * SEQ + kt) * D_KV + (KVH) * HD + ch * 8); } } \
                    _Pragma("unroll") for (int r2 = 0; r2 < 2; ++r2) _Pragma("unroll") for (int ks = 0; ks < 2; ++ks) \
                        Qn[r2][ks] = *(const bf16x8*)(zq + (size_t)(row0 + 16 * (2 * (wave & 1) + r2) + fr) * 2048 + ZQ_Q + ((KVH) * 4 + (wave >> 1)) * HD + ks * 32 + 8 * fg); } while (0)
                ATT_LOADS(0);
                for (int kvh = 0; kvh < KV_HEADS; ++kvh) {
                    __syncthreads();
#pragma unroll
                    for (int q3 = 0; q3 < 3; ++q3) { const int i = tid + 512 * q3, j = i >> 3, ch = i & 7; *(LAS v4u*)(Kl + j * 144 + ch * 16) = kreg[q3]; *(LAS v4u*)(Vl + j * 160 + ch * 16) = vreg[q3]; }
                    bf16x8 Qc[2][2];
#pragma unroll
                    for (int r2 = 0; r2 < 2; ++r2)
#pragma unroll
                        for (int ks = 0; ks < 2; ++ks) Qc[r2][ks] = Qn[r2][ks];
                    __syncthreads();
                    if (kvh + 1 < KV_HEADS) ATT_LOADS(kvh + 1);
                    const int head = kvh * 4 + (wave >> 1), rt0 = 2 * (wave & 1), jt0 = rt0;
                    const float sink = p.sinks[head]; const LAS float* bl = biasl + head * 128;
#pragma unroll 1
                    for (int r2 = 0; r2 < 2; ++r2) {
                        const int qi = 16 * (rt0 + r2) + fr;
                        bf16x8 Qf[2];
#pragma unroll
                        for (int ks = 0; ks < 2; ++ks) Qf[ks] = r2 ? Qc[1][ks] : Qc[0][ks];
                        f4 sacc[10];
#pragma unroll
                        for (int jt = 0; jt < 10; ++jt) sacc[jt] = (f4){0.f, 0.f, 0.f, 0.f};
#pragma unroll
                        for (int jt = 0; jt < 10; ++jt)
#pragma unroll
                            for (int ks = 0; ks < 2; ++ks) { const bf16x8 Kf = *(const LAS bf16x8*)(Kl + (16 * (jt0 + jt) + fr) * 144 + (ks * 32 + 8 * fg) * 2);
                                sacc[jt] = __builtin_amdgcn_mfma_f32_16x16x32_bf16(Kf, Qf[ks], sacc[jt], 0, 0, 0); }
                        float mx = sink;
#pragma unroll
                        for (int jt = 0; jt < 10; ++jt)
#pragma unroll
                            for (int j = 0; j < 4; ++j) { const int kj = 16 * (jt0 + jt) + 4 * fg + j, dist = qi + 128 - kj; const bool ok = dist >= 0 && dist < 128 && (t0 - 128 + kj) >= 0;
                                const float s = ok ? sacc[jt][j] * 0.125f + bl[dist & 127] : -INFINITY; sacc[jt][j] = s; mx = fmaxf(mx, s); }
                        mx = fmaxf(mx, __shfl_xor(mx, 16)); mx = fmaxf(mx, __shfl_xor(mx, 32));
                        float ls = 0.f;
#pragma unroll
                        for (int jt = 0; jt < 10; ++jt)
#pragma unroll
                            for (int j = 0; j < 4; ++j) { const float pe = __expf(sacc[jt][j] - mx); sacc[jt][j] = pe; ls += pe; }
                        ls += __shfl_xor(ls, 16); ls += __shfl_xor(ls, 32); ls += __expf(sink - mx);
                        f4 o[4];
#pragma unroll
                        for (int dt = 0; dt < 4; ++dt) o[dt] = (f4){0.f, 0.f, 0.f, 0.f};
#pragma unroll
                        for (int k5 = 0; k5 < 5; ++k5) { const f4 pa = sacc[2 * k5], pb = sacc[2 * k5 + 1];
                            union { bf16x8 v; unsigned u[4]; } Pf; Pf.u[0] = pg8::cvt_pk_bf16(pa[0], pa[1]); Pf.u[1] = pg8::cvt_pk_bf16(pa[2], pa[3]); Pf.u[2] = pg8::cvt_pk_bf16(pb[0], pb[1]); Pf.u[3] = pg8::cvt_pk_bf16(pb[2], pb[3]);
#pragma unroll
                            for (int dt = 0; dt < 4; ++dt) { const bf16x8 Vf = cat44(tr4(Vl, 160, 16 * (jt0 + 2 * k5) + 4 * fg, 16 * dt, lane), tr4(Vl, 160, 16 * (jt0 + 2 * k5 + 1) + 4 * fg, 16 * dt, lane));
                                o[dt] = __builtin_amdgcn_mfma_f32_16x16x32_bf16(Vf, Pf.v, o[dt], 0, 0, 0); } }
                        const float inv = 1.f / ls; float ss = 0.f;
                        bf16_t* op = zq + (size_t)(row0 + qi) * 2048 + ZQ_Q + head * HD + 4 * fg;
#pragma unroll
                        for (int dt = 0; dt < 4; ++dt) { const f4 ov = o[dt] * inv; ss += (ov[0] * ov[0] + ov[1] * ov[1]) + (ov[2] * ov[2] + ov[3] * ov[3]);
                            *(unsigned long long*)(op + 16 * dt) = (unsigned long long)pg8::cvt_pk_bf16(ov[0], ov[1]) | ((unsigned long long)pg8::cvt_pk_bf16(ov[2], ov[3]) << 32); }
                        ss += __shfl_xor(ss, 16); ss += __shfl_xor(ss, 32);
                        if (fg == 0) ssq[(row0 + qi) * 16 + head] = ss;
                    }
                }
            }
            __syncthreads();
        }
        PH_END(3);
    }

    if (IN(4)) { PH_BEGIN();
        typedef pg8::bf16x8 bf16x8; typedef pg8::f32x4 f4;
        const bf16_t* xbc = (const bf16_t*)(ws + WS_XBC); const float* dtr = (const float*)(ws + WS_DT); float* decg = (float*)(ws + WS_CS);
        LAS unsigned char* Xi = lds + RING_OFF; LAS unsigned char* Bi = lds + RING_OFF + 69632; LAS float* wl = (LAS float*)(lds + RING_OFF + 106496);
        const int fr = lane & 15, fg = lane >> 4;
        for (int unit = bx; unit < BATCH * NCHUNK * SSM_GROUPS; unit += G) {
            const int g = unit % SSM_GROUPS, bc = unit / SSM_GROUPS, rowc = bc * CHUNK, tc = rowc % SEQ;
            __syncthreads();
            if (wave < 4) { const int h = g * 4 + wave; const float A = -__expf(p.a_log[h]), bias = p.dt_bias[h];
                const float d0 = softplus_f(dtr[(rowc + lane) * 16 + h] + bias), d1 = softplus_f(dtr[(rowc + lane + 64) * 16 + h] + bias);
                float s0 = d0 * A, s1 = d1 * A;
#pragma unroll
                for (int o = 1; o < 64; o <<= 1) { const float u0 = __shfl_up(s0, o), u1 = __shfl_up(s1, o); if (lane >= o) { s0 += u0; s1 += u1; } }
                s1 += __shfl(s0, 63); const float cl = __shfl(s1, 63);
                wl[wave * 128 + lane] = d0 * __expf(cl - s0); wl[wave * 128 + lane + 64] = d1 * __expf(cl - s1);
                if (lane == 0) decg[bc * 16 + h] = __expf(cl); }
            __syncthreads();
            if (tid < 384) { const int co = tid % 48, l0 = 16 * (tid / 48);
                const int ch = co < 32 ? g * 256 + co * 8 : D_SSM + g * D_STATE + (co - 32) * 8;
                LAS unsigned char* dst = co < 32 ? Xi + l0 * 544 + co * 16 : Bi + l0 * 288 + (co - 32) * 16; const int st = co < 32 ? 544 : 288;
                const LAS float* wr_ = wl + (co < 32 ? (co >> 3) * 128 : 0) + l0; const bool scale = co < 32;
                conv16x8(xbc, p.conv_w, p.conv_b, rowc + l0, tc + l0, ch, [&](int r, const float (&o)[8]) { const float w = scale ? wr_[r] : 1.f;
                    *(LAS v4u*)(dst + r * st) = (v4u){pk2(o[0] * w, o[1] * w), pk2(o[2] * w, o[3] * w), pk2(o[4] * w, o[5] * w), pk2(o[6] * w, o[7] * w)}; }); }
            __syncthreads();
            bf16x8 Bf[4];
#pragma unroll
            for (int kk = 0; kk < 4; ++kk) Bf[kk] = cat44(tr4(Bi, 288, 32 * kk + 4 * fg, 16 * wave, lane), tr4(Bi, 288, 32 * kk + 16 + 4 * fg, 16 * wave, lane));
#pragma unroll
            for (int r4 = 0; r4 < 4; ++r4) { const int h = g * 4 + r4; float* S = p.out + (size_t)(bc * SSM_HEADS + h) * HD * D_STATE;
#pragma unroll
                for (int pt = 0; pt < 4; ++pt) { f4 acc = (f4){0.f, 0.f, 0.f, 0.f};
#pragma unroll
                    for (int kk = 0; kk < 4; ++kk) { const bf16x8 Af = cat44(tr4(Xi, 544, 32 * kk + 4 * fg, r4 * 64 + 16 * pt, lane), tr4(Xi, 544, 32 * kk + 16 + 4 * fg, r4 * 64 + 16 * pt, lane)); acc = __builtin_amdgcn_mfma_f32_16x16x32_bf16(Af, Bf[kk], acc, 0, 0, 0); }
#pragma unroll
                    for (int j = 0; j < 4; ++j) S[(16 * pt + 4 * fg + j) * D_STATE + 16 * wave + fr] = acc[j]; } }
        }
        if (BOTH(4)) xcd_barrier(bar);
        PH_END(4);
    }

    if (IN(5)) { PH_BEGIN();
        const float* S = p.out; const float* decg = (const float*)(ws + WS_CS); bf16_t* St = (bf16_t*)(ws + WS_ST);
        for (int i = bx * 512 + tid; i < BATCH * SSM_HEADS * HD * D_STATE / 2; i += G * 512) {
            const int pn = (i % (HD * D_STATE / 2)) * 2, bh = i / (HD * D_STATE / 2), h = bh % SSM_HEADS, b = bh / SSM_HEADS;
            float s0 = 0.f, s1 = 0.f;
#pragma unroll 4
            for (int c = 0; c < NCHUNK; ++c) { const size_t idx = ((size_t)((b * NCHUNK + c) * SSM_HEADS + h)) * HD * D_STATE + pn; const float2 sv = *(const float2*)(S + idx);
                *(unsigned*)(St + idx) = pk2(s0, s1); const float dec = decg[(b * NCHUNK + c) * 16 + h]; s0 = s0 * dec + sv.x; s1 = s1 * dec + sv.y; }
        }
        {
            const float* ssq = (const float*)(ws + WS_SSQ); float* ratt = (float*)(ws + WS_RATT);
            for (int m = bx * 512 + tid; m < M; m += G * 512) { const f32x4* sp = (const f32x4*)(ssq + (size_t)m * 16); const f32x4 a = sp[0], b = sp[1], c = sp[2], d = sp[3];
                const float sacc = ((a.x + a.y) + (a.z + a.w)) + ((b.x + b.y) + (b.z + b.w)) + ((c.x + c.y) + (c.z + c.w)) + ((d.x + d.y) + (d.z + d.w));
                ratt[m] = rsqrtf(sacc * (1.f / 1024.f) + EPS); }
        }
        if (BOTH(5)) xcd_barrier(bar);
        PH_END(5);
    }

    if (IN(6)) { PH_BEGIN();
        typedef pg8::bf16x8 bf16x8; typedef pg8::f32x4 f4;
        const bf16_t* xbc = (const bf16_t*)(ws + WS_XBC); const float* dtr = (const float*)(ws + WS_DT); bf16_t* zq = (bf16_t*)(ws + WS_ZQ); const bf16_t* Stg = (const bf16_t*)(ws + WS_ST);
        LAS unsigned char* Xi = lds + RING_OFF; LAS unsigned char* Bi = lds + RING_OFF + 69632; LAS unsigned char* Ci = lds + RING_OFF + 106496;
        LAS float* csl = (LAS float*)(lds + RING_OFF + 143360); LAS float* dtl = csl + 512;
        const int fr = lane & 15, fg = lane >> 4;
        for (int unit = bx; unit < BATCH * NCHUNK * SSM_GROUPS; unit += G) {
            const int g = unit % SSM_GROUPS, bc = unit / SSM_GROUPS, rowc = bc * CHUNK, tc = rowc % SEQ;
            __syncthreads();
            const unsigned long long _s0 = SUB_T();
            if (wave < 4) { const int h = g * 4 + wave; const float A = -__expf(p.a_log[h]), bias = p.dt_bias[h];
                const float d0 = softplus_f(dtr[(rowc + lane) * 16 + h] + bias), d1 = softplus_f(dtr[(rowc + lane + 64) * 16 + h] + bias);
                float s0 = d0 * A, s1 = d1 * A;
#pragma unroll
                for (int o = 1; o < 64; o <<= 1) { const float u0 = __shfl_up(s0, o), u1 = __shfl_up(s1, o); if (lane >= o) { s0 += u0; s1 += u1; } }
                s1 += __shfl(s0, 63);
                csl[wave * 128 + lane] = s0; csl[wave * 128 + lane + 64] = s1; dtl[wave * 128 + lane] = d0; dtl[wave * 128 + lane + 64] = d1; }
            { const int co = tid & 63, l0 = 16 * (tid >> 6);
                const int ch = co < 32 ? g * 256 + co * 8 : (co < 48 ? D_SSM + g * D_STATE + (co - 32) * 8 : D_SSM + SSM_GROUPS * D_STATE + g * D_STATE + (co - 48) * 8);
                LAS unsigned char* dst = co < 32 ? Xi + l0 * 544 + co * 16 : (co < 48 ? Bi + l0 * 288 + (co - 32) * 16 : Ci + l0 * 288 + (co - 48) * 16); const int st = co < 32 ? 544 : 288;
                conv16x8(xbc, p.conv_w, p.conv_b, rowc + l0, tc + l0, ch, [&](int r, const float (&o)[8]) {
                    *(LAS v4u*)(dst + r * st) = (v4u){pk2(o[0], o[1]), pk2(o[2], o[3]), pk2(o[4], o[5]), pk2(o[6], o[7])}; }); }
            __syncthreads();
            SUB_END(0, _s0); const unsigned long long _s1 = SUB_T();
            const int lrow = 16 * wave + fr;
            bf16x8 Cf[4];
#pragma unroll
            for (int kk = 0; kk < 4; ++kk) Cf[kk] = *(const LAS bf16x8*)(Ci + lrow * 288 + (4 * kk + fg) * 16);
            f4 Gt[8];
#pragma unroll
            for (int st = 0; st < 8; ++st) { Gt[st] = (f4){0.f, 0.f, 0.f, 0.f};
                if (st <= wave) {
#pragma unroll
                    for (int kk = 0; kk < 4; ++kk) { const bf16x8 Bf = *(const LAS bf16x8*)(Bi + (16 * st + fr) * 288 + (4 * kk + fg) * 16);
                        Gt[st] = __builtin_amdgcn_mfma_f32_16x16x32_bf16(Bf, Cf[kk], Gt[st], 0, 0, 0); } } }
            SUB_END(1, _s1); const unsigned long long _s2 = SUB_T();
            f4 Y[4][4];
            const bf16_t* zr0 = zq + (size_t)(rowc + lrow) * 2048 + ZQ_Z + g * 256 + 4 * fg; unsigned long long zz[4][4];
#pragma unroll
            for (int r4 = 0; r4 < 4; ++r4)
#pragma unroll
                for (int pt = 0; pt < 4; ++pt) zz[r4][pt] = *(const unsigned long long*)(zr0 + r4 * 64 + 16 * pt);
#pragma unroll
            for (int r4 = 0; r4 < 4; ++r4) { const int h = g * 4 + r4; const float ecl = __expf(csl[r4 * 128 + lrow]);
                const bf16_t* Sth = Stg + (size_t)(bc * SSM_HEADS + h) * HD * D_STATE;
#pragma unroll
                for (int pt = 0; pt < 4; ++pt) { f4 acc = (f4){0.f, 0.f, 0.f, 0.f};
#pragma unroll
                    for (int kk = 0; kk < 4; ++kk) { const bf16x8 Sf = *(const bf16x8*)(Sth + (16 * pt + fr) * D_STATE + (4 * kk + fg) * 8); acc = __builtin_amdgcn_mfma_f32_16x16x32_bf16(Sf, Cf[kk], acc, 0, 0, 0); }
                    Y[r4][pt] = acc * ecl; } }
#pragma unroll
            for (int r4 = 0; r4 < 4; ++r4) { const int h = g * 4 + r4; const float cl = csl[r4 * 128 + lrow];
#pragma unroll
                for (int k4 = 0; k4 < 4; ++k4) { if (2 * k4 <= wave) {
                    union { bf16x8 v; unsigned u[4]; } Pf;
#pragma unroll
                    for (int hh = 0; hh < 2; ++hh) { const int st = 2 * k4 + hh; const f4 c4 = *(const LAS f4*)(csl + r4 * 128 + 16 * st + 4 * fg), d4 = *(const LAS f4*)(dtl + r4 * 128 + 16 * st + 4 * fg);
                        float mv[4];
#pragma unroll
                        for (int j = 0; j < 4; ++j) { const int s = 16 * st + 4 * fg + j; mv[j] = (s <= lrow) ? Gt[st][j] * __expf(cl - c4[j]) * d4[j] : 0.f; }
                        Pf.u[2 * hh] = pg8::cvt_pk_bf16(mv[0], mv[1]); Pf.u[2 * hh + 1] = pg8::cvt_pk_bf16(mv[2], mv[3]); }
#pragma unroll
                    for (int pt = 0; pt < 4; ++pt) { const bf16x8 Xf = cat44(tr4(Xi, 544, 32 * k4 + 4 * fg, r4 * 64 + 16 * pt, lane), tr4(Xi, 544, 32 * k4 + 16 + 4 * fg, r4 * 64 + 16 * pt, lane));
                        Y[r4][pt] = __builtin_amdgcn_mfma_f32_16x16x32_bf16(Xf, Pf.v, Y[r4][pt], 0, 0, 0); } } }
                const float dsk = p.d_skip[h];
#pragma unroll
                for (int pt = 0; pt < 4; ++pt) { const unsigned long long xx = *(const LAS unsigned long long*)(Xi + lrow * 544 + (r4 * 64 + 16 * pt + 4 * fg) * 2); const unsigned x0 = (unsigned)xx, x1 = (unsigned)(xx >> 32);
                    Y[r4][pt][0] += dsk * __uint_as_float(x0 << 16); Y[r4][pt][1] += dsk * __uint_as_float(x0 & 0xffff0000u); Y[r4][pt][2] += dsk * __uint_as_float(x1 << 16); Y[r4][pt][3] += dsk * __uint_as_float(x1 & 0xffff0000u); }
            }
            SUB_END(2, _s2); const unsigned long long _s3 = SUB_T();
            bf16_t* zr = zq + (size_t)(rowc + lrow) * 2048 + ZQ_Z + g * 256 + 4 * fg; float ss = 0.f;
#pragma unroll
            for (int r4 = 0; r4 < 4; ++r4)
#pragma unroll
                for (int pt = 0; pt < 4; ++pt) { const unsigned z0 = (unsigned)zz[r4][pt], z1 = (unsigned)(zz[r4][pt] >> 32);
                    f4 v = Y[r4][pt]; v[0] *= silu_f(__uint_as_float(z0 << 16)); v[1] *= silu_f(__uint_as_float(z0 & 0xffff0000u)); v[2] *= silu_f(__uint_as_float(z1 << 16)); v[3] *= silu_f(__uint_as_float(z1 & 0xffff0000u));
                    Y[r4][pt] = v; ss += (v[0] * v[0] + v[1] * v[1]) + (v[2] * v[2] + v[3] * v[3]); }
            ss += __shfl_xor(ss, 16); ss += __shfl_xor(ss, 32);
            const float rr = rsqrtf(ss * (1.f / 256.f) + EPS);
#pragma unroll
            for (int r4 = 0; r4 < 4; ++r4)
#pragma unroll
                for (int pt = 0; pt < 4; ++pt) { const f4 gn = *(const f4*)(p.ssm_norm_g + g * 256 + r4 * 64 + 16 * pt + 4 * fg); const f4 v = Y[r4][pt] * rr * gn;
                    *(unsigned long long*)(zr + r4 * 64 + 16 * pt) = (unsigned long long)pg8::cvt_pk_bf16(v[0], v[1]) | ((unsigned long long)pg8::cvt_pk_bf16(v[2], v[3]) << 32); }
            SUB_END(3, _s3);
        }
        if (BOTH(6)) xcd_barrier(bar);
        PH_END(6);
    }

    if (IN(7)) { PH_BEGIN();
        pg8::DenseOrder S; S.init(ws + WS_ZQ, ws + WS_WOUT_T, M, D, 2048, G, bx);
        EpiOut E{p.x, p.out, modv, (const float*)(ws + WS_RATT)};
        pg8::gemm_phase<EpiOut, pg8::DenseOrder, true, true>(lds + RING_OFF, 2048, S, E);
        if (BOTH(7)) xcd_barrier(bar);
        PH_END(7);
    }

    if (IN(8)) { PH_BEGIN();
        typedef pg8::bf16x8 bf16x8; typedef pg8::f32x4 f4;
        LAS float* part = (LAS float*)(lds + RING_OFF);
        LAS float* red = (LAS float*)(lds + RING_OFF + 131072);
        LAS int* cnt_l = (LAS int*)(lds + RING_OFF + 133120);
        LAS int* base_l = (LAS int*)(lds + RING_OFF + 133376);
        LAS int* asg_e = (LAS int*)(lds + RING_OFF + 133632);
        LAS int* asg_pos = (LAS int*)(lds + RING_OFF + 135680);
        LAS float* asg_g = (LAS float*)(lds + RING_OFF + 137728);
        bf16_t* h2 = (bf16_t*)(ws + WS_H2); int* cnt = (int*)(ws + WS_CTL) + CW_CNT; int* list = (int*)(ws + WS_LIST); unsigned* pmeta = (unsigned*)(ws + WS_GLIST);
        const v4u* rwf = (const v4u*)(ws + WS_RWF);
        const float rbias = p.router_bias[lane];
        const int fr = lane & 15, fq = lane >> 4;
        for (int grp = bx; grp < M / 64; grp += G) {
            const int b = (grp * 64) / SEQ;
            __syncthreads();
            if (tid < NE) cnt_l[tid] = 0;
#pragma unroll 1
            for (int half = 0; half < 2; ++half) {
            f4 xv[2][4][2];
#pragma unroll
            for (int tile = 0; tile < 2; ++tile) { const float* xr = p.out + (size_t)(grp * 64 + half * 32 + tile * 16 + fr) * D + 128 * wave + 8 * fq;
#pragma unroll
                for (int kk = 0; kk < 4; ++kk) { xv[tile][kk][0] = *(const f4*)(xr + 32 * kk); xv[tile][kk][1] = *(const f4*)(xr + 32 * kk + 4); } }
#pragma unroll
            for (int tile = 0; tile < 2; ++tile) { float ss = 0.f;
#pragma unroll
                for (int kk = 0; kk < 4; ++kk)
#pragma unroll
                    for (int hf = 0; hf < 2; ++hf) { const f4 v = xv[tile][kk][hf]; ss += (v[0] * v[0] + v[1] * v[1]) + (v[2] * v[2] + v[3] * v[3]); }
                ss += __shfl_xor(ss, 16); ss += __shfl_xor(ss, 32);
                if (fq == 0) red[(tile * 8 + wave) * 16 + fr] = ss; }
            __syncthreads();
            float rstd2[2]; f4 acc[2][4];
#pragma unroll
            for (int tile = 0; tile < 2; ++tile) { float tot = 0.f;
#pragma unroll
                for (int w2 = 0; w2 < 8; ++w2) tot += red[(tile * 8 + w2) * 16 + fr];
                rstd2[tile] = rsqrtf(tot * (1.f / D) + EPS);
#pragma unroll
                for (int nt = 0; nt < 4; ++nt) acc[tile][nt] = (f4){0.f, 0.f, 0.f, 0.f}; }
#pragma unroll
            for (int kk = 0; kk < 4; ++kk) { const int d = 128 * wave + 32 * kk + 8 * fq;
                f4 gm[2], sm[2];
#pragma unroll
                for (int hf = 0; hf < 2; ++hf) { gm[hf] = *(const f4*)(p.norm2_g + d + 4 * hf) * (*(const f4*)(modv + b * 6 * D + 4 * D + d + 4 * hf) + 1.f); sm[hf] = *(const f4*)(modv + b * 6 * D + 3 * D + d + 4 * hf); }
                union { bf16x8 v; v4u q; } Rh[4], Rl[4];
#pragma unroll
                for (int nt = 0; nt < 4; ++nt) { const int fi = (((4 * wave + kk) * 4 + nt) * 2) * 64 + lane; Rh[nt].q = rwf[fi]; Rl[nt].q = rwf[fi + 64]; }
#pragma unroll
                for (int tile = 0; tile < 2; ++tile) { const int row = grp * 64 + half * 32 + tile * 16 + fr;
                    union { bf16x8 v; unsigned u[4]; v4u q; } Hh, Hl;
#pragma unroll
                    for (int hf = 0; hf < 2; ++hf) { const f4 h = xv[tile][kk][hf] * rstd2[tile] * gm[hf] + sm[hf];
                        const unsigned h01 = pk2(h[0], h[1]), h23 = pk2(h[2], h[3]);
                        Hh.u[2 * hf] = h01; Hh.u[2 * hf + 1] = h23;
                        Hl.u[2 * hf] = pk2(h[0] - __uint_as_float(h01 << 16), h[1] - __uint_as_float(h01 & 0xffff0000u)); Hl.u[2 * hf + 1] = pk2(h[2] - __uint_as_float(h23 << 16), h[3] - __uint_as_float(h23 & 0xffff0000u)); }
                    *(v4u*)(h2 + (size_t)row * D + d) = Hh.q;
#pragma unroll
                    for (int nt = 0; nt < 4; ++nt) {
                        acc[tile][nt] = __builtin_amdgcn_mfma_f32_16x16x32_bf16(Hh.v, Rh[nt].v, acc[tile][nt], 0, 0, 0);
                        acc[tile][nt] = __builtin_amdgcn_mfma_f32_16x16x32_bf16(Hh.v, Rl[nt].v, acc[tile][nt], 0, 0, 0);
                        acc[tile][nt] = __builtin_amdgcn_mfma_f32_16x16x32_bf16(Hl.v, Rh[nt].v, acc[tile][nt], 0, 0, 0); } }
                asm volatile("" ::: "memory"); }
#pragma unroll
            for (int tile = 0; tile < 2; ++tile)
#pragma unroll
                for (int nt = 0; nt < 4; ++nt)
#pragma unroll
                    for (int j = 0; j < 4; ++j) part[((tile * 8 + wave) * 16 + 4 * fq + j) * 64 + 16 * nt + fr] = acc[tile][nt][j];
            __syncthreads();
#pragma unroll 1
            for (int rr = 0; rr < 4; ++rr) { const int lr32 = 4 * wave + rr, tile = lr32 >> 4, lr = lr32 & 15, lr64 = half * 32 + lr32, m = grp * 64 + lr64;
                float lg = 0.f;
#pragma unroll
                for (int w2 = 0; w2 < 8; ++w2) lg += part[((tile * 8 + w2) * 16 + lr) * 64 + lane];
                const float sc = 1.f / (1.f + __expf(-lg)), sel = sc + rbias;
                float m1 = sel, m2 = -INFINITY;
#pragma unroll
                for (int o = 1; o < 8; o <<= 1) { const float p1 = __shfl_xor(m1, o), p2 = __shfl_xor(m2, o); const float n1 = fmaxf(m1, p1), n2 = fmaxf(fminf(m1, p1), fmaxf(m2, p2)); m1 = n1; m2 = n2; }
                const float gs = m1 + m2; const int myg = lane >> 3;
                unsigned gk = __float_as_uint(gs); gk = (gk & 0x80000000u) ? ~gk : (gk | 0x80000000u); gk = (gk & ~7u) | (unsigned)(7 - myg);
                int grank = 0;
#pragma unroll
                for (int g2 = 0; g2 < 8; ++g2) grank += (__builtin_amdgcn_readlane(gk, g2 * 8) > gk) ? 1 : 0;
                const bool allowed = grank < 4;
                unsigned ek = __float_as_uint(sel); ek = (ek & 0x80000000u) ? ~ek : (ek | 0x80000000u); ek = allowed ? ((ek & ~63u) | (unsigned)(63 - lane)) : 0u;
                int rank = 0;
#pragma unroll
                for (int e2 = 0; e2 < NE; ++e2) rank += (__builtin_amdgcn_readlane(ek, e2) > ek) ? 1 : 0;
                const bool selb = allowed && rank < TOPK;
                const float wsum = wave_sum(selb ? sc : 0.f);
                if (selb) { const float gate = sc / wsum * 2.5f; const int pl = __hip_atomic_fetch_add(cnt_l + lane, 1, __ATOMIC_RELAXED, __HIP_MEMORY_SCOPE_WORKGROUP); const int i = lr64 * 8 + rank; asg_e[i] = lane; asg_pos[i] = pl; asg_g[i] = gate; }
            }
            __syncthreads();
            }
            if (tid < NE) { int t2 = tid; asm volatile("" : "+v"(t2)); const int c = cnt_l[t2]; base_l[t2] = c > 0 ? atomicAdd(&cnt[t2], c) : 0; }
            __syncthreads();
            { const int e = asg_e[tid]; const size_t li = (size_t)e * M + base_l[e] + asg_pos[tid]; list[li] = (grp * 64 + (tid >> 3)) * 8 + (tid & 7); pmeta[li] = ((unsigned)((grp * 64 + (tid >> 3)) * NSLOT + (tid & 7)) << 14) | (unsigned)__float2int_rn(asg_g[tid] * 4096.f); }
        }
        if (BOTH(8)) xcd_barrier(bar);
        PH_END(8);
    }

    LAS int* plan = (LAS int*)(lds + PLAN_OFF);
#define MAKE_PLAN() do { __syncthreads(); if (tid <= NE) plan[80 + tid] = tid < NE ? (int)__hip_atomic_load((const int*)(ws + WS_CTL) + CW_CNT + tid, RLX_AGENT) : M; __syncthreads(); \
        if (tid == 0) { int off = 0; for (int e = 0; e <= NE; ++e) { plan[e] = off; off += (plan[80 + e] + 255) >> 8; } plan[NE + 1] = off; } __syncthreads(); } while (0)
    if (IN(9)) { PH_BEGIN();
        MAKE_PLAN();
        GroupedOrder<true> S; S.init(ws + WS_H2, ws + WS_WGU, D, 2, G, bx, plan, (const int*)(ws + WS_LIST), (size_t)512 * D * 2, (size_t)256 * D * 2, 0);
        EpiGU E{(bf16_t*)(ws + WS_U)};
        pg8::gemm_phase<EpiGU, GroupedOrder<true>, true, true>(lds + RING_OFF, D, S, E);
        STEAL_ITEMS(CW_Q2, (NE + 1) * I_D, ITEM_WD);
        if (BOTH(9)) xcd_barrier(bar);
        PH_END(9);
    }
    if (IN(10)) { PH_BEGIN(); MAKE_PLAN();
        GroupedOrder<false> S; S.init(ws + WS_U, ws + WS_WD, ED, 4, G, bx, plan, (const int*)(ws + WS_LIST), (size_t)D * ED * 2, (size_t)256 * ED * 2, 0);
        EpiDown E{(unsigned char*)(ws + WS_YC), (const unsigned*)(ws + WS_GLIST), ws + WS_DUMP + (size_t)bx * 8192};
        pg8::gemm_phase<EpiDown, GroupedOrder<false>, true, true, true>(lds + RING_OFF, ED, S, E);
        if (BOTH(10)) xcd_barrier(bar);
        PH_END(10);
    }
    if (IN(11)) { PH_BEGIN();
        typedef float f2 __attribute__((ext_vector_type(2)));
        const unsigned char* yc = (const unsigned char*)(ws + WS_YC);
        const int c0 = (lane >> 4) * 256 + ((lane >> 2) & 3) * 32 + (lane & 3) * 8;
        for (int m = gw; m < M; m += NGW) { const int b = m / SEQ;
            float s[16];
#pragma unroll
            for (int j = 0; j < 16; ++j) s[j] = 0.f;
#pragma unroll
            for (int k = 0; k < NSLOT; ++k) { const v4u raw = *(const v4u*)(yc + ((size_t)m * NSLOT + k) * 1024 + lane * 16); const unsigned w4[4] = {raw.x, raw.y, raw.z, raw.w};
#pragma unroll
                for (int q = 0; q < 4; ++q) { const f2 lo = __builtin_amdgcn_cvt_pk_f32_fp8((int)w4[q], false), hi = __builtin_amdgcn_cvt_pk_f32_fp8((int)w4[q], true);
                    s[4 * q] += lo.x; s[4 * q + 1] += lo.y; s[4 * q + 2] += hi.x; s[4 * q + 3] += hi.y; } }
            float* xo = p.out + (size_t)m * D; const float* g2 = modv + b * 6 * D + 5 * D;
            f32x4 xv[4]; float ss = 0.f;
#pragma unroll
            for (int q = 0; q < 4; ++q) { const int c = c0 + (q >> 1) * 128 + (q & 1) * 4; const f32x4 gv = *(const f32x4*)(g2 + c) * (1.f / YC_SCALE);
                xv[q] = *(const f32x4*)(xo + c) + gv * (f32x4){s[4 * q], s[4 * q + 1], s[4 * q + 2], s[4 * q + 3]};
                ss += (xv[q].x * xv[q].x + xv[q].y * xv[q].y) + (xv[q].z * xv[q].z + xv[q].w * xv[q].w); }
            const float rstd = rsqrtf(wave_sum(ss) * (1.f / D) + EPS);
#pragma unroll
            for (int q = 0; q < 4; ++q) { const int c = c0 + (q >> 1) * 128 + (q & 1) * 4; *(f32x4*)(xo + c) = xv[q] * rstd * *(const f32x4*)(p.final_g + c); }
        }
        PH_END(11);
    }
#undef IN
#undef BOTH
}

extern "C" void kernel_launch(void* const* d_in, const int* in_sizes, int n_in, void* d_out, int out_size, void* d_ws, size_t ws_size, hipStream_t stream) {
    static int grid = 0;
    if (grid == 0) {
        int dev = 0, cus = 0;
        if (hipGetDevice(&dev) != hipSuccess || hipDeviceGetAttribute(&cus, hipDeviceAttributeMultiprocessorCount, dev) != hipSuccess) { fprintf(stderr, "device query failed\n"); grid = -1; return; }
        if (hipFuncSetAttribute((const void*)mega, hipFuncAttributeMaxDynamicSharedMemorySize, LDS_BYTES) != hipSuccess) { fprintf(stderr, "hipFuncSetAttribute failed\n"); grid = -1; return; }
        int per_cu = 0;
        if (hipOccupancyMaxActiveBlocksPerMultiprocessor(&per_cu, (const void*)mega, NWAVES * 64, LDS_BYTES) != hipSuccess || per_cu < 1) fprintf(stderr, "occupancy query: %d\n", per_cu);
        (void)hipGetLastError();
        grid = cus;
        if (ws_size < WS_END) fprintf(stderr, "ws too small: %zu < %zu\n", ws_size, (size_t)WS_END);
    }
    if (grid < 0) return;
    P p{};
    const float** f = (const float**)&p;
    for (int i = 0; i < 26; ++i) f[i] = (const float*)d_in[i];
    p.out = (float*)d_out; p.ws = (unsigned char*)d_ws;
    (void)hipMemsetAsync(p.ws + WS_CTL, 0, CTL_BYTES, stream);
    p.ph_lo = 0; p.ph_hi = NPHASE; p.li = 0;
    hipLaunchKernelGGL(mega, dim3(grid), dim3(NWAVES * 64), LDS_BYTES, stream, p);
}
```

```cpp
#include <hip/hip_runtime.h>
#include <stdint.h>
#include <stdio.h>

typedef unsigned short bf16_t;

constexpr int D = 1024, BATCH = 4, SEQ = 4096, M = BATCH * SEQ;
constexpr int D_SSM = 1024, SSM_HEADS = 16, SSM_GROUPS = 4, D_STATE = 128, CONV_K = 4, CONV_CH = 2048, CHUNK = 128, NCHUNK = SEQ / CHUNK;
constexpr int HD = 64, ATT_HEADS = 16, KV_HEADS = 4, D_KV = 256, WINDOW = 128;
constexpr int IN_COLS = 4624;
constexpr int C_Z = 0, C_XBC = 1024, C_DT = 3072, C_Q = 3088, C_K = 4112, C_V = 4368;
constexpr int NE = 64, TOPK = 8, ED = 256;
constexpr float EPS = 1e-6f;
constexpr int NSLOT = 9;
constexpr int ZQ_Q = 0, ZQ_Z = 1024;
constexpr int NWIN = 4864;

constexpr size_t MiB = 1u << 20;
constexpr size_t WS_CTL = 0;
constexpr size_t CTL_BYTES = 64 * 1024;
constexpr int CW_CNT = 0;
constexpr int CW_Q1 = 128, CW_Q2 = 192;
constexpr int CW_BAR = 4096;
constexpr size_t WS_MOD = 1 * MiB;
constexpr size_t WS_DUMP = 2 * MiB;
constexpr size_t WS_RWF = 1 * MiB + 256 * 1024;
constexpr size_t WS_LIST = 4 * MiB;
constexpr size_t WS_WIN_T = 8 * MiB;
constexpr size_t WS_WOUT_T = 18 * MiB;
constexpr size_t WS_SSQ = 22 * MiB;
constexpr size_t WS_RATT = 23 * MiB;
constexpr size_t WS_ZQ = 24 * MiB;
constexpr size_t WS_XBC = 88 * MiB;
constexpr size_t WS_K = 152 * MiB;
constexpr size_t WS_V = 160 * MiB;
constexpr size_t WS_DT = 168 * MiB;
constexpr size_t WS_CS = 169 * MiB;
constexpr size_t WS_ST = 170 * MiB;
constexpr size_t WS_H2 = 170 * MiB;
constexpr size_t WS_WGU = 202 * MiB;
constexpr size_t WS_YC = 104 * MiB;
constexpr size_t WS_U = 24 * MiB;
constexpr size_t WS_WD = 267 * MiB;
constexpr size_t WS_GLIST = 300 * MiB;
constexpr size_t WS_END = 304 * MiB;
constexpr int UROWS_MAX = 163840;

__device__ __forceinline__ float bf2f(bf16_t v) { return __uint_as_float(((unsigned)v) << 16); }
__device__ __forceinline__ bf16_t f2bf(float f) { unsigned u = __float_as_uint(f); return (bf16_t)((u + 0x7fffu + ((u >> 16) & 1u)) >> 16); }
__device__ __forceinline__ unsigned pk2(float lo, float hi) { return (unsigned)f2bf(lo) | ((unsigned)f2bf(hi) << 16); }
__device__ __forceinline__ float silu_f(float x) { return x * __builtin_amdgcn_rcpf(1.f + __expf(-x)); }
__device__ __forceinline__ float softplus_f(float x) { return x > 20.f ? x : log1pf(__expf(x)); }

__constant__ int c_bucket[128] = {0, 1, 2, 3, 4, 5, 6, 7, 8, 9, 10, 11, 12, 13, 14, 15, 16, 16, 16, 17, 17, 18, 18, 18, 19, 19, 19, 20, 20, 20, 20, 21, 21, 21, 21, 22, 22, 22, 22, 22, 23, 23, 23, 23, 23, 23, 24, 24, 24, 24, 24, 24, 25, 25, 25, 25, 25, 25, 25, 26, 26, 26, 26, 26, 26, 26, 26, 27, 27, 27, 27, 27, 27, 27, 27, 27, 27, 28, 28, 28, 28, 28, 28, 28, 28, 28, 28, 29, 29, 29, 29, 29, 29, 29, 29, 29, 29, 29, 29, 30, 30, 30, 30, 30, 30, 30, 30, 30, 30, 30, 30, 30, 30, 31, 31, 31, 31, 31, 31, 31, 31, 31, 31, 31, 31, 31, 31, 31};

struct P {
    const float *x, *c, *mod_w, *mod_b, *norm1_g, *norm2_g, *w_in, *conv_w, *conv_b, *dt_bias, *a_log, *d_skip, *ssm_norm_g, *att_norm_g, *sinks, *rel_bias,
        *w_out, *router_w, *router_bias, *exp_w_gate, *exp_w_up, *exp_w_down, *sh_w_gate, *sh_w_up, *sh_w_down, *final_g;
    float* out; unsigned char* ws;
    int ph_lo, ph_hi, li, pad;
};

#ifdef PROBE_SUB
#define SUB_T() __builtin_amdgcn_s_memrealtime()
#define SUB_END(id, t0) do { if ((PROBE_SUB >> (id)) & 1u) { const unsigned long long _st1 = __builtin_amdgcn_s_memrealtime(); while (__builtin_amdgcn_s_memrealtime() < _st1 + (_st1 - (t0))) __builtin_amdgcn_s_sleep(4); } } while (0)
#else
#define SUB_T() 0ull
#define SUB_END(id, t0) do {} while (0)
#endif
namespace pg8 {
#define PG8_LAS __attribute__((address_space(3)))
typedef short bf16x8 __attribute__((ext_vector_type(8)));
typedef float f32x4 __attribute__((ext_vector_type(4)));
typedef unsigned u32x4 __attribute__((ext_vector_type(4)));
constexpr int BM = 256, BK = 64, HALF = 128, HTB = HALF * BK * 2  , STAGE_BYTES = 8 * HTB, NXCD = 8, WGM = 8;

__host__ __device__ __forceinline__ int lds_byte(int r, int c) { const int st = (r >> 4) * 2 + (c >> 5), rr = r & 15, cc = c & 31, ob = rr * 64 + cc * 2; return st * 1024 + (ob ^ (((ob >> 9) & 1) << 5)); }
__host__ __device__ __forceinline__ void stage_rc(int b, int& R, int& C) { const int st = b / 1024, sb = b % 1024, swz = sb ^ (((sb >> 9) & 1) << 5); R = (st >> 1) * 16 + swz / 64; C = (st & 1) * 32 + (swz % 64) / 2; }
__host__ __device__ __forceinline__ int perm32(int rho) { const int n = rho >> 4, i = rho & 15; return 8 * (i >> 2) + 4 * n + (i & 3); }

struct Unit { int pm, pn, e, nrows, lt; };

__device__ __forceinline__ unsigned cvt_pk_bf16(float lo, float hi) { unsigned r; asm volatile("v_cvt_pk_bf16_f32 %0, %1, %2" : "=v"(r) : "v"(lo), "v"(hi)); return r; }

struct DenseOrder {
    typedef pg8::Unit Unit;
    const char* A; const char* Bt; int K; int nM, nN, nwg, G, c;
    __device__ __forceinline__ void init(const void* A_, const void* Bt_, int M_, int N_, int K_, int G_, int c_) { A = (const char*)A_; Bt = (const char*)Bt_; K = K_; nM = M_ / BM; nN = N_ / BM; nwg = nM * nN; G = G_; c = c_; }
    __device__ __forceinline__ bool next(int i, Unit& u) const {
        const long L = (long)i * G + c; if (L >= nwg) return false;
        int wgid = (int)L; { const int q = nwg / NXCD, r = nwg % NXCD, xcd = wgid % NXCD, off = wgid / NXCD; wgid = (xcd < r ? xcd * (q + 1) : r * (q + 1) + (xcd - r) * q) + off; }
        const int nig = WGM * nN, gid = wgid / nig, fm = gid * WGM, gsz = (nM - fm) < WGM ? (nM - fm) : WGM;
        u.pm = fm + ((wgid % nig) % gsz); u.pn = (wgid % nig) / gsz; u.e = 0; u.nrows = 256; u.lt = 0; return true;
    }
    __device__ __forceinline__ const char* a_base(const Unit& u) const { return A + (size_t)u.pm * 512 * K; }
    __device__ __forceinline__ const char* b_base(const Unit& u) const { return Bt + (size_t)u.pn * 512 * K; }
    __device__ __forceinline__ void lane_off(const Unit&, const int (&R)[2], const int (&C)[2], unsigned (&o)[2][2]) const {
#pragma unroll
        for (int h = 0; h < 2; ++h)
#pragma unroll
            for (int i = 0; i < 2; ++i) o[h][i] = (unsigned)(((h * HALF + R[i]) * K + C[i]) * 2);
    }
    __device__ __forceinline__ void a_ready(const Unit&) const {}
    __device__ __forceinline__ void done(const Unit&) const {}
};

template <class Epi, class Sched, bool ALIGN_EPI = false, bool SP2 = false, bool ALLOW = false>
__device__ __forceinline__ void gemm_phase(PG8_LAS unsigned char* lds, const int K, const Sched& S, const Epi& E) {
    typedef typename Sched::Unit Unit;
    const int tid = threadIdx.x, wid = __builtin_amdgcn_readfirstlane(tid >> 6), lane = tid & 63, wr = wid >> 2, wc = wid & 3, fr = lane & 15, fq = lane >> 4;
    const int nt = K / BK;
    unsigned voffB[2]; int stR[2], stC[2];
#pragma unroll
    for (int i = 0; i < 2; ++i) { int R, C; stage_rc(tid * 16 + i * 8192, R, C); const int Rb = Epi::PERM ? ((R & ~31) + perm32(R & 31)) : R;
        stR[i] = R; stC[i] = C; voffB[i] = (unsigned)(Rb * K + C) * 2u; }
    const size_t kstep = (size_t)(BK * 2);
    const size_t hstep = (size_t)HALF * K * 2;
    const size_t tstep = 2 * hstep;
    const unsigned ldsw = (unsigned)wid * 1024u;
    const int aoff = lds_byte(wr * 64 + fr, fq * 8), boff = lds_byte(wc * 32 + fr, fq * 8);
#define PG8_SA(b, h) (((b) * 2 + (h)) * HTB)
#define PG8_SB(b, h) ((4 + (b) * 2 + (h)) * HTB)
#define PG8_STAGE(bufoff, gbase, voff) do { _Pragma("unroll") for (int _i = 0; _i < 2; ++_i) \
        __builtin_amdgcn_global_load_lds((const unsigned*)((const char*)(gbase) + (voff)[_i]), (PG8_LAS unsigned*)(lds + (bufoff) + ldsw + _i * 8192), 16, 0, 0); } while (0)
#define PG8_LDA(dst, b, h) do { _Pragma("unroll") for (int m = 0; m < 4; ++m) _Pragma("unroll") for (int k = 0; k < 2; ++k) dst[m][k] = *(const PG8_LAS bf16x8*)(lds + PG8_SA(b, h) + aoff + m * 2048 + k * 1024); } while (0)
#define PG8_LDB(dst, b, h) do { _Pragma("unroll") for (int n = 0; n < 2; ++n) _Pragma("unroll") for (int k = 0; k < 2; ++k) dst[n][k] = *(const PG8_LAS bf16x8*)(lds + PG8_SB(b, h) + boff + n * 2048 + k * 1024); } while (0)
#define PG8_MMA(ai, bj, At, Bt) do { __builtin_amdgcn_s_setprio(1); _Pragma("unroll") for (int m = 0; m < 4; ++m) _Pragma("unroll") for (int n = 0; n < 2; ++n) _Pragma("unroll") for (int k = 0; k < 2; ++k) \
        acc[ai][bj][m][n] = __builtin_amdgcn_mfma_f32_16x16x32_bf16(Bt[n][k], At[m][k], acc[ai][bj][m][n], 0, 0, 0); __builtin_amdgcn_s_setprio(0); } while (0)
#define PG8_WAIT_V(n) asm volatile("s_waitcnt vmcnt(" #n ")" ::: "memory")
#define PG8_WAIT_L(n) asm volatile("s_waitcnt lgkmcnt(" #n ")" ::: "memory")
#define PG8_WAIT_VA() do { if (ALLOW && t == 0 && ns_pending >= 8) { if (ns_pending >= 16) PG8_WAIT_V(24); else PG8_WAIT_V(16); } else PG8_WAIT_V(8); } while (0)
#define PG8_BAR __builtin_amdgcn_s_barrier()
#define PG8_SCHED __builtin_amdgcn_sched_barrier(0)
    Unit cur, nxt; int ui = 0; int ns_pending = 0; typename Epi::State est;
    if (!S.next(0, cur)) return;
    f32x4 acc[2][2][4][2];
#pragma unroll
    for (int a = 0; a < 2; ++a)
#pragma unroll
        for (int b = 0; b < 2; ++b)
#pragma unroll
            for (int m = 0; m < 4; ++m)
#pragma unroll
                for (int n = 0; n < 2; ++n) acc[a][b][m][n] = (f32x4){0.f, 0.f, 0.f, 0.f};
    bf16x8 At[4][2], B0[2][2], B1[2][2];
    const char* cA = S.a_base(cur); const char* cB = S.b_base(cur);
    unsigned oc[2][2], on[2][2];
    S.lane_off(cur, stR, stC, oc);
    S.a_ready(cur);
    if constexpr (SP2) {
        PG8_STAGE(PG8_SB(0, 0), cB, voffB); PG8_STAGE(PG8_SB(0, 1), cB + hstep, voffB); PG8_STAGE(PG8_SA(0, 0), cA, oc[0]); PG8_STAGE(PG8_SA(0, 1), cA, oc[1]);
        if (wr == 1) PG8_BAR;
        PG8_WAIT_V(2); PG8_BAR;
        PG8_STAGE(PG8_SB(1, 0), cB + kstep, voffB); PG8_STAGE(PG8_SA(1, 0), cA + kstep, oc[0]); PG8_STAGE(PG8_SB(1, 1), cB + hstep + kstep, voffB);
        PG8_WAIT_V(6); PG8_BAR;
    } else {
        PG8_STAGE(PG8_SB(0, 0), cB, voffB); PG8_STAGE(PG8_SA(0, 0), cA, oc[0]); PG8_STAGE(PG8_SB(0, 1), cB + hstep, voffB); PG8_STAGE(PG8_SA(0, 1), cA, oc[1]);
        if (wr == 1) PG8_BAR;
        PG8_WAIT_V(4); PG8_BAR;
        PG8_STAGE(PG8_SB(1, 0), cB + kstep, voffB); PG8_STAGE(PG8_SA(1, 0), cA + kstep, oc[0]); PG8_STAGE(PG8_SB(1, 1), cB + hstep + kstep, voffB);
        PG8_WAIT_V(6); PG8_BAR;
    }
    for (;;) {
        const bool has_next = S.next(ui + 1, nxt);
        E.pre(cur, wr, wc, fr, fq, est);
        const char* nA = has_next ? S.a_base(nxt) : cA; const char* nB = has_next ? S.b_base(nxt) : cB;
        if (has_next) S.lane_off(nxt, stR, stC, on); else {
#pragma unroll
            for (int h = 0; h < 2; ++h)
#pragma unroll
                for (int i = 0; i < 2; ++i) on[h][i] = oc[h][i]; }
        const unsigned long long _gs0 = SUB_T();
        asm volatile(".p2align 8" ::: "memory");
#pragma unroll 1
        for (int t = 0; t < nt; t += 2) {
            const bool last = (t == nt - 2);
            const char* a1 = cA + (size_t)(t + 1) * kstep;
            const char* a2 = last ? nA : cA + (size_t)(t + 2) * kstep; const char* b2 = last ? nB : cB + (size_t)(t + 2) * kstep;
            const char* a3 = a2 + kstep; const char* b3 = b2 + kstep;
            unsigned o2[2][2];
#pragma unroll
            for (int h = 0; h < 2; ++h)
#pragma unroll
                for (int i = 0; i < 2; ++i) o2[h][i] = last ? on[h][i] : oc[h][i];
            if (last && has_next) S.a_ready(nxt);
            if constexpr (Epi::MIDSCALE) { if (t == nt / 2) E.mid(acc, cur, wr, fr); }
            if constexpr (SP2) {
            PG8_LDB(B0, 0, 0); PG8_LDB(B1, 0, 1); PG8_SCHED; PG8_LDA(At, 0, 0); PG8_STAGE(PG8_SA(1, 1), a1, oc[1]);
            PG8_WAIT_VA(); PG8_WAIT_L(0); PG8_BAR; PG8_MMA(0, 0, At, B0); PG8_MMA(0, 1, At, B1); PG8_BAR; PG8_SCHED;
            PG8_LDA(At, 0, 1); PG8_STAGE(PG8_SB(0, 0), b2, voffB); PG8_STAGE(PG8_SB(0, 1), b2 + hstep, voffB); PG8_STAGE(PG8_SA(0, 0), a2, o2[0]);
            PG8_WAIT_VA(); PG8_WAIT_L(0); PG8_BAR; PG8_MMA(1, 0, At, B0); PG8_MMA(1, 1, At, B1); PG8_BAR; PG8_SCHED;
            PG8_LDB(B0, 1, 0); PG8_LDB(B1, 1, 1); PG8_SCHED; PG8_LDA(At, 1, 0); PG8_STAGE(PG8_SA(0, 1), a2, o2[1]);
            PG8_WAIT_V(8); PG8_WAIT_L(0); PG8_BAR; PG8_MMA(0, 0, At, B0); PG8_MMA(0, 1, At, B1); PG8_BAR; PG8_SCHED;
            PG8_LDA(At, 1, 1); PG8_STAGE(PG8_SB(1, 0), b3, voffB); PG8_STAGE(PG8_SB(1, 1), b3 + hstep, voffB); PG8_STAGE(PG8_SA(1, 0), a3, o2[0]);
            PG8_WAIT_V(8); PG8_WAIT_L(0); PG8_BAR; PG8_MMA(1, 0, At, B0); PG8_MMA(1, 1, At, B1); PG8_BAR; PG8_SCHED;
            } else {
            PG8_LDB(B0, 0, 0); PG8_SCHED; PG8_LDA(At, 0, 0); PG8_STAGE(PG8_SA(1, 1), a1, oc[1]);
            PG8_WAIT_L(8); PG8_BAR; PG8_WAIT_L(0); PG8_MMA(0, 0, At, B0); PG8_BAR; PG8_SCHED;
            PG8_LDB(B1, 0, 1); PG8_STAGE(PG8_SB(0, 0), b2, voffB);
            PG8_BAR; PG8_WAIT_L(0); PG8_MMA(0, 1, At, B1); PG8_BAR;
            PG8_LDA(At, 0, 1); PG8_STAGE(PG8_SA(0, 0), a2, o2[0]);
            PG8_BAR; PG8_WAIT_L(0); PG8_MMA(1, 0, At, B0); PG8_BAR; PG8_SCHED;
            PG8_STAGE(PG8_SB(0, 1), b2 + hstep, voffB);
            PG8_WAIT_V(6); PG8_BAR; PG8_MMA(1, 1, At, B1); PG8_BAR;
            PG8_LDB(B0, 1, 0); PG8_SCHED; PG8_LDA(At, 1, 0); PG8_STAGE(PG8_SA(0, 1), a2, o2[1]);
            PG8_WAIT_L(8); PG8_BAR; PG8_WAIT_L(0); PG8_MMA(0, 0, At, B0); PG8_BAR; PG8_SCHED;
            PG8_LDB(B1, 1, 1); PG8_STAGE(PG8_SB(1, 0), b3, voffB);
            PG8_BAR; PG8_WAIT_L(0); PG8_MMA(0, 1, At, B1); PG8_BAR;
            PG8_LDA(At, 1, 1); PG8_STAGE(PG8_SA(1, 0), a3, o2[0]);
            PG8_BAR; PG8_WAIT_L(0); PG8_MMA(1, 0, At, B0); PG8_BAR; PG8_SCHED;
            PG8_STAGE(PG8_SB(1, 1), b3 + hstep, voffB);
            PG8_WAIT_V(6); PG8_BAR; PG8_MMA(1, 1, At, B1); PG8_BAR;
            }
        }
        if constexpr (Epi::PROBE_TAG == 1) { SUB_END(0, _gs0); }
        const unsigned long long _gs1 = SUB_T();
        if constexpr (ALIGN_EPI) { if (wr == 0) PG8_BAR; }
        if constexpr (!Epi::AFTER_DRAIN) { E(acc, cur, wr, wc, fr, fq, est); S.done(cur); ns_pending = E.nstore(cur); }
        if constexpr (Epi::PROBE_TAG == 1) { SUB_END(1, _gs1); }
        if (!has_next) break;
#pragma unroll
        for (int a = 0; a < 2; ++a)
#pragma unroll
            for (int b = 0; b < 2; ++b)
#pragma unroll
                for (int m = 0; m < 4; ++m)
#pragma unroll
                    for (int n = 0; n < 2; ++n) acc[a][b][m][n] = (f32x4){0.f, 0.f, 0.f, 0.f};
        cur = nxt; cA = nA; cB = nB; ++ui;
#pragma unroll
        for (int h = 0; h < 2; ++h)
#pragma unroll
            for (int i = 0; i < 2; ++i) oc[h][i] = on[h][i];
        if constexpr (ALIGN_EPI) { if (wr == 1) PG8_BAR; }
    }
    PG8_WAIT_V(0);
    if constexpr (!ALIGN_EPI) { if (wr == 0) PG8_BAR; }
    PG8_BAR;
    if constexpr (Epi::AFTER_DRAIN) { E.fused(acc, cur, wr, wc, fr, fq, lds, wid, lane); S.done(cur); }
#undef PG8_SA
#undef PG8_SB
#undef PG8_STAGE
#undef PG8_LDA
#undef PG8_LDB
#undef PG8_MMA
#undef PG8_WAIT_V
#undef PG8_WAIT_L
#undef PG8_WAIT_VA
#undef PG8_BAR
#undef PG8_SCHED
}
}

#define GAS __attribute__((address_space(1)))
#define LAS __attribute__((address_space(3)))
typedef unsigned v4u __attribute__((ext_vector_type(4)));
typedef float f32x4 __attribute__((ext_vector_type(4)));
typedef GAS unsigned gu32;
#define RLX_AGENT __ATOMIC_RELAXED, __HIP_MEMORY_SCOPE_AGENT
#define LDS_WAIT() asm volatile("s_waitcnt lgkmcnt(0)" ::: "memory")
#define VM_WAIT() asm volatile("s_waitcnt vmcnt(0)" ::: "memory")
constexpr int NWAVES = 8;
constexpr int RING_OFF = 0, RING_BYTES = 131072;
constexpr int LDS_BYTES = 163840;
constexpr int LDSCTL_OFF = LDS_BYTES - 4096, MISC_OFF = LDSCTL_OFF + 320;
constexpr int PLAN_OFF = LDSCTL_OFF + 1024;

#define XB_TMO      128
#define XB_XCNT(j)  (256  + 64 * (j))
#define XB_XSUB(j)  (1280 + 64 * (j))
#define XB_XGEN(j)  (2304 + 64 * (j))
#define XB_TOP      3328
#define XB_TOPGEN   3392
#define XCD_BAR_WORDS 3456
#define XB_SPIN_CAP (1u << 18)

__device__ __forceinline__ unsigned xb_ld(unsigned* p)              { return __hip_atomic_load(p, __ATOMIC_RELAXED, __HIP_MEMORY_SCOPE_AGENT); }
__device__ __forceinline__ unsigned xb_add(unsigned* p, unsigned v) { return __hip_atomic_fetch_add(p, v, __ATOMIC_RELAXED, __HIP_MEMORY_SCOPE_AGENT); }
__device__ __forceinline__ unsigned xb_xcc_id() { return (unsigned)__builtin_amdgcn_s_getreg((3 << 11) | 20) & 0xFu; }
#define XB_SPIN(cond, bar) do { unsigned _sp = 0; while (cond) { __builtin_amdgcn_s_sleep(1); \
    if ((++_sp & 255u) == 0u) { if (xb_ld(&(bar)[XB_TMO])) break; if (_sp > XB_SPIN_CAP) { atomicAdd(&(bar)[XB_TMO], 1u); break; } } } } while (0)

struct XcdBarrier {
    unsigned* bar; unsigned x;
    volatile LAS unsigned* st;
};

__device__ __forceinline__ XcdBarrier xcd_barrier_post(unsigned* bar, volatile LAS unsigned* st) {
    XcdBarrier b; b.bar = bar; b.x = xb_xcc_id(); b.st = st;
    if (threadIdx.x == 0) (void)xb_add(&bar[XB_XCNT(b.x)], 1u);
    return b;
}
__device__ __forceinline__ void xcd_barrier_complete(unsigned* bar, unsigned x, unsigned& nloc, unsigned& nx) {
    const unsigned G = gridDim.x * gridDim.y * gridDim.z;
    unsigned sum, cnt, mine, sp = 0u;
    for (;;) {
        sum = 0u; cnt = 0u; mine = 0u;
#pragma unroll
        for (unsigned j = 0; j < 16; ++j) { const unsigned c = xb_ld(&bar[XB_XCNT(j)]); sum += c; cnt += (c > 0u) ? 1u : 0u; mine = (j == x) ? c : mine; }
        if (sum == G) break;
        __builtin_amdgcn_s_sleep(1);
        if ((++sp & 255u) == 0u) { if (xb_ld(&bar[XB_TMO])) break; if (sp > XB_SPIN_CAP) { atomicAdd(&bar[XB_TMO], 1u); break; } }
    }
    nloc = mine > 0u ? mine : 1u; nx = cnt > 0u ? cnt : 1u;
}

__device__ __forceinline__ void xcd_barrier(const XcdBarrier& b) {
    asm volatile("s_waitcnt vmcnt(0)" ::: "memory");
    __syncthreads();
    if (threadIdx.x == 0) {
        unsigned* bar = b.bar;
        __builtin_amdgcn_s_waitcnt(0);
        unsigned nloc = b.st[0], nx = b.st[1];
        if (nloc == 0u) { xcd_barrier_complete(bar, b.x, nloc, nx); b.st[0] = nloc; b.st[1] = nx; }
        const unsigned old = xb_add(&bar[XB_XSUB(b.x)], 1u);
        const unsigned gen = old / nloc;
        if (old + 1u == (gen + 1u) * nloc) {
            __builtin_amdgcn_fence(__ATOMIC_RELEASE, "agent");
            asm volatile("s_waitcnt vmcnt(0)" ::: "memory");
            const unsigned og = xb_add(&bar[XB_TOP], 1u);
            const unsigned tg = og / nx;
            if (og + 1u == (tg + 1u) * nx) xb_add(&bar[XB_TOPGEN], 1u);
            else XB_SPIN(xb_ld(&bar[XB_TOPGEN]) == tg, bar);
            __builtin_amdgcn_fence(__ATOMIC_ACQUIRE, "agent");
            xb_add(&bar[XB_XGEN(b.x)], 1u);
            asm volatile("s_waitcnt vmcnt(0)" ::: "memory");
        } else {
            XB_SPIN(xb_ld(&bar[XB_XGEN(b.x)]) == gen, bar);
            __builtin_amdgcn_fence(__ATOMIC_ACQUIRE, "agent");
            asm volatile("s_waitcnt vmcnt(0)" ::: "memory");
        }
    }
    __syncthreads();
}

__device__ __forceinline__ float wave_sum(float v) {
#pragma unroll
    for (int o = 1; o < 64; o <<= 1) v += __shfl_xor(v, o);
    return v;
}

struct EpiIn { static constexpr int PROBE_TAG = 0; static constexpr bool MIDSCALE = false; struct State {}; __device__ __forceinline__ void pre(const pg8::Unit&, int, int, int, int, State&) const {}
    static constexpr bool PERM = true, AFTER_DRAIN = false;
    __device__ __forceinline__ int nstore(const pg8::Unit& u) const { return u.pn == 18 ? 0 : 16; }
    bf16_t *zq, *xbc, *kk, *vv; float* dt;
    __device__ __forceinline__ void operator()(const pg8::f32x4 (&acc)[2][2][4][2], const pg8::Unit& u, int wr, int wc, int fr, int fq, const State&) const {
        const int row0 = u.pm * 256 + wr * 64 + fr, pn = u.pn;
        if (pn == 18) {
            if (wc == 0 && fq < 2) {
#pragma unroll
                for (int ai = 0; ai < 2; ++ai)
#pragma unroll
                    for (int m = 0; m < 4; ++m) { float* o = dt + (size_t)(row0 + ai * 128 + m * 16) * 16 + 8 * fq; *(pg8::f32x4*)o = acc[ai][0][m][0]; *(pg8::f32x4*)(o + 4) = acc[ai][0][m][1]; }
            }
            return;
        }
        bf16_t* base; int ldc, colt;
        if (pn < 4) { base = zq; ldc = 2048; colt = ZQ_Z + pn * 256; }
        else if (pn < 12) { base = xbc; ldc = 2048; colt = (pn - 4) * 256; }
        else if (pn < 16) { base = zq; ldc = 2048; colt = ZQ_Q + (pn - 12) * 256; }
        else if (pn == 16) { base = kk; ldc = 256; colt = 0; }
        else { base = vv; ldc = 256; colt = 0; }
        const int col0 = colt + wc * 32 + 8 * fq;
#pragma unroll
        for (int ai = 0; ai < 2; ++ai)
#pragma unroll
            for (int m = 0; m < 4; ++m) { bf16_t* rowp = base + (size_t)(row0 + ai * 128 + m * 16) * ldc + col0;
#pragma unroll
                for (int bj = 0; bj < 2; ++bj) { const pg8::f32x4 v0 = acc[ai][bj][m][0], v1 = acc[ai][bj][m][1];
                    pg8::u32x4 w; w.x = pg8::cvt_pk_bf16(v0[0], v0[1]); w.y = pg8::cvt_pk_bf16(v0[2], v0[3]); w.z = pg8::cvt_pk_bf16(v1[0], v1[1]); w.w = pg8::cvt_pk_bf16(v1[2], v1[3]);
                    *(pg8::u32x4*)(rowp + bj * 128) = w; } }
    }
};

struct EpiOut { static constexpr int PROBE_TAG = 0; static constexpr bool MIDSCALE = true; struct State {}; __device__ __forceinline__ void pre(const pg8::Unit&, int, int, int, int, State&) const {}
    static constexpr bool PERM = true, AFTER_DRAIN = false;
    __device__ __forceinline__ int nstore(const pg8::Unit&) const { return 16; }
    const float* x; float* x1; const float* mod; const float* ratt;
    __device__ __forceinline__ void mid(pg8::f32x4 (&acc)[2][2][4][2], const pg8::Unit& u, int wr, int fr) const {
        float rs[2][4];
#pragma unroll
        for (int ai = 0; ai < 2; ++ai)
#pragma unroll
            for (int m = 0; m < 4; ++m) rs[ai][m] = ratt[u.pm * 256 + ai * 128 + wr * 64 + m * 16 + fr];
#pragma unroll
        for (int ai = 0; ai < 2; ++ai)
#pragma unroll
            for (int bj = 0; bj < 2; ++bj)
#pragma unroll
                for (int m = 0; m < 4; ++m)
#pragma unroll
                    for (int n = 0; n < 2; ++n) acc[ai][bj][m][n] = acc[ai][bj][m][n] * rs[ai][m];
    }
    __device__ __forceinline__ void operator()(const pg8::f32x4 (&acc)[2][2][4][2], const pg8::Unit& u, int wr, int wc, int fr, int fq, const State&) const {
        const int row0 = u.pm * 256 + wr * 64 + fr, col0 = u.pn * 256 + wc * 32 + 8 * fq, b = (u.pm * 256) / SEQ;
        const float* g1 = mod + b * 6 * D + 2 * D + col0;
        pg8::f32x4 gv[2][2];
#pragma unroll
        for (int bj = 0; bj < 2; ++bj) { gv[bj][0] = *(const pg8::f32x4*)(g1 + bj * 128); gv[bj][1] = *(const pg8::f32x4*)(g1 + bj * 128 + 4); }
#pragma unroll
        for (int ai = 0; ai < 2; ++ai)
#pragma unroll
            for (int m = 0; m < 4; ++m) { const size_t off = (size_t)(row0 + ai * 128 + m * 16) * D + col0;
#pragma unroll
                for (int bj = 0; bj < 2; ++bj) { const float* xi = x + off + bj * 128; float* xo = x1 + off + bj * 128;
                    *(pg8::f32x4*)xo = *(const pg8::f32x4*)xi + gv[bj][0] * acc[ai][bj][m][0]; *(pg8::f32x4*)(xo + 4) = *(const pg8::f32x4*)(xi + 4) + gv[bj][1] * acc[ai][bj][m][1]; } }
    }
};
struct EpiGU { static constexpr int PROBE_TAG = 0; static constexpr bool MIDSCALE = false; struct State {}; __device__ __forceinline__ void pre(const pg8::Unit&, int, int, int, int, State&) const {}
    static constexpr bool PERM = true, AFTER_DRAIN = false;
    __device__ __forceinline__ int nstore(const pg8::Unit&) const { return 8; }
    bf16_t* u;
    __device__ __forceinline__ void operator()(const pg8::f32x4 (&acc)[2][2][4][2], const pg8::Unit& un, int wr, int wc, int fr, int fq, const State&) const {
        const int row0 = un.pm * 256 + wr * 64 + fr, col0 = un.pn * 128 + wc * 32 + 8 * fq;
#pragma unroll
        for (int ai = 0; ai < 2; ++ai)
#pragma unroll
            for (int m = 0; m < 4; ++m) { bf16_t* rowp = u + (size_t)(row0 + ai * 128 + m * 16) * ED + col0;
                float o[8];
#pragma unroll
                for (int n = 0; n < 2; ++n)
#pragma unroll
                    for (int j = 0; j < 4; ++j) o[4 * n + j] = silu_f(acc[ai][0][m][n][j]) * acc[ai][1][m][n][j];
                pg8::u32x4 w; w.x = pg8::cvt_pk_bf16(o[0], o[1]); w.y = pg8::cvt_pk_bf16(o[2], o[3]); w.z = pg8::cvt_pk_bf16(o[4], o[5]); w.w = pg8::cvt_pk_bf16(o[6], o[7]);
                *(pg8::u32x4*)rowp = w; }
    }
};
constexpr float YC_SCALE = 16.f;
struct EpiDown {
    static constexpr bool PERM = true, AFTER_DRAIN = false;
    static constexpr int PROBE_TAG = 1; static constexpr bool MIDSCALE = false; struct State { unsigned pm[8]; };
    unsigned char* yc; const unsigned* pmeta; unsigned char* dump;
    __device__ __forceinline__ int nstore(const pg8::Unit&) const { return 8; }
    __device__ __forceinline__ void pre(const pg8::Unit& u, int wr, int wc, int fr, int fq, State& st) const {
        if (u.e < NE) { const unsigned* lp = pmeta + (size_t)u.e * M + u.lt * 256;
#pragma unroll
            for (int i = 0; i < 8; ++i) { const int r = (i >> 2) * 128 + wr * 64 + (i & 3) * 16 + fr; st.pm[i] = lp[r < u.nrows ? r : 0]; }
#pragma unroll
            for (int i = 0; i < 8; ++i) { const int r = (i >> 2) * 128 + wr * 64 + (i & 3) * 16 + fr; if (r >= u.nrows) st.pm[i] = 0xffffffffu; }
        } else {
#pragma unroll
            for (int i = 0; i < 8; ++i) { const int r = (i >> 2) * 128 + wr * 64 + (i & 3) * 16 + fr; st.pm[i] = r < u.nrows ? ((unsigned)((u.lt * 256 + r) * NSLOT + 8) << 14) | 4096u : 0xffffffffu; }
        }
    }
    __device__ __forceinline__ void operator()(const pg8::f32x4 (&acc)[2][2][4][2], const pg8::Unit& u, int wr, int wc, int fr, int fq, const State& st) const {
        const unsigned pos0 = (unsigned)(u.pn * 256 + wc * 64 + fq * 16);
#pragma unroll
        for (int ai = 0; ai < 2; ++ai)
#pragma unroll
            for (int m = 0; m < 4; ++m) { const unsigned pmv = st.pm[ai * 4 + m]; const float gt = (float)(pmv & 0x3fffu) * (YC_SCALE / 4096.f);
                unsigned char* dst = pmv != 0xffffffffu ? yc + ((size_t)(pmv >> 14) * 1024u + pos0) : dump + (threadIdx.x & 511) * 16;
                pg8::u32x4 w;
#pragma unroll
                for (int bj = 0; bj < 2; ++bj)
#pragma unroll
                    for (int n = 0; n < 2; ++n) { const pg8::f32x4 v = acc[ai][bj][m][n] * gt; int q = __builtin_amdgcn_cvt_pk_fp8_f32(v[0], v[1], 0, false); q = __builtin_amdgcn_cvt_pk_fp8_f32(v[2], v[3], q, true); w[bj * 2 + n] = (unsigned)q; }
                *(pg8::u32x4*)dst = w; }
    }
};
template <bool GATHER>
struct GroupedOrder {
    typedef pg8::Unit Unit;
    const char* A; const char* Bt; int K, nN, G, c, total; const LAS int* plan; const int* list; size_t bs_e, bs_pn; int pn0;
    __device__ __forceinline__ void init(const void* A_, const void* Bt_, int K_, int nN_, int G_, int c_, const LAS int* plan_, const int* list_, size_t bs_e_, size_t bs_pn_, int pn0_) {
        A = (const char*)A_; Bt = (const char*)Bt_; K = K_; nN = nN_; G = G_; c = c_; plan = plan_; list = list_; bs_e = bs_e_; bs_pn = bs_pn_; pn0 = pn0_; total = __builtin_amdgcn_readfirstlane(plan[NE + 1]) * nN; }
    __device__ __forceinline__ bool next(int i, Unit& u) const {
        const int L = i * G + c; if (L >= total) return false;
        int wgid = L; { const int q = total / 8, r = total % 8, xcd = wgid % 8, off = wgid / 8; wgid = (xcd < r ? xcd * (q + 1) : r * (q + 1) + (xcd - r) * q) + off; }
        const int tile = wgid / nN; u.pn = wgid % nN; u.pm = tile;
        int e = 0;
        for (int j = 1; j <= NE; ++j) e += (plan[j] <= tile) ? 1 : 0;
        e = __builtin_amdgcn_readfirstlane(e);
        u.e = e; u.lt = __builtin_amdgcn_readfirstlane(tile - plan[e]); const int rem = __builtin_amdgcn_readfirstlane(plan[80 + e]) - u.lt * 256; u.nrows = rem < 256 ? rem : 256; return true;
    }
    __device__ __forceinline__ const char* a_base(const Unit& u) const { return GATHER ? A : A + (size_t)u.pm * 512 * K; }
    __device__ __forceinline__ const char* b_base(const Unit& u) const { return Bt + (size_t)u.e * bs_e + (size_t)(pn0 + u.pn) * bs_pn; }
    __device__ __forceinline__ void lane_off(const Unit& u, const int (&R)[2], const int (&C)[2], unsigned (&o)[2][2]) const {
#pragma unroll
        for (int h = 0; h < 2; ++h)
#pragma unroll
            for (int i = 0; i < 2; ++i) { const int r = h * 128 + R[i];
                if (GATHER) { int tok = 0; if (r < u.nrows) { const int idx = u.lt * 256 + r; tok = u.e < NE ? (list[(size_t)u.e * M + idx] >> 3) : idx; }
                    o[h][i] = (unsigned)((tok * K + C[i]) * 2); }
                else o[h][i] = (unsigned)((r * K + C[i]) * 2); }
    }
    __device__ __forceinline__ void a_ready(const Unit&) const {}
    __device__ __forceinline__ void done(const Unit&) const {}
};

template <class CM>
__device__ __forceinline__ void transpose_item(const float* W, int ldw, bf16_t* WT, int ldt, int k0, int n0, LAS float* scr, int lane, const CM& colmap, int ksrc0 = -1, const float* kscale = nullptr) {
    const int sc = colmap(n0 + (lane & 31)); if (ksrc0 < 0) ksrc0 = k0;
#pragma unroll
    for (int i = 0; i < 32; ++i) { const int kk = 2 * i + (lane >> 5); scr[kk * 33 + (lane & 31)] = sc >= 0 ? W[(size_t)(ksrc0 + kk) * ldw + sc] * (kscale ? kscale[kk] : 1.f) : 0.f; }
    LDS_WAIT(); asm volatile("" ::: "memory");
    const int c = lane & 7;
#pragma unroll
    for (int j = 0; j < 4; ++j) { const int n = (lane >> 3) + 8 * j; const LAS float* s = scr + (8 * c) * 33 + n;
        v4u o; o.x = pk2(s[0 * 33], s[1 * 33]); o.y = pk2(s[2 * 33], s[3 * 33]); o.z = pk2(s[4 * 33], s[5 * 33]); o.w = pk2(s[6 * 33], s[7 * 33]);
        *(GAS v4u*)(WT + (size_t)(n0 + n) * ldt + k0 + 8 * c) = o; }
    LDS_WAIT(); asm volatile("" ::: "memory");
}

typedef short v4i16_t __attribute__((ext_vector_type(4)));
__device__ __forceinline__ v4i16_t tr4(const LAS unsigned char* img, int stride, int row0, int col0, int lane) {
    const LAS unsigned char* a = img + (row0 + ((lane & 15) >> 2)) * stride + (col0 + 4 * (lane & 3)) * 2;
    return __builtin_amdgcn_ds_read_tr16_b64_v4i16((LAS v4i16_t*)a);
}
__device__ __forceinline__ pg8::bf16x8 cat44(v4i16_t lo, v4i16_t hi) { return (pg8::bf16x8){lo[0], lo[1], lo[2], lo[3], hi[0], hi[1], hi[2], hi[3]}; }

template <class EMIT>
__device__ __forceinline__ void conv16x8(const bf16_t* xbc, const float* cw, const float* cb, int row0, int t0, int ch, const EMIT& emit) {
    v4u raw[19];
#pragma unroll
    for (int k = 0; k < 19; ++k) { raw[k] = (v4u){0u, 0u, 0u, 0u}; if (t0 - 3 + k >= 0) raw[k] = *(const v4u*)(xbc + (size_t)(row0 - 3 + k) * CONV_CH + ch); }
    float wv[4][8], bv[8];
#pragma unroll
    for (int k = 0; k < 4; ++k) { const f32x4 a = *(const f32x4*)(cw + k * CONV_CH + ch), b = *(const f32x4*)(cw + k * CONV_CH + ch + 4); wv[k][0] = a.x; wv[k][1] = a.y; wv[k][2] = a.z; wv[k][3] = a.w; wv[k][4] = b.x; wv[k][5] = b.y; wv[k][6] = b.z; wv[k][7] = b.w; }
    { const f32x4 a = *(const f32x4*)(cb + ch), b = *(const f32x4*)(cb + ch + 4); bv[0] = a.x; bv[1] = a.y; bv[2] = a.z; bv[3] = a.w; bv[4] = b.x; bv[5] = b.y; bv[6] = b.z; bv[7] = b.w; }
    float win[4][8];
#pragma unroll
    for (int k = 0; k < 3; ++k) { const unsigned w4[4] = {raw[k].x, raw[k].y, raw[k].z, raw[k].w};
#pragma unroll
        for (int j = 0; j < 4; ++j) { win[k][2 * j] = __uint_as_float(w4[j] << 16); win[k][2 * j + 1] = __uint_as_float(w4[j] & 0xffff0000u); } }
#pragma unroll
    for (int r = 0; r < 16; ++r) {
        { const unsigned w4[4] = {raw[r + 3].x, raw[r + 3].y, raw[r + 3].z, raw[r + 3].w};
#pragma unroll
          for (int j = 0; j < 4; ++j) { win[(r + 3) & 3][2 * j] = __uint_as_float(w4[j] << 16); win[(r + 3) & 3][2 * j + 1] = __uint_as_float(w4[j] & 0xffff0000u); } }
        float o[8];
#pragma unroll
        for (int j = 0; j < 8; ++j) { float a = bv[j];
#pragma unroll
            for (int k = 0; k < 4; ++k) a += wv[k][j] * win[(r + k) & 3][j];
            o[j] = silu_f(a); }
        emit(r, o);
    }
}

__device__ __forceinline__ void conv2x8(const bf16_t* xbc, const float* cw, const float* cb, int row, int t, int ch, float (&o0)[8], float (&o1)[8]) {
    float xr[5][8];
#pragma unroll
    for (int k = 0; k < 5; ++k) { v4u raw = (v4u){0u, 0u, 0u, 0u}; if (t - 3 + k >= 0) raw = *(const v4u*)(xbc + (size_t)(row - 3 + k) * CONV_CH + ch);
        const unsigned w4[4] = {raw.x, raw.y, raw.z, raw.w};
#pragma unroll
        for (int j = 0; j < 4; ++j) { xr[k][2 * j] = __uint_as_float(w4[j] << 16); xr[k][2 * j + 1] = __uint_as_float(w4[j] & 0xffff0000u); } }
    float wv[4][8], bv[8];
#pragma unroll
    for (int k = 0; k < 4; ++k) { const f32x4 a = *(const f32x4*)(cw + k * CONV_CH + ch), b = *(const f32x4*)(cw + k * CONV_CH + ch + 4); wv[k][0] = a.x; wv[k][1] = a.y; wv[k][2] = a.z; wv[k][3] = a.w; wv[k][4] = b.x; wv[k][5] = b.y; wv[k][6] = b.z; wv[k][7] = b.w; }
    { const f32x4 a = *(const f32x4*)(cb + ch), b = *(const f32x4*)(cb + ch + 4); bv[0] = a.x; bv[1] = a.y; bv[2] = a.z; bv[3] = a.w; bv[4] = b.x; bv[5] = b.y; bv[6] = b.z; bv[7] = b.w; }
#pragma unroll
    for (int j = 0; j < 8; ++j) { float a0 = bv[j], a1 = bv[j];
#pragma unroll
        for (int k = 0; k < 4; ++k) { a0 += wv[k][j] * xr[k][j]; a1 += wv[k][j] * xr[k + 1][j]; }
        o0[j] = silu_f(a0); o1[j] = silu_f(a1); }
}

constexpr int NPHASE = 12;
__global__ void __launch_bounds__(NWAVES * 64, 2) mega(P p) {
    extern __shared__ __attribute__((aligned(16))) unsigned char lds_raw[];
    LAS unsigned char* lds = (LAS unsigned char*)lds_raw;
    volatile LAS unsigned* MISC = (volatile LAS unsigned*)(lds + MISC_OFF);
    const int tid = threadIdx.x, lane = tid & 63, wave = __builtin_amdgcn_readfirstlane(tid >> 6);
    const int G = gridDim.x; const int bx = blockIdx.x; const int vcu = (G % 8 == 0) ? (bx % 8) * (G / 8) + bx / 8 : bx;
    unsigned char* ws = p.ws;
    gu32* ctl = (gu32*)(ws + WS_CTL);
    for (int u = tid; u < (LDS_BYTES - LDSCTL_OFF) / 4; u += NWAVES * 64) ((LAS unsigned*)(lds + LDSCTL_OFF))[u] = 0u;
    __syncthreads();
    XcdBarrier bar = xcd_barrier_post((unsigned*)(ctl + CW_BAR) + p.li * XCD_BAR_WORDS, MISC + 8);
    const int lo = p.ph_lo, hi = p.ph_hi;
#ifndef PHMASK
#define PHMASK 0xffffffffu
#endif
#define IN(k) (((PHMASK >> (k)) & 1u) && lo <= (k) && (k) < hi)
#define BOTH(k) (IN(k) && IN((k) + 1))
#ifdef PROBE_MASK
#define PH_BEGIN() const unsigned long long _pt0 = __builtin_amdgcn_s_memrealtime()
#define PH_END(k) do { if ((PROBE_MASK >> (k)) & 1u) { const unsigned long long _pt1 = __builtin_amdgcn_s_memrealtime(); while (__builtin_amdgcn_s_memrealtime() < _pt1 + (_pt1 - _pt0)) __builtin_amdgcn_s_sleep(8); } } while (0)
#else
#define PH_BEGIN() do {} while (0)
#define PH_END(k) do {} while (0)
#endif
    const int gw = vcu * NWAVES + wave, NGW = G * NWAVES;
    float* modv = (float*)(ws + WS_MOD);

    constexpr int I_GU = 16 * 16, I_D = 4 * 32, QBATCH = 16;
    LAS int* qslot = (LAS int*)(lds + PLAN_OFF + 1024);
#define STEAL_ITEMS(qword, NITEMS, ITEM_BODY) do { LAS float* scr = (LAS float*)(lds + RING_OFF + wave * 16384); \
        for (;;) { __syncthreads(); if (tid == 0) *qslot = (int)atomicAdd((unsigned*)(ws + WS_CTL) + (qword), (unsigned)QBATCH); __syncthreads(); \
            const int qb_ = __builtin_amdgcn_readfirstlane(*qslot); if (qb_ >= (NITEMS)) break; \
            for (int it = qb_ + wave; it < qb_ + QBATCH && it < (NITEMS); it += NWAVES) { ITEM_BODY } } } while (0)
#define ITEM_WGU { const int e = it / I_GU, r = it % I_GU, nb = r & 15, kb = r >> 4, up = (nb >> 2) & 1; \
        const float* W = e < NE ? (up ? p.exp_w_up : p.exp_w_gate) + (size_t)e * D * ED : (up ? p.sh_w_up : p.sh_w_gate); \
        transpose_item(W, ED, (bf16_t*)(ws + WS_WGU) + (size_t)e * 512 * D, D, kb * 64, nb * 32, scr, lane, [](int n) { return (n >> 8) * 128 + (n & 127); }); }
#define ITEM_WD { const int e = it / I_D, r2 = it % I_D, nb = r2 & 31, kb = r2 >> 5; \
        const float* W = e < NE ? p.exp_w_down + (size_t)e * ED * D : p.sh_w_down; \
        transpose_item(W, D, (bf16_t*)(ws + WS_WD) + (size_t)e * D * ED, ED, kb * 64, nb * 32, scr, lane, [](int n) { return n; }); }

    if (IN(0)) { PH_BEGIN();
        {
            LAS float* scl = (LAS float*)(lds + RING_OFF);
            LAS float* part = (LAS float*)(lds + RING_OFF + 16384);
            for (int i = tid; i < BATCH * D; i += 512) scl[i] = silu_f(p.c[i]);
            __syncthreads();
            const int cc = tid & 15, ks = tid >> 4;
            for (int item = bx; item < 6 * D / 16; item += G) { const int j0 = item * 16;
                float wv[32];
#pragma unroll
                for (int k = 0; k < 32; ++k) wv[k] = p.mod_w[(size_t)(ks * 32 + k) * 6 * D + j0 + cc];
                float a0 = 0.f, a1 = 0.f, a2 = 0.f, a3 = 0.f;
#pragma unroll
                for (int k = 0; k < 32; ++k) { const int kk = ks * 32 + k; a0 += scl[kk] * wv[k]; a1 += scl[D + kk] * wv[k]; a2 += scl[2 * D + kk] * wv[k]; a3 += scl[3 * D + kk] * wv[k]; }
                part[(ks * 4 + 0) * 16 + cc] = a0; part[(ks * 4 + 1) * 16 + cc] = a1; part[(ks * 4 + 2) * 16 + cc] = a2; part[(ks * 4 + 3) * 16 + cc] = a3;
                __syncthreads();
                if (tid < 64) { const int b = tid >> 4, c2 = tid & 15; float sacc = p.mod_b[j0 + c2];
                    for (int q = 0; q < 32; ++q) sacc += part[(q * 4 + b) * 16 + c2];
                    modv[b * 6 * D + j0 + c2] = sacc; }
                __syncthreads();
            }
        }
        LAS float* scr = (LAS float*)(lds + RING_OFF + wave * 16384);
        constexpr int I_IN = (D / 64) * (NWIN / 32), I_OUT = (2048 / 64) * (D / 32);
        bf16_t* WinT = (bf16_t*)(ws + WS_WIN_T); bf16_t* WoutT = (bf16_t*)(ws + WS_WOUT_T);
        for (int it = gw; it < I_IN + I_OUT; it += NGW) {
            if (it < I_IN) { const int nb = it % (NWIN / 32), kb = it / (NWIN / 32);
                transpose_item(p.w_in, IN_COLS, WinT, D, kb * 64, nb * 32, scr, lane, [](int n) { return n < 3072 ? n : (n < 4608 ? n + 16 : (n < 4624 ? n - 1536 : -1)); }); }
            else { const int r = it - I_IN, nb = r % (D / 32), kb = r / (D / 32);
                const int k0 = kb * 64;
                transpose_item(p.w_out, D, WoutT, 2048, k0, nb * 32, scr, lane, [](int n) { return n; }, k0 < 1024 ? k0 + 1024 : k0 - 1024, k0 < 1024 ? p.att_norm_g + k0 : nullptr); }
        }
        {
            v4u* rwf = (v4u*)(ws + WS_RWF);
            for (int i = bx * 512 + tid; i < 32 * 4 * 64; i += G * 512) { const int ln = i & 63, nt = (i >> 6) & 3, ks = i >> 8, c = ln & 15, q = ln >> 4;
                float v[8]; unsigned hi[4], lo[4];
#pragma unroll
                for (int j = 0; j < 8; ++j) v[j] = p.router_w[(32 * ks + 8 * q + j) * NE + 16 * nt + c];
#pragma unroll
                for (int j = 0; j < 4; ++j) { hi[j] = pk2(v[2 * j], v[2 * j + 1]); lo[j] = pk2(v[2 * j] - __uint_as_float(hi[j] << 16), v[2 * j + 1] - __uint_as_float(hi[j] & 0xffff0000u)); }
                rwf[((ks * 4 + nt) * 2) * 64 + ln] = (v4u){hi[0], hi[1], hi[2], hi[3]}; rwf[((ks * 4 + nt) * 2 + 1) * 64 + ln] = (v4u){lo[0], lo[1], lo[2], lo[3]}; }
        }
        if (BOTH(0)) xcd_barrier(bar);
        PH_END(0);
    }

    if (IN(1)) { PH_BEGIN();
        bf16_t* hn = (bf16_t*)p.out;
        for (int m = gw; m < M; m += NGW) {
            const int b = m / SEQ; const GAS f32x4* xr = (const GAS f32x4*)(p.x + (size_t)m * D) + lane;
            f32x4 v[4]; float s = 0.f;
#pragma unroll
            for (int j = 0; j < 4; ++j) { v[j] = xr[64 * j]; s += (v[j].x * v[j].x + v[j].y * v[j].y) + (v[j].z * v[j].z + v[j].w * v[j].w); }
            const float rstd = rsqrtf(wave_sum(s) * (1.f / D) + EPS);
            GAS unsigned long long* o8 = (GAS unsigned long long*)(hn + (size_t)m * D) + lane;
#pragma unroll
            for (int j = 0; j < 4; ++j) { const int d = 4 * lane + 256 * j; const f32x4 g = *(const f32x4*)(p.norm1_g + d), sc = *(const f32x4*)(modv + b * 6 * D + D + d), sh = *(const f32x4*)(modv + b * 6 * D + d);
                const f32x4 h = v[j] * rstd * g * (sc + 1.f) + sh;
                o8[64 * j] = (unsigned long long)pk2(h.x, h.y) | ((unsigned long long)pk2(h.z, h.w) << 32); }
        }
        if (BOTH(1)) xcd_barrier(bar);
        PH_END(1);
    }

    if (IN(2)) { PH_BEGIN();
        pg8::DenseOrder S; S.init(p.out, ws + WS_WIN_T, M, NWIN, D, G, bx);
        EpiIn E{(bf16_t*)(ws + WS_ZQ), (bf16_t*)(ws + WS_XBC), (bf16_t*)(ws + WS_K), (bf16_t*)(ws + WS_V), (float*)(ws + WS_DT)};
        pg8::gemm_phase<EpiIn, pg8::DenseOrder, true, true>(lds + RING_OFF, D, S, E);
        STEAL_ITEMS(CW_Q1, (NE + 1) * I_GU, ITEM_WGU);
        if (BOTH(2)) xcd_barrier(bar);
        PH_END(2);
    }

    if (IN(3)) { PH_BEGIN();
        {
            typedef pg8::bf16x8 bf16x8; typedef pg8::f32x4 f4;
            bf16_t* zq = (bf16_t*)(ws + WS_ZQ); const bf16_t* kk = (const bf16_t*)(ws + WS_K); const bf16_t* vv = (const bf16_t*)(ws + WS_V); float* ssq = (float*)(ws + WS_SSQ);
            LAS unsigned char* Kl = lds + RING_OFF; LAS unsigned char* Vl = lds + RING_OFF + 27648; LAS float* biasl = (LAS float*)(lds + RING_OFF + 58368);
            __syncthreads();
            for (int i = tid; i < ATT_HEADS * 192; i += 512) { const int h = i / 192, dist = 159 - (i % 192); biasl[i] = (dist >= 0 && dist < 128) ? p.rel_bias[c_bucket[dist & 127] * ATT_HEADS + h] * 1.4426950408889634f : -INFINITY; }
            const int fr = lane & 15, fg = lane >> 4;
            for (int unit = bx; unit < BATCH * (SEQ / 64); unit += G) {
                const int b = unit / (SEQ / 64), qb = unit % (SEQ / 64), t0 = qb * 64, row0 = b * SEQ + t0;
                v4u kreg[3], vreg[3]; bf16x8 Qn[2][2];
#define ATT_LOADS(KVH) do { _Pragma("unroll") for (int q3 = 0; q3 < 3; ++q3) { const int i = tid + 512 * q3, j = i >> 3, ch = i & 7, kt = t0 - 128 + j; \
                        kreg[q3] = (v4u){0u, 0u, 0u, 0u}; vreg[q3] = (v4u){0u, 0u, 0u, 0u}; \
                        if (kt >= 0) { kreg[q3] = *(const v4u*)(kk + (size_t)(b * SEQ + kt) * D_KV + (KVH) * HD + ch * 8); vreg[q3] = *(const v4u*)(vv + (size_t)(b * SEQ + kt) * D_KV + (KVH) * HD + ch * 8); } } \
                    _Pragma("unroll") for (int r2 = 0; r2 < 2; ++r2) _Pragma("unroll") for (int ks = 0; ks < 2; ++ks) \
                        Qn[r2][ks] = *(const bf16x8*)(zq + (size_t)(row0 + 16 * (2 * (wave & 1) + r2) + fr) * 2048 + ZQ_Q + ((KVH) * 4 + (wave >> 1)) * HD + ks * 32 + 8 * fg); } while (0)
                ATT_LOADS(0);
                for (int kvh = 0; kvh < KV_HEADS; ++kvh) {
                    __syncthreads();
#pragma unroll
                    for (int q3 = 0; q3 < 3; ++q3) { const int i = tid + 512 * q3, j = i >> 3, ch = i & 7; *(LAS v4u*)(Kl + j * 144 + ch * 16) = kreg[q3]; *(LAS v4u*)(Vl + j * 160 + ch * 16) = vreg[q3]; }
                    bf16x8 Qc[2][2];
#pragma unroll
                    for (int r2 = 0; r2 < 2; ++r2)
#pragma unroll
                        for (int ks = 0; ks < 2; ++ks) Qc[r2][ks] = Qn[r2][ks];
                    __syncthreads();
                    if (kvh + 1 < KV_HEADS) ATT_LOADS(kvh + 1);
                    const int head = kvh * 4 + (wave >> 1), rt0 = 2 * (wave & 1), jt0 = rt0;
                    const float sink = p.sinks[head] * 1.4426950408889634f; const LAS float* bl = biasl + head * 192; const bool edge = t0 < 128;
#pragma unroll 1
                    for (int r2 = 0; r2 < 2; ++r2) {
                        const int qi = 16 * (rt0 + r2) + fr;
                        bf16x8 Qf[2];
#pragma unroll
                        for (int ks = 0; ks < 2; ++ks) Qf[ks] = r2 ? Qc[1][ks] : Qc[0][ks];
                        f4 sacc[10];
#pragma unroll
                        for (int jt = 0; jt < 10; ++jt) sacc[jt] = (f4){0.f, 0.f, 0.f, 0.f};
#pragma unroll
                        for (int jt = 0; jt < 10; ++jt)
#pragma unroll
                            for (int ks = 0; ks < 2; ++ks) { const bf16x8 Kf = *(const LAS bf16x8*)(Kl + (16 * (jt0 + jt) + fr) * 144 + (ks * 32 + 8 * fg) * 2);
                                sacc[jt] = __builtin_amdgcn_mfma_f32_16x16x32_bf16(Kf, Qf[ks], sacc[jt], 0, 0, 0); }
                        float mx = sink;
                        { const LAS float* br = bl + (159 - (qi + 128 - 16 * jt0 - 4 * fg));
                          const int lim = (qi + 128 - 16 * jt0 - 4 * fg) - (t0 + qi);
#pragma unroll
                          for (int jt = 0; jt < 10; ++jt)
#pragma unroll
                            for (int j = 0; j < 4; ++j) { float sv = sacc[jt][j] * (0.125f * 1.4426950408889634f) + br[16 * jt + j]; if (edge) sv = (16 * jt + j < lim) ? -INFINITY : sv; sacc[jt][j] = sv; mx = fmaxf(mx, sv); } }
                        mx = fmaxf(mx, __shfl_xor(mx, 16)); mx = fmaxf(mx, __shfl_xor(mx, 32));
                        float ls = 0.f;
#pragma unroll
                        for (int jt = 0; jt < 10; ++jt)
#pragma unroll
                            for (int j = 0; j < 4; ++j) { const float pe = __builtin_amdgcn_exp2f(sacc[jt][j] - mx); sacc[jt][j] = pe; ls += pe; }
                        ls += __shfl_xor(ls, 16); ls += __shfl_xor(ls, 32); ls += __builtin_amdgcn_exp2f(sink - mx);
                        f4 o[4];
#pragma unroll
                        for (int dt = 0; dt < 4; ++dt) o[dt] = (f4){0.f, 0.f, 0.f, 0.f};
#pragma unroll
                        for (int k5 = 0; k5 < 5; ++k5) { const f4 pa = sacc[2 * k5], pb = sacc[2 * k5 + 1];
                            union { bf16x8 v; unsigned u[4]; } Pf; Pf.u[0] = pg8::cvt_pk_bf16(pa[0], pa[1]); Pf.u[1] = pg8::cvt_pk_bf16(pa[2], pa[3]); Pf.u[2] = pg8::cvt_pk_bf16(pb[0], pb[1]); Pf.u[3] = pg8::cvt_pk_bf16(pb[2], pb[3]);
#pragma unroll
                            for (int dt = 0; dt < 4; ++dt) { const bf16x8 Vf = cat44(tr4(Vl, 160, 16 * (jt0 + 2 * k5) + 4 * fg, 16 * dt, lane), tr4(Vl, 160, 16 * (jt0 + 2 * k5 + 1) + 4 * fg, 16 * dt, lane));
                                o[dt] = __builtin_amdgcn_mfma_f32_16x16x32_bf16(Vf, Pf.v, o[dt], 0, 0, 0); } }
                        const float inv = 1.f / ls; float ss = 0.f;
                        bf16_t* op = zq + (size_t)(row0 + qi) * 2048 + ZQ_Q + head * HD + 4 * fg;
#pragma unroll
                        for (int dt = 0; dt < 4; ++dt) { const f4 ov = o[dt] * inv; ss += (ov[0] * ov[0] + ov[1] * ov[1]) + (ov[2] * ov[2] + ov[3] * ov[3]);
                            *(unsigned long long*)(op + 16 * dt) = (unsigned long long)pg8::cvt_pk_bf16(ov[0], ov[1]) | ((unsigned long long)pg8::cvt_pk_bf16(ov[2], ov[3]) << 32); }
                        ss += __shfl_xor(ss, 16); ss += __shfl_xor(ss, 32);
                        if (fg == 0) ssq[(row0 + qi) * 16 + head] = ss;
                    }
                }
            }
            __syncthreads();
        }
        PH_END(3);
    }

    if (IN(4)) { PH_BEGIN();
        typedef pg8::bf16x8 bf16x8; typedef pg8::f32x4 f4;
        const bf16_t* xbc = (const bf16_t*)(ws + WS_XBC); const float* dtr = (const float*)(ws + WS_DT); float* decg = (float*)(ws + WS_CS);
        LAS unsigned char* Xi = lds + RING_OFF; LAS unsigned char* Bi = lds + RING_OFF + 69632; LAS float* wl = (LAS float*)(lds + RING_OFF + 106496);
        const int fr = lane & 15, fg = lane >> 4;
        for (int unit = bx; unit < BATCH * NCHUNK * SSM_GROUPS; unit += G) {
            const int g = unit % SSM_GROUPS, bc = unit / SSM_GROUPS, rowc = bc * CHUNK, tc = rowc % SEQ;
            __syncthreads();
            if (wave < 4) { const int h = g * 4 + wave; const float A = -__expf(p.a_log[h]), bias = p.dt_bias[h];
                const float d0 = softplus_f(dtr[(rowc + lane) * 16 + h] + bias), d1 = softplus_f(dtr[(rowc + lane + 64) * 16 + h] + bias);
                float s0 = d0 * A, s1 = d1 * A;
#pragma unroll
                for (int o = 1; o < 64; o <<= 1) { const float u0 = __shfl_up(s0, o), u1 = __shfl_up(s1, o); if (lane >= o) { s0 += u0; s1 += u1; } }
                s1 += __shfl(s0, 63); const float cl = __shfl(s1, 63);
                wl[wave * 128 + lane] = d0 * __expf(cl - s0); wl[wave * 128 + lane + 64] = d1 * __expf(cl - s1);
                if (lane == 0) decg[bc * 16 + h] = __expf(cl); }
            __syncthreads();
            if (tid < 384) { const int co = tid % 48, l0 = 16 * (tid / 48);
                const int ch = co < 32 ? g * 256 + co * 8 : D_SSM + g * D_STATE + (co - 32) * 8;
                LAS unsigned char* dst = co < 32 ? Xi + l0 * 544 + co * 16 : Bi + l0 * 288 + (co - 32) * 16; const int st = co < 32 ? 544 : 288;
                const LAS float* wr_ = wl + (co < 32 ? (co >> 3) * 128 : 0) + l0; const bool scale = co < 32;
                conv16x8(xbc, p.conv_w, p.conv_b, rowc + l0, tc + l0, ch, [&](int r, const float (&o)[8]) { const float w = scale ? wr_[r] : 1.f;
                    *(LAS v4u*)(dst + r * st) = (v4u){pk2(o[0] * w, o[1] * w), pk2(o[2] * w, o[3] * w), pk2(o[4] * w, o[5] * w), pk2(o[6] * w, o[7] * w)}; }); }
            __syncthreads();
            bf16x8 Bf[4];
#pragma unroll
            for (int kk = 0; kk < 4; ++kk) Bf[kk] = cat44(tr4(Bi, 288, 32 * kk + 4 * fg, 16 * wave, lane), tr4(Bi, 288, 32 * kk + 16 + 4 * fg, 16 * wave, lane));
#pragma unroll
            for (int r4 = 0; r4 < 4; ++r4) { const int h = g * 4 + r4; float* S = p.out + (size_t)(bc * SSM_HEADS + h) * HD * D_STATE;
#pragma unroll
                for (int pt = 0; pt < 4; ++pt) { f4 acc = (f4){0.f, 0.f, 0.f, 0.f};
#pragma unroll
                    for (int kk = 0; kk < 4; ++kk) { const bf16x8 Af = cat44(tr4(Xi, 544, 32 * kk + 4 * fg, r4 * 64 + 16 * pt, lane), tr4(Xi, 544, 32 * kk + 16 + 4 * fg, r4 * 64 + 16 * pt, lane)); acc = __builtin_amdgcn_mfma_f32_16x16x32_bf16(Af, Bf[kk], acc, 0, 0, 0); }
#pragma unroll
                    for (int j = 0; j < 4; ++j) S[(16 * pt + 4 * fg + j) * D_STATE + 16 * wave + fr] = acc[j]; } }
        }
        if (BOTH(4)) xcd_barrier(bar);
        PH_END(4);
    }

    if (IN(5)) { PH_BEGIN();
        const float* S = p.out; const float* decg = (const float*)(ws + WS_CS); bf16_t* St = (bf16_t*)(ws + WS_ST);
        for (int i = bx * 512 + tid; i < BATCH * SSM_HEADS * HD * D_STATE / 2; i += G * 512) {
            const int pn = (i % (HD * D_STATE / 2)) * 2, bh = i / (HD * D_STATE / 2), h = bh % SSM_HEADS, b = bh / SSM_HEADS;
            float s0 = 0.f, s1 = 0.f;
#pragma unroll 4
            for (int c = 0; c < NCHUNK; ++c) { const size_t idx = ((size_t)((b * NCHUNK + c) * SSM_HEADS + h)) * HD * D_STATE + pn; const float2 sv = *(const float2*)(S + idx);
                *(unsigned*)(St + idx) = pk2(s0, s1); const float dec = decg[(b * NCHUNK + c) * 16 + h]; s0 = s0 * dec + sv.x; s1 = s1 * dec + sv.y; }
        }
        {
            const float* ssq = (const float*)(ws + WS_SSQ); float* ratt = (float*)(ws + WS_RATT);
            for (int m = bx * 512 + tid; m < M; m += G * 512) { const f32x4* sp = (const f32x4*)(ssq + (size_t)m * 16); const f32x4 a = sp[0], b = sp[1], c = sp[2], d = sp[3];
                const float sacc = ((a.x + a.y) + (a.z + a.w)) + ((b.x + b.y) + (b.z + b.w)) + ((c.x + c.y) + (c.z + c.w)) + ((d.x + d.y) + (d.z + d.w));
                ratt[m] = rsqrtf(sacc * (1.f / 1024.f) + EPS); }
        }
        if (BOTH(5)) xcd_barrier(bar);
        PH_END(5);
    }

    if (IN(6)) { PH_BEGIN();
        typedef pg8::bf16x8 bf16x8; typedef pg8::f32x4 f4;
        const bf16_t* xbc = (const bf16_t*)(ws + WS_XBC); const float* dtr = (const float*)(ws + WS_DT); bf16_t* zq = (bf16_t*)(ws + WS_ZQ); const bf16_t* Stg = (const bf16_t*)(ws + WS_ST);
        LAS unsigned char* Xi = lds + RING_OFF; LAS unsigned char* Bi = lds + RING_OFF + 69632; LAS unsigned char* Ci = lds + RING_OFF + 106496;
        LAS float* csl = (LAS float*)(lds + RING_OFF + 143360); LAS float* dtl = csl + 512;
        const int fr = lane & 15, fg = lane >> 4;
        for (int unit = bx; unit < BATCH * NCHUNK * SSM_GROUPS; unit += G) {
            const int g = unit % SSM_GROUPS, bc = unit / SSM_GROUPS, rowc = bc * CHUNK, tc = rowc % SEQ;
            __syncthreads();
            const unsigned long long _s0 = SUB_T();
            if (wave < 4) { const int h = g * 4 + wave; const float A = -__expf(p.a_log[h]), bias = p.dt_bias[h];
                const float d0 = softplus_f(dtr[(rowc + lane) * 16 + h] + bias), d1 = softplus_f(dtr[(rowc + lane + 64) * 16 + h] + bias);
                float s0 = d0 * A, s1 = d1 * A;
#pragma unroll
                for (int o = 1; o < 64; o <<= 1) { const float u0 = __shfl_up(s0, o), u1 = __shfl_up(s1, o); if (lane >= o) { s0 += u0; s1 += u1; } }
                s1 += __shfl(s0, 63);
                csl[wave * 128 + lane] = s0; csl[wave * 128 + lane + 64] = s1; dtl[wave * 128 + lane] = d0; dtl[wave * 128 + lane + 64] = d1; }
            { const int co = tid & 63, l0 = 16 * (tid >> 6);
                const int ch = co < 32 ? g * 256 + co * 8 : (co < 48 ? D_SSM + g * D_STATE + (co - 32) * 8 : D_SSM + SSM_GROUPS * D_STATE + g * D_STATE + (co - 48) * 8);
                LAS unsigned char* dst = co < 32 ? Xi + l0 * 544 + co * 16 : (co < 48 ? Bi + l0 * 288 + (co - 32) * 16 : Ci + l0 * 288 + (co - 48) * 16); const int st = co < 32 ? 544 : 288;
                conv16x8(xbc, p.conv_w, p.conv_b, rowc + l0, tc + l0, ch, [&](int r, const float (&o)[8]) {
                    *(LAS v4u*)(dst + r * st) = (v4u){pk2(o[0], o[1]), pk2(o[2], o[3]), pk2(o[4], o[5]), pk2(o[6], o[7])}; }); }
            __syncthreads();
            SUB_END(0, _s0); const unsigned long long _s1 = SUB_T();
            const int lrow = 16 * wave + fr;
            bf16x8 Cf[4];
#pragma unroll
            for (int kk = 0; kk < 4; ++kk) Cf[kk] = *(const LAS bf16x8*)(Ci + lrow * 288 + (4 * kk + fg) * 16);
            f4 Gt[8];
#pragma unroll
            for (int st = 0; st < 8; ++st) { Gt[st] = (f4){0.f, 0.f, 0.f, 0.f};
                if (st <= wave) {
#pragma unroll
                    for (int kk = 0; kk < 4; ++kk) { const bf16x8 Bf = *(const LAS bf16x8*)(Bi + (16 * st + fr) * 288 + (4 * kk + fg) * 16);
                        Gt[st] = __builtin_amdgcn_mfma_f32_16x16x32_bf16(Bf, Cf[kk], Gt[st], 0, 0, 0); } } }
            SUB_END(1, _s1); const unsigned long long _s2 = SUB_T();
            f4 Y[4][4];
            const bf16_t* zr0 = zq + (size_t)(rowc + lrow) * 2048 + ZQ_Z + g * 256 + 4 * fg; unsigned long long zz[4][4];
#pragma unroll
            for (int r4 = 0; r4 < 4; ++r4)
#pragma unroll
                for (int pt = 0; pt < 4; ++pt) zz[r4][pt] = *(const unsigned long long*)(zr0 + r4 * 64 + 16 * pt);
            const bf16_t* St0 = Stg + (size_t)(bc * SSM_HEADS + g * 4) * HD * D_STATE;
            __syncthreads();
            v4u stn[4];
#pragma unroll
            for (int q = 0; q < 4; ++q) { const int i = tid + 512 * q, h2 = i >> 10, pp = (i >> 4) & 63, ch = i & 15;
                const v4u v = *(const v4u*)(St0 + (size_t)h2 * HD * D_STATE + pp * D_STATE + ch * 8); *(LAS v4u*)(Bi + h2 * 17408 + pp * 272 + ch * 16) = v;
                stn[q] = *(const v4u*)(St0 + (size_t)(2 + h2) * HD * D_STATE + pp * D_STATE + ch * 8); }
            __syncthreads();
#pragma unroll
            for (int hp = 0; hp < 2; ++hp) {
                if (hp == 1) { __syncthreads();
#pragma unroll
                    for (int q = 0; q < 4; ++q) { const int i = tid + 512 * q, h2 = i >> 10, pp = (i >> 4) & 63, ch = i & 15; *(LAS v4u*)(Bi + h2 * 17408 + pp * 272 + ch * 16) = stn[q]; }
                    __syncthreads(); }
#pragma unroll
                for (int h2 = 0; h2 < 2; ++h2) { const int r4 = 2 * hp + h2; const float ecl = __expf(csl[r4 * 128 + lrow]);
#pragma unroll
                    for (int pt = 0; pt < 4; ++pt) { f4 acc = (f4){0.f, 0.f, 0.f, 0.f};
#pragma unroll
                        for (int kk = 0; kk < 4; ++kk) { const bf16x8 Sf = *(const LAS bf16x8*)(Bi + h2 * 17408 + (16 * pt + fr) * 272 + (4 * kk + fg) * 16); acc = __builtin_amdgcn_mfma_f32_16x16x32_bf16(Sf, Cf[kk], acc, 0, 0, 0); }
                        Y[r4][pt] = acc * ecl; } }
            }
#pragma unroll
            for (int r4 = 0; r4 < 4; ++r4) { const int h = g * 4 + r4; const float cl = csl[r4 * 128 + lrow];
#pragma unroll
                for (int k4 = 0; k4 < 4; ++k4) { if (2 * k4 <= wave) {
                    union { bf16x8 v; unsigned u[4]; } Pf;
#pragma unroll
                    for (int hh = 0; hh < 2; ++hh) { const int st = 2 * k4 + hh; const f4 c4 = *(const LAS f4*)(csl + r4 * 128 + 16 * st + 4 * fg), d4 = *(const LAS f4*)(dtl + r4 * 128 + 16 * st + 4 * fg);
                        float mv[4];
#pragma unroll
                        for (int j = 0; j < 4; ++j) { const int s = 16 * st + 4 * fg + j; mv[j] = (s <= lrow) ? Gt[st][j] * __expf(cl - c4[j]) * d4[j] : 0.f; }
                        Pf.u[2 * hh] = pg8::cvt_pk_bf16(mv[0], mv[1]); Pf.u[2 * hh + 1] = pg8::cvt_pk_bf16(mv[2], mv[3]); }
#pragma unroll
                    for (int pt = 0; pt < 4; ++pt) { const bf16x8 Xf = cat44(tr4(Xi, 544, 32 * k4 + 4 * fg, r4 * 64 + 16 * pt, lane), tr4(Xi, 544, 32 * k4 + 16 + 4 * fg, r4 * 64 + 16 * pt, lane));
                        Y[r4][pt] = __builtin_amdgcn_mfma_f32_16x16x32_bf16(Xf, Pf.v, Y[r4][pt], 0, 0, 0); } } }
                const float dsk = p.d_skip[h];
#pragma unroll
                for (int pt = 0; pt < 4; ++pt) { const unsigned long long xx = *(const LAS unsigned long long*)(Xi + lrow * 544 + (r4 * 64 + 16 * pt + 4 * fg) * 2); const unsigned x0 = (unsigned)xx, x1 = (unsigned)(xx >> 32);
                    Y[r4][pt][0] += dsk * __uint_as_float(x0 << 16); Y[r4][pt][1] += dsk * __uint_as_float(x0 & 0xffff0000u); Y[r4][pt][2] += dsk * __uint_as_float(x1 << 16); Y[r4][pt][3] += dsk * __uint_as_float(x1 & 0xffff0000u); }
            }
            SUB_END(2, _s2); const unsigned long long _s3 = SUB_T();
            bf16_t* zr = zq + (size_t)(rowc + lrow) * 2048 + ZQ_Z + g * 256 + 4 * fg; float ss = 0.f;
#pragma unroll
            for (int r4 = 0; r4 < 4; ++r4)
#pragma unroll
                for (int pt = 0; pt < 4; ++pt) { const unsigned z0 = (unsigned)zz[r4][pt], z1 = (unsigned)(zz[r4][pt] >> 32);
                    f4 v = Y[r4][pt]; v[0] *= silu_f(__uint_as_float(z0 << 16)); v[1] *= silu_f(__uint_as_float(z0 & 0xffff0000u)); v[2] *= silu_f(__uint_as_float(z1 << 16)); v[3] *= silu_f(__uint_as_float(z1 & 0xffff0000u));
                    Y[r4][pt] = v; ss += (v[0] * v[0] + v[1] * v[1]) + (v[2] * v[2] + v[3] * v[3]); }
            ss += __shfl_xor(ss, 16); ss += __shfl_xor(ss, 32);
            const float rr = rsqrtf(ss * (1.f / 256.f) + EPS);
#pragma unroll
            for (int r4 = 0; r4 < 4; ++r4)
#pragma unroll
                for (int pt = 0; pt < 4; ++pt) { const f4 gn = *(const f4*)(p.ssm_norm_g + g * 256 + r4 * 64 + 16 * pt + 4 * fg); const f4 v = Y[r4][pt] * rr * gn;
                    *(unsigned long long*)(zr + r4 * 64 + 16 * pt) = (unsigned long long)pg8::cvt_pk_bf16(v[0], v[1]) | ((unsigned long long)pg8::cvt_pk_bf16(v[2], v[3]) << 32); }
            SUB_END(3, _s3);
        }
        if (BOTH(6)) xcd_barrier(bar);
        PH_END(6);
    }

    if (IN(7)) { PH_BEGIN();
        pg8::DenseOrder S; S.init(ws + WS_ZQ, ws + WS_WOUT_T, M, D, 2048, G, bx);
        EpiOut E{p.x, p.out, modv, (const float*)(ws + WS_RATT)};
        pg8::gemm_phase<EpiOut, pg8::DenseOrder, true, true>(lds + RING_OFF, 2048, S, E);
        if (BOTH(7)) xcd_barrier(bar);
        PH_END(7);
    }

    if (IN(8)) { PH_BEGIN();
        typedef pg8::bf16x8 bf16x8; typedef pg8::f32x4 f4;
        LAS float* part = (LAS float*)(lds + RING_OFF);
        LAS float* red = (LAS float*)(lds + RING_OFF + 131072);
        LAS int* cnt_l = (LAS int*)(lds + RING_OFF + 133120);
        LAS int* base_l = (LAS int*)(lds + RING_OFF + 133376);
        LAS int* asg_e = (LAS int*)(lds + RING_OFF + 133632);
        LAS int* asg_pos = (LAS int*)(lds + RING_OFF + 135680);
        LAS float* asg_g = (LAS float*)(lds + RING_OFF + 137728);
        bf16_t* h2 = (bf16_t*)(ws + WS_H2); int* cnt = (int*)(ws + WS_CTL) + CW_CNT; int* list = (int*)(ws + WS_LIST); unsigned* pmeta = (unsigned*)(ws + WS_GLIST);
        const v4u* rwf = (const v4u*)(ws + WS_RWF);
        const float rbias = p.router_bias[lane];
        const int fr = lane & 15, fq = lane >> 4;
        for (int grp = bx; grp < M / 64; grp += G) {
            const int b = (grp * 64) / SEQ;
            __syncthreads();
            if (tid < NE) cnt_l[tid] = 0;
#pragma unroll 1
            for (int half = 0; half < 2; ++half) {
            f4 xv[2][4][2];
#pragma unroll
            for (int tile = 0; tile < 2; ++tile) { const float* xr = p.out + (size_t)(grp * 64 + half * 32 + tile * 16 + fr) * D + 128 * wave + 8 * fq;
#pragma unroll
                for (int kk = 0; kk < 4; ++kk) { xv[tile][kk][0] = *(const f4*)(xr + 32 * kk); xv[tile][kk][1] = *(const f4*)(xr + 32 * kk + 4); } }
#pragma unroll
            for (int tile = 0; tile < 2; ++tile) { float ss = 0.f;
#pragma unroll
                for (int kk = 0; kk < 4; ++kk)
#pragma unroll
                    for (int hf = 0; hf < 2; ++hf) { const f4 v = xv[tile][kk][hf]; ss += (v[0] * v[0] + v[1] * v[1]) + (v[2] * v[2] + v[3] * v[3]); }
                ss += __shfl_xor(ss, 16); ss += __shfl_xor(ss, 32);
                if (fq == 0) red[(tile * 8 + wave) * 16 + fr] = ss; }
            __syncthreads();
            float rstd2[2]; f4 acc[2][4];
#pragma unroll
            for (int tile = 0; tile < 2; ++tile) { float tot = 0.f;
#pragma unroll
                for (int w2 = 0; w2 < 8; ++w2) tot += red[(tile * 8 + w2) * 16 + fr];
                rstd2[tile] = rsqrtf(tot * (1.f / D) + EPS);
#pragma unroll
                for (int nt = 0; nt < 4; ++nt) acc[tile][nt] = (f4){0.f, 0.f, 0.f, 0.f}; }
#pragma unroll
            for (int kk = 0; kk < 4; ++kk) { const int d = 128 * wave + 32 * kk + 8 * fq;
                f4 gm[2], sm[2];
#pragma unroll
                for (int hf = 0; hf < 2; ++hf) { gm[hf] = *(const f4*)(p.norm2_g + d + 4 * hf) * (*(const f4*)(modv + b * 6 * D + 4 * D + d + 4 * hf) + 1.f); sm[hf] = *(const f4*)(modv + b * 6 * D + 3 * D + d + 4 * hf); }
                union { bf16x8 v; v4u q; } Rh[4], Rl[4];
#pragma unroll
                for (int nt = 0; nt < 4; ++nt) { const int fi = (((4 * wave + kk) * 4 + nt) * 2) * 64 + lane; Rh[nt].q = rwf[fi]; Rl[nt].q = rwf[fi + 64]; }
#pragma unroll
                for (int tile = 0; tile < 2; ++tile) { const int row = grp * 64 + half * 32 + tile * 16 + fr;
                    union { bf16x8 v; unsigned u[4]; v4u q; } Hh, Hl;
#pragma unroll
                    for (int hf = 0; hf < 2; ++hf) { const f4 h = xv[tile][kk][hf] * rstd2[tile] * gm[hf] + sm[hf];
                        const unsigned h01 = pk2(h[0], h[1]), h23 = pk2(h[2], h[3]);
                        Hh.u[2 * hf] = h01; Hh.u[2 * hf + 1] = h23;
                        Hl.u[2 * hf] = pk2(h[0] - __uint_as_float(h01 << 16), h[1] - __uint_as_float(h01 & 0xffff0000u)); Hl.u[2 * hf + 1] = pk2(h[2] - __uint_as_float(h23 << 16), h[3] - __uint_as_float(h23 & 0xffff0000u)); }
                    *(v4u*)(h2 + (size_t)row * D + d) = Hh.q;
#pragma unroll
                    for (int nt = 0; nt < 4; ++nt) {
                        acc[tile][nt] = __builtin_amdgcn_mfma_f32_16x16x32_bf16(Hh.v, Rh[nt].v, acc[tile][nt], 0, 0, 0);
                        acc[tile][nt] = __builtin_amdgcn_mfma_f32_16x16x32_bf16(Hh.v, Rl[nt].v, acc[tile][nt], 0, 0, 0);
                        acc[tile][nt] = __builtin_amdgcn_mfma_f32_16x16x32_bf16(Hl.v, Rh[nt].v, acc[tile][nt], 0, 0, 0); } }
                asm volatile("" ::: "memory"); }
#pragma unroll
            for (int tile = 0; tile < 2; ++tile)
#pragma unroll
                for (int nt = 0; nt < 4; ++nt)
#pragma unroll
                    for (int j = 0; j < 4; ++j) part[((tile * 8 + wave) * 16 + 4 * fq + j) * 64 + 16 * nt + fr] = acc[tile][nt][j];
            __syncthreads();
#pragma unroll 1
            for (int rr = 0; rr < 4; ++rr) { const int lr32 = 4 * wave + rr, tile = lr32 >> 4, lr = lr32 & 15, lr64 = half * 32 + lr32, m = grp * 64 + lr64;
                float lg = 0.f;
#pragma unroll
                for (int w2 = 0; w2 < 8; ++w2) lg += part[((tile * 8 + w2) * 16 + lr) * 64 + lane];
                const float sc = 1.f / (1.f + __expf(-lg)), sel = sc + rbias;
                float m1 = sel, m2 = -INFINITY;
#pragma unroll
                for (int o = 1; o < 8; o <<= 1) { const float p1 = __shfl_xor(m1, o), p2 = __shfl_xor(m2, o); const float n1 = fmaxf(m1, p1), n2 = fmaxf(fminf(m1, p1), fmaxf(m2, p2)); m1 = n1; m2 = n2; }
                const float gs = m1 + m2; const int myg = lane >> 3;
                unsigned gk = __float_as_uint(gs); gk = (gk & 0x80000000u) ? ~gk : (gk | 0x80000000u); gk = (gk & ~7u) | (unsigned)(7 - myg);
                int grank = 0;
#pragma unroll
                for (int g2 = 0; g2 < 8; ++g2) grank += (__builtin_amdgcn_readlane(gk, g2 * 8) > gk) ? 1 : 0;
                const bool allowed = grank < 4;
                unsigned ek = __float_as_uint(sel); ek = (ek & 0x80000000u) ? ~ek : (ek | 0x80000000u); ek = allowed ? ((ek & ~63u) | (unsigned)(63 - lane)) : 0u;
                int rank = 0;
#pragma unroll
                for (int e2 = 0; e2 < NE; ++e2) rank += (__builtin_amdgcn_readlane(ek, e2) > ek) ? 1 : 0;
                const bool selb = allowed && rank < TOPK;
                const float wsum = wave_sum(selb ? sc : 0.f);
                if (selb) { const float gate = sc / wsum * 2.5f; const int pl = __hip_atomic_fetch_add(cnt_l + lane, 1, __ATOMIC_RELAXED, __HIP_MEMORY_SCOPE_WORKGROUP); const int i = lr64 * 8 + rank; asg_e[i] = lane; asg_pos[i] = pl; asg_g[i] = gate; }
            }
            __syncthreads();
            }
            if (tid < NE) { int t2 = tid; asm volatile("" : "+v"(t2)); const int c = cnt_l[t2]; base_l[t2] = c > 0 ? atomicAdd(&cnt[t2], c) : 0; }
            __syncthreads();
            { const int e = asg_e[tid]; const size_t li = (size_t)e * M + base_l[e] + asg_pos[tid]; list[li] = (grp * 64 + (tid >> 3)) * 8 + (tid & 7); pmeta[li] = ((unsigned)((grp * 64 + (tid >> 3)) * NSLOT + (tid & 7)) << 14) | (unsigned)__float2int_rn(asg_g[tid] * 4096.f); }
        }
        if (BOTH(8)) xcd_barrier(bar);
        PH_END(8);
    }

    LAS int* plan = (LAS int*)(lds + PLAN_OFF);
#define MAKE_PLAN() do { __syncthreads(); if (tid <= NE) plan[80 + tid] = tid < NE ? (int)__hip_atomic_load((const int*)(ws + WS_CTL) + CW_CNT + tid, RLX_AGENT) : M; __syncthreads(); \
        if (tid == 0) { int off = 0; for (int e = 0; e <= NE; ++e) { plan[e] = off; off += (plan[80 + e] + 255) >> 8; } plan[NE + 1] = off; } __syncthreads(); } while (0)
    if (IN(9)) { PH_BEGIN();
        MAKE_PLAN();
        GroupedOrder<true> S; S.init(ws + WS_H2, ws + WS_WGU, D, 2, G, bx, plan, (const int*)(ws + WS_LIST), (size_t)512 * D * 2, (size_t)256 * D * 2, 0);
        EpiGU E{(bf16_t*)(ws + WS_U)};
        pg8::gemm_phase<EpiGU, GroupedOrder<true>, true, true>(lds + RING_OFF, D, S, E);
        STEAL_ITEMS(CW_Q2, (NE + 1) * I_D, ITEM_WD);
        if (BOTH(9)) xcd_barrier(bar);
        PH_END(9);
    }
    if (IN(10)) { PH_BEGIN(); MAKE_PLAN();
        GroupedOrder<false> S; S.init(ws + WS_U, ws + WS_WD, ED, 4, G, bx, plan, (const int*)(ws + WS_LIST), (size_t)D * ED * 2, (size_t)256 * ED * 2, 0);
        EpiDown E{(unsigned char*)(ws + WS_YC), (const unsigned*)(ws + WS_GLIST), ws + WS_DUMP + (size_t)bx * 8192};
        pg8::gemm_phase<EpiDown, GroupedOrder<false>, true, true, true>(lds + RING_OFF, ED, S, E);
        if (BOTH(10)) xcd_barrier(bar);
        PH_END(10);
    }
    if (IN(11)) { PH_BEGIN();
        typedef float f2 __attribute__((ext_vector_type(2)));
        const unsigned char* yc = (const unsigned char*)(ws + WS_YC);
        const int c0 = (lane >> 4) * 256 + ((lane >> 2) & 3) * 32 + (lane & 3) * 8;
        for (int m = gw; m < M; m += NGW) { const int b = m / SEQ;
            float s[16];
#pragma unroll
            for (int j = 0; j < 16; ++j) s[j] = 0.f;
#pragma unroll
            for (int k = 0; k < NSLOT; ++k) { const v4u raw = *(const v4u*)(yc + ((size_t)m * NSLOT + k) * 1024 + lane * 16); const unsigned w4[4] = {raw.x, raw.y, raw.z, raw.w};
#pragma unroll
                for (int q = 0; q < 4; ++q) { const f2 lo = __builtin_amdgcn_cvt_pk_f32_fp8((int)w4[q], false), hi = __builtin_amdgcn_cvt_pk_f32_fp8((int)w4[q], true);
                    s[4 * q] += lo.x; s[4 * q + 1] += lo.y; s[4 * q + 2] += hi.x; s[4 * q + 3] += hi.y; } }
            float* xo = p.out + (size_t)m * D; const float* g2 = modv + b * 6 * D + 5 * D;
            f32x4 xv[4]; float ss = 0.f;
#pragma unroll
            for (int q = 0; q < 4; ++q) { const int c = c0 + (q >> 1) * 128 + (q & 1) * 4; const f32x4 gv = *(const f32x4*)(g2 + c) * (1.f / YC_SCALE);
                xv[q] = *(const f32x4*)(xo + c) + gv * (f32x4){s[4 * q], s[4 * q + 1], s[4 * q + 2], s[4 * q + 3]};
                ss += (xv[q].x * xv[q].x + xv[q].y * xv[q].y) + (xv[q].z * xv[q].z + xv[q].w * xv[q].w); }
            const float rstd = rsqrtf(wave_sum(ss) * (1.f / D) + EPS);
#pragma unroll
            for (int q = 0; q < 4; ++q) { const int c = c0 + (q >> 1) * 128 + (q & 1) * 4; *(f32x4*)(xo + c) = xv[q] * rstd * *(const f32x4*)(p.final_g + c); }
        }
        PH_END(11);
    }
#undef IN
#undef BOTH
}

extern "C" void kernel_launch(void* const* d_in, const int* in_sizes, int n_in, void* d_out, int out_size, void* d_ws, size_t ws_size, hipStream_t stream) {
    static int grid = 0;
    if (grid == 0) {
        int dev = 0, cus = 0;
        if (hipGetDevice(&dev) != hipSuccess || hipDeviceGetAttribute(&cus, hipDeviceAttributeMultiprocessorCount, dev) != hipSuccess) { fprintf(stderr, "device query failed\n"); grid = -1; return; }
        if (hipFuncSetAttribute((const void*)mega, hipFuncAttributeMaxDynamicSharedMemorySize, LDS_BYTES) != hipSuccess) { fprintf(stderr, "hipFuncSetAttribute failed\n"); grid = -1; return; }
        int per_cu = 0;
        if (hipOccupancyMaxActiveBlocksPerMultiprocessor(&per_cu, (const void*)mega, NWAVES * 64, LDS_BYTES) != hipSuccess || per_cu < 1) fprintf(stderr, "occupancy query: %d\n", per_cu);
        (void)hipGetLastError();
        grid = cus;
        if (ws_size < WS_END) fprintf(stderr, "ws too small: %zu < %zu\n", ws_size, (size_t)WS_END);
    }
    if (grid < 0) return;
    P p{};
    const float** f = (const float**)&p;
    for (int i = 0; i < 26; ++i) f[i] = (const float*)d_in[i];
    p.out = (float*)d_out; p.ws = (unsigned char*)d_ws;
    (void)hipMemsetAsync(p.ws + WS_CTL, 0, CTL_BYTES, stream);
    p.ph_lo = 0; p.ph_hi = NPHASE; p.li = 0;
    hipLaunchKernelGGL(mega, dim3(grid), dim3(NWAVES * 64), LDS_BYTES, stream, p);
}
```

```cpp
#include <hip/hip_runtime.h>
#include <stdint.h>
#include <stdio.h>

typedef unsigned short bf16_t;

constexpr int D = 1024, BATCH = 4, SEQ = 4096, M = BATCH * SEQ;
constexpr int D_SSM = 1024, SSM_HEADS = 16, SSM_GROUPS = 4, D_STATE = 128, CONV_K = 4, CONV_CH = 2048, CHUNK = 128, NCHUNK = SEQ / CHUNK;
constexpr int HD = 64, ATT_HEADS = 16, KV_HEADS = 4, D_KV = 256, WINDOW = 128;
constexpr int IN_COLS = 4624;
constexpr int C_Z = 0, C_XBC = 1024, C_DT = 3072, C_Q = 3088, C_K = 4112, C_V = 4368;
constexpr int NE = 64, TOPK = 8, ED = 256;
constexpr float EPS = 1e-6f;
constexpr int NSLOT = 9;
constexpr int ZQ_Q = 0, ZQ_Z = 1024;
constexpr int NWIN = 4864;

constexpr size_t MiB = 1u << 20;
constexpr size_t WS_CTL = 0;
constexpr size_t CTL_BYTES = 64 * 1024;
constexpr int CW_CNT = 0;
constexpr int CW_Q1 = 128, CW_Q2 = 192;
constexpr int CW_BAR = 4096;
constexpr size_t WS_MOD = 1 * MiB;
constexpr size_t WS_DUMP = 2 * MiB;
constexpr size_t WS_RWF = 1 * MiB + 256 * 1024;
constexpr size_t WS_LIST = 4 * MiB;
constexpr size_t WS_WIN_T = 8 * MiB;
constexpr size_t WS_WOUT_T = 18 * MiB;
constexpr size_t WS_SSQ = 22 * MiB;
constexpr size_t WS_RATT = 23 * MiB;
constexpr size_t WS_ZQ = 24 * MiB;
constexpr size_t WS_XBC = 88 * MiB;
constexpr size_t WS_K = 152 * MiB;
constexpr size_t WS_V = 160 * MiB;
constexpr size_t WS_DT = 168 * MiB;
constexpr size_t WS_CS = 169 * MiB;
constexpr size_t WS_ST = 170 * MiB;
constexpr size_t WS_H2 = 170 * MiB;
constexpr size_t WS_WGU = 202 * MiB;
constexpr size_t WS_YC = 104 * MiB;
constexpr size_t WS_U = 24 * MiB;
constexpr size_t WS_WD = 267 * MiB;
constexpr size_t WS_GLIST = 300 * MiB;
constexpr size_t WS_END = 304 * MiB;
constexpr int UROWS_MAX = 163840;

__device__ __forceinline__ float bf2f(bf16_t v) { return __uint_as_float(((unsigned)v) << 16); }
__device__ __forceinline__ bf16_t f2bf(float f) { unsigned u = __float_as_uint(f); return (bf16_t)((u + 0x7fffu + ((u >> 16) & 1u)) >> 16); }
__device__ __forceinline__ unsigned pk2(float lo, float hi) { return (unsigned)f2bf(lo) | ((unsigned)f2bf(hi) << 16); }
__device__ __forceinline__ float silu_f(float x) { return x * __builtin_amdgcn_rcpf(1.f + __expf(-x)); }
__device__ __forceinline__ float softplus_f(float x) { return x > 20.f ? x : log1pf(__expf(x)); }

__constant__ int c_bucket[128] = {0, 1, 2, 3, 4, 5, 6, 7, 8, 9, 10, 11, 12, 13, 14, 15, 16, 16, 16, 17, 17, 18, 18, 18, 19, 19, 19, 20, 20, 20, 20, 21, 21, 21, 21, 22, 22, 22, 22, 22, 23, 23, 23, 23, 23, 23, 24, 24, 24, 24, 24, 24, 25, 25, 25, 25, 25, 25, 25, 26, 26, 26, 26, 26, 26, 26, 26, 27, 27, 27, 27, 27, 27, 27, 27, 27, 27, 28, 28, 28, 28, 28, 28, 28, 28, 28, 28, 29, 29, 29, 29, 29, 29, 29, 29, 29, 29, 29, 29, 30, 30, 30, 30, 30, 30, 30, 30, 30, 30, 30, 30, 30, 30, 31, 31, 31, 31, 31, 31, 31, 31, 31, 31, 31, 31, 31, 31, 31};

struct P {
    const float *x, *c, *mod_w, *mod_b, *norm1_g, *norm2_g, *w_in, *conv_w, *conv_b, *dt_bias, *a_log, *d_skip, *ssm_norm_g, *att_norm_g, *sinks, *rel_bias,
        *w_out, *router_w, *router_bias, *exp_w_gate, *exp_w_up, *exp_w_down, *sh_w_gate, *sh_w_up, *sh_w_down, *final_g;
    float* out; unsigned char* ws;
    int ph_lo, ph_hi, li, pad;
};

#ifdef PROBE_SUB
#define SUB_T() __builtin_amdgcn_s_memrealtime()
#define SUB_END(id, t0) do { if ((PROBE_SUB >> (id)) & 1u) { const unsigned long long _st1 = __builtin_amdgcn_s_memrealtime(); while (__builtin_amdgcn_s_memrealtime() < _st1 + (_st1 - (t0))) __builtin_amdgcn_s_sleep(4); } } while (0)
#else
#define SUB_T() 0ull
#define SUB_END(id, t0) do {} while (0)
#endif
namespace pg8 {
#define PG8_LAS __attribute__((address_space(3)))
typedef short bf16x8 __attribute__((ext_vector_type(8)));
typedef float f32x4 __attribute__((ext_vector_type(4)));
typedef unsigned u32x4 __attribute__((ext_vector_type(4)));
constexpr int BM = 256, BK = 64, HALF = 128, HTB = HALF * BK * 2  , STAGE_BYTES = 8 * HTB, NXCD = 8, WGM = 8;

__host__ __device__ __forceinline__ int lds_byte(int r, int c) { const int st = (r >> 4) * 2 + (c >> 5), rr = r & 15, cc = c & 31, ob = rr * 64 + cc * 2; return st * 1024 + (ob ^ (((ob >> 9) & 1) << 5)); }
__host__ __device__ __forceinline__ void stage_rc(int b, int& R, int& C) { const int st = b / 1024, sb = b % 1024, swz = sb ^ (((sb >> 9) & 1) << 5); R = (st >> 1) * 16 + swz / 64; C = (st & 1) * 32 + (swz % 64) / 2; }
__host__ __device__ __forceinline__ int perm32(int rho) { const int n = rho >> 4, i = rho & 15; return 8 * (i >> 2) + 4 * n + (i & 3); }

struct Unit { int pm, pn, e, nrows, lt; };

__device__ __forceinline__ unsigned cvt_pk_bf16(float lo, float hi) { unsigned r; asm volatile("v_cvt_pk_bf16_f32 %0, %1, %2" : "=v"(r) : "v"(lo), "v"(hi)); return r; }

struct DenseOrder {
    typedef pg8::Unit Unit;
    const char* A; const char* Bt; int K; int nM, nN, nwg, G, c;
    __device__ __forceinline__ void init(const void* A_, const void* Bt_, int M_, int N_, int K_, int G_, int c_) { A = (const char*)A_; Bt = (const char*)Bt_; K = K_; nM = M_ / BM; nN = N_ / BM; nwg = nM * nN; G = G_; c = c_; }
    __device__ __forceinline__ bool next(int i, Unit& u) const {
        const long L = (long)i * G + c; if (L >= nwg) return false;
        int wgid = (int)L; { const int q = nwg / NXCD, r = nwg % NXCD, xcd = wgid % NXCD, off = wgid / NXCD; wgid = (xcd < r ? xcd * (q + 1) : r * (q + 1) + (xcd - r) * q) + off; }
        const int nig = WGM * nN, gid = wgid / nig, fm = gid * WGM, gsz = (nM - fm) < WGM ? (nM - fm) : WGM;
        u.pm = fm + ((wgid % nig) % gsz); u.pn = (wgid % nig) / gsz; u.e = 0; u.nrows = 256; u.lt = 0; return true;
    }
    __device__ __forceinline__ const char* a_base(const Unit& u) const { return A + (size_t)u.pm * 512 * K; }
    __device__ __forceinline__ const char* b_base(const Unit& u) const { return Bt + (size_t)u.pn * 512 * K; }
    __device__ __forceinline__ void lane_off(const Unit&, const int (&R)[2], const int (&C)[2], unsigned (&o)[2][2]) const {
#pragma unroll
        for (int h = 0; h < 2; ++h)
#pragma unroll
            for (int i = 0; i < 2; ++i) o[h][i] = (unsigned)(((h * HALF + R[i]) * K + C[i]) * 2);
    }
    __device__ __forceinline__ void a_ready(const Unit&) const {}
    __device__ __forceinline__ void done(const Unit&) const {}
};

template <class Epi, class Sched, bool ALIGN_EPI = false, bool SP2 = false, bool ALLOW = false>
__device__ __forceinline__ void gemm_phase(PG8_LAS unsigned char* lds, const int K, const Sched& S, const Epi& E) {
    typedef typename Sched::Unit Unit;
    const int tid = threadIdx.x, wid = __builtin_amdgcn_readfirstlane(tid >> 6), lane = tid & 63, wr = wid >> 2, wc = wid & 3, fr = lane & 15, fq = lane >> 4;
    const int nt = K / BK;
    unsigned voffB[2]; int stR[2], stC[2];
#pragma unroll
    for (int i = 0; i < 2; ++i) { int R, C; stage_rc(tid * 16 + i * 8192, R, C); const int Rb = Epi::PERM ? ((R & ~31) + perm32(R & 31)) : R;
        stR[i] = R; stC[i] = C; voffB[i] = (unsigned)(Rb * K + C) * 2u; }
    const size_t kstep = (size_t)(BK * 2);
    const size_t hstep = (size_t)HALF * K * 2;
    const size_t tstep = 2 * hstep;
    const unsigned ldsw = (unsigned)wid * 1024u;
    const int aoff = lds_byte(wr * 64 + fr, fq * 8), boff = lds_byte(wc * 32 + fr, fq * 8);
#define PG8_SA(b, h) (((b) * 2 + (h)) * HTB)
#define PG8_SB(b, h) ((4 + (b) * 2 + (h)) * HTB)
#define PG8_STAGE(bufoff, gbase, voff) do { _Pragma("unroll") for (int _i = 0; _i < 2; ++_i) \
        __builtin_amdgcn_global_load_lds((const unsigned*)((const char*)(gbase) + (voff)[_i]), (PG8_LAS unsigned*)(lds + (bufoff) + ldsw + _i * 8192), 16, 0, 0); } while (0)
#define PG8_LDA(dst, b, h) do { _Pragma("unroll") for (int m = 0; m < 4; ++m) _Pragma("unroll") for (int k = 0; k < 2; ++k) dst[m][k] = *(const PG8_LAS bf16x8*)(lds + PG8_SA(b, h) + aoff + m * 2048 + k * 1024); } while (0)
#define PG8_LDB(dst, b, h) do { _Pragma("unroll") for (int n = 0; n < 2; ++n) _Pragma("unroll") for (int k = 0; k < 2; ++k) dst[n][k] = *(const PG8_LAS bf16x8*)(lds + PG8_SB(b, h) + boff + n * 2048 + k * 1024); } while (0)
#define PG8_MMA(ai, bj, At, Bt) do { __builtin_amdgcn_s_setprio(1); _Pragma("unroll") for (int m = 0; m < 4; ++m) _Pragma("unroll") for (int n = 0; n < 2; ++n) _Pragma("unroll") for (int k = 0; k < 2; ++k) \
        acc[ai][bj][m][n] = __builtin_amdgcn_mfma_f32_16x16x32_bf16(Bt[n][k], At[m][k], acc[ai][bj][m][n], 0, 0, 0); __builtin_amdgcn_s_setprio(0); } while (0)
#define PG8_WAIT_V(n) asm volatile("s_waitcnt vmcnt(" #n ")" ::: "memory")
#define PG8_WAIT_L(n) asm volatile("s_waitcnt lgkmcnt(" #n ")" ::: "memory")
#define PG8_WAIT_VA() do { if (ALLOW && t == 0 && ns_pending >= 8) { if (ns_pending >= 16) PG8_WAIT_V(24); else PG8_WAIT_V(16); } else PG8_WAIT_V(8); } while (0)
#define PG8_BAR __builtin_amdgcn_s_barrier()
#define PG8_SCHED __builtin_amdgcn_sched_barrier(0)
    Unit cur, nxt; int ui = 0; int ns_pending = 0; typename Epi::State est;
    if (!S.next(0, cur)) return;
    f32x4 acc[2][2][4][2];
#pragma unroll
    for (int a = 0; a < 2; ++a)
#pragma unroll
        for (int b = 0; b < 2; ++b)
#pragma unroll
            for (int m = 0; m < 4; ++m)
#pragma unroll
                for (int n = 0; n < 2; ++n) acc[a][b][m][n] = (f32x4){0.f, 0.f, 0.f, 0.f};
    bf16x8 At[4][2], B0[2][2], B1[2][2];
    const char* cA = S.a_base(cur); const char* cB = S.b_base(cur);
    unsigned oc[2][2], on[2][2];
    S.lane_off(cur, stR, stC, oc);
    S.a_ready(cur);
    if constexpr (SP2) {
        PG8_STAGE(PG8_SB(0, 0), cB, voffB); PG8_STAGE(PG8_SB(0, 1), cB + hstep, voffB); PG8_STAGE(PG8_SA(0, 0), cA, oc[0]); PG8_STAGE(PG8_SA(0, 1), cA, oc[1]);
        if (wr == 1) PG8_BAR;
        PG8_WAIT_V(2); PG8_BAR;
        PG8_STAGE(PG8_SB(1, 0), cB + kstep, voffB); PG8_STAGE(PG8_SA(1, 0), cA + kstep, oc[0]); PG8_STAGE(PG8_SB(1, 1), cB + hstep + kstep, voffB);
        PG8_WAIT_V(6); PG8_BAR;
    } else {
        PG8_STAGE(PG8_SB(0, 0), cB, voffB); PG8_STAGE(PG8_SA(0, 0), cA, oc[0]); PG8_STAGE(PG8_SB(0, 1), cB + hstep, voffB); PG8_STAGE(PG8_SA(0, 1), cA, oc[1]);
        if (wr == 1) PG8_BAR;
        PG8_WAIT_V(4); PG8_BAR;
        PG8_STAGE(PG8_SB(1, 0), cB + kstep, voffB); PG8_STAGE(PG8_SA(1, 0), cA + kstep, oc[0]); PG8_STAGE(PG8_SB(1, 1), cB + hstep + kstep, voffB);
        PG8_WAIT_V(6); PG8_BAR;
    }
    for (;;) {
        const bool has_next = S.next(ui + 1, nxt);
        E.pre(cur, wr, wc, fr, fq, est);
        const char* nA = has_next ? S.a_base(nxt) : cA; const char* nB = has_next ? S.b_base(nxt) : cB;
        if (has_next) S.lane_off(nxt, stR, stC, on); else {
#pragma unroll
            for (int h = 0; h < 2; ++h)
#pragma unroll
                for (int i = 0; i < 2; ++i) on[h][i] = oc[h][i]; }
        const unsigned long long _gs0 = SUB_T();
        asm volatile(".p2align 8" ::: "memory");
#pragma unroll 1
        for (int t = 0; t < nt; t += 2) {
            const bool last = (t == nt - 2);
            const char* a1 = cA + (size_t)(t + 1) * kstep;
            const char* a2 = last ? nA : cA + (size_t)(t + 2) * kstep; const char* b2 = last ? nB : cB + (size_t)(t + 2) * kstep;
            const char* a3 = a2 + kstep; const char* b3 = b2 + kstep;
            unsigned o2[2][2];
#pragma unroll
            for (int h = 0; h < 2; ++h)
#pragma unroll
                for (int i = 0; i < 2; ++i) o2[h][i] = last ? on[h][i] : oc[h][i];
            if (last && has_next) S.a_ready(nxt);
            if constexpr (Epi::MIDSCALE) { if (t == nt / 2) E.mid(acc, cur, wr, fr); }
            if constexpr (SP2) {
            PG8_LDB(B0, 0, 0); PG8_LDB(B1, 0, 1); PG8_SCHED; PG8_LDA(At, 0, 0); PG8_STAGE(PG8_SA(1, 1), a1, oc[1]);
            PG8_WAIT_VA(); PG8_WAIT_L(0); PG8_BAR; PG8_MMA(0, 0, At, B0); PG8_MMA(0, 1, At, B1); PG8_BAR; PG8_SCHED;
            PG8_LDA(At, 0, 1); PG8_STAGE(PG8_SB(0, 0), b2, voffB); PG8_STAGE(PG8_SB(0, 1), b2 + hstep, voffB); PG8_STAGE(PG8_SA(0, 0), a2, o2[0]);
            PG8_WAIT_VA(); PG8_WAIT_L(0); PG8_BAR; PG8_MMA(1, 0, At, B0); PG8_MMA(1, 1, At, B1); PG8_BAR; PG8_SCHED;
            PG8_LDB(B0, 1, 0); PG8_LDB(B1, 1, 1); PG8_SCHED; PG8_LDA(At, 1, 0); PG8_STAGE(PG8_SA(0, 1), a2, o2[1]);
            PG8_WAIT_V(8); PG8_WAIT_L(0); PG8_BAR; PG8_MMA(0, 0, At, B0); PG8_MMA(0, 1, At, B1); PG8_BAR; PG8_SCHED;
            PG8_LDA(At, 1, 1); PG8_STAGE(PG8_SB(1, 0), b3, voffB); PG8_STAGE(PG8_SB(1, 1), b3 + hstep, voffB); PG8_STAGE(PG8_SA(1, 0), a3, o2[0]);
            PG8_WAIT_V(8); PG8_WAIT_L(0); PG8_BAR; PG8_MMA(1, 0, At, B0); PG8_MMA(1, 1, At, B1); PG8_BAR; PG8_SCHED;
            } else {
            PG8_LDB(B0, 0, 0); PG8_SCHED; PG8_LDA(At, 0, 0); PG8_STAGE(PG8_SA(1, 1), a1, oc[1]);
            PG8_WAIT_L(8); PG8_BAR; PG8_WAIT_L(0); PG8_MMA(0, 0, At, B0); PG8_BAR; PG8_SCHED;
            PG8_LDB(B1, 0, 1); PG8_STAGE(PG8_SB(0, 0), b2, voffB);
            PG8_BAR; PG8_WAIT_L(0); PG8_MMA(0, 1, At, B1); PG8_BAR;
            PG8_LDA(At, 0, 1); PG8_STAGE(PG8_SA(0, 0), a2, o2[0]);
            PG8_BAR; PG8_WAIT_L(0); PG8_MMA(1, 0, At, B0); PG8_BAR; PG8_SCHED;
            PG8_STAGE(PG8_SB(0, 1), b2 + hstep, voffB);
            PG8_WAIT_V(6); PG8_BAR; PG8_MMA(1, 1, At, B1); PG8_BAR;
            PG8_LDB(B0, 1, 0); PG8_SCHED; PG8_LDA(At, 1, 0); PG8_STAGE(PG8_SA(0, 1), a2, o2[1]);
            PG8_WAIT_L(8); PG8_BAR; PG8_WAIT_L(0); PG8_MMA(0, 0, At, B0); PG8_BAR; PG8_SCHED;
            PG8_LDB(B1, 1, 1); PG8_STAGE(PG8_SB(1, 0), b3, voffB);
            PG8_BAR; PG8_WAIT_L(0); PG8_MMA(0, 1, At, B1); PG8_BAR;
            PG8_LDA(At, 1, 1); PG8_STAGE(PG8_SA(1, 0), a3, o2[0]);
            PG8_BAR; PG8_WAIT_L(0); PG8_MMA(1, 0, At, B0); PG8_BAR; PG8_SCHED;
            PG8_STAGE(PG8_SB(1, 1), b3 + hstep, voffB);
            PG8_WAIT_V(6); PG8_BAR; PG8_MMA(1, 1, At, B1); PG8_BAR;
            }
        }
        if constexpr (Epi::PROBE_TAG == 1) { SUB_END(0, _gs0); }
        const unsigned long long _gs1 = SUB_T();
        if constexpr (ALIGN_EPI) { if (wr == 0) PG8_BAR; }
        if constexpr (!Epi::AFTER_DRAIN) { E(acc, cur, wr, wc, fr, fq, est); S.done(cur); ns_pending = E.nstore(cur); }
        if constexpr (Epi::PROBE_TAG == 1) { SUB_END(1, _gs1); }
        if (!has_next) break;
#pragma unroll
        for (int a = 0; a < 2; ++a)
#pragma unroll
            for (int b = 0; b < 2; ++b)
#pragma unroll
                for (int m = 0; m < 4; ++m)
#pragma unroll
                    for (int n = 0; n < 2; ++n) acc[a][b][m][n] = (f32x4){0.f, 0.f, 0.f, 0.f};
        cur = nxt; cA = nA; cB = nB; ++ui;
#pragma unroll
        for (int h = 0; h < 2; ++h)
#pragma unroll
            for (int i = 0; i < 2; ++i) oc[h][i] = on[h][i];
        if constexpr (ALIGN_EPI) { if (wr == 1) PG8_BAR; }
    }
    PG8_WAIT_V(0);
    if constexpr (!ALIGN_EPI) { if (wr == 0) PG8_BAR; }
    PG8_BAR;
    if constexpr (Epi::AFTER_DRAIN) { E.fused(acc, cur, wr, wc, fr, fq, lds, wid, lane); S.done(cur); }
#undef PG8_SA
#undef PG8_SB
#undef PG8_STAGE
#undef PG8_LDA
#undef PG8_LDB
#undef PG8_MMA
#undef PG8_WAIT_V
#undef PG8_WAIT_L
#undef PG8_WAIT_VA
#undef PG8_BAR
#undef PG8_SCHED
}
}

#define GAS __attribute__((address_space(1)))
#define LAS __attribute__((address_space(3)))
typedef unsigned v4u __attribute__((ext_vector_type(4)));
typedef float f32x4 __attribute__((ext_vector_type(4)));
typedef GAS unsigned gu32;
#define RLX_AGENT __ATOMIC_RELAXED, __HIP_MEMORY_SCOPE_AGENT
#define LDS_WAIT() asm volatile("s_waitcnt lgkmcnt(0)" ::: "memory")
#define VM_WAIT() asm volatile("s_waitcnt vmcnt(0)" ::: "memory")
constexpr int NWAVES = 8;
constexpr int RING_OFF = 0, RING_BYTES = 131072;
constexpr int LDS_BYTES = 163840;
constexpr int LDSCTL_OFF = LDS_BYTES - 4096, MISC_OFF = LDSCTL_OFF + 320;
constexpr int PLAN_OFF = LDSCTL_OFF + 1024;

#define XB_TMO      128
#define XB_XCNT(j)  (256  + 64 * (j))
#define XB_XSUB(j)  (1280 + 64 * (j))
#define XB_XGEN(j)  (2304 + 64 * (j))
#define XB_TOP      3328
#define XB_TOPGEN   3392
#define XCD_BAR_WORDS 3456
#define XB_SPIN_CAP (1u << 18)

__device__ __forceinline__ unsigned xb_ld(unsigned* p)              { return __hip_atomic_load(p, __ATOMIC_RELAXED, __HIP_MEMORY_SCOPE_AGENT); }
__device__ __forceinline__ unsigned xb_add(unsigned* p, unsigned v) { return __hip_atomic_fetch_add(p, v, __ATOMIC_RELAXED, __HIP_MEMORY_SCOPE_AGENT); }
__device__ __forceinline__ unsigned xb_xcc_id() { return (unsigned)__builtin_amdgcn_s_getreg((3 << 11) | 20) & 0xFu; }
#define XB_SPIN(cond, bar) do { unsigned _sp = 0; while (cond) { __builtin_amdgcn_s_sleep(1); \
    if ((++_sp & 255u) == 0u) { if (xb_ld(&(bar)[XB_TMO])) break; if (_sp > XB_SPIN_CAP) { atomicAdd(&(bar)[XB_TMO], 1u); break; } } } } while (0)

struct XcdBarrier {
    unsigned* bar; unsigned x;
    volatile LAS unsigned* st;
};

__device__ __forceinline__ XcdBarrier xcd_barrier_post(unsigned* bar, volatile LAS unsigned* st) {
    XcdBarrier b; b.bar = bar; b.x = xb_xcc_id(); b.st = st;
    if (threadIdx.x == 0) (void)xb_add(&bar[XB_XCNT(b.x)], 1u);
    return b;
}
__device__ __forceinline__ void xcd_barrier_complete(unsigned* bar, unsigned x, unsigned& nloc, unsigned& nx) {
    const unsigned G = gridDim.x * gridDim.y * gridDim.z;
    unsigned sum, cnt, mine, sp = 0u;
    for (;;) {
        sum = 0u; cnt = 0u; mine = 0u;
#pragma unroll
        for (unsigned j = 0; j < 16; ++j) { const unsigned c = xb_ld(&bar[XB_XCNT(j)]); sum += c; cnt += (c > 0u) ? 1u : 0u; mine = (j == x) ? c : mine; }
        if (sum == G) break;
        __builtin_amdgcn_s_sleep(1);
        if ((++sp & 255u) == 0u) { if (xb_ld(&bar[XB_TMO])) break; if (sp > XB_SPIN_CAP) { atomicAdd(&bar[XB_TMO], 1u); break; } }
    }
    nloc = mine > 0u ? mine : 1u; nx = cnt > 0u ? cnt : 1u;
}

__device__ __forceinline__ void xcd_barrier(const XcdBarrier& b) {
    asm volatile("s_waitcnt vmcnt(0)" ::: "memory");
    __syncthreads();
    if (threadIdx.x == 0) {
        unsigned* bar = b.bar;
        __builtin_amdgcn_s_waitcnt(0);
        unsigned nloc = b.st[0], nx = b.st[1];
        if (nloc == 0u) { xcd_barrier_complete(bar, b.x, nloc, nx); b.st[0] = nloc; b.st[1] = nx; }
        const unsigned old = xb_add(&bar[XB_XSUB(b.x)], 1u);
        const unsigned gen = old / nloc;
        if (old + 1u == (gen + 1u) * nloc) {
            __builtin_amdgcn_fence(__ATOMIC_RELEASE, "agent");
            asm volatile("s_waitcnt vmcnt(0)" ::: "memory");
            const unsigned og = xb_add(&bar[XB_TOP], 1u);
            const unsigned tg = og / nx;
            if (og + 1u == (tg + 1u) * nx) xb_add(&bar[XB_TOPGEN], 1u);
            else XB_SPIN(xb_ld(&bar[XB_TOPGEN]) == tg, bar);
            __builtin_amdgcn_fence(__ATOMIC_ACQUIRE, "agent");
            xb_add(&bar[XB_XGEN(b.x)], 1u);
            asm volatile("s_waitcnt vmcnt(0)" ::: "memory");
        } else {
            XB_SPIN(xb_ld(&bar[XB_XGEN(b.x)]) == gen, bar);
            __builtin_amdgcn_fence(__ATOMIC_ACQUIRE, "agent");
            asm volatile("s_waitcnt vmcnt(0)" ::: "memory");
        }
    }
    __syncthreads();
}

__device__ __forceinline__ float wave_sum(float v) {
#pragma unroll
    for (int o = 1; o < 64; o <<= 1) v += __shfl_xor(v, o);
    return v;
}

struct EpiIn { static constexpr int PROBE_TAG = 0; static constexpr bool MIDSCALE = false; struct State {}; __device__ __forceinline__ void pre(const pg8::Unit&, int, int, int, int, State&) const {}
    static constexpr bool PERM = true, AFTER_DRAIN = false;
    __device__ __forceinline__ int nstore(const pg8::Unit& u) const { return u.pn == 18 ? 0 : 16; }
    bf16_t *zq, *xbc, *kk, *vv; float* dt;
    __device__ __forceinline__ void operator()(const pg8::f32x4 (&acc)[2][2][4][2], const pg8::Unit& u, int wr, int wc, int fr, int fq, const State&) const {
        const int row0 = u.pm * 256 + wr * 64 + fr, pn = u.pn;
        if (pn == 18) {
            if (wc == 0 && fq < 2) {
#pragma unroll
                for (int ai = 0; ai < 2; ++ai)
#pragma unroll
                    for (int m = 0; m < 4; ++m) { float* o = dt + (size_t)(row0 + ai * 128 + m * 16) * 16 + 8 * fq; *(pg8::f32x4*)o = acc[ai][0][m][0]; *(pg8::f32x4*)(o + 4) = acc[ai][0][m][1]; }
            }
            return;
        }
        bf16_t* base; int ldc, colt;
        if (pn < 4) { base = zq; ldc = 2048; colt = ZQ_Z + pn * 256; }
        else if (pn < 12) { base = xbc; ldc = 2048; colt = (pn - 4) * 256; }
        else if (pn < 16) { base = zq; ldc = 2048; colt = ZQ_Q + (pn - 12) * 256; }
        else if (pn == 16) { base = kk; ldc = 256; colt = 0; }
        else { base = vv; ldc = 256; colt = 0; }
        const int col0 = colt + wc * 32 + 8 * fq;
#pragma unroll
        for (int ai = 0; ai < 2; ++ai)
#pragma unroll
            for (int m = 0; m < 4; ++m) { bf16_t* rowp = base + (size_t)(row0 + ai * 128 + m * 16) * ldc + col0;
#pragma unroll
                for (int bj = 0; bj < 2; ++bj) { const pg8::f32x4 v0 = acc[ai][bj][m][0], v1 = acc[ai][bj][m][1];
                    pg8::u32x4 w; w.x = pg8::cvt_pk_bf16(v0[0], v0[1]); w.y = pg8::cvt_pk_bf16(v0[2], v0[3]); w.z = pg8::cvt_pk_bf16(v1[0], v1[1]); w.w = pg8::cvt_pk_bf16(v1[2], v1[3]);
                    *(pg8::u32x4*)(rowp + bj * 128) = w; } }
    }
};

struct EpiOut { static constexpr int PROBE_TAG = 0; static constexpr bool MIDSCALE = true; struct State {}; __device__ __forceinline__ void pre(const pg8::Unit&, int, int, int, int, State&) const {}
    static constexpr bool PERM = true, AFTER_DRAIN = false;
    __device__ __forceinline__ int nstore(const pg8::Unit&) const { return 16; }
    const float* x; float* x1; const float* mod; const float* ratt;
    __device__ __forceinline__ void mid(pg8::f32x4 (&acc)[2][2][4][2], const pg8::Unit& u, int wr, int fr) const {
        float rs[2][4];
#pragma unroll
        for (int ai = 0; ai < 2; ++ai)
#pragma unroll
            for (int m = 0; m < 4; ++m) rs[ai][m] = ratt[u.pm * 256 + ai * 128 + wr * 64 + m * 16 + fr];
#pragma unroll
        for (int ai = 0; ai < 2; ++ai)
#pragma unroll
            for (int bj = 0; bj < 2; ++bj)
#pragma unroll
                for (int m = 0; m < 4; ++m)
#pragma unroll
                    for (int n = 0; n < 2; ++n) acc[ai][bj][m][n] = acc[ai][bj][m][n] * rs[ai][m];
    }
    __device__ __forceinline__ void operator()(const pg8::f32x4 (&acc)[2][2][4][2], const pg8::Unit& u, int wr, int wc, int fr, int fq, const State&) const {
        const int row0 = u.pm * 256 + wr * 64 + fr, col0 = u.pn * 256 + wc * 32 + 8 * fq, b = (u.pm * 256) / SEQ;
        const float* g1 = mod + b * 6 * D + 2 * D + col0;
        pg8::f32x4 gv[2][2];
#pragma unroll
        for (int bj = 0; bj < 2; ++bj) { gv[bj][0] = *(const pg8::f32x4*)(g1 + bj * 128); gv[bj][1] = *(const pg8::f32x4*)(g1 + bj * 128 + 4); }
#pragma unroll
        for (int ai = 0; ai < 2; ++ai)
#pragma unroll
            for (int m = 0; m < 4; ++m) { const size_t off = (size_t)(row0 + ai * 128 + m * 16) * D + col0;
#pragma unroll
                for (int bj = 0; bj < 2; ++bj) { const float* xi = x + off + bj * 128; float* xo = x1 + off + bj * 128;
                    *(pg8::f32x4*)xo = *(const pg8::f32x4*)xi + gv[bj][0] * acc[ai][bj][m][0]; *(pg8::f32x4*)(xo + 4) = *(const pg8::f32x4*)(xi + 4) + gv[bj][1] * acc[ai][bj][m][1]; } }
    }
};
struct EpiGU { static constexpr int PROBE_TAG = 0; static constexpr bool MIDSCALE = false; struct State {}; __device__ __forceinline__ void pre(const pg8::Unit&, int, int, int, int, State&) const {}
    static constexpr bool PERM = true, AFTER_DRAIN = false;
    __device__ __forceinline__ int nstore(const pg8::Unit&) const { return 8; }
    bf16_t* u;
    __device__ __forceinline__ void operator()(const pg8::f32x4 (&acc)[2][2][4][2], const pg8::Unit& un, int wr, int wc, int fr, int fq, const State&) const {
        const int row0 = un.pm * 256 + wr * 64 + fr, col0 = un.pn * 128 + wc * 32 + 8 * fq;
#pragma unroll
        for (int ai = 0; ai < 2; ++ai)
#pragma unroll
            for (int m = 0; m < 4; ++m) { bf16_t* rowp = u + (size_t)(row0 + ai * 128 + m * 16) * ED + col0;
                float o[8];
#pragma unroll
                for (int n = 0; n < 2; ++n)
#pragma unroll
                    for (int j = 0; j < 4; ++j) o[4 * n + j] = silu_f(acc[ai][0][m][n][j]) * acc[ai][1][m][n][j];
                pg8::u32x4 w; w.x = pg8::cvt_pk_bf16(o[0], o[1]); w.y = pg8::cvt_pk_bf16(o[2], o[3]); w.z = pg8::cvt_pk_bf16(o[4], o[5]); w.w = pg8::cvt_pk_bf16(o[6], o[7]);
                *(pg8::u32x4*)rowp = w; }
    }
};
constexpr float YC_SCALE = 16.f;
struct EpiDown {
    static constexpr bool PERM = true, AFTER_DRAIN = false;
    static constexpr int PROBE_TAG = 1; static constexpr bool MIDSCALE = false; struct State { unsigned pm[8]; };
    unsigned char* yc; const unsigned* pmeta; unsigned char* dump;
    __device__ __forceinline__ int nstore(const pg8::Unit&) const { return 8; }
    __device__ __forceinline__ void pre(const pg8::Unit& u, int wr, int wc, int fr, int fq, State& st) const {
        if (u.e < NE) { const unsigned* lp = pmeta + (size_t)u.e * M + u.lt * 256;
#pragma unroll
            for (int i = 0; i < 8; ++i) { const int r = (i >> 2) * 128 + wr * 64 + (i & 3) * 16 + fr; st.pm[i] = lp[r < u.nrows ? r : 0]; }
#pragma unroll
            for (int i = 0; i < 8; ++i) { const int r = (i >> 2) * 128 + wr * 64 + (i & 3) * 16 + fr; if (r >= u.nrows) st.pm[i] = 0xffffffffu; }
        } else {
#pragma unroll
            for (int i = 0; i < 8; ++i) { const int r = (i >> 2) * 128 + wr * 64 + (i & 3) * 16 + fr; st.pm[i] = r < u.nrows ? ((unsigned)((u.lt * 256 + r) * NSLOT + 8) << 14) | 4096u : 0xffffffffu; }
        }
    }
    __device__ __forceinline__ void operator()(const pg8::f32x4 (&acc)[2][2][4][2], const pg8::Unit& u, int wr, int wc, int fr, int fq, const State& st) const {
        const unsigned pos0 = (unsigned)(u.pn * 256 + wc * 64 + fq * 16);
#pragma unroll
        for (int ai = 0; ai < 2; ++ai)
#pragma unroll
            for (int m = 0; m < 4; ++m) { const unsigned pmv = st.pm[ai * 4 + m]; const float gt = (float)(pmv & 0x3fffu) * (YC_SCALE / 4096.f);
                unsigned char* dst = pmv != 0xffffffffu ? yc + ((size_t)(pmv >> 14) * 1024u + pos0) : dump + (threadIdx.x & 511) * 16;
                pg8::u32x4 w;
#pragma unroll
                for (int bj = 0; bj < 2; ++bj)
#pragma unroll
                    for (int n = 0; n < 2; ++n) { const pg8::f32x4 v = acc[ai][bj][m][n] * gt; int q = __builtin_amdgcn_cvt_pk_fp8_f32(v[0], v[1], 0, false); q = __builtin_amdgcn_cvt_pk_fp8_f32(v[2], v[3], q, true); w[bj * 2 + n] = (unsigned)q; }
                *(pg8::u32x4*)dst = w; }
    }
};
template <bool GATHER>
struct GroupedOrder {
    typedef pg8::Unit Unit;
    const char* A; const char* Bt; int K, nN, G, c, total; const LAS int* plan; const int* list; size_t bs_e, bs_pn; int pn0;
    __device__ __forceinline__ void init(const void* A_, const void* Bt_, int K_, int nN_, int G_, int c_, const LAS int* plan_, const int* list_, size_t bs_e_, size_t bs_pn_, int pn0_) {
        A = (const char*)A_; Bt = (const char*)Bt_; K = K_; nN = nN_; G = G_; c = c_; plan = plan_; list = list_; bs_e = bs_e_; bs_pn = bs_pn_; pn0 = pn0_; total = __builtin_amdgcn_readfirstlane(plan[NE + 1]) * nN; }
    __device__ __forceinline__ bool next(int i, Unit& u) const {
        const int L = i * G + c; if (L >= total) return false;
        int wgid = L; { const int q = total / 8, r = total % 8, xcd = wgid % 8, off = wgid / 8; wgid = (xcd < r ? xcd * (q + 1) : r * (q + 1) + (xcd - r) * q) + off; }
        const int tile = wgid / nN; u.pn = wgid % nN; u.pm = tile;
        int e = 0;
        for (int j = 1; j <= NE; ++j) e += (plan[j] <= tile) ? 1 : 0;
        e = __builtin_amdgcn_readfirstlane(e);
        u.e = e; u.lt = __builtin_amdgcn_readfirstlane(tile - plan[e]); const int rem = __builtin_amdgcn_readfirstlane(plan[80 + e]) - u.lt * 256; u.nrows = rem < 256 ? rem : 256; return true;
    }
    __device__ __forceinline__ const char* a_base(const Unit& u) const { return GATHER ? A : A + (size_t)u.pm * 512 * K; }
    __device__ __forceinline__ const char* b_base(const Unit& u) const { return Bt + (size_t)u.e * bs_e + (size_t)(pn0 + u.pn) * bs_pn; }
    __device__ __forceinline__ void lane_off(const Unit& u, const int (&R)[2], const int (&C)[2], unsigned (&o)[2][2]) const {
#pragma unroll
        for (int h = 0; h < 2; ++h)
#pragma unroll
            for (int i = 0; i < 2; ++i) { const int r = h * 128 + R[i];
                if (GATHER) { int tok = 0; if (r < u.nrows) { const int idx = u.lt * 256 + r; tok = u.e < NE ? (list[(size_t)u.e * M + idx] >> 3) : idx; }
                    o[h][i] = (unsigned)((tok * K + C[i]) * 2); }
                else o[h][i] = (unsigned)((r * K + C[i]) * 2); }
    }
    __device__ __forceinline__ void a_ready(const Unit&) const {}
    __device__ __forceinline__ void done(const Unit&) const {}
};

template <class CM>
__device__ __forceinline__ void transpose_item(const float* W, int ldw, bf16_t* WT, int ldt, int k0, int n0, LAS float* scr, int lane, const CM& colmap, int ksrc0 = -1, const float* kscale = nullptr) {
    const int sc = colmap(n0 + (lane & 31)); if (ksrc0 < 0) ksrc0 = k0;
#pragma unroll
    for (int i = 0; i < 32; ++i) { const int kk = 2 * i + (lane >> 5); scr[kk * 33 + (lane & 31)] = sc >= 0 ? W[(size_t)(ksrc0 + kk) * ldw + sc] * (kscale ? kscale[kk] : 1.f) : 0.f; }
    LDS_WAIT(); asm volatile("" ::: "memory");
    const int c = lane & 7;
#pragma unroll
    for (int j = 0; j < 4; ++j) { const int n = (lane >> 3) + 8 * j; const LAS float* s = scr + (8 * c) * 33 + n;
        v4u o; o.x = pk2(s[0 * 33], s[1 * 33]); o.y = pk2(s[2 * 33], s[3 * 33]); o.z = pk2(s[4 * 33], s[5 * 33]); o.w = pk2(s[6 * 33], s[7 * 33]);
        *(GAS v4u*)(WT + (size_t)(n0 + n) * ldt + k0 + 8 * c) = o; }
    LDS_WAIT(); asm volatile("" ::: "memory");
}

typedef short v4i16_t __attribute__((ext_vector_type(4)));
__device__ __forceinline__ v4i16_t tr4(const LAS unsigned char* img, int stride, int row0, int col0, int lane) {
    const LAS unsigned char* a = img + (row0 + ((lane & 15) >> 2)) * stride + (col0 + 4 * (lane & 3)) * 2;
    return __builtin_amdgcn_ds_read_tr16_b64_v4i16((LAS v4i16_t*)a);
}
__device__ __forceinline__ pg8::bf16x8 cat44(v4i16_t lo, v4i16_t hi) { return (pg8::bf16x8){lo[0], lo[1], lo[2], lo[3], hi[0], hi[1], hi[2], hi[3]}; }

template <class EMIT>
__device__ __forceinline__ void conv16x8(const bf16_t* xbc, const float* cw, const float* cb, int row0, int t0, int ch, const EMIT& emit) {
    v4u raw[19];
#pragma unroll
    for (int k = 0; k < 19; ++k) { raw[k] = (v4u){0u, 0u, 0u, 0u}; if (t0 - 3 + k >= 0) raw[k] = *(const v4u*)(xbc + (size_t)(row0 - 3 + k) * CONV_CH + ch); }
    float wv[4][8], bv[8];
#pragma unroll
    for (int k = 0; k < 4; ++k) { const f32x4 a = *(const f32x4*)(cw + k * CONV_CH + ch), b = *(const f32x4*)(cw + k * CONV_CH + ch + 4); wv[k][0] = a.x; wv[k][1] = a.y; wv[k][2] = a.z; wv[k][3] = a.w; wv[k][4] = b.x; wv[k][5] = b.y; wv[k][6] = b.z; wv[k][7] = b.w; }
    { const f32x4 a = *(const f32x4*)(cb + ch), b = *(const f32x4*)(cb + ch + 4); bv[0] = a.x; bv[1] = a.y; bv[2] = a.z; bv[3] = a.w; bv[4] = b.x; bv[5] = b.y; bv[6] = b.z; bv[7] = b.w; }
    float win[4][8];
#pragma unroll
    for (int k = 0; k < 3; ++k) { const unsigned w4[4] = {raw[k].x, raw[k].y, raw[k].z, raw[k].w};
#pragma unroll
        for (int j = 0; j < 4; ++j) { win[k][2 * j] = __uint_as_float(w4[j] << 16); win[k][2 * j + 1] = __uint_as_float(w4[j] & 0xffff0000u); } }
#pragma unroll
    for (int r = 0; r < 16; ++r) {
        { const unsigned w4[4] = {raw[r + 3].x, raw[r + 3].y, raw[r + 3].z, raw[r + 3].w};
#pragma unroll
          for (int j = 0; j < 4; ++j) { win[(r + 3) & 3][2 * j] = __uint_as_float(w4[j] << 16); win[(r + 3) & 3][2 * j + 1] = __uint_as_float(w4[j] & 0xffff0000u); } }
        float o[8];
#pragma unroll
        for (int j = 0; j < 8; ++j) { float a = bv[j];
#pragma unroll
            for (int k = 0; k < 4; ++k) a += wv[k][j] * win[(r + k) & 3][j];
            o[j] = silu_f(a); }
        emit(r, o);
    }
}

__device__ __forceinline__ void conv2x8(const bf16_t* xbc, const float* cw, const float* cb, int row, int t, int ch, float (&o0)[8], float (&o1)[8]) {
    float xr[5][8];
#pragma unroll
    for (int k = 0; k < 5; ++k) { v4u raw = (v4u){0u, 0u, 0u, 0u}; if (t - 3 + k >= 0) raw = *(const v4u*)(xbc + (size_t)(row - 3 + k) * CONV_CH + ch);
        const unsigned w4[4] = {raw.x, raw.y, raw.z, raw.w};
#pragma unroll
        for (int j = 0; j < 4; ++j) { xr[k][2 * j] = __uint_as_float(w4[j] << 16); xr[k][2 * j + 1] = __uint_as_float(w4[j] & 0xffff0000u); } }
    float wv[4][8], bv[8];
#pragma unroll
    for (int k = 0; k < 4; ++k) { const f32x4 a = *(const f32x4*)(cw + k * CONV_CH + ch), b = *(const f32x4*)(cw + k * CONV_CH + ch + 4); wv[k][0] = a.x; wv[k][1] = a.y; wv[k][2] = a.z; wv[k][3] = a.w; wv[k][4] = b.x; wv[k][5] = b.y; wv[k][6] = b.z; wv[k][7] = b.w; }
    { const f32x4 a = *(const f32x4*)(cb + ch), b = *(const f32x4*)(cb + ch + 4); bv[0] = a.x; bv[1] = a.y; bv[2] = a.z; bv[3] = a.w; bv[4] = b.x; bv[5] = b.y; bv[6] = b.z; bv[7] = b.w; }
#pragma unroll
    for (int j = 0; j < 8; ++j) { float a0 = bv[j], a1 = bv[j];
#pragma unroll
        for (int k = 0; k < 4; ++k) { a0 += wv[k][j] * xr[k][j]; a1 += wv[k][j] * xr[k + 1][j]; }
        o0[j] = silu_f(a0); o1[j] = silu_f(a1); }
}

constexpr int NPHASE = 12;
__global__ void __launch_bounds__(NWAVES * 64, 2) mega(P p) {
    extern __shared__ __attribute__((aligned(16))) unsigned char lds_raw[];
    LAS unsigned char* lds = (LAS unsigned char*)lds_raw;
    volatile LAS unsigned* MISC = (volatile LAS unsigned*)(lds + MISC_OFF);
    const int tid = threadIdx.x, lane = tid & 63, wave = __builtin_amdgcn_readfirstlane(tid >> 6);
    const int G = gridDim.x; const int bx = blockIdx.x; const int vcu = (G % 8 == 0) ? (bx % 8) * (G / 8) + bx / 8 : bx;
    unsigned char* ws = p.ws;
    gu32* ctl = (gu32*)(ws + WS_CTL);
    for (int u = tid; u < (LDS_BYTES - LDSCTL_OFF) / 4; u += NWAVES * 64) ((LAS unsigned*)(lds + LDSCTL_OFF))[u] = 0u;
    __syncthreads();
    XcdBarrier bar = xcd_barrier_post((unsigned*)(ctl + CW_BAR) + p.li * XCD_BAR_WORDS, MISC + 8);
    const int lo = p.ph_lo, hi = p.ph_hi;
#ifndef PHMASK
#define PHMASK 0xffffffffu
#endif
#define IN(k) (((PHMASK >> (k)) & 1u) && lo <= (k) && (k) < hi)
#define BOTH(k) (IN(k) && IN((k) + 1))
#ifdef PROBE_MASK
#define PH_BEGIN() const unsigned long long _pt0 = __builtin_amdgcn_s_memrealtime()
#define PH_END(k) do { if ((PROBE_MASK >> (k)) & 1u) { const unsigned long long _pt1 = __builtin_amdgcn_s_memrealtime(); while (__builtin_amdgcn_s_memrealtime() < _pt1 + (_pt1 - _pt0)) __builtin_amdgcn_s_sleep(8); } } while (0)
#else
#define PH_BEGIN() do {} while (0)
#define PH_END(k) do {} while (0)
#endif
    const int gw = vcu * NWAVES + wave, NGW = G * NWAVES;
    float* modv = (float*)(ws + WS_MOD);

    constexpr int I_GU = 16 * 16, I_D = 4 * 32, QBATCH = 16, N_WGU_P0 = 7168;
    LAS int* qslot = (LAS int*)(lds + PLAN_OFF + 1024);
#define STEAL_ITEMS(qword, NITEMS, ITEM_BODY) do { LAS float* scr = (LAS float*)(lds + RING_OFF + wave * 16384); \
        for (;;) { __syncthreads(); if (tid == 0) *qslot = (int)atomicAdd((unsigned*)(ws + WS_CTL) + (qword), (unsigned)QBATCH); __syncthreads(); \
            const int qb_ = __builtin_amdgcn_readfirstlane(*qslot); if (qb_ >= (NITEMS)) break; \
            for (int it = qb_ + wave; it < qb_ + QBATCH && it < (NITEMS); it += NWAVES) { ITEM_BODY } } } while (0)
#define ITEM_WGU { const int e = it / I_GU, r = it % I_GU, nb = r & 15, kb = r >> 4, up = (nb >> 2) & 1; \
        const float* W = e < NE ? (up ? p.exp_w_up : p.exp_w_gate) + (size_t)e * D * ED : (up ? p.sh_w_up : p.sh_w_gate); \
        transpose_item(W, ED, (bf16_t*)(ws + WS_WGU) + (size_t)e * 512 * D, D, kb * 64, nb * 32, scr, lane, [](int n) { return (n >> 8) * 128 + (n & 127); }); }
#define ITEM_WD { const int e = it / I_D, r2 = it % I_D, nb = r2 & 31, kb = r2 >> 5; \
        const float* W = e < NE ? p.exp_w_down + (size_t)e * ED * D : p.sh_w_down; \
        transpose_item(W, D, (bf16_t*)(ws + WS_WD) + (size_t)e * D * ED, ED, kb * 64, nb * 32, scr, lane, [](int n) { return n; }); }

    if (IN(0)) { PH_BEGIN();
        {
            LAS float* scl = (LAS float*)(lds + RING_OFF);
            LAS float* part = (LAS float*)(lds + RING_OFF + 16384);
            for (int i = tid; i < BATCH * D; i += 512) scl[i] = silu_f(p.c[i]);
            __syncthreads();
            const int cc = tid & 15, ks = tid >> 4;
            for (int item = bx; item < 6 * D / 16; item += G) { const int j0 = item * 16;
                float wv[32];
#pragma unroll
                for (int k = 0; k < 32; ++k) wv[k] = p.mod_w[(size_t)(ks * 32 + k) * 6 * D + j0 + cc];
                float a0 = 0.f, a1 = 0.f, a2 = 0.f, a3 = 0.f;
#pragma unroll
                for (int k = 0; k < 32; ++k) { const int kk = ks * 32 + k; a0 += scl[kk] * wv[k]; a1 += scl[D + kk] * wv[k]; a2 += scl[2 * D + kk] * wv[k]; a3 += scl[3 * D + kk] * wv[k]; }
                part[(ks * 4 + 0) * 16 + cc] = a0; part[(ks * 4 + 1) * 16 + cc] = a1; part[(ks * 4 + 2) * 16 + cc] = a2; part[(ks * 4 + 3) * 16 + cc] = a3;
                __syncthreads();
                if (tid < 64) { const int b = tid >> 4, c2 = tid & 15; float sacc = p.mod_b[j0 + c2];
                    for (int q = 0; q < 32; ++q) sacc += part[(q * 4 + b) * 16 + c2];
                    modv[b * 6 * D + j0 + c2] = sacc; }
                __syncthreads();
            }
        }
        LAS float* scr = (LAS float*)(lds + RING_OFF + wave * 16384);
        constexpr int I_IN = (D / 64) * (NWIN / 32), I_OUT = (2048 / 64) * (D / 32);
        bf16_t* WinT = (bf16_t*)(ws + WS_WIN_T); bf16_t* WoutT = (bf16_t*)(ws + WS_WOUT_T);
        for (int it = gw; it < I_IN + I_OUT; it += NGW) {
            if (it < I_IN) { const int nb = it % (NWIN / 32), kb = it / (NWIN / 32);
                transpose_item(p.w_in, IN_COLS, WinT, D, kb * 64, nb * 32, scr, lane, [](int n) { return n < 3072 ? n : (n < 4608 ? n + 16 : (n < 4624 ? n - 1536 : -1)); }); }
            else { const int r = it - I_IN, nb = r % (D / 32), kb = r / (D / 32);
                const int k0 = kb * 64;
                transpose_item(p.w_out, D, WoutT, 2048, k0, nb * 32, scr, lane, [](int n) { return n; }, k0 < 1024 ? k0 + 1024 : k0 - 1024, k0 < 1024 ? p.att_norm_g + k0 : nullptr); }
        }
        {
            v4u* rwf = (v4u*)(ws + WS_RWF);
            for (int i = bx * 512 + tid; i < 32 * 4 * 64; i += G * 512) { const int ln = i & 63, nt = (i >> 6) & 3, ks = i >> 8, c = ln & 15, q = ln >> 4;
                float v[8]; unsigned hi[4], lo[4];
#pragma unroll
                for (int j = 0; j < 8; ++j) v[j] = p.router_w[(32 * ks + 8 * q + j) * NE + 16 * nt + c];
#pragma unroll
                for (int j = 0; j < 4; ++j) { hi[j] = pk2(v[2 * j], v[2 * j + 1]); lo[j] = pk2(v[2 * j] - __uint_as_float(hi[j] << 16), v[2 * j + 1] - __uint_as_float(hi[j] & 0xffff0000u)); }
                rwf[((ks * 4 + nt) * 2) * 64 + ln] = (v4u){hi[0], hi[1], hi[2], hi[3]}; rwf[((ks * 4 + nt) * 2 + 1) * 64 + ln] = (v4u){lo[0], lo[1], lo[2], lo[3]}; }
        }
        {
            for (int it = (NE + 1) * I_GU - N_WGU_P0 + gw; it < (NE + 1) * I_GU; it += NGW) ITEM_WGU
        }
        if (BOTH(0)) xcd_barrier(bar);
        PH_END(0);
    }

    if (IN(1)) { PH_BEGIN();
        bf16_t* hn = (bf16_t*)p.out;
        for (int m0 = gw; m0 < M; m0 += 4 * NGW) {
            f32x4 v[4][4]; float s[4];
#pragma unroll
            for (int r = 0; r < 4; ++r) { const int mr = m0 + r * NGW < M ? m0 + r * NGW : M - 1; const GAS f32x4* xr = (const GAS f32x4*)(p.x + (size_t)mr * D) + lane; s[r] = 0.f;
#pragma unroll
                for (int j = 0; j < 4; ++j) v[r][j] = xr[64 * j]; }
#pragma unroll
            for (int r = 0; r < 4; ++r) {
#pragma unroll
                for (int j = 0; j < 4; ++j) s[r] += (v[r][j].x * v[r][j].x + v[r][j].y * v[r][j].y) + (v[r][j].z * v[r][j].z + v[r][j].w * v[r][j].w);
                s[r] = rsqrtf(wave_sum(s[r]) * (1.f / D) + EPS); }
#pragma unroll
            for (int r = 0; r < 4; ++r) { const int m = m0 + r * NGW; if (m >= M) break; const int b = m / SEQ;
                GAS unsigned long long* o8 = (GAS unsigned long long*)(hn + (size_t)m * D) + lane;
#pragma unroll
                for (int j = 0; j < 4; ++j) { const int d = 4 * lane + 256 * j; const f32x4 g = *(const f32x4*)(p.norm1_g + d), sc = *(const f32x4*)(modv + b * 6 * D + D + d), sh = *(const f32x4*)(modv + b * 6 * D + d);
                    const f32x4 h = v[r][j] * s[r] * g * (sc + 1.f) + sh;
                    o8[64 * j] = (unsigned long long)pk2(h.x, h.y) | ((unsigned long long)pk2(h.z, h.w) << 32); } }
        }
        if (BOTH(1)) xcd_barrier(bar);
        PH_END(1);
    }

    if (IN(2)) { PH_BEGIN();
        pg8::DenseOrder S; S.init(p.out, ws + WS_WIN_T, M, NWIN, D, G, bx);
        EpiIn E{(bf16_t*)(ws + WS_ZQ), (bf16_t*)(ws + WS_XBC), (bf16_t*)(ws + WS_K), (bf16_t*)(ws + WS_V), (float*)(ws + WS_DT)};
        pg8::gemm_phase<EpiIn, pg8::DenseOrder, true, true>(lds + RING_OFF, D, S, E);
        STEAL_ITEMS(CW_Q1, (NE + 1) * I_GU - N_WGU_P0, ITEM_WGU);
        if (BOTH(2)) xcd_barrier(bar);
        PH_END(2);
    }

    if (IN(3)) { PH_BEGIN();
        {
            typedef pg8::bf16x8 bf16x8; typedef pg8::f32x4 f4;
            bf16_t* zq = (bf16_t*)(ws + WS_ZQ); const bf16_t* kk = (const bf16_t*)(ws + WS_K); const bf16_t* vv = (const bf16_t*)(ws + WS_V); float* ssq = (float*)(ws + WS_SSQ);
            LAS unsigned char* Kl = lds + RING_OFF; LAS unsigned char* Vl = lds + RING_OFF + 27648; LAS float* biasl = (LAS float*)(lds + RING_OFF + 58368);
            __syncthreads();
            for (int i = tid; i < ATT_HEADS * 192; i += 512) { const int h = i / 192, dist = 159 - (i % 192); biasl[i] = (dist >= 0 && dist < 128) ? p.rel_bias[c_bucket[dist & 127] * ATT_HEADS + h] * 1.4426950408889634f : -INFINITY; }
            const int fr = lane & 15, fg = lane >> 4;
            for (int unit = bx; unit < BATCH * (SEQ / 64); unit += G) {
                const int b = unit / (SEQ / 64), qb = unit % (SEQ / 64), t0 = qb * 64, row0 = b * SEQ + t0;
                v4u kreg[3], vreg[3]; bf16x8 Qn[2][2];
#define ATT_LOADS(KVH) do { _Pragma("unroll") for (int q3 = 0; q3 < 3; ++q3) { const int i = tid + 512 * q3, j = i >> 3, ch = i & 7, kt = t0 - 128 + j; \
                        kreg[q3] = (v4u){0u, 0u, 0u, 0u}; vreg[q3] = (v4u){0u, 0u, 0u, 0u}; \
                        if (kt >= 0) { kreg[q3] = *(const v4u*)(kk + (size_t)(b * SEQ + kt) * D_KV + (KVH) * HD + ch * 8); vreg[q3] = *(const v4u*)(vv + (size_t)(b * SEQ + kt) * D_KV + (KVH) * HD + ch * 8); } } \
                    _Pragma("unroll") for (int r2 = 0; r2 < 2; ++r2) _Pragma("unroll") for (int ks = 0; ks < 2; ++ks) \
                        Qn[r2][ks] = *(const bf16x8*)(zq + (size_t)(row0 + 16 * (2 * (wave & 1) + r2) + fr) * 2048 + ZQ_Q + ((KVH) * 4 + (wave >> 1)) * HD + ks * 32 + 8 * fg); } while (0)
                ATT_LOADS(0);
                for (int kvh = 0; kvh < KV_HEADS; ++kvh) {
                    __syncthreads();
#pragma unroll
                    for (int q3 = 0; q3 < 3; ++q3) { const int i = tid + 512 * q3, j = i >> 3, ch = i & 7; *(LAS v4u*)(Kl + j * 144 + ch * 16) = kreg[q3]; *(LAS v4u*)(Vl + j * 160 + ch * 16) = vreg[q3]; }
                    bf16x8 Qc[2][2];
#pragma unroll
                    for (int r2 = 0; r2 < 2; ++r2)
#pragma unroll
                        for (int ks = 0; ks < 2; ++ks) Qc[r2][ks] = Qn[r2][ks];
                    __syncthreads();
                    if (kvh + 1 < KV_HEADS) ATT_LOADS(kvh + 1);
                    const int head = kvh * 4 + (wave >> 1), rt0 = 2 * (wave & 1), jt0 = rt0;
                    const float sink = p.sinks[head] * 1.4426950408889634f; const LAS float* bl = biasl + head * 192; const bool edge = t0 < 128;
#pragma unroll 1
                    for (int r2 = 0; r2 < 2; ++r2) {
                        const int qi = 16 * (rt0 + r2) + fr;
                        bf16x8 Qf[2];
#pragma unroll
                        for (int ks = 0; ks < 2; ++ks) Qf[ks] = r2 ? Qc[1][ks] : Qc[0][ks];
                        f4 sacc[10];
#pragma unroll
                        for (int jt = 0; jt < 10; ++jt) sacc[jt] = (f4){0.f, 0.f, 0.f, 0.f};
#pragma unroll
                        for (int jt = 0; jt < 10; ++jt)
#pragma unroll
                            for (int ks = 0; ks < 2; ++ks) { const bf16x8 Kf = *(const LAS bf16x8*)(Kl + (16 * (jt0 + jt) + fr) * 144 + (ks * 32 + 8 * fg) * 2);
                                sacc[jt] = __builtin_amdgcn_mfma_f32_16x16x32_bf16(Kf, Qf[ks], sacc[jt], 0, 0, 0); }
                        float mx = sink;
                        { const LAS float* br = bl + (159 - (qi + 128 - 16 * jt0 - 4 * fg));
                          const int lim = (qi + 128 - 16 * jt0 - 4 * fg) - (t0 + qi);
#pragma unroll
                          for (int jt = 0; jt < 10; ++jt)
#pragma unroll
                            for (int j = 0; j < 4; ++j) { float sv = sacc[jt][j] * (0.125f * 1.4426950408889634f) + br[16 * jt + j]; if (edge) sv = (16 * jt + j < lim) ? -INFINITY : sv; sacc[jt][j] = sv; mx = fmaxf(mx, sv); } }
                        mx = fmaxf(mx, __shfl_xor(mx, 16)); mx = fmaxf(mx, __shfl_xor(mx, 32));
                        float ls = 0.f;
#pragma unroll
                        for (int jt = 0; jt < 10; ++jt)
#pragma unroll
                            for (int j = 0; j < 4; ++j) { const float pe = __builtin_amdgcn_exp2f(sacc[jt][j] - mx); sacc[jt][j] = pe; ls += pe; }
                        ls += __shfl_xor(ls, 16); ls += __shfl_xor(ls, 32); ls += __builtin_amdgcn_exp2f(sink - mx);
                        f4 o[4];
#pragma unroll
                        for (int dt = 0; dt < 4; ++dt) o[dt] = (f4){0.f, 0.f, 0.f, 0.f};
#pragma unroll
                        for (int k5 = 0; k5 < 5; ++k5) { const f4 pa = sacc[2 * k5], pb = sacc[2 * k5 + 1];
                            union { bf16x8 v; unsigned u[4]; } Pf; Pf.u[0] = pg8::cvt_pk_bf16(pa[0], pa[1]); Pf.u[1] = pg8::cvt_pk_bf16(pa[2], pa[3]); Pf.u[2] = pg8::cvt_pk_bf16(pb[0], pb[1]); Pf.u[3] = pg8::cvt_pk_bf16(pb[2], pb[3]);
#pragma unroll
                            for (int dt = 0; dt < 4; ++dt) { const bf16x8 Vf = cat44(tr4(Vl, 160, 16 * (jt0 + 2 * k5) + 4 * fg, 16 * dt, lane), tr4(Vl, 160, 16 * (jt0 + 2 * k5 + 1) + 4 * fg, 16 * dt, lane));
                                o[dt] = __builtin_amdgcn_mfma_f32_16x16x32_bf16(Vf, Pf.v, o[dt], 0, 0, 0); } }
                        const float inv = 1.f / ls; float ss = 0.f;
                        bf16_t* op = zq + (size_t)(row0 + qi) * 2048 + ZQ_Q + head * HD + 4 * fg;
#pragma unroll
                        for (int dt = 0; dt < 4; ++dt) { const f4 ov = o[dt] * inv; ss += (ov[0] * ov[0] + ov[1] * ov[1]) + (ov[2] * ov[2] + ov[3] * ov[3]);
                            *(unsigned long long*)(op + 16 * dt) = (unsigned long long)pg8::cvt_pk_bf16(ov[0], ov[1]) | ((unsigned long long)pg8::cvt_pk_bf16(ov[2], ov[3]) << 32); }
                        ss += __shfl_xor(ss, 16); ss += __shfl_xor(ss, 32);
                        if (fg == 0) ssq[(row0 + qi) * 16 + head] = ss;
                    }
                }
            }
            __syncthreads();
        }
        PH_END(3);
    }

    if (IN(4)) { PH_BEGIN();
        typedef pg8::bf16x8 bf16x8; typedef pg8::f32x4 f4;
        const bf16_t* xbc = (const bf16_t*)(ws + WS_XBC); const float* dtr = (const float*)(ws + WS_DT); float* decg = (float*)(ws + WS_CS);
        LAS unsigned char* Xi = lds + RING_OFF; LAS unsigned char* Bi = lds + RING_OFF + 69632; LAS float* wl = (LAS float*)(lds + RING_OFF + 106496);
        const int fr = lane & 15, fg = lane >> 4;
        for (int unit = bx; unit < BATCH * NCHUNK * SSM_GROUPS; unit += G) {
            const int g = unit % SSM_GROUPS, bc = unit / SSM_GROUPS, rowc = bc * CHUNK, tc = rowc % SEQ;
            __syncthreads();
            if (wave < 4) { const int h = g * 4 + wave; const float A = -__expf(p.a_log[h]), bias = p.dt_bias[h];
                const float d0 = softplus_f(dtr[(rowc + lane) * 16 + h] + bias), d1 = softplus_f(dtr[(rowc + lane + 64) * 16 + h] + bias);
                float s0 = d0 * A, s1 = d1 * A;
#pragma unroll
                for (int o = 1; o < 64; o <<= 1) { const float u0 = __shfl_up(s0, o), u1 = __shfl_up(s1, o); if (lane >= o) { s0 += u0; s1 += u1; } }
                s1 += __shfl(s0, 63); const float cl = __shfl(s1, 63);
                wl[wave * 128 + lane] = d0 * __expf(cl - s0); wl[wave * 128 + lane + 64] = d1 * __expf(cl - s1);
                if (lane == 0) decg[bc * 16 + h] = __expf(cl); }
            __syncthreads();
            if (tid < 384) { const int co = tid % 48, l0 = 16 * (tid / 48);
                const int ch = co < 32 ? g * 256 + co * 8 : D_SSM + g * D_STATE + (co - 32) * 8;
                LAS unsigned char* dst = co < 32 ? Xi + l0 * 544 + co * 16 : Bi + l0 * 288 + (co - 32) * 16; const int st = co < 32 ? 544 : 288;
                const LAS float* wr_ = wl + (co < 32 ? (co >> 3) * 128 : 0) + l0; const bool scale = co < 32;
                conv16x8(xbc, p.conv_w, p.conv_b, rowc + l0, tc + l0, ch, [&](int r, const float (&o)[8]) { const float w = scale ? wr_[r] : 1.f;
                    *(LAS v4u*)(dst + r * st) = (v4u){pk2(o[0] * w, o[1] * w), pk2(o[2] * w, o[3] * w), pk2(o[4] * w, o[5] * w), pk2(o[6] * w, o[7] * w)}; }); }
            __syncthreads();
            bf16x8 Bf[4];
#pragma unroll
            for (int kk = 0; kk < 4; ++kk) Bf[kk] = cat44(tr4(Bi, 288, 32 * kk + 4 * fg, 16 * wave, lane), tr4(Bi, 288, 32 * kk + 16 + 4 * fg, 16 * wave, lane));
#pragma unroll
            for (int r4 = 0; r4 < 4; ++r4) { const int h = g * 4 + r4; float* S = p.out + (size_t)(bc * SSM_HEADS + h) * HD * D_STATE;
#pragma unroll
                for (int pt = 0; pt < 4; ++pt) { f4 acc = (f4){0.f, 0.f, 0.f, 0.f};
#pragma unroll
                    for (int kk = 0; kk < 4; ++kk) { const bf16x8 Af = cat44(tr4(Xi, 544, 32 * kk + 4 * fg, r4 * 64 + 16 * pt, lane), tr4(Xi, 544, 32 * kk + 16 + 4 * fg, r4 * 64 + 16 * pt, lane)); acc = __builtin_amdgcn_mfma_f32_16x16x32_bf16(Af, Bf[kk], acc, 0, 0, 0); }
#pragma unroll
                    for (int j = 0; j < 4; ++j) S[(16 * pt + 4 * fg + j) * D_STATE + 16 * wave + fr] = acc[j]; } }
        }
        if (BOTH(4)) xcd_barrier(bar);
        PH_END(4);
    }

    if (IN(5)) { PH_BEGIN();
        const float* S = p.out; const float* decg = (const float*)(ws + WS_CS); bf16_t* St = (bf16_t*)(ws + WS_ST);
        for (int i = bx * 512 + tid; i < BATCH * SSM_HEADS * HD * D_STATE / 2; i += G * 512) {
            const int pn = (i % (HD * D_STATE / 2)) * 2, bh = i / (HD * D_STATE / 2), h = bh % SSM_HEADS, b = bh / SSM_HEADS;
            float s0 = 0.f, s1 = 0.f;
#pragma unroll 4
            for (int c = 0; c < NCHUNK; ++c) { const size_t idx = ((size_t)((b * NCHUNK + c) * SSM_HEADS + h)) * HD * D_STATE + pn; const float2 sv = *(const float2*)(S + idx);
                *(unsigned*)(St + idx) = pk2(s0, s1); const float dec = decg[(b * NCHUNK + c) * 16 + h]; s0 = s0 * dec + sv.x; s1 = s1 * dec + sv.y; }
        }
        {
            const float* ssq = (const float*)(ws + WS_SSQ); float* ratt = (float*)(ws + WS_RATT);
            for (int m = bx * 512 + tid; m < M; m += G * 512) { const f32x4* sp = (const f32x4*)(ssq + (size_t)m * 16); const f32x4 a = sp[0], b = sp[1], c = sp[2], d = sp[3];
                const float sacc = ((a.x + a.y) + (a.z + a.w)) + ((b.x + b.y) + (b.z + b.w)) + ((c.x + c.y) + (c.z + c.w)) + ((d.x + d.y) + (d.z + d.w));
                ratt[m] = rsqrtf(sacc * (1.f / 1024.f) + EPS); }
        }
        if (BOTH(5)) xcd_barrier(bar);
        PH_END(5);
    }

    if (IN(6)) { PH_BEGIN();
        typedef pg8::bf16x8 bf16x8; typedef pg8::f32x4 f4;
        const bf16_t* xbc = (const bf16_t*)(ws + WS_XBC); const float* dtr = (const float*)(ws + WS_DT); bf16_t* zq = (bf16_t*)(ws + WS_ZQ); const bf16_t* Stg = (const bf16_t*)(ws + WS_ST);
        LAS unsigned char* Xi = lds + RING_OFF; LAS unsigned char* Bi = lds + RING_OFF + 69632; LAS unsigned char* Ci = lds + RING_OFF + 106496;
        LAS float* csl = (LAS float*)(lds + RING_OFF + 143360); LAS float* dtl = csl + 512;
        const int fr = lane & 15, fg = lane >> 4;
        for (int unit = bx; unit < BATCH * NCHUNK * SSM_GROUPS; unit += G) {
            const int g = unit % SSM_GROUPS, bc = unit / SSM_GROUPS, rowc = bc * CHUNK, tc = rowc % SEQ;
            __syncthreads();
            const unsigned long long _s0 = SUB_T();
            if (wave < 4) { const int h = g * 4 + wave; const float A = -__expf(p.a_log[h]), bias = p.dt_bias[h];
                const float d0 = softplus_f(dtr[(rowc + lane) * 16 + h] + bias), d1 = softplus_f(dtr[(rowc + lane + 64) * 16 + h] + bias);
                float s0 = d0 * A, s1 = d1 * A;
#pragma unroll
                for (int o = 1; o < 64; o <<= 1) { const float u0 = __shfl_up(s0, o), u1 = __shfl_up(s1, o); if (lane >= o) { s0 += u0; s1 += u1; } }
                s1 += __shfl(s0, 63);
                csl[wave * 128 + lane] = s0; csl[wave * 128 + lane + 64] = s1; dtl[wave * 128 + lane] = d0; dtl[wave * 128 + lane + 64] = d1; }
            { const int co = tid & 63, l0 = 16 * (tid >> 6);
                const int ch = co < 32 ? g * 256 + co * 8 : (co < 48 ? D_SSM + g * D_STATE + (co - 32) * 8 : D_SSM + SSM_GROUPS * D_STATE + g * D_STATE + (co - 48) * 8);
                LAS unsigned char* dst = co < 32 ? Xi + l0 * 544 + co * 16 : (co < 48 ? Bi + l0 * 288 + (co - 32) * 16 : Ci + l0 * 288 + (co - 48) * 16); const int st = co < 32 ? 544 : 288;
                conv16x8(xbc, p.conv_w, p.conv_b, rowc + l0, tc + l0, ch, [&](int r, const float (&o)[8]) {
                    *(LAS v4u*)(dst + r * st) = (v4u){pk2(o[0], o[1]), pk2(o[2], o[3]), pk2(o[4], o[5]), pk2(o[6], o[7])}; }); }
            __syncthreads();
            SUB_END(0, _s0); const unsigned long long _s1 = SUB_T();
            const int lrow = 16 * wave + fr;
            bf16x8 Cf[4];
#pragma unroll
            for (int kk = 0; kk < 4; ++kk) Cf[kk] = *(const LAS bf16x8*)(Ci + lrow * 288 + (4 * kk + fg) * 16);
            f4 Gt[8];
#pragma unroll
            for (int st = 0; st < 8; ++st) { Gt[st] = (f4){0.f, 0.f, 0.f, 0.f};
                if (st <= wave) {
#pragma unroll
                    for (int kk = 0; kk < 4; ++kk) { const bf16x8 Bf = *(const LAS bf16x8*)(Bi + (16 * st + fr) * 288 + (4 * kk + fg) * 16);
                        Gt[st] = __builtin_amdgcn_mfma_f32_16x16x32_bf16(Bf, Cf[kk], Gt[st], 0, 0, 0); } } }
            SUB_END(1, _s1); const unsigned long long _s2 = SUB_T();
            f4 Y[4][4];
            const bf16_t* zr0 = zq + (size_t)(rowc + lrow) * 2048 + ZQ_Z + g * 256 + 4 * fg; unsigned long long zz[4][4];
#pragma unroll
            for (int r4 = 0; r4 < 4; ++r4)
#pragma unroll
                for (int pt = 0; pt < 4; ++pt) zz[r4][pt] = *(const unsigned long long*)(zr0 + r4 * 64 + 16 * pt);
            const bf16_t* St0 = Stg + (size_t)(bc * SSM_HEADS + g * 4) * HD * D_STATE;
            __syncthreads();
            v4u stn[4];
#pragma unroll
            for (int q = 0; q < 4; ++q) { const int i = tid + 512 * q, h2 = i >> 10, pp = (i >> 4) & 63, ch = i & 15;
                const v4u v = *(const v4u*)(St0 + (size_t)h2 * HD * D_STATE + pp * D_STATE + ch * 8); *(LAS v4u*)(Bi + h2 * 17408 + pp * 272 + ch * 16) = v;
                stn[q] = *(const v4u*)(St0 + (size_t)(2 + h2) * HD * D_STATE + pp * D_STATE + ch * 8); }
            __syncthreads();
#pragma unroll
            for (int hp = 0; hp < 2; ++hp) {
                if (hp == 1) { __syncthreads();
#pragma unroll
                    for (int q = 0; q < 4; ++q) { const int i = tid + 512 * q, h2 = i >> 10, pp = (i >> 4) & 63, ch = i & 15; *(LAS v4u*)(Bi + h2 * 17408 + pp * 272 + ch * 16) = stn[q]; }
                    __syncthreads(); }
#pragma unroll
                for (int h2 = 0; h2 < 2; ++h2) { const int r4 = 2 * hp + h2; const float ecl = __expf(csl[r4 * 128 + lrow]);
#pragma unroll
                    for (int pt = 0; pt < 4; ++pt) { f4 acc = (f4){0.f, 0.f, 0.f, 0.f};
#pragma unroll
                        for (int kk = 0; kk < 4; ++kk) { const bf16x8 Sf = *(const LAS bf16x8*)(Bi + h2 * 17408 + (16 * pt + fr) * 272 + (4 * kk + fg) * 16); acc = __builtin_amdgcn_mfma_f32_16x16x32_bf16(Sf, Cf[kk], acc, 0, 0, 0); }
                        Y[r4][pt] = acc * ecl; } }
            }
#pragma unroll
            for (int r4 = 0; r4 < 4; ++r4) { const int h = g * 4 + r4; const float cl = csl[r4 * 128 + lrow];
#pragma unroll
                for (int k4 = 0; k4 < 4; ++k4) { if (2 * k4 <= wave) {
                    union { bf16x8 v; unsigned u[4]; } Pf;
#pragma unroll
                    for (int hh = 0; hh < 2; ++hh) { const int st = 2 * k4 + hh; const f4 c4 = *(const LAS f4*)(csl + r4 * 128 + 16 * st + 4 * fg), d4 = *(const LAS f4*)(dtl + r4 * 128 + 16 * st + 4 * fg);
                        float mv[4];
#pragma unroll
                        for (int j = 0; j < 4; ++j) { const int s = 16 * st + 4 * fg + j; mv[j] = (s <= lrow) ? Gt[st][j] * __expf(cl - c4[j]) * d4[j] : 0.f; }
                        Pf.u[2 * hh] = pg8::cvt_pk_bf16(mv[0], mv[1]); Pf.u[2 * hh + 1] = pg8::cvt_pk_bf16(mv[2], mv[3]); }
#pragma unroll
                    for (int pt = 0; pt < 4; ++pt) { const bf16x8 Xf = cat44(tr4(Xi, 544, 32 * k4 + 4 * fg, r4 * 64 + 16 * pt, lane), tr4(Xi, 544, 32 * k4 + 16 + 4 * fg, r4 * 64 + 16 * pt, lane));
                        Y[r4][pt] = __builtin_amdgcn_mfma_f32_16x16x32_bf16(Xf, Pf.v, Y[r4][pt], 0, 0, 0); } } }
                const float dsk = p.d_skip[h];
#pragma unroll
                for (int pt = 0; pt < 4; ++pt) { const unsigned long long xx = *(const LAS unsigned long long*)(Xi + lrow * 544 + (r4 * 64 + 16 * pt + 4 * fg) * 2); const unsigned x0 = (unsigned)xx, x1 = (unsigned)(xx >> 32);
                    Y[r4][pt][0] += dsk * __uint_as_float(x0 << 16); Y[r4][pt][1] += dsk * __uint_as_float(x0 & 0xffff0000u); Y[r4][pt][2] += dsk * __uint_as_float(x1 << 16); Y[r4][pt][3] += dsk * __uint_as_float(x1 & 0xffff0000u); }
            }
            SUB_END(2, _s2); const unsigned long long _s3 = SUB_T();
            bf16_t* zr = zq + (size_t)(rowc + lrow) * 2048 + ZQ_Z + g * 256 + 4 * fg; float ss = 0.f;
#pragma unroll
            for (int r4 = 0; r4 < 4; ++r4)
#pragma unroll
                for (int pt = 0; pt < 4; ++pt) { const unsigned z0 = (unsigned)zz[r4][pt], z1 = (unsigned)(zz[r4][pt] >> 32);
                    f4 v = Y[r4][pt]; v[0] *= silu_f(__uint_as_float(z0 << 16)); v[1] *= silu_f(__uint_as_float(z0 & 0xffff0000u)); v[2] *= silu_f(__uint_as_float(z1 << 16)); v[3] *= silu_f(__uint_as_float(z1 & 0xffff0000u));
                    Y[r4][pt] = v; ss += (v[0] * v[0] + v[1] * v[1]) + (v[2] * v[2] + v[3] * v[3]); }
            ss += __shfl_xor(ss, 16); ss += __shfl_xor(ss, 32);
            const float rr = rsqrtf(ss * (1.f / 256.f) + EPS);
#pragma unroll
            for (int r4 = 0; r4 < 4; ++r4)
#pragma unroll
                for (int pt = 0; pt < 4; ++pt) { const f4 gn = *(const f4*)(p.ssm_norm_g + g * 256 + r4 * 64 + 16 * pt + 4 * fg); const f4 v = Y[r4][pt] * rr * gn;
                    *(unsigned long long*)(zr + r4 * 64 + 16 * pt) = (unsigned long long)pg8::cvt_pk_bf16(v[0], v[1]) | ((unsigned long long)pg8::cvt_pk_bf16(v[2], v[3]) << 32); }
            SUB_END(3, _s3);
        }
        if (BOTH(6)) xcd_barrier(bar);
        PH_END(6);
    }

    if (IN(7)) { PH_BEGIN();
        pg8::DenseOrder S; S.init(ws + WS_ZQ, ws + WS_WOUT_T, M, D, 2048, G, bx);
        EpiOut E{p.x, p.out, modv, (const float*)(ws + WS_RATT)};
        pg8::gemm_phase<EpiOut, pg8::DenseOrder, true, true>(lds + RING_OFF, 2048, S, E);
        if (BOTH(7)) xcd_barrier(bar);
        PH_END(7);
    }

    if (IN(8)) { PH_BEGIN();
        typedef pg8::bf16x8 bf16x8; typedef pg8::f32x4 f4;
        LAS float* part = (LAS float*)(lds + RING_OFF);
        LAS float* red = (LAS float*)(lds + RING_OFF + 131072);
        LAS int* cnt_l = (LAS int*)(lds + RING_OFF + 133120);
        LAS int* base_l = (LAS int*)(lds + RING_OFF + 133376);
        LAS int* asg_e = (LAS int*)(lds + RING_OFF + 133632);
        LAS int* asg_pos = (LAS int*)(lds + RING_OFF + 135680);
        LAS float* asg_g = (LAS float*)(lds + RING_OFF + 137728);
        bf16_t* h2 = (bf16_t*)(ws + WS_H2); int* cnt = (int*)(ws + WS_CTL) + CW_CNT; int* list = (int*)(ws + WS_LIST); unsigned* pmeta = (unsigned*)(ws + WS_GLIST);
        const v4u* rwf = (const v4u*)(ws + WS_RWF);
        const float rbias = p.router_bias[lane];
        const int fr = lane & 15, fq = lane >> 4;
        for (int grp = bx; grp < M / 64; grp += G) {
            const int b = (grp * 64) / SEQ;
            __syncthreads();
            if (tid < NE) cnt_l[tid] = 0;
#pragma unroll 1
            for (int half = 0; half < 2; ++half) {
            f4 xv[2][4][2];
#pragma unroll
            for (int tile = 0; tile < 2; ++tile) { const float* xr = p.out + (size_t)(grp * 64 + half * 32 + tile * 16 + fr) * D + 128 * wave + 8 * fq;
#pragma unroll
                for (int kk = 0; kk < 4; ++kk) { xv[tile][kk][0] = *(const f4*)(xr + 32 * kk); xv[tile][kk][1] = *(const f4*)(xr + 32 * kk + 4); } }
#pragma unroll
            for (int tile = 0; tile < 2; ++tile) { float ss = 0.f;
#pragma unroll
                for (int kk = 0; kk < 4; ++kk)
#pragma unroll
                    for (int hf = 0; hf < 2; ++hf) { const f4 v = xv[tile][kk][hf]; ss += (v[0] * v[0] + v[1] * v[1]) + (v[2] * v[2] + v[3] * v[3]); }
                ss += __shfl_xor(ss, 16); ss += __shfl_xor(ss, 32);
                if (fq == 0) red[(tile * 8 + wave) * 16 + fr] = ss; }
            __syncthreads();
            float rstd2[2]; f4 acc[2][4];
#pragma unroll
            for (int tile = 0; tile < 2; ++tile) { float tot = 0.f;
#pragma unroll
                for (int w2 = 0; w2 < 8; ++w2) tot += red[(tile * 8 + w2) * 16 + fr];
                rstd2[tile] = rsqrtf(tot * (1.f / D) + EPS);
#pragma unroll
                for (int nt = 0; nt < 4; ++nt) acc[tile][nt] = (f4){0.f, 0.f, 0.f, 0.f}; }
#pragma unroll
            for (int kk = 0; kk < 4; ++kk) { const int d = 128 * wave + 32 * kk + 8 * fq;
                f4 gm[2], sm[2];
#pragma unroll
                for (int hf = 0; hf < 2; ++hf) { gm[hf] = *(const f4*)(p.norm2_g + d + 4 * hf) * (*(const f4*)(modv + b * 6 * D + 4 * D + d + 4 * hf) + 1.f); sm[hf] = *(const f4*)(modv + b * 6 * D + 3 * D + d + 4 * hf); }
                union { bf16x8 v; v4u q; } Rh[4], Rl[4];
#pragma unroll
                for (int nt = 0; nt < 4; ++nt) { const int fi = (((4 * wave + kk) * 4 + nt) * 2) * 64 + lane; Rh[nt].q = rwf[fi]; Rl[nt].q = rwf[fi + 64]; }
#pragma unroll
                for (int tile = 0; tile < 2; ++tile) { const int row = grp * 64 + half * 32 + tile * 16 + fr;
                    union { bf16x8 v; unsigned u[4]; v4u q; } Hh, Hl;
#pragma unroll
                    for (int hf = 0; hf < 2; ++hf) { const f4 h = xv[tile][kk][hf] * rstd2[tile] * gm[hf] + sm[hf];
                        const unsigned h01 = pk2(h[0], h[1]), h23 = pk2(h[2], h[3]);
                        Hh.u[2 * hf] = h01; Hh.u[2 * hf + 1] = h23;
                        Hl.u[2 * hf] = pk2(h[0] - __uint_as_float(h01 << 16), h[1] - __uint_as_float(h01 & 0xffff0000u)); Hl.u[2 * hf + 1] = pk2(h[2] - __uint_as_float(h23 << 16), h[3] - __uint_as_float(h23 & 0xffff0000u)); }
                    *(v4u*)(h2 + (size_t)row * D + d) = Hh.q;
#pragma unroll
                    for (int nt = 0; nt < 4; ++nt) {
                        acc[tile][nt] = __builtin_amdgcn_mfma_f32_16x16x32_bf16(Hh.v, Rh[nt].v, acc[tile][nt], 0, 0, 0);
                        acc[tile][nt] = __builtin_amdgcn_mfma_f32_16x16x32_bf16(Hh.v, Rl[nt].v, acc[tile][nt], 0, 0, 0);
                        acc[tile][nt] = __builtin_amdgcn_mfma_f32_16x16x32_bf16(Hl.v, Rh[nt].v, acc[tile][nt], 0, 0, 0); } }
                asm volatile("" ::: "memory"); }
#pragma unroll
            for (int tile = 0; tile < 2; ++tile)
#pragma unroll
                for (int nt = 0; nt < 4; ++nt)
#pragma unroll
                    for (int j = 0; j < 4; ++j) part[((tile * 8 + wave) * 16 + 4 * fq + j) * 64 + 16 * nt + fr] = acc[tile][nt][j];
            __syncthreads();
#pragma unroll 1
            for (int rr = 0; rr < 4; ++rr) { const int lr32 = 4 * wave + rr, tile = lr32 >> 4, lr = lr32 & 15, lr64 = half * 32 + lr32, m = grp * 64 + lr64;
                float lg = 0.f;
#pragma unroll
                for (int w2 = 0; w2 < 8; ++w2) lg += part[((tile * 8 + w2) * 16 + lr) * 64 + lane];
                const float sc = 1.f / (1.f + __expf(-lg)), sel = sc + rbias;
                float m1 = sel, m2 = -INFINITY;
#pragma unroll
                for (int o = 1; o < 8; o <<= 1) { const float p1 = __shfl_xor(m1, o), p2 = __shfl_xor(m2, o); const float n1 = fmaxf(m1, p1), n2 = fmaxf(fminf(m1, p1), fmaxf(m2, p2)); m1 = n1; m2 = n2; }
                const float gs = m1 + m2; const int myg = lane >> 3;
                unsigned gk = __float_as_uint(gs); gk = (gk & 0x80000000u) ? ~gk : (gk | 0x80000000u); gk = (gk & ~7u) | (unsigned)(7 - myg);
                int grank = 0;
#pragma unroll
                for (int g2 = 0; g2 < 8; ++g2) grank += (__builtin_amdgcn_readlane(gk, g2 * 8) > gk) ? 1 : 0;
                const bool allowed = grank < 4;
                unsigned ek = __float_as_uint(sel); ek = (ek & 0x80000000u) ? ~ek : (ek | 0x80000000u); ek = allowed ? ((ek & ~63u) | (unsigned)(63 - lane)) : 0u;
                int rank = 0;
#pragma unroll
                for (int e2 = 0; e2 < NE; ++e2) rank += (__builtin_amdgcn_readlane(ek, e2) > ek) ? 1 : 0;
                const bool selb = allowed && rank < TOPK;
                const float wsum = wave_sum(selb ? sc : 0.f);
                if (selb) { const float gate = sc / wsum * 2.5f; const int pl = __hip_atomic_fetch_add(cnt_l + lane, 1, __ATOMIC_RELAXED, __HIP_MEMORY_SCOPE_WORKGROUP); const int i = lr64 * 8 + rank; asg_e[i] = lane; asg_pos[i] = pl; asg_g[i] = gate; }
            }
            __syncthreads();
            }
            if (tid < NE) { int t2 = tid; asm volatile("" : "+v"(t2)); const int c = cnt_l[t2]; base_l[t2] = c > 0 ? atomicAdd(&cnt[t2], c) : 0; }
            __syncthreads();
            { const int e = asg_e[tid]; const size_t li = (size_t)e * M + base_l[e] + asg_pos[tid]; list[li] = (grp * 64 + (tid >> 3)) * 8 + (tid & 7); pmeta[li] = ((unsigned)((grp * 64 + (tid >> 3)) * NSLOT + (tid & 7)) << 14) | (unsigned)__float2int_rn(asg_g[tid] * 4096.f); }
        }
        if (BOTH(8)) xcd_barrier(bar);
        PH_END(8);
    }

    LAS int* plan = (LAS int*)(lds + PLAN_OFF);
#define MAKE_PLAN() do { __syncthreads(); if (tid <= NE) plan[80 + tid] = tid < NE ? (int)__hip_atomic_load((const int*)(ws + WS_CTL) + CW_CNT + tid, RLX_AGENT) : M; __syncthreads(); \
        if (tid == 0) { int off = 0; for (int e = 0; e <= NE; ++e) { plan[e] = off; off += (plan[80 + e] + 255) >> 8; } plan[NE + 1] = off; } __syncthreads(); } while (0)
    if (IN(9)) { PH_BEGIN();
        MAKE_PLAN();
        GroupedOrder<true> S; S.init(ws + WS_H2, ws + WS_WGU, D, 2, G, bx, plan, (const int*)(ws + WS_LIST), (size_t)512 * D * 2, (size_t)256 * D * 2, 0);
        EpiGU E{(bf16_t*)(ws + WS_U)};
        pg8::gemm_phase<EpiGU, GroupedOrder<true>, true, true>(lds + RING_OFF, D, S, E);
        STEAL_ITEMS(CW_Q2, (NE + 1) * I_D, ITEM_WD);
        if (BOTH(9)) xcd_barrier(bar);
        PH_END(9);
    }
    if (IN(10)) { PH_BEGIN(); MAKE_PLAN();
        GroupedOrder<false> S; S.init(ws + WS_U, ws + WS_WD, ED, 4, G, bx, plan, (const int*)(ws + WS_LIST), (size_t)D * ED * 2, (size_t)256 * ED * 2, 0);
        EpiDown E{(unsigned char*)(ws + WS_YC), (const unsigned*)(ws + WS_GLIST), ws + WS_DUMP + (size_t)bx * 8192};
        pg8::gemm_phase<EpiDown, GroupedOrder<false>, true, true, true>(lds + RING_OFF, ED, S, E);
        if (BOTH(10)) xcd_barrier(bar);
        PH_END(10);
    }
    if (IN(11)) { PH_BEGIN();
        typedef float f2 __attribute__((ext_vector_type(2)));
        const unsigned char* yc = (const unsigned char*)(ws + WS_YC);
        const int c0 = (lane >> 4) * 256 + ((lane >> 2) & 3) * 32 + (lane & 3) * 8;
        for (int m = gw; m < M; m += NGW) { const int b = m / SEQ;
            float s[16];
#pragma unroll
            for (int j = 0; j < 16; ++j) s[j] = 0.f;
#pragma unroll
            for (int k = 0; k < NSLOT; ++k) { const v4u raw = *(const v4u*)(yc + ((size_t)m * NSLOT + k) * 1024 + lane * 16); const unsigned w4[4] = {raw.x, raw.y, raw.z, raw.w};
#pragma unroll
                for (int q = 0; q < 4; ++q) { const f2 lo = __builtin_amdgcn_cvt_pk_f32_fp8((int)w4[q], false), hi = __builtin_amdgcn_cvt_pk_f32_fp8((int)w4[q], true);
                    s[4 * q] += lo.x; s[4 * q + 1] += lo.y; s[4 * q + 2] += hi.x; s[4 * q + 3] += hi.y; } }
            float* xo = p.out + (size_t)m * D; const float* g2 = modv + b * 6 * D + 5 * D;
            f32x4 xv[4]; float ss = 0.f;
#pragma unroll
            for (int q = 0; q < 4; ++q) { const int c = c0 + (q >> 1) * 128 + (q & 1) * 4; const f32x4 gv = *(const f32x4*)(g2 + c) * (1.f / YC_SCALE);
                xv[q] = *(const f32x4*)(xo + c) + gv * (f32x4){s[4 * q], s[4 * q + 1], s[4 * q + 2], s[4 * q + 3]};
                ss += (xv[q].x * xv[q].x + xv[q].y * xv[q].y) + (xv[q].z * xv[q].z + xv[q].w * xv[q].w); }
            const float rstd = rsqrtf(wave_sum(ss) * (1.f / D) + EPS);
#pragma unroll
            for (int q = 0; q < 4; ++q) { const int c = c0 + (q >> 1) * 128 + (q & 1) * 4; *(f32x4*)(xo + c) = xv[q] * rstd * *(const f32x4*)(p.final_g + c); }
        }
        PH_END(11);
    }
#undef IN
#undef BOTH
}

extern "C" void kernel_launch(void* const* d_in, const int* in_sizes, int n_in, void* d_out, int out_size, void* d_ws, size_t ws_size, hipStream_t stream) {
    static int grid = 0;
    if (grid == 0) {
        int dev = 0, cus = 0;
        if (hipGetDevice(&dev) != hipSuccess || hipDeviceGetAttribute(&cus, hipDeviceAttributeMultiprocessorCount, dev) != hipSuccess) { fprintf(stderr, "device query failed\n"); grid = -1; return; }
        if (hipFuncSetAttribute((const void*)mega, hipFuncAttributeMaxDynamicSharedMemorySize, LDS_BYTES) != hipSuccess) { fprintf(stderr, "hipFuncSetAttribute failed\n"); grid = -1; return; }
        int per_cu = 0;
        if (hipOccupancyMaxActiveBlocksPerMultiprocessor(&per_cu, (const void*)mega, NWAVES * 64, LDS_BYTES) != hipSuccess || per_cu < 1) fprintf(stderr, "occupancy query: %d\n", per_cu);
        (void)hipGetLastError();
        grid = cus;
        if (ws_size < WS_END) fprintf(stderr, "ws too small: %zu < %zu\n", ws_size, (size_t)WS_END);
    }
    if (grid < 0) return;
    P p{};
    const float** f = (const float**)&p;
    for (int i = 0; i < 26; ++i) f[i] = (const float*)d_in[i];
    p.out = (float*)d_out; p.ws = (unsigned char*)d_ws;
    (void)hipMemsetAsync(p.ws + WS_CTL, 0, CTL_BYTES, stream);
    p.ph_lo = 0; p.ph_hi = NPHASE; p.li = 0;
    hipLaunchKernelGGL(mega, dim3(grid), dim3(NWAVES * 64), LDS_BYTES, stream, p);
}
```
